# Optimizing an MI355X kernel written in HIP

```python
import math
import jax, jax.numpy as jnp
from jax import lax
import numpy as np

D_MODEL = 1024
BATCH = 16
SEQ = 4096
DEPTH = 1

HEAD_DIM = 64
ROPE_THETA = 500000.0
NORM_EPS = 1e-6
Q_BLOCK = 128

MLA_HEADS = 8
MLA_Q_RANK = 256
MLA_KV_RANK = 128
MLA_NOPE_DIM = 64
MLA_ROPE_DIM = 32
MLA_V_DIM = 64
MLA_WIDTH = MLA_HEADS * MLA_V_DIM

NSA_HEADS = 8
NSA_KV_GROUPS = 2
NSA_HPG = NSA_HEADS // NSA_KV_GROUPS
NSA_ROPE_DIM = HEAD_DIM // 4
NSA_WIDTH = NSA_HEADS * HEAD_DIM
NSA_KV_WIDTH = NSA_KV_GROUPS * HEAD_DIM
CMP_BLOCK = 32
CMP_STRIDE = 16
CMP_HIDDEN = 2 * HEAD_DIM
SLC_BLOCK = 64
SLC_TOPK = 16
WINDOW = 512
FORCE_SCORE = 1e9

MIX_WIDTH = MLA_WIDTH + NSA_WIDTH
D_FF = 4 * D_MODEL

IN_SIZES = (MLA_Q_RANK, MLA_KV_RANK, MLA_ROPE_DIM, NSA_WIDTH, 6 * NSA_KV_WIDTH, 3 * NSA_HEADS)
IN_COLS = MLA_Q_RANK + MLA_KV_RANK + MLA_ROPE_DIM + NSA_WIDTH + 6 * NSA_KV_WIDTH + 3 * NSA_HEADS

kernel_name = 'hymba_mla_nsa_hybrid_layer'


def rmsnorm(x, g):
    xf = x.astype(jnp.float32)
    y = xf * lax.rsqrt(jnp.mean(xf * xf, axis=-1, keepdims=True) + NORM_EPS)
    return (y * g.astype(jnp.float32)).astype(x.dtype)


def rope_tables(pos, dim):
    inv_freq = jnp.exp(-math.log(ROPE_THETA) * jnp.arange(0, dim, 2, dtype=jnp.float32) / dim)
    ang = pos.astype(jnp.float32)[:, None] * inv_freq[None, :]
    return jnp.cos(ang), jnp.sin(ang)


def apply_rope(x, cos, sin):
    half = x.shape[-1] // 2
    xf = x.astype(jnp.float32)
    x1, x2 = xf[..., :half], xf[..., half:]
    c = cos[None, :, None, :]
    s = sin[None, :, None, :]
    return jnp.concatenate([x1 * c - x2 * s, x2 * c + x1 * s], axis=-1).astype(x.dtype)


def partial_rope(x, cos, sin):
    return jnp.concatenate([apply_rope(x[..., :NSA_ROPE_DIM], cos, sin), x[..., NSA_ROPE_DIM:]], axis=-1)


def masked_softmax(s, mask):
    s = jnp.where(mask, s, -jnp.inf)
    m = jnp.max(s, axis=-1, keepdims=True)
    m = jnp.where(jnp.isfinite(m), m, 0.0)
    p = jnp.exp(s - m)
    return p / jnp.maximum(jnp.sum(p, axis=-1, keepdims=True), 1e-30)


def to_blocks(a):
    b, s = a.shape[0], a.shape[1]
    return a.reshape(b, s // Q_BLOCK, Q_BLOCK, *a.shape[2:]).swapaxes(0, 1)


def from_blocks(a):
    nb, b, qb = a.shape[0], a.shape[1], a.shape[2]
    return a.swapaxes(0, 1).reshape(b, nb * qb, *a.shape[3:])


def mla_mixer(c_q, c_kv, k_rope, g_cq, w_uq, g_ckv, w_ukv, cos, sin):
    B, S, _ = c_q.shape
    q = (rmsnorm(c_q, g_cq) @ w_uq).reshape(B, S, MLA_HEADS, MLA_NOPE_DIM + MLA_ROPE_DIM)
    q_nope = q[..., :MLA_NOPE_DIM]
    q_pe = apply_rope(q[..., MLA_NOPE_DIM:], cos, sin)
    kv = (rmsnorm(c_kv, g_ckv) @ w_ukv).reshape(B, S, MLA_HEADS, MLA_NOPE_DIM + MLA_V_DIM)
    k_nope = kv[..., :MLA_NOPE_DIM]
    v = kv[..., MLA_NOPE_DIM:]
    k_pe = apply_rope(k_rope[:, :, None, :], cos, sin)[:, :, 0]
    scale = (MLA_NOPE_DIM + MLA_ROPE_DIM) ** -0.5
    kpos = jnp.arange(S)

    def attend(blk):
        qn, qp, qpos = blk
        s = (jnp.einsum('bqhd,bkhd->bhqk', qn, k_nope, preferred_element_type=jnp.float32)
             + jnp.einsum('bqhr,bkr->bhqk', qp, k_pe, preferred_element_type=jnp.float32)) * scale
        p = masked_softmax(s, kpos[None, :] <= qpos[:, None])
        return jnp.einsum('bhqk,bkhd->bqhd', p.astype(v.dtype), v)

    out = lax.map(attend, (to_blocks(q_nope), to_blocks(q_pe), kpos.reshape(-1, Q_BLOCK)))
    return from_blocks(out).reshape(B, S, MLA_WIDTH)


def compress_blocks(x, pe, w1, b1, w2, b2):
    B, S, G, dh = x.shape
    n_cmp = (S - CMP_BLOCK) // CMP_STRIDE + 1
    idx = jnp.arange(n_cmp)[:, None] * CMP_STRIDE + jnp.arange(CMP_BLOCK)[None, :]
    blocks = x[:, idx] + pe[None, None, :, None, :].astype(x.dtype)
    flat = blocks.transpose(0, 1, 3, 2, 4).reshape(B, n_cmp, G, CMP_BLOCK * dh)
    hid = jax.nn.gelu(flat @ w1 + b1)
    return hid @ w2 + b2


def nsa_mixer(q, kv_tok, gate_logits, cmp_pe_k, cmp_w1_k, cmp_b1_k, cmp_w2_k, cmp_b2_k,
              cmp_pe_v, cmp_w1_v, cmp_b1_v, cmp_w2_v, cmp_b2_v, cos, sin):
    B, S, H, dh = q.shape
    G = NSA_KV_GROUPS
    dt = q.dtype
    scale = dh ** -0.5
    q = partial_rope(q, cos, sin)
    k_slc = partial_rope(kv_tok[:, :, 2], cos, sin)
    v_slc = kv_tok[:, :, 3]
    k_win = partial_rope(kv_tok[:, :, 4], cos, sin)
    v_win = kv_tok[:, :, 5]

    n_cmp = (S - CMP_BLOCK) // CMP_STRIDE + 1
    cmp_end = jnp.arange(n_cmp) * CMP_STRIDE + CMP_BLOCK - 1
    k_cmp = compress_blocks(kv_tok[:, :, 0], cmp_pe_k, cmp_w1_k, cmp_b1_k, cmp_w2_k, cmp_b2_k)
    k_cmp = partial_rope(k_cmp, cos[cmp_end], sin[cmp_end])
    v_cmp = compress_blocks(kv_tok[:, :, 1], cmp_pe_v, cmp_w1_v, cmp_b1_v, cmp_w2_v, cmp_b2_v)

    n_slc = S // SLC_BLOCK
    k_top = min(SLC_TOPK, n_slc)
    cs = jnp.arange(n_cmp)[:, None] * CMP_STRIDE
    ss = jnp.arange(n_slc)[None, :] * SLC_BLOCK
    overlap = jnp.clip(jnp.minimum(cs + CMP_BLOCK, ss + SLC_BLOCK) - jnp.maximum(cs, ss), 0, None).astype(jnp.float32) / CMP_BLOCK
    k_slc_blocks = k_slc.reshape(B, n_slc, SLC_BLOCK, G, dh).transpose(0, 3, 1, 2, 4)
    v_slc_blocks = v_slc.reshape(B, n_slc, SLC_BLOCK, G, dh).transpose(0, 3, 1, 2, 4)
    gather = jax.vmap(jax.vmap(lambda blocks, ix: blocks[ix]))

    pad = ((0, 0), (WINDOW, 0), (0, 0), (0, 0))
    k_win_pad = jnp.pad(k_win, pad)
    v_win_pad = jnp.pad(v_win, pad)

    def attend(blk):
        qb, gb, bi = blk
        q0 = bi * Q_BLOCK
        qpos = q0 + jnp.arange(Q_BLOCK)
        qg = qb.reshape(B, Q_BLOCK, G, NSA_HPG, dh)

        s_c = jnp.einsum('bqghd,bngd->bghqn', qg, k_cmp, preferred_element_type=jnp.float32) * scale
        p_c = masked_softmax(s_c, cmp_end[None, :] <= qpos[:, None])
        o_c = jnp.einsum('bghqn,bngd->bqghd', p_c.astype(dt), v_cmp)

        imp = jnp.einsum('bghqn,nj->bgqj', p_c, overlap)
        j = jnp.arange(n_slc)[None, :]
        cur = (qpos // SLC_BLOCK)[:, None]
        forced = (j == 0) | (j == cur) | (j == cur - 1)
        causal = j * SLC_BLOCK <= qpos[:, None]
        score = jnp.where(forced, FORCE_SCORE, jnp.where(causal, imp, -FORCE_SCORE))
        _, sel = lax.top_k(score, k_top)
        kg = gather(k_slc_blocks, sel).reshape(B, G, Q_BLOCK, k_top * SLC_BLOCK, dh)
        vg = gather(v_slc_blocks, sel).reshape(B, G, Q_BLOCK, k_top * SLC_BLOCK, dh)
        tok = (sel[..., None] * SLC_BLOCK + jnp.arange(SLC_BLOCK)).reshape(B, G, Q_BLOCK, k_top * SLC_BLOCK)
        s_s = jnp.einsum('bqghd,bgqmd->bghqm', qg, kg, preferred_element_type=jnp.float32) * scale
        p_s = masked_softmax(s_s, (tok <= qpos[None, None, :, None])[:, :, None])
        o_s = jnp.einsum('bghqm,bgqmd->bqghd', p_s.astype(dt), vg)

        kw = lax.dynamic_slice_in_dim(k_win_pad, q0, Q_BLOCK + WINDOW, axis=1)
        vw = lax.dynamic_slice_in_dim(v_win_pad, q0, Q_BLOCK + WINDOW, axis=1)
        kpos = q0 - WINDOW + jnp.arange(Q_BLOCK + WINDOW)
        dist = qpos[:, None] - kpos[None, :]
        mask_w = (dist >= 0) & (dist < WINDOW) & (kpos[None, :] >= 0)
        s_w = jnp.einsum('bqghd,bkgd->bghqk', qg, kw, preferred_element_type=jnp.float32) * scale
        p_w = masked_softmax(s_w, mask_w)
        o_w = jnp.einsum('bghqk,bkgd->bqghd', p_w.astype(dt), vw)

        g = jax.nn.sigmoid(gb.astype(jnp.float32)).reshape(B, Q_BLOCK, 3, G, NSA_HPG)[..., None]
        o = g[:, :, 0] * o_c + g[:, :, 1] * o_s + g[:, :, 2] * o_w
        return o.reshape(B, Q_BLOCK, H * dh).astype(dt)

    nb = S // Q_BLOCK
    out = lax.map(attend, (to_blocks(q), to_blocks(gate_logits), jnp.arange(nb)))
    return from_blocks(out)


def setup_inputs(seed: int = 0) -> dict:
    key = jax.random.key(seed)
    keys = jax.random.split(key, 32)
    f32 = jnp.float32
    L = DEPTH
    flat = CMP_BLOCK * HEAD_DIM

    def w(i, shape, fan_in):
        return jax.random.normal(keys[i], shape, f32) * fan_in ** -0.5

    def gain(i, shape):
        return 1.0 + 0.02 * jax.random.normal(keys[i], shape, f32)

    def small(i, shape, s=0.01):
        return s * jax.random.normal(keys[i], shape, f32)

    return {
        'x': jax.random.normal(keys[0], (BATCH, SEQ, D_MODEL), f32),
        'g_mix_norm': gain(1, (L, D_MODEL)),
        'w_in': w(2, (L, D_MODEL, IN_COLS), D_MODEL),
        'g_cq': gain(3, (L, MLA_Q_RANK)),
        'w_uq': w(4, (L, MLA_Q_RANK, MLA_HEADS * (MLA_NOPE_DIM + MLA_ROPE_DIM)), MLA_Q_RANK),
        'g_ckv': gain(5, (L, MLA_KV_RANK)),
        'w_ukv': w(6, (L, MLA_KV_RANK, MLA_HEADS * (MLA_NOPE_DIM + MLA_V_DIM)), MLA_KV_RANK),
        'cmp_pe_k': small(7, (L, CMP_BLOCK, HEAD_DIM), 0.1),
        'cmp_w1_k': w(8, (L, flat, CMP_HIDDEN), flat),
        'cmp_b1_k': small(9, (L, CMP_HIDDEN)),
        'cmp_w2_k': w(10, (L, CMP_HIDDEN, HEAD_DIM), CMP_HIDDEN),
        'cmp_b2_k': small(11, (L, HEAD_DIM)),
        'cmp_pe_v': small(12, (L, CMP_BLOCK, HEAD_DIM), 0.1),
        'cmp_w1_v': w(13, (L, flat, CMP_HIDDEN), flat),
        'cmp_b1_v': small(14, (L, CMP_HIDDEN)),
        'cmp_w2_v': w(15, (L, CMP_HIDDEN, HEAD_DIM), CMP_HIDDEN),
        'cmp_b2_v': small(16, (L, HEAD_DIM)),
        'g_out_mla': gain(17, (L, MLA_WIDTH)),
        'g_out_nsa': gain(18, (L, NSA_WIDTH)),
        'w_o': w(19, (L, MIX_WIDTH, D_MODEL), MIX_WIDTH),
        'g_mlp_norm': gain(20, (L, D_MODEL)),
        'w_up': w(21, (L, D_MODEL, D_FF), D_MODEL),
        'w_down': w(22, (L, D_FF, D_MODEL), D_FF),
        'g_final': gain(23, (D_MODEL,)),
    }


def reference(x, g_mix_norm, w_in, g_cq, w_uq, g_ckv, w_ukv,
              cmp_pe_k, cmp_w1_k, cmp_b1_k, cmp_w2_k, cmp_b2_k,
              cmp_pe_v, cmp_w1_v, cmp_b1_v, cmp_w2_v, cmp_b2_v,
              g_out_mla, g_out_nsa, w_o, g_mlp_norm, w_up, w_down, g_final):
    B, S, _ = x.shape
    pos = jnp.arange(S)
    cos_m, sin_m = rope_tables(pos, MLA_ROPE_DIM)
    cos_n, sin_n = rope_tables(pos, NSA_ROPE_DIM)
    split_points = [int(v) for v in np.cumsum(IN_SIZES)[:-1]]
    h = x
    for l in range(DEPTH):
        u = rmsnorm(h, g_mix_norm[l]) @ w_in[l]
        c_q, c_kv, k_rope, q_nsa, kv_nsa, gate_nsa = jnp.split(u, split_points, axis=-1)
        y_mla = mla_mixer(c_q, c_kv, k_rope, g_cq[l], w_uq[l], g_ckv[l], w_ukv[l], cos_m, sin_m)
        y_nsa = nsa_mixer(q_nsa.reshape(B, S, NSA_HEADS, HEAD_DIM),
                          kv_nsa.reshape(B, S, 6, NSA_KV_GROUPS, HEAD_DIM),
                          gate_nsa.reshape(B, S, 3, NSA_HEADS),
                          cmp_pe_k[l], cmp_w1_k[l], cmp_b1_k[l], cmp_w2_k[l], cmp_b2_k[l],
                          cmp_pe_v[l], cmp_w1_v[l], cmp_b1_v[l], cmp_w2_v[l], cmp_b2_v[l],
                          cos_n, sin_n)
        mixed = jnp.concatenate([rmsnorm(y_mla, g_out_mla[l]), rmsnorm(y_nsa, g_out_nsa[l])], axis=-1)
        h = h + mixed @ w_o[l]
        a = jax.nn.relu(rmsnorm(h, g_mlp_norm[l]) @ w_up[l])
        h = h + (a * a) @ w_down[l]
    return rmsnorm(h, g_final)
```

```cpp
#include <hip/hip_runtime.h>
#include <cstdio>
#include <cstdint>

#ifndef MK_N_LAUNCHES
#define MK_N_LAUNCHES 1
#endif

#define LAS __attribute__((address_space(3)))
typedef _Float16 half_t;
typedef _Float16 half8 __attribute__((ext_vector_type(8)));
typedef _Float16 half2v __attribute__((ext_vector_type(2)));
typedef float f32x4 __attribute__((ext_vector_type(4)));
typedef float f32x16 __attribute__((ext_vector_type(16)));
typedef unsigned u32x4 __attribute__((ext_vector_type(4)));
typedef unsigned u32x2 __attribute__((ext_vector_type(2)));
typedef short v4i16 __attribute__((ext_vector_type(4)));

constexpr int BATCH = 16, SEQ = 4096, DM = 1024, MROWS = BATCH * SEQ;
constexpr int IN_COLS = 1720, NIN = 1792;
constexpr int DFF = 4096;
constexpr float NORM_EPS = 1e-6f;
constexpr float LOG2E = 1.4426950408889634f;
constexpr float QS_N = 0.125f * LOG2E;
constexpr float QS_M = 0.10206207261596577f * LOG2E;

constexpr size_t MiB = 1u << 20;
constexpr size_t WS_CTL = 0, CTL_ZERO_BYTES = 1 * MiB;
constexpr size_t WS_WIN = 1 * MiB, WS_WUQ = 5 * MiB, WS_WUKV = 6 * MiB, WS_WC1 = 7 * MiB, WS_WO = 9 * MiB, WS_WUP = 11 * MiB, WS_WDN = 19 * MiB;
constexpr size_t WS_ROPEM = 27 * MiB, WS_ROPEN = 27 * MiB + 512 * 1024, WS_B1P = 27 * MiB + 768 * 1024;
constexpr size_t WS_KC = 28 * MiB, WS_VC = 29 * MiB;
constexpr size_t WS_RS1 = 32 * MiB, WS_SSQ = 33 * MiB, WS_SSKV = 34 * MiB, WS_SSM = 35 * MiB, WS_SSN = 37 * MiB, WS_SS2 = 39 * MiB, WS_SS3 = 43 * MiB;
constexpr size_t WS_GATE = 47 * MiB, WS_KPE = 53 * MiB;
constexpr size_t WS_CQ = 64 * MiB, WS_T1 = 96 * MiB, WS_QN = 128 * MiB, WS_KVT = 192 * MiB  ;
constexpr size_t WS_QM = 288 * MiB, WS_KNM = 384 * MiB, WS_VM = 448 * MiB, WS_HIDP = 512 * MiB;
constexpr size_t WS_A2 = 64 * MiB;
constexpr size_t WS_XH = 576 * MiB, WS_H2 = 576 * MiB, WS_Y = 704 * MiB, WS_H1 = 832 * MiB, WS_END = 960 * MiB;
constexpr size_t KVT_STRIDE = 16 * MiB / 2;

constexpr int CW_QHEAD = 64;
constexpr int CW_BAR = 4096;

constexpr int LDS_BYTES = 147456;
constexpr int LDS_MISC = 140 * 1024;

#define XB_TMO      128
#define XB_XCNT(j)  (256  + 64 * (j))
#define XB_XSUB(j)  (1280 + 64 * (j))
#define XB_XGEN(j)  (2304 + 64 * (j))
#define XB_TOP      3328
#define XB_TOPGEN   3392
#define XCD_BAR_WORDS 3456
#define XB_SPIN_CAP (1u << 22)

__device__ __forceinline__ unsigned xb_ld(unsigned* p)              { return __hip_atomic_load(p, __ATOMIC_RELAXED, __HIP_MEMORY_SCOPE_AGENT); }
__device__ __forceinline__ unsigned xb_add(unsigned* p, unsigned v) { return __hip_atomic_fetch_add(p, v, __ATOMIC_RELAXED, __HIP_MEMORY_SCOPE_AGENT); }
__device__ __forceinline__ unsigned xb_xcc_id() { return (unsigned)__builtin_amdgcn_s_getreg((3 << 11) | 20) & 0xFu; }
#define XB_SPIN(cond, bar) do { unsigned _sp = 0; while (cond) { __builtin_amdgcn_s_sleep(1); \
    if ((++_sp & 255u) == 0u) { if (xb_ld(&(bar)[XB_TMO])) break; if (_sp > XB_SPIN_CAP) { atomicAdd(&(bar)[XB_TMO], 1u); break; } } } } while (0)

struct XcdBarrier { unsigned* bar; unsigned x; volatile LAS unsigned* st; };

__device__ __forceinline__ XcdBarrier xcd_barrier_post(unsigned* bar, volatile LAS unsigned* st) {
    XcdBarrier b; b.bar = bar; b.x = xb_xcc_id(); b.st = st;
    if (threadIdx.x == 0) (void)xb_add(&bar[XB_XCNT(b.x)], 1u);
    return b;
}
__device__ __forceinline__ void xcd_barrier_complete(unsigned* bar, unsigned x, unsigned& nloc, unsigned& nx) {
    const unsigned G = gridDim.x * gridDim.y * gridDim.z;
    unsigned sum, cnt, mine, sp = 0u;
    for (;;) {
        sum = 0u; cnt = 0u; mine = 0u;
#pragma unroll
        for (unsigned j = 0; j < 16; ++j) { const unsigned c = xb_ld(&bar[XB_XCNT(j)]); sum += c; cnt += (c > 0u) ? 1u : 0u; mine = (j == x) ? c : mine; }
        if (sum == G) break;
        __builtin_amdgcn_s_sleep(1);
        if ((++sp & 255u) == 0u) { if (xb_ld(&bar[XB_TMO])) break; if (sp > XB_SPIN_CAP) { atomicAdd(&bar[XB_TMO], 1u); break; } }
    }
    nloc = mine > 0u ? mine : 1u; nx = cnt > 0u ? cnt : 1u;
}
__device__ __forceinline__ void xcd_barrier(const XcdBarrier& b) {
    asm volatile("s_waitcnt vmcnt(0)" ::: "memory");
    __syncthreads();
    if (threadIdx.x == 0) {
        unsigned* bar = b.bar;
        __builtin_amdgcn_s_waitcnt(0);
        unsigned nloc = b.st[0], nx = b.st[1];
        if (nloc == 0u) { xcd_barrier_complete(bar, b.x, nloc, nx); b.st[0] = nloc; b.st[1] = nx; }
        const unsigned old = xb_add(&bar[XB_XSUB(b.x)], 1u);
        const unsigned gen = old / nloc;
        if (old + 1u == (gen + 1u) * nloc) {
            __builtin_amdgcn_fence(__ATOMIC_RELEASE, "agent");
            asm volatile("s_waitcnt vmcnt(0)" ::: "memory");
            const unsigned og = xb_add(&bar[XB_TOP], 1u);
            const unsigned tg = og / nx;
            if (og + 1u == (tg + 1u) * nx) xb_add(&bar[XB_TOPGEN], 1u);
            else XB_SPIN(xb_ld(&bar[XB_TOPGEN]) == tg, bar);
            __builtin_amdgcn_fence(__ATOMIC_ACQUIRE, "agent");
            xb_add(&bar[XB_XGEN(b.x)], 1u);
            asm volatile("s_waitcnt vmcnt(0)" ::: "memory");
        } else {
            XB_SPIN(xb_ld(&bar[XB_XGEN(b.x)]) == gen, bar);
            __builtin_amdgcn_fence(__ATOMIC_ACQUIRE, "agent");
            asm volatile("s_waitcnt vmcnt(0)" ::: "memory");
        }
    }
    __syncthreads();
}

__device__ __forceinline__ unsigned pk_rne(float a, float b) { half2v v = {(_Float16)a, (_Float16)b}; return __builtin_bit_cast(unsigned, v); }
__device__ __forceinline__ unsigned pk_rtz(float a, float b) { auto v = __builtin_amdgcn_cvt_pkrtz(a, b); return __builtin_bit_cast(unsigned, v); }
__device__ __forceinline__ u32x4 pk8(const float* v) { u32x4 w; w.x = pk_rne(v[0], v[1]); w.y = pk_rne(v[2], v[3]); w.z = pk_rne(v[4], v[5]); w.w = pk_rne(v[6], v[7]); return w; }
__device__ __forceinline__ void unpk8(u32x4 w, float* v) {
    const half8 h = __builtin_bit_cast(half8, w);
#pragma unroll
    for (int i = 0; i < 8; ++i) v[i] = (float)h[i];
}
__device__ __forceinline__ float wave_sum(float v) {
#pragma unroll
    for (int o = 1; o < 64; o <<= 1) v += __shfl_xor(v, o);
    return v;
}
__device__ __forceinline__ void rope4(float* v, const float2* cs) {
#pragma unroll
    for (int p = 0; p < 4; ++p) { const float2 t = cs[p]; const float x1 = v[2 * p], x2 = v[2 * p + 1]; v[2 * p] = x1 * t.x - x2 * t.y; v[2 * p + 1] = x2 * t.x + x1 * t.y; }
}

namespace pg8 {
constexpr int BM = 256, BK = 64, HALF = 128, HTB = HALF * BK * 2, NXCD = 8, WGM = 8;
__host__ __device__ __forceinline__ int lds_byte(int r, int c) { const int st = (r >> 4) * 2 + (c >> 5), rr = r & 15, cc = c & 31, ob = rr * 64 + cc * 2; return st * 1024 + (ob ^ (((ob >> 9) & 1) << 5)); }
__host__ __device__ __forceinline__ void stage_rc(int b, int& R, int& C) { const int st = b / 1024, sb = b % 1024, swz = sb ^ (((sb >> 9) & 1) << 5); R = (st >> 1) * 16 + swz / 64; C = (st & 1) * 32 + (swz % 64) / 2; }
__host__ __device__ __forceinline__ int perm32(int rho) { const int n = rho >> 4, i = rho & 15; return 8 * (i >> 2) + 4 * n + (i & 3); }

struct Unit { int pm, pn; size_t aoff, boff; };
struct Gemm { const half_t* A; const half_t* Bt; int K, lda, ldb; };

struct StaticOrder {
    int nM, nN, nwg, G, c; size_t tA, tB;
    __device__ void init(int M, int N, int G_, int c_, int lda, int ldb) { nM = M / BM; nN = N / BM; nwg = nM * nN; G = G_; c = c_; tA = (size_t)BM * lda * 2; tB = (size_t)BM * ldb * 2; }
    __device__ bool next(int i, Unit& u) const {
        const long L = (long)i * G + c; if (L >= nwg) return false;
        int wgid = (int)L; { const int q = nwg / NXCD, r = nwg % NXCD, xcd = wgid % NXCD, off = wgid / NXCD; wgid = (xcd < r ? xcd * (q + 1) : r * (q + 1) + (xcd - r) * q) + off; }
        const int nig = WGM * nN, gid = wgid / nig, fm = gid * WGM, gsz = (nM - fm) < WGM ? (nM - fm) : WGM;
        u.pm = fm + ((wgid % nig) % gsz); u.pn = (wgid % nig) / gsz; u.aoff = (size_t)u.pm * tA; u.boff = (size_t)u.pn * tB; return true;
    }
};
struct Cmp1Order {
    int G, c;
    __device__ bool next(int i, Unit& u) const {
        const int L = i * G + c; if (L >= 256) return false;
        const int kv = L >> 7, slab = (L >> 2) & 31, ch = L & 3;
        u.pm = L; u.pn = 0; u.aoff = (size_t)kv * (16 * MiB) + (size_t)slab * (512 * 1024) + (size_t)ch * 1024; u.boff = (size_t)kv * (256 * 2048 * 2) + (size_t)ch * 1024; return true;
    }
};

template <class Epi, class Sched>
__device__ __forceinline__ void gemm_phase(LAS unsigned char* lds, const Gemm g, const Sched& S, const Epi& E) {
    int tid_ = threadIdx.x; asm volatile("" : "+v"(tid_));
    const int tid = tid_, wid = __builtin_amdgcn_readfirstlane(tid >> 6), lane = tid & 63, wr = wid >> 2, wc = wid & 3, fr = lane & 15, fq = lane >> 4;
    const int K = g.K, nt = K / BK;
    unsigned voffA[2], voffB[2];
#pragma unroll
    for (int i = 0; i < 2; ++i) { int R, C; stage_rc(tid * 16 + i * 8192, R, C); const int Rb = (R & ~31) + perm32(R & 31);
        voffA[i] = (unsigned)(R * g.lda + C) * 2u; voffB[i] = (unsigned)(Rb * g.ldb + C) * 2u; }
    const size_t kstep = (size_t)(BK * 2);
    const size_t hstepA = (size_t)HALF * g.lda * 2, hstepB = (size_t)HALF * g.ldb * 2;
    const unsigned ldsw = (unsigned)wid * 1024u;
    const int aoff = lds_byte(wr * 64 + fr, fq * 8), boff = lds_byte(wc * 32 + fr, fq * 8);
#define PG8_SA(b, h) (((b) * 2 + (h)) * HTB)
#define PG8_SB(b, h) ((4 + (b) * 2 + (h)) * HTB)
#define PG8_STAGE(bufoff, gbase, voff) do { _Pragma("unroll") for (int _i = 0; _i < 2; ++_i) \
        __builtin_amdgcn_global_load_lds((const unsigned*)((const char*)(gbase) + (voff)[_i]), (LAS unsigned*)(lds + (bufoff) + ldsw + _i * 8192), 16, 0, 0); } while (0)
#define PG8_LDA(dst, b, h) do { _Pragma("unroll") for (int m = 0; m < 4; ++m) _Pragma("unroll") for (int k = 0; k < 2; ++k) dst[m][k] = *(const LAS half8*)(lds + PG8_SA(b, h) + aoff + m * 2048 + k * 1024); } while (0)
#define PG8_LDB(dst, b, h) do { _Pragma("unroll") for (int n = 0; n < 2; ++n) _Pragma("unroll") for (int k = 0; k < 2; ++k) dst[n][k] = *(const LAS half8*)(lds + PG8_SB(b, h) + boff + n * 2048 + k * 1024); } while (0)
#define PG8_MMA(ai, bj, At, Bt) do { __builtin_amdgcn_s_setprio(1); _Pragma("unroll") for (int m = 0; m < 4; ++m) _Pragma("unroll") for (int n = 0; n < 2; ++n) _Pragma("unroll") for (int k = 0; k < 2; ++k) \
        acc[ai][bj][m][n] = __builtin_amdgcn_mfma_f32_16x16x32_f16(Bt[n][k], At[m][k], acc[ai][bj][m][n], 0, 0, 0); __builtin_amdgcn_s_setprio(0); } while (0)
#define PG8_WAIT_V(n) asm volatile("s_waitcnt vmcnt(" #n ")" ::: "memory")
#define PG8_WAIT_L(n) asm volatile("s_waitcnt lgkmcnt(" #n ")" ::: "memory")
#define PG8_BAR __builtin_amdgcn_s_barrier()
#define PG8_SCHED __builtin_amdgcn_sched_barrier(0)
    Unit cur, nxt; int ui = 0;
    if (!S.next(0, cur)) return;
    f32x4 acc[2][2][4][2];
#pragma unroll
    for (int a = 0; a < 2; ++a)
#pragma unroll
        for (int b = 0; b < 2; ++b)
#pragma unroll
            for (int m = 0; m < 4; ++m)
#pragma unroll
                for (int n = 0; n < 2; ++n) acc[a][b][m][n] = (f32x4){0.f, 0.f, 0.f, 0.f};
    half8 At[4][2], B0[2][2], B1[2][2];
    const char* cA = (const char*)g.A + cur.aoff; const char* cB = (const char*)g.Bt + cur.boff;
    PG8_STAGE(PG8_SB(0, 0), cB, voffB); PG8_STAGE(PG8_SB(0, 1), cB + hstepB, voffB); PG8_STAGE(PG8_SA(0, 0), cA, voffA); PG8_STAGE(PG8_SA(0, 1), cA + hstepA, voffA);
    if (wr == 1) PG8_BAR;
    PG8_WAIT_V(2); PG8_BAR;
    PG8_STAGE(PG8_SB(1, 0), cB + kstep, voffB); PG8_STAGE(PG8_SA(1, 0), cA + kstep, voffA); PG8_STAGE(PG8_SB(1, 1), cB + hstepB + kstep, voffB);
    PG8_WAIT_V(6); PG8_BAR;
    for (;;) {
        const bool has_next = S.next(ui + 1, nxt);
        const char* nA = has_next ? (const char*)g.A + nxt.aoff : cA; const char* nB = has_next ? (const char*)g.Bt + nxt.boff : cB;
        for (int t = 0; t < nt; t += 2) {
            const bool last = (t == nt - 2);
            const char* a1 = cA + (size_t)(t + 1) * kstep;
            const char* a2 = last ? nA : cA + (size_t)(t + 2) * kstep; const char* b2 = last ? nB : cB + (size_t)(t + 2) * kstep;
            const char* a3 = a2 + kstep; const char* b3 = b2 + kstep;
            PG8_LDB(B0, 0, 0); PG8_LDB(B1, 0, 1); PG8_SCHED; PG8_LDA(At, 0, 0); PG8_STAGE(PG8_SA(1, 1), a1 + hstepA, voffA);
            PG8_WAIT_V(8); PG8_WAIT_L(0); PG8_BAR; PG8_MMA(0, 0, At, B0); PG8_MMA(0, 1, At, B1); PG8_BAR; PG8_SCHED;
            PG8_LDA(At, 0, 1); PG8_STAGE(PG8_SB(0, 0), b2, voffB); PG8_STAGE(PG8_SB(0, 1), b2 + hstepB, voffB); PG8_STAGE(PG8_SA(0, 0), a2, voffA);
            PG8_WAIT_V(8); PG8_WAIT_L(0); PG8_BAR; PG8_MMA(1, 0, At, B0); PG8_MMA(1, 1, At, B1); PG8_BAR; PG8_SCHED;
            PG8_LDB(B0, 1, 0); PG8_LDB(B1, 1, 1); PG8_SCHED; PG8_LDA(At, 1, 0); PG8_STAGE(PG8_SA(0, 1), a2 + hstepA, voffA);
            PG8_WAIT_V(8); PG8_WAIT_L(0); PG8_BAR; PG8_MMA(0, 0, At, B0); PG8_MMA(0, 1, At, B1); PG8_BAR; PG8_SCHED;
            PG8_LDA(At, 1, 1); PG8_STAGE(PG8_SB(1, 0), b3, voffB); PG8_STAGE(PG8_SB(1, 1), b3 + hstepB, voffB); PG8_STAGE(PG8_SA(1, 0), a3, voffA);
            PG8_WAIT_V(8); PG8_WAIT_L(0); PG8_BAR; PG8_MMA(1, 0, At, B0); PG8_MMA(1, 1, At, B1); PG8_BAR; PG8_SCHED;
        }
        if (wr == 0) PG8_BAR;
        E(acc, cur, wr, wc, fr, fq);
        if (!has_next) break;
#pragma unroll
        for (int a = 0; a < 2; ++a)
#pragma unroll
            for (int b = 0; b < 2; ++b)
#pragma unroll
                for (int m = 0; m < 4; ++m)
#pragma unroll
                    for (int n = 0; n < 2; ++n) acc[a][b][m][n] = (f32x4){0.f, 0.f, 0.f, 0.f};
        cur = nxt; cA = nA; cB = nB; ++ui;
        if (wr == 1) PG8_BAR;
    }
    PG8_WAIT_V(0);
    PG8_BAR;
#undef PG8_SA
#undef PG8_SB
#undef PG8_STAGE
#undef PG8_LDA
#undef PG8_LDB
#undef PG8_MMA
#undef PG8_WAIT_V
#undef PG8_WAIT_L
#undef PG8_BAR
#undef PG8_SCHED
}
}

typedef f32x4 AccT[2][2][4][2];
#define EPI_IDS() int t_ = threadIdx.x; asm volatile("" : "+v"(t_)); const int fr = t_ & 15, fq = (t_ >> 4) & 3; (void)fr_; (void)fq_
#define EPI_ROWS_BEGIN _Pragma("unroll") for (int ai = 0; ai < 2; ++ai) _Pragma("unroll") for (int m = 0; m < 4; ++m) { const int row = u.pm * 256 + ai * 128 + wr * 64 + m * 16 + fr;
#define EPI_ROWS_END }
#define EPI_GET8(v, bj, s) do { const f32x4 _a = acc[ai][bj][m][0], _b = acc[ai][bj][m][1]; v[0] = _a[0] * (s); v[1] = _a[1] * (s); v[2] = _a[2] * (s); v[3] = _a[3] * (s); v[4] = _b[0] * (s); v[5] = _b[1] * (s); v[6] = _b[2] * (s); v[7] = _b[3] * (s); } while (0)

struct EpiIn {
    const float* rs1; half_t* CQ; half_t* T1; half_t* KPE; float* GATE; float* SSQ; float* SSKV; half_t* QN; half_t* KVT; const float2* ropeM; const float2* ropeN;
    __device__ __forceinline__ void operator()(const AccT& acc, const pg8::Unit& u, int wr, int wc, int fr_, int fq_) const {
        EPI_IDS();
        const int pn = u.pn;
        EPI_ROWS_BEGIN
            const float rs = rs1[row]; const int pos = row & (SEQ - 1), b = row >> 12;
            float v[8];
            if (pn == 0) {
                float ss = 0.f;
#pragma unroll
                for (int bj = 0; bj < 2; ++bj) { EPI_GET8(v, bj, rs);
#pragma unroll
                    for (int i = 0; i < 8; ++i) ss += v[i] * v[i];
                    *(u32x4*)(CQ + (size_t)row * 256 + bj * 128 + wc * 32 + fq * 8) = pk8(v); }
                ss += __shfl_xor(ss, 16); ss += __shfl_xor(ss, 32);
                if (fq == 0) SSQ[(size_t)row * 4 + wc] = ss;
            } else if (pn == 1) {
                { EPI_GET8(v, 0, rs); float ss = 0.f;
#pragma unroll
                    for (int i = 0; i < 8; ++i) ss += v[i] * v[i];
                    *(u32x4*)(T1 + (size_t)row * 256 + wc * 32 + fq * 8) = pk8(v);
                    ss += __shfl_xor(ss, 16); ss += __shfl_xor(ss, 32);
                    if (fq == 0) SSKV[(size_t)row * 4 + wc] = ss; }
                { EPI_GET8(v, 1, rs);
                    if (wc == 0) { rope4(v, ropeM + (size_t)pos * 16 + fq * 4); const u32x4 w = pk8(v);
                        *(u32x4*)(T1 + (size_t)row * 256 + 128 + fq * 8) = w; *(u32x4*)(KPE + (size_t)row * 32 + fq * 8) = w; }
                    else { if (wc == 1 && fq < 3) { float* gp = GATE + (size_t)row * 24 + fq * 8;
#pragma unroll
                            for (int i = 0; i < 8; ++i) v[i] = 1.f / (1.f + __expf(-v[i]));
                            *(f32x4*)gp = (f32x4){v[0], v[1], v[2], v[3]}; *(f32x4*)(gp + 4) = (f32x4){v[4], v[5], v[6], v[7]}; }
                        *(u32x4*)(T1 + (size_t)row * 256 + 128 + wc * 32 + fq * 8) = (u32x4){0u, 0u, 0u, 0u}; } }
            } else if (pn < 4) {
#pragma unroll
                for (int bj = 0; bj < 2; ++bj) { EPI_GET8(v, bj, rs); const int head = (pn - 2) * 4 + 2 * bj + (wc >> 1), off = 32 * (wc & 1) + 8 * fq;
                    if ((wc & 1) == 0 && fq < 2) rope4(v, ropeN + (size_t)pos * 8 + fq * 4);
#pragma unroll
                    for (int i = 0; i < 8; ++i) v[i] *= QS_N;
                    *(u32x4*)(QN + (size_t)row * 512 + head * 64 + off) = pk8(v); }
            } else {
#pragma unroll
                for (int bj = 0; bj < 2; ++bj) { EPI_GET8(v, bj, rs); const int g = wc >> 1, d = 32 * (wc & 1) + 8 * fq;
                    if (pn > 4 && bj == 0 && (wc & 1) == 0 && fq < 2) rope4(v, ropeN + (size_t)pos * 8 + fq * 4);
                    half_t* base = KVT + (size_t)((pn - 4) * 2 + bj) * KVT_STRIDE;
                    *(u32x4*)(base + ((size_t)(b * 2 + g) * SEQ + pos) * 64 + d) = pk8(v); }
            }
        EPI_ROWS_END
    }
};

struct EpiUq {
    const float* SSQ; half_t* QM; const float2* ropeM;
    __device__ __forceinline__ void operator()(const AccT& acc, const pg8::Unit& u, int wr, int wc, int fr_, int fq_) const {
        EPI_IDS();
        EPI_ROWS_BEGIN
            const f32x4 s4 = *(const f32x4*)(SSQ + (size_t)row * 4);
            const float rs = __builtin_amdgcn_rsqf(((s4[0] + s4[1]) + (s4[2] + s4[3])) * (1.f / 256.f) + NORM_EPS) * QS_M; const int pos = row & (SEQ - 1);
            float v[8];
#pragma unroll
            for (int bj = 0; bj < 2; ++bj) { EPI_GET8(v, bj, rs); const int sidx = 8 * u.pn + 4 * bj + wc;
                if (sidx % 3 == 2) rope4(v, ropeM + (size_t)pos * 16 + fq * 4);
                *(u32x4*)(QM + (size_t)row * 768 + sidx * 32 + fq * 8) = pk8(v); }
        EPI_ROWS_END
    }
};
struct EpiUkv {
    const float* SSKV; half_t* KNM; half_t* VM;
    __device__ __forceinline__ void operator()(const AccT& acc, const pg8::Unit& u, int wr, int wc, int fr_, int fq_) const {
        EPI_IDS();
        EPI_ROWS_BEGIN
            const f32x4 s4 = *(const f32x4*)(SSKV + (size_t)row * 4);
            const float rs = __builtin_amdgcn_rsqf(((s4[0] + s4[1]) + (s4[2] + s4[3])) * (1.f / 128.f) + NORM_EPS); const int pos = row & (SEQ - 1), b = row >> 12;
            float v[8];
#pragma unroll
            for (int bj = 0; bj < 2; ++bj) { EPI_GET8(v, bj, rs); const int c = (u.pn & 1) * 256 + bj * 128 + wc * 32 + fq * 8, head = c >> 6, d = c & 63;
                half_t* base = (u.pn < 2) ? KNM : VM;
                *(u32x4*)(base + ((size_t)(b * 8 + head) * SEQ + pos) * 64 + d) = pk8(v); }
        EPI_ROWS_END
    }
};
struct EpiC1 {
    float* HIDP;
    __device__ __forceinline__ void operator()(const AccT& acc, const pg8::Unit& u, int wr, int wc, int fr_, int fq_) const {
        EPI_IDS();
#pragma unroll
        for (int ai = 0; ai < 2; ++ai)
#pragma unroll
            for (int m = 0; m < 4; ++m) { const int rl = ai * 128 + wr * 64 + m * 16 + fr; float* p = HIDP + ((size_t)u.pm * 256 + rl) * 128 + wc * 32 + fq * 8;
                *(f32x4*)p = acc[ai][0][m][0]; *(f32x4*)(p + 4) = acc[ai][0][m][1]; }
    }
};
struct EpiWo {
    const half_t* XH; half_t* H1; float* SS2;
    __device__ __forceinline__ void operator()(const AccT& acc, const pg8::Unit& u, int wr, int wc, int fr_, int fq_) const {
        EPI_IDS();
        EPI_ROWS_BEGIN
            float v[8], x[8], ss = 0.f;
#pragma unroll
            for (int bj = 0; bj < 2; ++bj) { EPI_GET8(v, bj, 1.f); const size_t o = (size_t)row * DM + u.pn * 256 + bj * 128 + wc * 32 + fq * 8;
                unpk8(*(const u32x4*)(XH + o), x);
#pragma unroll
                for (int i = 0; i < 8; ++i) { v[i] += x[i]; ss += v[i] * v[i]; }
                *(u32x4*)(H1 + o) = pk8(v); }
            ss += __shfl_xor(ss, 16); ss += __shfl_xor(ss, 32);
            if (fq == 0) SS2[(size_t)row * 16 + u.pn * 4 + wc] = ss;
        EPI_ROWS_END
    }
};
__device__ __forceinline__ float rstd16(const float* p, float inv_n) {
    const f32x4 a = *(const f32x4*)p, b = *(const f32x4*)(p + 4), c = *(const f32x4*)(p + 8), d = *(const f32x4*)(p + 12);
    const float s = (((a[0] + a[1]) + (a[2] + a[3])) + ((b[0] + b[1]) + (b[2] + b[3]))) + (((c[0] + c[1]) + (c[2] + c[3])) + ((d[0] + d[1]) + (d[2] + d[3])));
    return __builtin_amdgcn_rsqf(s * inv_n + NORM_EPS);
}
struct EpiUp {
    const float* SS2; half_t* A2;
    __device__ __forceinline__ void operator()(const AccT& acc, const pg8::Unit& u, int wr, int wc, int fr_, int fq_) const {
        EPI_IDS();
        EPI_ROWS_BEGIN
            const float rs = rstd16(SS2 + (size_t)row * 16, 1.f / 1024.f);
            float v[8];
#pragma unroll
            for (int bj = 0; bj < 2; ++bj) { EPI_GET8(v, bj, rs);
#pragma unroll
                for (int i = 0; i < 8; ++i) { const float a = fmaxf(v[i], 0.f); v[i] = a * a; }
                *(u32x4*)(A2 + (size_t)row * DFF + u.pn * 256 + bj * 128 + wc * 32 + fq * 8) = pk8(v); }
        EPI_ROWS_END
    }
};
struct EpiDn {
    const half_t* H1; half_t* H2; float* SS3;
    __device__ __forceinline__ void operator()(const AccT& acc, const pg8::Unit& u, int wr, int wc, int fr_, int fq_) const {
        EPI_IDS();
        EPI_ROWS_BEGIN
            float v[8], x[8], ss = 0.f;
#pragma unroll
            for (int bj = 0; bj < 2; ++bj) { EPI_GET8(v, bj, 1.f); const size_t o = (size_t)row * DM + u.pn * 256 + bj * 128 + wc * 32 + fq * 8;
                unpk8(*(const u32x4*)(H1 + o), x);
#pragma unroll
                for (int i = 0; i < 8; ++i) { v[i] += x[i]; ss += v[i] * v[i]; }
                *(u32x4*)(H2 + o) = pk8(v); }
            ss += __shfl_xor(ss, 16); ss += __shfl_xor(ss, 32);
            if (fq == 0) SS3[(size_t)row * 16 + u.pn * 4 + wc] = ss;
        EPI_ROWS_END
    }
};

constexpr int AT_KB = 0, AT_VB = 12288, AT_BUF = 20480;
constexpr int AT_IMP = 2 * AT_BUF;
constexpr int AT_IMPW = 8 * 2 * 68 * 4;
constexpr int AT_SEL = AT_IMP + 8 * AT_IMPW;
constexpr int AT_QIDX = AT_SEL + 8 * 64;

struct TileRegs { u32x4 k, kp, v; };
__device__ __forceinline__ void tile_load(TileRegs& r, const half_t* Kt, const half_t* KPt, const half_t* Vt, int tid, int wid, int lane) {
    r.k = *(const u32x4*)(Kt + (size_t)(tid & 63) * 64 + wid * 8);
    if (KPt != nullptr && tid < 256) r.kp = *(const u32x4*)(KPt + (size_t)(tid & 63) * 32 + wid * 8);
    r.v = *(const u32x4*)(Vt + (size_t)(16 * (wid & 3) + (lane >> 2)) * 64 + (wid >> 2) * 32 + (lane & 3) * 8);
}
__device__ __forceinline__ void tile_store(const TileRegs& r, LAS unsigned char* buf, bool haspe, int tid, int wid, int lane) {
    *(LAS u32x4*)(buf + AT_KB + wid * 1024 + lane * 16) = r.k;
    if (haspe && tid < 256) *(LAS u32x4*)(buf + AT_KB + (8 + wid) * 1024 + lane * 16) = r.kp;
    *(LAS u32x4*)(buf + AT_VB + wid * 1024 + lane * 16) = r.v;
}
template <int NKS>
__device__ __forceinline__ void tile_qk(const LAS unsigned char* kb, const half8 (&qf)[NKS], f32x16& p0, f32x16& p1) {
    p0 = (f32x16){0.f}; p1 = (f32x16){0.f};
#pragma unroll
    for (int ks = 0; ks < NKS; ++ks) {
        const half8 a0 = *(const LAS half8*)(kb + ks * 2048), a1 = *(const LAS half8*)(kb + ks * 2048 + 512);
        p0 = __builtin_amdgcn_mfma_f32_32x32x16_f16(a0, qf[ks], p0, 0, 0, 0);
        p1 = __builtin_amdgcn_mfma_f32_32x32x16_f16(a1, qf[ks], p1, 0, 0, 0);
    }
}
__device__ __forceinline__ void tile_emask(f32x16& p0, f32x16& p1, int hiL, int loL) {
#pragma unroll
    for (int r = 0; r < 16; ++r) { const int c = (r & 3) + 8 * (r >> 2);
        if (!(c <= hiL && c >= loL)) p0[r] = -INFINITY;
        if (!(c + 32 <= hiL && c + 32 >= loL)) p1[r] = -INFINITY; }
}
__device__ __forceinline__ float tile_rowmax(const f32x16& p0, const f32x16& p1) {
    float a = fmaxf(p0[0], p1[0]);
#pragma unroll
    for (int r = 1; r < 16; ++r) a = fmaxf(a, fmaxf(p0[r], p1[r]));
    return fmaxf(a, __shfl_xor(a, 32));
}
__device__ __forceinline__ half8 vfrag(const LAS unsigned char* vb, int off) {
    const v4i16 lo = __builtin_amdgcn_ds_read_tr16_b64_v4i16((LAS v4i16*)(vb + off));
    const v4i16 hi = __builtin_amdgcn_ds_read_tr16_b64_v4i16((LAS v4i16*)(vb + off + 512));
    typedef short s8 __attribute__((ext_vector_type(8)));
    const s8 t = {lo[0], lo[1], lo[2], lo[3], hi[0], hi[1], hi[2], hi[3]};
    return __builtin_bit_cast(half8, t);
}
__device__ __forceinline__ void tile_pv(const f32x16& p0, const f32x16& p1, const LAS unsigned char* vb, f32x16 (&o)[2]) {
    u32x4 pw[4];
#pragma unroll
    for (int s = 0; s < 2; ++s) {
        pw[s]     = (u32x4){pk_rtz(p0[8 * s], p0[8 * s + 1]), pk_rtz(p0[8 * s + 2], p0[8 * s + 3]), pk_rtz(p0[8 * s + 4], p0[8 * s + 5]), pk_rtz(p0[8 * s + 6], p0[8 * s + 7])};
        pw[2 + s] = (u32x4){pk_rtz(p1[8 * s], p1[8 * s + 1]), pk_rtz(p1[8 * s + 2], p1[8 * s + 3]), pk_rtz(p1[8 * s + 4], p1[8 * s + 5]), pk_rtz(p1[8 * s + 6], p1[8 * s + 7])};
    }
#pragma unroll
    for (int db = 0; db < 2; ++db)
#pragma unroll
        for (int ks = 0; ks < 4; ++ks) {
            const half8 vf = vfrag(vb, db * 4096 + ks * 1024);
            o[db] = __builtin_amdgcn_mfma_f32_32x32x16_f16(vf, __builtin_bit_cast(half8, pw[ks]), o[db], 0, 0, 0);
        }
}
__device__ __forceinline__ void tile_softmax_pv(f32x16& p0, f32x16& p1, const LAS unsigned char* vb, f32x16 (&o)[2], float& m, float& l, bool rowsel) {
    float tm = tile_rowmax(p0, p1);
    if (!rowsel) tm = -INFINITY;
    const float mn = fmaxf(m, tm), alpha = __builtin_amdgcn_exp2f(m - mn), msub = rowsel ? mn : INFINITY;
    float sum = 0.f;
#pragma unroll
    for (int r = 0; r < 16; ++r) { p0[r] = __builtin_amdgcn_exp2f(p0[r] - msub); p1[r] = __builtin_amdgcn_exp2f(p1[r] - msub); sum += p0[r] + p1[r]; }
    l = l * alpha + sum; m = mn;
#pragma unroll
    for (int r = 0; r < 16; ++r) { o[0][r] *= alpha; o[1][r] *= alpha; }
    tile_pv(p0, p1, vb, o);
}

struct AttnPtrs {
    const half_t* QM; const half_t* KNM; const half_t* KPE; const half_t* VM;
    const half_t* QN; const half_t* KC; const half_t* VC; const half_t* KS; const half_t* VS; const half_t* KW; const half_t* VW; const float* GATE;
    half_t* Y; float* SSM; float* SSN;
};

__device__ __forceinline__ void mla_unit(const AttnPtrs& P, int bh, int qb, LAS unsigned char* lds) {
    int tid_ = threadIdx.x; asm volatile("" : "+v"(tid_));
    const int tid = tid_, lane = tid & 63, wid = __builtin_amdgcn_readfirstlane(tid >> 6), q = lane & 31, h = lane >> 5;
    const int b = bh >> 3, hd = bh & 7, q0 = qb * 256, qpos = q0 + wid * 32 + q;
    const size_t trow = (size_t)b * SEQ + qpos;
    half8 qf[6];
#pragma unroll
    for (int ks = 0; ks < 6; ++ks) qf[ks] = *(const half8*)(P.QM + trow * 768 + hd * 96 + ks * 16 + h * 8);
    const half_t* Kb = P.KNM + (size_t)bh * SEQ * 64; const half_t* Vb = P.VM + (size_t)bh * SEQ * 64; const half_t* KPb = P.KPE + (size_t)b * SEQ * 32;
    const int ntiles = 4 * qb + 4, my_last = 4 * qb + (wid >> 1);
    f32x16 o[2]; o[0] = (f32x16){0.f}; o[1] = (f32x16){0.f};
    float m = -1e30f, l = 0.f;
    const int koff = h * 1024 + q * 16, voff = (4 * h + ((lane & 15) >> 2)) * 64 + ((lane >> 4) & 1) * 32 + (lane & 3) * 8;
    TileRegs tr;
    tile_load(tr, Kb, KPb, Vb, tid, wid, lane);
    tile_store(tr, lds, true, tid, wid, lane);
    __syncthreads();
    for (int t = 0; t < ntiles; ++t) {
        LAS unsigned char* buf = lds + (t & 1) * AT_BUF;
        if (t + 1 < ntiles) tile_load(tr, Kb + (size_t)(t + 1) * 64 * 64, KPb + (size_t)(t + 1) * 64 * 32, Vb + (size_t)(t + 1) * 64 * 64, tid, wid, lane);
        if (t <= my_last) {
            f32x16 p0, p1;
            tile_qk<6>(buf + AT_KB + koff, qf, p0, p1);
            if (t == my_last) tile_emask(p0, p1, qpos - 64 * t - 4 * h, -1000);
            tile_softmax_pv(p0, p1, buf + AT_VB + voff, o, m, l, true);
        }
        if (t + 1 < ntiles) tile_store(tr, lds + ((t + 1) & 1) * AT_BUF, true, tid, wid, lane);
        __syncthreads();
    }
    l += __shfl_xor(l, 32);
    const float inv = 1.f / l;
    float ss = 0.f;
    half_t* yrow = P.Y + trow * DM + hd * 64;
#pragma unroll
    for (int db = 0; db < 2; ++db)
#pragma unroll
        for (int c = 0; c < 4; ++c) { const float a0 = o[db][4 * c] * inv, a1 = o[db][4 * c + 1] * inv, a2 = o[db][4 * c + 2] * inv, a3 = o[db][4 * c + 3] * inv;
            ss += (a0 * a0 + a1 * a1) + (a2 * a2 + a3 * a3);
            *(u32x2*)(yrow + db * 32 + 8 * c + 4 * h) = (u32x2){pk_rne(a0, a1), pk_rne(a2, a3)}; }
    ss += __shfl_xor(ss, 32);
    if (h == 0) P.SSM[trow * 8 + hd] = ss;
}

template <int NKS_unused = 4>
__device__ __forceinline__ void nsa_stream_begin(TileRegs& tr, const half_t* Kt, const half_t* Vt, LAS unsigned char* lds, int tid, int wid, int lane) {
    tile_load(tr, Kt, nullptr, Vt, tid, wid, lane);
    tile_store(tr, lds, false, tid, wid, lane);
    __syncthreads();
}
__device__ __forceinline__ void nsa_unit(const AttnPtrs& P, int bg, int qb, LAS unsigned char* lds) {
    int tid_ = threadIdx.x; asm volatile("" : "+v"(tid_));
    const int tid = tid_, lane = tid & 63, wid = __builtin_amdgcn_readfirstlane(tid >> 6), j = lane & 31, h = lane >> 5;
    const int b = bg >> 1, g = bg & 1, q0 = qb * 64, cur = qb, qi = j >> 2, hh = j & 3, qrel = wid * 8 + qi, qpos = q0 + qrel, head = g * 4 + hh;
    const size_t trow = (size_t)b * SEQ + qpos;
    half8 qf[4];
#pragma unroll
    for (int ks = 0; ks < 4; ++ks) qf[ks] = *(const half8*)(P.QN + trow * 512 + head * 64 + ks * 16 + h * 8);
    const float g0 = P.GATE[trow * 24 + head], g1 = P.GATE[trow * 24 + 8 + head], g2 = P.GATE[trow * 24 + 16 + head];
    const int koff = h * 1024 + j * 16, voff = (4 * h + ((lane & 15) >> 2)) * 64 + ((lane >> 4) & 1) * 32 + (lane & 3) * 8;
    f32x16 acc[2]; acc[0] = (f32x16){0.f}; acc[1] = (f32x16){0.f};
    f32x16 o[2];
    TileRegs tr;
    LAS float* impw = (LAS float*)(lds + AT_IMP + wid * AT_IMPW);
    unsigned long long selmask = (2ull << cur) - 1ull;

    const int ncmp = ((q0 + 32) >> 4) / 64 + 1;
    const half_t* Kc = P.KC + (size_t)bg * 256 * 64; const half_t* Vc = P.VC + (size_t)bg * 256 * 64;
    float m = -1e30f, l = 0.f;
    nsa_stream_begin(tr, Kc, Vc, lds, tid, wid, lane);
    for (int t = 0; t < ncmp; ++t) {
        LAS unsigned char* buf = lds + (t & 1) * AT_BUF;
        if (t + 1 < ncmp) tile_load(tr, Kc + (size_t)(t + 1) * 4096, nullptr, Vc + (size_t)(t + 1) * 4096, tid, wid, lane);
        f32x16 p0, p1;
        tile_qk<4>(buf + AT_KB + koff, qf, p0, p1);
        tile_emask(p0, p1, ((qpos - 31 - 1024 * t) >> 4) - 4 * h, -1000);
        const float tm = tile_rowmax(p0, p1), mn = fmaxf(m, tm), alpha = __builtin_amdgcn_exp2f(m - mn);
        float sum = 0.f;
#pragma unroll
        for (int r = 0; r < 16; ++r) sum += __builtin_amdgcn_exp2f(p0[r] - mn) + __builtin_amdgcn_exp2f(p1[r] - mn);
        l = l * alpha + sum; m = mn;
        if (t + 1 < ncmp) tile_store(tr, lds + ((t + 1) & 1) * AT_BUF, false, tid, wid, lane);
        __syncthreads();
    }
    l += __shfl_xor(l, 32);
    const float invl = (l > 0.f) ? 1.f / l : 0.f;
    o[0] = (f32x16){0.f}; o[1] = (f32x16){0.f};
    nsa_stream_begin(tr, Kc, Vc, lds, tid, wid, lane);
    for (int t = 0; t < ncmp; ++t) {
        LAS unsigned char* buf = lds + (t & 1) * AT_BUF;
        if (t + 1 < ncmp) tile_load(tr, Kc + (size_t)(t + 1) * 4096, nullptr, Vc + (size_t)(t + 1) * 4096, tid, wid, lane);
        f32x16 p0, p1;
        tile_qk<4>(buf + AT_KB + koff, qf, p0, p1);
        tile_emask(p0, p1, ((qpos - 31 - 1024 * t) >> 4) - 4 * h, -1000);
#pragma unroll
        for (int r = 0; r < 16; ++r) { p0[r] = __builtin_amdgcn_exp2f(p0[r] - m) * invl; p1[r] = __builtin_amdgcn_exp2f(p1[r] - m) * invl; }
        if (cur >= 16) {
#pragma unroll
            for (int kb = 0; kb < 2; ++kb)
#pragma unroll
                for (int c = 0; c < 4; ++c) {
                    const f32x16& p = kb ? p1 : p0;
                    float C = (p[4 * c] + p[4 * c + 1]) + (p[4 * c + 2] + 0.5f * p[4 * c + 3]), D = 0.5f * p[4 * c + 3];
                    C += __shfl_xor(C, 1); C += __shfl_xor(C, 2); D += __shfl_xor(D, 1); D += __shfl_xor(D, 2);
                    const int jb = 16 * t + 8 * kb + 2 * c + h;
                    if (hh == 0) { impw[qi * 136 + jb] = C; impw[qi * 136 + 68 + jb + 1] = D; }
                }
        }
        tile_pv(p0, p1, buf + AT_VB + voff, o);
        if (t + 1 < ncmp) tile_store(tr, lds + ((t + 1) & 1) * AT_BUF, false, tid, wid, lane);
        __syncthreads();
    }
#pragma unroll
    for (int r = 0; r < 16; ++r) { acc[0][r] = g0 * o[0][r]; acc[1][r] = g0 * o[1][r]; }

    if (cur >= 16) {
        const int tq = lane >> 3, e = lane & 7;
        float v[8];
#pragma unroll
        for (int i = 0; i < 8; ++i) { const int jb = e + 8 * i; const float s = impw[tq * 136 + jb] + impw[tq * 136 + 68 + jb];
            v[i] = (jb >= 1 && jb <= cur - 2) ? s : -1.f; }
        unsigned selb = 0u;
        for (int it = 0; it < 13; ++it) {
            float lm = v[0];
#pragma unroll
            for (int i = 1; i < 8; ++i) lm = fmaxf(lm, v[i]);
            float gm = fmaxf(lm, __shfl_xor(lm, 1)); gm = fmaxf(gm, __shfl_xor(gm, 2)); gm = fmaxf(gm, __shfl_xor(gm, 4));
            int cj = 99;
#pragma unroll
            for (int i = 7; i >= 0; --i) cj = (v[i] == gm) ? (e + 8 * i) : cj;
            int gj = min(cj, __shfl_xor(cj, 1)); gj = min(gj, __shfl_xor(gj, 2)); gj = min(gj, __shfl_xor(gj, 4));
#pragma unroll
            for (int i = 0; i < 8; ++i) if (gj == e + 8 * i) { v[i] = -2.f; selb |= 1u << i; }
        }
        unsigned lo = 0u, hi = 0u;
#pragma unroll
        for (int i = 0; i < 4; ++i) { lo |= ((selb >> i) & 1u) << (e + 8 * i); hi |= ((selb >> (i + 4)) & 1u) << (e + 8 * i); }
        lo |= __shfl_xor(lo, 1); lo |= __shfl_xor(lo, 2); lo |= __shfl_xor(lo, 4);
        hi |= __shfl_xor(hi, 1); hi |= __shfl_xor(hi, 2); hi |= __shfl_xor(hi, 4);
        unsigned long long mk = ((unsigned long long)hi << 32) | lo;
        mk |= 1ull | (1ull << cur) | (1ull << (cur - 1));
        LAS unsigned long long* selw = (LAS unsigned long long*)(lds + AT_SEL + wid * 64);
        if (e == 0) selw[tq] = mk;
        selmask = selw[qi];
    }

    {
        const half_t* Ks = P.KS + (size_t)bg * SEQ * 64; const half_t* Vs = P.VS + (size_t)bg * SEQ * 64;
        m = -1e30f; l = 0.f; o[0] = (f32x16){0.f}; o[1] = (f32x16){0.f};
        const int nt = cur + 1;
        nsa_stream_begin(tr, Ks, Vs, lds, tid, wid, lane);
        for (int t = 0; t < nt; ++t) {
            LAS unsigned char* buf = lds + (t & 1) * AT_BUF;
            if (t + 1 < nt) tile_load(tr, Ks + (size_t)(t + 1) * 4096, nullptr, Vs + (size_t)(t + 1) * 4096, tid, wid, lane);
            const bool rowsel = (selmask >> t) & 1ull;
            if (__any(rowsel)) {
                f32x16 p0, p1;
                tile_qk<4>(buf + AT_KB + koff, qf, p0, p1);
                if (t == cur) tile_emask(p0, p1, qrel - 4 * h, -1000);
                tile_softmax_pv(p0, p1, buf + AT_VB + voff, o, m, l, rowsel);
            }
            if (t + 1 < nt) tile_store(tr, lds + ((t + 1) & 1) * AT_BUF, false, tid, wid, lane);
            __syncthreads();
        }
        l += __shfl_xor(l, 32);
        const float sc = g1 / l;
#pragma unroll
        for (int r = 0; r < 16; ++r) { acc[0][r] += sc * o[0][r]; acc[1][r] += sc * o[1][r]; }
    }
    {
        const half_t* Kw = P.KW + (size_t)bg * SEQ * 64; const half_t* Vw = P.VW + (size_t)bg * SEQ * 64;
        m = -1e30f; l = 0.f; o[0] = (f32x16){0.f}; o[1] = (f32x16){0.f};
        const int t0 = (cur >= 8) ? cur - 8 : 0, nt = cur - t0 + 1;
        nsa_stream_begin(tr, Kw + (size_t)t0 * 4096, Vw + (size_t)t0 * 4096, lds, tid, wid, lane);
        for (int i = 0; i < nt; ++i) {
            const int t = t0 + i;
            LAS unsigned char* buf = lds + (i & 1) * AT_BUF;
            if (i + 1 < nt) tile_load(tr, Kw + (size_t)(t + 1) * 4096, nullptr, Vw + (size_t)(t + 1) * 4096, tid, wid, lane);
            f32x16 p0, p1;
            tile_qk<4>(buf + AT_KB + koff, qf, p0, p1);
            if (t == cur) tile_emask(p0, p1, qrel - 4 * h, -1000);
            else if (t == cur - 8) tile_emask(p0, p1, 1000, qrel + 1 - 4 * h);
            tile_softmax_pv(p0, p1, buf + AT_VB + voff, o, m, l, true);
            if (i + 1 < nt) tile_store(tr, lds + ((i + 1) & 1) * AT_BUF, false, tid, wid, lane);
            __syncthreads();
        }
        l += __shfl_xor(l, 32);
        const float sc = g2 / l;
#pragma unroll
        for (int r = 0; r < 16; ++r) { acc[0][r] += sc * o[0][r]; acc[1][r] += sc * o[1][r]; }
    }
    float ss = 0.f;
    half_t* yrow = P.Y + trow * DM + 512 + head * 64;
#pragma unroll
    for (int db = 0; db < 2; ++db)
#pragma unroll
        for (int c = 0; c < 4; ++c) { const float a0 = acc[db][4 * c], a1 = acc[db][4 * c + 1], a2 = acc[db][4 * c + 2], a3 = acc[db][4 * c + 3];
            ss += (a0 * a0 + a1 * a1) + (a2 * a2 + a3 * a3);
            *(u32x2*)(yrow + db * 32 + 8 * c + 4 * h) = (u32x2){pk_rne(a0, a1), pk_rne(a2, a3)}; }
    ss += __shfl_xor(ss, 32);
    if (h == 0) P.SSN[trow * 8 + head] = ss;
}

struct Args { const float* in[24]; float* out; unsigned char* ws; int ph_lo, ph_hi, li, pad; };

template <class SrcFn>
__device__ __forceinline__ void conv_wt(const float* W, int Ksrc, int Nsrc, const float* gain, half_t* WT, int Ndst, int Kdst, SrcFn src, int gt, int ngt) {
    const int nitems = Ndst * (Kdst / 8);
    for (int it = gt; it < nitems; it += ngt) {
        const int n = it % Ndst, k0 = (it / Ndst) * 8; const int sc = src(n);
        float v[8];
#pragma unroll
        for (int i = 0; i < 8; ++i) { const int k = k0 + i; v[i] = (sc >= 0 && k < Ksrc) ? W[(size_t)k * Nsrc + sc] * (gain ? gain[k] : 1.f) : 0.f; }
        *(u32x4*)(WT + (size_t)n * Kdst + k0) = pk8(v);
    }
}
__device__ __forceinline__ int src_win(int n) {
    const int t = n >> 8, c = n & 255;
    if (t == 0) return c;
    if (t == 1) { if (c < 128) return 256 + c;
                  if (c < 160) { const int p = c - 128; return 384 + (p >> 1) + 16 * (p & 1); }
                  if (c < 184) return 1696 + (c - 160);
                  return -1; }
    if (t < 4) { const int hd = (t - 2) * 4 + (c >> 6), p = c & 63; const int d = (p < 16) ? (p >> 1) + 8 * (p & 1) : p; return 416 + hd * 64 + d; }
    const int br = (t - 4) * 2 + (c >> 7), g = (c >> 6) & 1, p = c & 63;
    const bool roped = (br == 2 || br == 4);
    const int d = (roped && p < 16) ? (p >> 1) + 8 * (p & 1) : p;
    return 928 + br * 128 + g * 64 + d;
}
__device__ __forceinline__ int src_wuq(int n) { const int hd = n / 96, p = n % 96; return (p < 64) ? hd * 96 + p : hd * 96 + 64 + ((p - 64) >> 1) + 16 * ((p - 64) & 1); }
__device__ __forceinline__ int src_wukv(int n) { return (n < 512) ? (n >> 6) * 128 + (n & 63) : ((n - 512) >> 6) * 128 + 64 + (n & 63); }

#define PH_IDS() int tid_ = threadIdx.x; asm volatile("" : "+v"(tid_)); const int tid = tid_, lane = tid & 63, wid = __builtin_amdgcn_readfirstlane(tid >> 6); \
    const int G = gridDim.x, gt = blockIdx.x * 512 + tid, ngt = G * 512, gw = blockIdx.x * 8 + wid, ngw = G * 8; (void)lane; (void)gt; (void)ngt; (void)gw; (void)ngw; (void)G
#define WSP(T, off) ((T*)(ws + (off)))


__global__ void __launch_bounds__(512, 2) hymba_fwd(Args args) {
    extern __shared__ __attribute__((aligned(16))) unsigned char lds_raw[];
    LAS unsigned char* lds = (LAS unsigned char*)lds_raw;
    unsigned char* ws = args.ws;
    volatile LAS unsigned* MISC = (volatile LAS unsigned*)(lds + LDS_MISC);
    if (threadIdx.x < 16) MISC[threadIdx.x] = 0u;
    __syncthreads();
    XcdBarrier bar = xcd_barrier_post(WSP(unsigned, WS_CTL) + CW_BAR + args.li * XCD_BAR_WORDS, MISC + 8);
    const int lo = args.ph_lo, hi = args.ph_hi;
#define IN(k) (lo <= (k) && (k) < hi)
#define SEAM(k) do { if (IN(k) && IN((k) + 1)) xcd_barrier(bar); } while (0)

    if (IN(0)) {
        PH_IDS();
        conv_wt(args.in[2], 1024, IN_COLS, args.in[1], WSP(half_t, WS_WIN), NIN, 1024, [](int n) { return src_win(n); }, gt, ngt);
        conv_wt(args.in[4], 256, 768, args.in[3], WSP(half_t, WS_WUQ), 768, 256, [](int n) { return src_wuq(n); }, gt, ngt);
        conv_wt(args.in[6], 128, 1024, args.in[5], WSP(half_t, WS_WUKV), 1024, 256, [](int n) { return src_wukv(n); }, gt, ngt);
        conv_wt(args.in[8], 2048, 128, nullptr, WSP(half_t, WS_WC1), 256, 2048, [](int n) { return n < 128 ? n : -1; }, gt, ngt);
        conv_wt(args.in[13], 2048, 128, nullptr, WSP(half_t, WS_WC1) + 256 * 2048, 256, 2048, [](int n) { return n < 128 ? n : -1; }, gt, ngt);
        {
            const float* gm = args.in[17]; const float* gn = args.in[18]; const float* W = args.in[19]; half_t* WO = WSP(half_t, WS_WO);
            for (int it = gt; it < 1024 * 128; it += ngt) { const int n = it & 1023, k0 = (it >> 10) * 8; float v[8];
#pragma unroll
                for (int i = 0; i < 8; ++i) { const int k = k0 + i; v[i] = W[(size_t)k * 1024 + n] * (k < 512 ? gm[k] : gn[k - 512]); }
                *(u32x4*)(WO + (size_t)n * 1024 + k0) = pk8(v); }
        }
        conv_wt(args.in[21], 1024, 4096, args.in[20], WSP(half_t, WS_WUP), 4096, 1024, [](int n) { return n; }, gt, ngt);
        conv_wt(args.in[22], 4096, 1024, nullptr, WSP(half_t, WS_WDN), 1024, 4096, [](int n) { return n; }, gt, ngt);
        { float2* ROPEM = WSP(float2, WS_ROPEM); float2* ROPEN = WSP(float2, WS_ROPEN);
          for (int it = gt; it < SEQ * 16; it += ngt) { const int pos = it >> 4, i = it & 15; const float inv = expf(-logf(500000.f) * (float)(2 * i) / 32.f), a = (float)pos * inv; ROPEM[it] = make_float2(cosf(a), sinf(a)); }
          for (int it = gt; it < SEQ * 8; it += ngt) { const int pos = it >> 3, i = it & 7; const float inv = expf(-logf(500000.f) * (float)(2 * i) / 16.f), a = (float)pos * inv; ROPEN[it] = make_float2(cosf(a), sinf(a)); } }
        if (gt < 256) { const int kv = gt >> 7, jj = gt & 127; const float* pe = args.in[kv ? 12 : 7]; const float* w1 = args.in[kv ? 13 : 8]; const float* b1 = args.in[kv ? 14 : 9];
            float s = b1[jj]; for (int k = 0; k < 2048; ++k) s += pe[k] * w1[(size_t)k * 128 + jj]; WSP(float, WS_B1P)[gt] = s; }
        { const float* x = args.in[0]; half_t* XH = WSP(half_t, WS_XH); float* RS1 = WSP(float, WS_RS1);
          for (int r = gw; r < MROWS; r += ngw) {
            const f32x4* xr = (const f32x4*)(x + (size_t)r * DM) + lane; f32x4 v[4]; float s = 0.f;
#pragma unroll
            for (int jv = 0; jv < 4; ++jv) { v[jv] = xr[64 * jv]; s += (v[jv][0] * v[jv][0] + v[jv][1] * v[jv][1]) + (v[jv][2] * v[jv][2] + v[jv][3] * v[jv][3]); }
            s = wave_sum(s);
            u32x2* o8 = (u32x2*)(XH + (size_t)r * DM) + lane;
#pragma unroll
            for (int jv = 0; jv < 4; ++jv) o8[64 * jv] = (u32x2){pk_rne(v[jv][0], v[jv][1]), pk_rne(v[jv][2], v[jv][3])};
            if (lane == 0) RS1[r] = __builtin_amdgcn_rsqf(s * (1.f / DM) + NORM_EPS);
          } }
    }
    SEAM(0);
    if (IN(1)) {
        pg8::Gemm g{WSP(half_t, WS_XH), WSP(half_t, WS_WIN), 1024, 1024, 1024}; pg8::StaticOrder S; S.init(MROWS, NIN, gridDim.x, (int)blockIdx.x, 1024, 1024);
        EpiIn E{WSP(float, WS_RS1), WSP(half_t, WS_CQ), WSP(half_t, WS_T1), WSP(half_t, WS_KPE), WSP(float, WS_GATE), WSP(float, WS_SSQ), WSP(float, WS_SSKV), WSP(half_t, WS_QN), WSP(half_t, WS_KVT), WSP(float2, WS_ROPEM), WSP(float2, WS_ROPEN)};
        pg8::gemm_phase(lds, g, S, E);
    }
    SEAM(1);
    if (IN(2)) {
        { pg8::Gemm g{WSP(half_t, WS_CQ), WSP(half_t, WS_WUQ), 256, 256, 256}; pg8::StaticOrder S; S.init(MROWS, 768, gridDim.x, (int)blockIdx.x, 256, 256); EpiUq E{WSP(float, WS_SSQ), WSP(half_t, WS_QM), WSP(float2, WS_ROPEM)}; pg8::gemm_phase(lds, g, S, E); }
        { pg8::Gemm g{WSP(half_t, WS_T1), WSP(half_t, WS_WUKV), 256, 256, 256}; pg8::StaticOrder S; S.init(MROWS, 1024, gridDim.x, (int)blockIdx.x, 256, 256); EpiUkv E{WSP(float, WS_SSKV), WSP(half_t, WS_KNM), WSP(half_t, WS_VM)}; pg8::gemm_phase(lds, g, S, E); }
        { pg8::Gemm g{WSP(half_t, WS_KVT), WSP(half_t, WS_WC1), 512, 1024, 2048}; pg8::Cmp1Order S{(int)gridDim.x, (int)blockIdx.x}; EpiC1 E{WSP(float, WS_HIDP)}; pg8::gemm_phase(lds, g, S, E); }
    }
    SEAM(2);
    if (IN(3)) {
        PH_IDS();
        const float* B1P = WSP(float, WS_B1P); const float* HIDP = WSP(float, WS_HIDP); const float2* ROPEN = WSP(float2, WS_ROPEN);
        LAS float* hl = (LAS float*)(lds + wid * 1024);
        for (int it = gw; it < 2 * 32 * 128; it += ngw) {
            const int kv = it >> 12, slab = (it >> 7) & 31, n0 = (it & 127) * 2;
            const float* w2 = args.in[kv ? 15 : 10]; const float* b2 = args.in[kv ? 16 : 11];
#pragma unroll
            for (int rr = 0; rr < 2; ++rr)
#pragma unroll
                for (int c = 0; c < 2; ++c) { const int col = lane + 64 * c; float s = B1P[kv * 128 + col];
#pragma unroll
                    for (int ch = 0; ch < 4; ++ch) s += HIDP[((size_t)((kv * 32 + slab) * 4 + ch) * 256 + n0 + rr) * 128 + col];
                    const float z = 0.7978845608028654f * (s + 0.044715f * s * s * s), th = 1.f - 2.f / (1.f + __expf(2.f * z));
                    hl[rr * 128 + col] = 0.5f * s * (1.f + th); }
            asm volatile("s_waitcnt lgkmcnt(0)" ::: "memory");
            const int dsrc = (kv == 0 && lane < 16) ? (lane >> 1) + 8 * (lane & 1) : lane;
            float a0 = b2[dsrc], a1 = a0;
            for (int k = 0; k < 128; ++k) { const float w = w2[k * 64 + dsrc]; a0 += hl[k] * w; a1 += hl[128 + k] * w; }
            if (kv == 0) {
                const float p0 = __shfl_xor(a0, 1), p1 = __shfl_xor(a1, 1);
                if (lane < 16) { const int pr = lane >> 1; const int e1 = 16 * (n0 + 1) + 31; const float2 c0 = ROPEN[(size_t)(16 * n0 + 31) * 8 + pr], c1 = ROPEN[(size_t)(e1 > 4095 ? 4095 : e1) * 8 + pr];
                    a0 = (lane & 1) ? (a0 * c0.x + p0 * c0.y) : (a0 * c0.x - p0 * c0.y);
                    a1 = (lane & 1) ? (a1 * c1.x + p1 * c1.y) : (a1 * c1.x - p1 * c1.y); }
            }
            if (n0 + 1 >= 255) a1 = 0.f;
            half_t* dst = (kv ? WSP(half_t, WS_VC) : WSP(half_t, WS_KC)) + ((size_t)slab * 256 + n0) * 64 + lane;
            dst[0] = (half_t)a0; dst[64] = (half_t)a1;
            asm volatile("s_waitcnt lgkmcnt(0)" ::: "memory");
        }
    }
    SEAM(3);
    if (IN(4)) {
        half_t* KVT = WSP(half_t, WS_KVT);
        const AttnPtrs P{WSP(half_t, WS_QM), WSP(half_t, WS_KNM), WSP(half_t, WS_KPE), WSP(half_t, WS_VM), WSP(half_t, WS_QN), WSP(half_t, WS_KC), WSP(half_t, WS_VC),
                         KVT + 2 * KVT_STRIDE, KVT + 3 * KVT_STRIDE, KVT + 4 * KVT_STRIDE, KVT + 5 * KVT_STRIDE, WSP(float, WS_GATE), WSP(half_t, WS_Y), WSP(float, WS_SSM), WSP(float, WS_SSN)};
        volatile LAS int* qw = (volatile LAS int*)(lds + AT_QIDX);
        unsigned* qhead = WSP(unsigned, WS_CTL) + CW_QHEAD;
        for (;;) {
            if (threadIdx.x == 0) *qw = (int)__hip_atomic_fetch_add(qhead, 1u, __ATOMIC_RELAXED, __HIP_MEMORY_SCOPE_AGENT);
            __syncthreads();
            const int qi = __builtin_amdgcn_readfirstlane(*qw);
            __syncthreads();
            if (qi >= 4096) break;
            const int L = qi >> 8, r = qi & 255;
            if (r < 128) mla_unit(P, r, 15 - L, lds);
            else { const int r2 = r - 128; nsa_unit(P, r2 & 31, 63 - 4 * L - (r2 >> 5), lds); }
        }
    }
    SEAM(4);
    if (IN(5)) {
        PH_IDS();
        const float* SSM = WSP(float, WS_SSM); const float* SSN = WSP(float, WS_SSN); half_t* Y = WSP(half_t, WS_Y);
        for (int r = gw; r < MROWS; r += ngw) {
            const f32x4 a = *(const f32x4*)(SSM + (size_t)r * 8), b = *(const f32x4*)(SSM + (size_t)r * 8 + 4), c = *(const f32x4*)(SSN + (size_t)r * 8), d = *(const f32x4*)(SSN + (size_t)r * 8 + 4);
            const float rm = __builtin_amdgcn_rsqf((((a[0] + a[1]) + (a[2] + a[3])) + ((b[0] + b[1]) + (b[2] + b[3]))) * (1.f / 512.f) + NORM_EPS);
            const float rn = __builtin_amdgcn_rsqf((((c[0] + c[1]) + (c[2] + c[3])) + ((d[0] + d[1]) + (d[2] + d[3]))) * (1.f / 512.f) + NORM_EPS);
            u32x4* yr = (u32x4*)(Y + (size_t)r * DM) + lane;
#pragma unroll
            for (int jv = 0; jv < 2; ++jv) { float v[8]; unpk8(yr[64 * jv], v); const float s = jv ? rn : rm;
#pragma unroll
                for (int i = 0; i < 8; ++i) v[i] *= s;
                yr[64 * jv] = pk8(v); }
        }
    }
    SEAM(5);
    if (IN(6)) { pg8::Gemm g{WSP(half_t, WS_Y), WSP(half_t, WS_WO), 1024, 1024, 1024}; pg8::StaticOrder S; S.init(MROWS, 1024, gridDim.x, (int)blockIdx.x, 1024, 1024); EpiWo E{WSP(half_t, WS_XH), WSP(half_t, WS_H1), WSP(float, WS_SS2)}; pg8::gemm_phase(lds, g, S, E); }
    SEAM(6);
    if (IN(7)) { pg8::Gemm g{WSP(half_t, WS_H1), WSP(half_t, WS_WUP), 1024, 1024, 1024}; pg8::StaticOrder S; S.init(MROWS, DFF, gridDim.x, (int)blockIdx.x, 1024, 1024); EpiUp E{WSP(float, WS_SS2), WSP(half_t, WS_A2)}; pg8::gemm_phase(lds, g, S, E); }
    SEAM(7);
    if (IN(8)) { pg8::Gemm g{WSP(half_t, WS_A2), WSP(half_t, WS_WDN), 4096, 4096, 4096}; pg8::StaticOrder S; S.init(MROWS, 1024, gridDim.x, (int)blockIdx.x, 4096, 4096); EpiDn E{WSP(half_t, WS_H1), WSP(half_t, WS_H2), WSP(float, WS_SS3)}; pg8::gemm_phase(lds, g, S, E); }
    SEAM(8);
    if (IN(9)) {
        PH_IDS();
        const float* gf = args.in[23]; const float* SS3 = WSP(float, WS_SS3); const half_t* H2 = WSP(half_t, WS_H2);
        for (int r = gw; r < MROWS; r += ngw) {
            const float rs = rstd16(SS3 + (size_t)r * 16, 1.f / 1024.f);
            const u32x4* hr = (const u32x4*)(H2 + (size_t)r * DM) + lane; f32x4* orow = (f32x4*)(args.out + (size_t)r * DM);
#pragma unroll
            for (int jv = 0; jv < 2; ++jv) { float v[8]; unpk8(hr[64 * jv], v); const int c0 = (64 * jv + lane) * 8;
                const f32x4 ga = *(const f32x4*)(gf + c0), gb = *(const f32x4*)(gf + c0 + 4);
                orow[(c0 >> 2)] = (f32x4){v[0] * rs * ga[0], v[1] * rs * ga[1], v[2] * rs * ga[2], v[3] * rs * ga[3]};
                orow[(c0 >> 2) + 1] = (f32x4){v[4] * rs * gb[0], v[5] * rs * gb[1], v[6] * rs * gb[2], v[7] * rs * gb[3]}; }
        }
    }
#undef IN
#undef SEAM
}

#ifndef DBG_CHECK
#define DBG_CHECK 0
#define DBG_SKIP 0
#endif
#if DBG_CHECK
constexpr int CW_DBG = 96;
__device__ __forceinline__ void dbg_flag(unsigned* ctl, int id, float got, float ref) {
    const float d = fabsf(got - ref);
    if (!(d <= 0.03f + 0.03f * fabsf(ref))) atomicOr(ctl + CW_DBG, 1u << id);
}
__device__ __forceinline__ float h2f(const half_t* p) { return (float)(*p); }
__device__ float dbg_rope_cs(int pos, int i, int dim, bool want_sin) { const float inv = expf(-logf(500000.f) * (float)(2 * i) / (float)dim), a = (float)pos * inv; return want_sin ? sinf(a) : cosf(a); }
__device__ float dbg_u(const Args& args, int row, int co, int lane) {
    const float* x = args.in[0] + (size_t)row * DM; const float* g = args.in[1]; const float* w = args.in[2];
    float ss = 0.f, acc = 0.f;
    for (int k = lane; k < DM; k += 64) { const float xv = x[k]; ss += xv * xv; acc += xv * g[k] * w[(size_t)k * IN_COLS + co]; }
    ss = wave_sum(ss); acc = wave_sum(acc);
    return acc * (1.f / sqrtf(ss / DM + NORM_EPS));
}
__device__ const int dbgt_0_dbg_rows[4] = {0, 4096 + 6, 30000, 65535};
__device__ const int dbgt_1_cs[3] = {0, 77, 255};
__device__ const int dbgt_2_cs[2] = {5, 127};
__device__ const int dbgt_3_ps[4] = {0, 1, 14, 31};
__device__ const int dbgt_4_is[3] = {0, 13, 23};
__device__ const int dbgt_5_hs[4] = {0, 3, 5, 7};
__device__ const int dbgt_6_ps[4] = {0, 1, 14, 40};
__device__ const int dbgt_7_brs[7] = {0, 1, 2, 2, 3, 4, 5};
__device__ const int dbgt_8_gs[7] = {0, 1, 0, 1, 0, 1, 1};
__device__ const int dbgt_9_ps[7] = {3, 20, 1, 50, 9, 14, 63};
__device__ const int dbgt_10_hs[4] = {0, 2, 5, 7};
__device__ const int dbgt_11_ps[4] = {3, 64, 77, 95};
__device__ const int dbgt_12_slabs[3] = {0, 17, 31};
__device__ const int dbgt_13_ns[3] = {0, 100, 254};
__device__ const int dbgt_14_ps[4] = {0, 1, 15, 40};
__device__ const int dbgt_15_bs[5] = {0, 0, 5, 15, 9};
__device__ const int dbgt_16_hs[5] = {0, 3, 7, 2, 5};
__device__ const int dbgt_17_qs[5] = {0, 100, 2047, 4095, 1234};
__device__ const int dbgt_18_bs[6] = {0, 3, 7, 15, 11, 2};
__device__ const int dbgt_19_gs[6] = {0, 1, 0, 1, 1, 0};
__device__ const int dbgt_20_hhs[6] = {0, 2, 3, 1, 0, 2};
__device__ const int dbgt_21_qs[6] = {5, 700, 1030, 4095, 2500, 3071};
__device__ const int dbgt_22_dd[3] = {0, 33, 63};
__device__ const int dbgt_23_c4[4] = {0, 1300, 2777, 4095};
__device__ const int dbgt_24_cols[4] = {0, 300, 777, 1023};
__device__ const int dbgt_25_cc[6] = {768, 896, 800, 776, 775, 1023};
__global__ void __launch_bounds__(512) dbg_checks_a(Args args) {
    extern __shared__ __attribute__((aligned(16))) unsigned char lds_raw[]; LAS unsigned char* lds = (LAS unsigned char*)lds_raw;
    unsigned char* ws = args.ws; unsigned* ctl = WSP(unsigned, WS_CTL);
    const int lane = threadIdx.x & 63, wid = threadIdx.x >> 6;
    const int* rows = dbgt_0_dbg_rows;
    const half_t* XH = WSP(half_t, WS_XH);
    if (blockIdx.x == 0) {
        if (wid == 0) for (int s = 0; s < 4; ++s) { const int r = rows[s]; const float* x = args.in[0] + (size_t)r * DM; float ss = 0.f; for (int k = lane; k < DM; k += 64) ss += x[k] * x[k]; ss = wave_sum(ss);
            if (lane == 0) { dbg_flag(ctl, 1, WSP(float, WS_RS1)[r], 1.f / sqrtf(ss / DM + NORM_EPS)); dbg_flag(ctl, 1, h2f(XH + (size_t)r * DM + 517), x[517]); } }
        if (wid == 1) for (int s = 0; s < 4; ++s) { const int r = rows[s], pos = r & 4095, b = r >> 12;
            { const int* cs = dbgt_1_cs; for (int i = 0; i < 3; ++i) { const float u = dbg_u(args, r, cs[i], lane); if (lane == 0) dbg_flag(ctl, 2, h2f(WSP(half_t, WS_CQ) + (size_t)r * 256 + cs[i]), u); } }
            { const int* cs = dbgt_2_cs; for (int i = 0; i < 2; ++i) { const float u = dbg_u(args, r, 256 + cs[i], lane); if (lane == 0) dbg_flag(ctl, 3, h2f(WSP(half_t, WS_T1) + (size_t)r * 256 + cs[i]), u); } }
            { const int* ps = dbgt_3_ps; for (int i = 0; i < 4; ++i) { const int p = ps[i], pr = p >> 1; const float x1 = dbg_u(args, r, 384 + pr, lane), x2 = dbg_u(args, r, 384 + pr + 16, lane);
                const float c = dbg_rope_cs(pos, pr, 32, false), sn = dbg_rope_cs(pos, pr, 32, true); const float ref = (p & 1) ? (x2 * c + x1 * sn) : (x1 * c - x2 * sn);
                if (lane == 0) dbg_flag(ctl, 4, h2f(WSP(half_t, WS_KPE) + (size_t)r * 32 + p), ref); } }
            { const int* is = dbgt_4_is; for (int i = 0; i < 3; ++i) { const float u = dbg_u(args, r, 1696 + is[i], lane); if (lane == 0) dbg_flag(ctl, 5, WSP(float, WS_GATE)[(size_t)r * 24 + is[i]], 1.f / (1.f + expf(-u))); } }
            { const int* hs = dbgt_5_hs; const int* ps = dbgt_6_ps; for (int i = 0; i < 4; ++i) { const int hd = hs[i], p = ps[i]; float ref;
                if (p < 16) { const int pr = p >> 1; const float x1 = dbg_u(args, r, 416 + hd * 64 + pr, lane), x2 = dbg_u(args, r, 416 + hd * 64 + pr + 8, lane);
                    const float c = dbg_rope_cs(pos, pr, 16, false), sn = dbg_rope_cs(pos, pr, 16, true); ref = (p & 1) ? (x2 * c + x1 * sn) : (x1 * c - x2 * sn); }
                else ref = dbg_u(args, r, 416 + hd * 64 + p, lane);
                if (lane == 0) dbg_flag(ctl, 6, h2f(WSP(half_t, WS_QN) + (size_t)r * 512 + hd * 64 + p), ref * QS_N); } }
            { const int* brs = dbgt_7_brs; const int* gs = dbgt_8_gs; const int* ps = dbgt_9_ps;
              for (int i = 0; i < 7; ++i) { const int br = brs[i], g = gs[i], p = ps[i]; const int base = 928 + br * 128 + g * 64; float ref;
                if ((br == 2 || br == 4) && p < 16) { const int pr = p >> 1; const float x1 = dbg_u(args, r, base + pr, lane), x2 = dbg_u(args, r, base + pr + 8, lane);
                    const float c = dbg_rope_cs(pos, pr, 16, false), sn = dbg_rope_cs(pos, pr, 16, true); ref = (p & 1) ? (x2 * c + x1 * sn) : (x1 * c - x2 * sn); }
                else ref = dbg_u(args, r, base + p, lane);
                if (lane == 0) dbg_flag(ctl, 7, h2f(WSP(half_t, WS_KVT) + (size_t)br * KVT_STRIDE + ((size_t)(b * 2 + g) * SEQ + pos) * 64 + p), ref); } }
        }
        if (wid == 2) for (int s = 0; s < 4; ++s) { const int r = rows[s], pos = r & 4095, b = r >> 12;
            const half_t* cq = WSP(half_t, WS_CQ) + (size_t)r * 256; const half_t* t1 = WSP(half_t, WS_T1) + (size_t)r * 256;
            float sq = 0.f, skv = 0.f; for (int k = lane; k < 256; k += 64) { const float a = h2f(cq + k); sq += a * a; } for (int k = lane; k < 128; k += 64) { const float a = h2f(t1 + k); skv += a * a; }
            sq = wave_sum(sq); skv = wave_sum(skv); const float rq = 1.f / sqrtf(sq / 256.f + NORM_EPS), rkv = 1.f / sqrtf(skv / 128.f + NORM_EPS);
            const int* hs = dbgt_10_hs; const int* ps = dbgt_11_ps;
            for (int i = 0; i < 4; ++i) { const int hd = hs[i], p = ps[i]; float ref;
                auto qcol = [&](int col) { float a = 0.f; for (int k = lane; k < 256; k += 64) a += h2f(cq + k) * args.in[3][k] * args.in[4][(size_t)k * 768 + col]; return wave_sum(a) * rq; };
                if (p < 64) ref = qcol(hd * 96 + p);
                else { const int pp = p - 64, pr = pp >> 1; const float x1 = qcol(hd * 96 + 64 + pr), x2 = qcol(hd * 96 + 64 + pr + 16);
                    const float c = dbg_rope_cs(pos, pr, 32, false), sn = dbg_rope_cs(pos, pr, 32, true); ref = (pp & 1) ? (x2 * c + x1 * sn) : (x1 * c - x2 * sn); }
                if (lane == 0) dbg_flag(ctl, 8, h2f(WSP(half_t, WS_QM) + (size_t)r * 768 + hd * 96 + p), ref * QS_M); }
            for (int i = 0; i < 4; ++i) { const int hd = hs[i], d = ps[i] & 63;
                auto kvcol = [&](int col) { float a = 0.f; for (int k = lane; k < 128; k += 64) a += h2f(t1 + k) * args.in[5][k] * args.in[6][(size_t)k * 1024 + col]; return wave_sum(a) * rkv; };
                const float kr = kvcol(hd * 128 + d), vr = kvcol(hd * 128 + 64 + d);
                if (lane == 0) { dbg_flag(ctl, 9, h2f(WSP(half_t, WS_KNM) + ((size_t)(b * 8 + hd) * SEQ + pos) * 64 + d), kr); dbg_flag(ctl, 10, h2f(WSP(half_t, WS_VM) + ((size_t)(b * 8 + hd) * SEQ + pos) * 64 + d), vr); } }
        }
        if (wid == 3 || wid == 4) { const int kv = wid - 3; const int* slabs = dbgt_12_slabs; const int* ns = dbgt_13_ns;
            LAS float* hid = (LAS float*)(lds + 65536 + kv * 1024);
            const float* pe = args.in[kv ? 12 : 7]; const float* w1 = args.in[kv ? 13 : 8]; const float* b1 = args.in[kv ? 14 : 9]; const float* w2 = args.in[kv ? 15 : 10]; const float* b2 = args.in[kv ? 16 : 11];
            for (int s = 0; s < 3; ++s) { const int slab = slabs[s], n = ns[s]; const half_t* tok = WSP(half_t, WS_KVT) + (size_t)kv * KVT_STRIDE + ((size_t)slab * SEQ + 16 * n) * 64;
                for (int jj = 0; jj < 2; ++jj) { const int j = lane + 64 * jj; float a = b1[j]; for (int k = 0; k < 2048; ++k) a += (h2f(tok + k) + pe[k]) * w1[(size_t)k * 128 + j];
                    const float z = 0.7978845608028654f * (a + 0.044715f * a * a * a); hid[j] = 0.5f * a * (1.f + tanhf(z)); }
                asm volatile("s_waitcnt lgkmcnt(0)" ::: "memory");
                float o = b2[lane]; for (int j = 0; j < 128; ++j) o += hid[j] * w2[j * 64 + lane];
                const int* ps = dbgt_14_ps;
                for (int i = 0; i < 4; ++i) { const int p = ps[i]; float ref;
                    if (kv == 0 && p < 16) { const int pr = p >> 1; const float x1 = __shfl(o, pr), x2 = __shfl(o, pr + 8); const int pos = 16 * n + 31;
                        const float c = dbg_rope_cs(pos, pr, 16, false), sn = dbg_rope_cs(pos, pr, 16, true); ref = (p & 1) ? (x2 * c + x1 * sn) : (x1 * c - x2 * sn); }
                    else ref = __shfl(o, p);
                    if (lane == 0) dbg_flag(ctl, 11 + kv, h2f((kv ? WSP(half_t, WS_VC) : WSP(half_t, WS_KC)) + ((size_t)slab * 256 + n) * 64 + p), ref); }
                asm volatile("s_waitcnt lgkmcnt(0)" ::: "memory"); }
        }
        if (wid == 5) { const int* bs = dbgt_15_bs; const int* hs = dbgt_16_hs; const int* qs = dbgt_17_qs;
            for (int s = 0; s < 5; ++s) { const int b = bs[s], hd = hs[s], q = qs[s]; const size_t r = (size_t)b * SEQ + q;
                const half_t* qv = WSP(half_t, WS_QM) + r * 768 + hd * 96; const half_t* Kn = WSP(half_t, WS_KNM) + (size_t)(b * 8 + hd) * SEQ * 64; const half_t* Kp = WSP(half_t, WS_KPE) + (size_t)b * SEQ * 32; const half_t* V = WSP(half_t, WS_VM) + (size_t)(b * 8 + hd) * SEQ * 64;
                float mx = -1e30f;
                for (int k = lane; k <= q; k += 64) { float sc = 0.f; for (int d = 0; d < 64; ++d) sc += h2f(qv + d) * h2f(Kn + (size_t)k * 64 + d); for (int d = 0; d < 32; ++d) sc += h2f(qv + 64 + d) * h2f(Kp + (size_t)k * 32 + d); mx = fmaxf(mx, sc); }
                for (int o = 1; o < 64; o <<= 1) mx = fmaxf(mx, __shfl_xor(mx, o));
                float l = 0.f, o0 = 0.f, o1 = 0.f, o2 = 0.f;
                for (int k = lane; k <= q; k += 64) { float sc = 0.f; for (int d = 0; d < 64; ++d) sc += h2f(qv + d) * h2f(Kn + (size_t)k * 64 + d); for (int d = 0; d < 32; ++d) sc += h2f(qv + 64 + d) * h2f(Kp + (size_t)k * 32 + d);
                    const float p = exp2f(sc - mx); l += p; o0 += p * h2f(V + (size_t)k * 64 + 0); o1 += p * h2f(V + (size_t)k * 64 + 33); o2 += p * h2f(V + (size_t)k * 64 + 63); }
                l = wave_sum(l); o0 = wave_sum(o0); o1 = wave_sum(o1); o2 = wave_sum(o2);
                if (lane == 0) { const half_t* y = WSP(half_t, WS_Y) + r * DM + hd * 64; dbg_flag(ctl, 13, h2f(y + 0), o0 / l); dbg_flag(ctl, 13, h2f(y + 33), o1 / l); dbg_flag(ctl, 13, h2f(y + 63), o2 / l); } }
        }
        if (wid == 6 || wid == 7) { const int* bs = dbgt_18_bs; const int* gs = dbgt_19_gs; const int* hhs = dbgt_20_hhs; const int* qs = dbgt_21_qs;
            LAS float* pc = (LAS float*)(lds + 70000 + (wid - 6) * 8192);
            for (int s = wid - 6; s < 6; s += 2) { const int b = bs[s], g = gs[s], hh = hhs[s], q = qs[s], cur = q >> 6; const size_t r = (size_t)b * SEQ + q; const int bg = b * 2 + g;
                const half_t* Kc = WSP(half_t, WS_KC) + (size_t)bg * 256 * 64; const half_t* Vc = WSP(half_t, WS_VC) + (size_t)bg * 256 * 64;
                for (int h4 = 0; h4 < 4; ++h4) { const half_t* qv = WSP(half_t, WS_QN) + r * 512 + (g * 4 + h4) * 64;
                    float sc[4]; float mx = -1e30f;
                    for (int i = 0; i < 4; ++i) { const int n = lane + 64 * i; float a = -INFINITY; if (n < 255 && 16 * n + 31 <= q) { a = 0.f; for (int d = 0; d < 64; ++d) a += h2f(qv + d) * h2f(Kc + (size_t)n * 64 + d); } sc[i] = a; mx = fmaxf(mx, a); }
                    for (int o = 1; o < 64; o <<= 1) mx = fmaxf(mx, __shfl_xor(mx, o));
                    float l = 0.f; for (int i = 0; i < 4; ++i) { sc[i] = exp2f(sc[i] - mx); l += sc[i]; } l = wave_sum(l);
                    for (int i = 0; i < 4; ++i) pc[h4 * 256 + lane + 64 * i] = (l > 0.f) ? sc[i] / l : 0.f; }
                asm volatile("s_waitcnt lgkmcnt(0)" ::: "memory");
                { float imp = 0.f; const int jb = lane;
                  for (int n = 0; n < 255; ++n) { const int cs = 16 * n, ss0 = 64 * jb; const int lo2 = cs > ss0 ? cs : ss0, hi2 = (cs + 32 < ss0 + 64) ? cs + 32 : ss0 + 64; const int ov = hi2 - lo2; if (ov > 0) { const float w = (float)ov / 32.f; for (int h4 = 0; h4 < 4; ++h4) imp += pc[h4 * 256 + n] * w; } }
                  const bool forced = (jb == 0) || (jb == cur) || (jb == cur - 1), causal = jb * 64 <= q;
                  pc[1024 + jb] = forced ? 1e9f : (causal ? imp : -1e9f); }
                asm volatile("s_waitcnt lgkmcnt(0)" ::: "memory");
                if (lane == 0) { for (int jb = 0; jb < 64; ++jb) pc[1088 + jb] = 0.f; for (int it = 0; it < 16; ++it) { int best = -1; float bv = -INFINITY; for (int jb = 0; jb < 64; ++jb) if (pc[1088 + jb] == 0.f && pc[1024 + jb] > bv) { bv = pc[1024 + jb]; best = jb; } pc[1088 + best] = 1.f; } }
                asm volatile("s_waitcnt lgkmcnt(0)" ::: "memory");
                const half_t* qv = WSP(half_t, WS_QN) + r * 512 + (g * 4 + hh) * 64; const int* dd = dbgt_22_dd;
                float oc[3] = {0.f, 0.f, 0.f};
                for (int i = 0; i < 4; ++i) { const int n = lane + 64 * i; if (n < 255) { const float p = pc[hh * 256 + n]; for (int e = 0; e < 3; ++e) oc[e] += p * h2f(Vc + (size_t)n * 64 + dd[e]); } }
                for (int e = 0; e < 3; ++e) oc[e] = wave_sum(oc[e]);
                float osw[2][3];
                for (int br = 0; br < 2; ++br) { const half_t* Kx = WSP(half_t, WS_KVT) + (size_t)(2 + 2 * br) * KVT_STRIDE + (size_t)bg * SEQ * 64; const half_t* Vx = WSP(half_t, WS_KVT) + (size_t)(3 + 2 * br) * KVT_STRIDE + (size_t)bg * SEQ * 64;
                    float mx = -1e30f;
                    for (int k = lane; k <= q; k += 64) { const bool ok = br ? (q - k < 512) : (pc[1088 + (k >> 6)] != 0.f); if (!ok) continue; float a = 0.f; for (int d = 0; d < 64; ++d) a += h2f(qv + d) * h2f(Kx + (size_t)k * 64 + d); mx = fmaxf(mx, a); }
                    for (int o = 1; o < 64; o <<= 1) mx = fmaxf(mx, __shfl_xor(mx, o));
                    float l = 0.f, a3[3] = {0.f, 0.f, 0.f};
                    for (int k = lane; k <= q; k += 64) { const bool ok = br ? (q - k < 512) : (pc[1088 + (k >> 6)] != 0.f); if (!ok) continue; float a = 0.f; for (int d = 0; d < 64; ++d) a += h2f(qv + d) * h2f(Kx + (size_t)k * 64 + d);
                        const float p = exp2f(a - mx); l += p; for (int e = 0; e < 3; ++e) a3[e] += p * h2f(Vx + (size_t)k * 64 + dd[e]); }
                    l = wave_sum(l); for (int e = 0; e < 3; ++e) osw[br][e] = wave_sum(a3[e]) / l; }
                if (lane == 0) { const float* gt = WSP(float, WS_GATE) + r * 24; const int head = g * 4 + hh; const float g0 = gt[head], g1 = gt[8 + head], g2 = gt[16 + head];
                    for (int e = 0; e < 3; ++e) dbg_flag(ctl, q < 1024 ? 14 : 15, h2f(WSP(half_t, WS_Y) + r * DM + 512 + head * 64 + dd[e]), g0 * oc[e] + g1 * osw[0][e] + g2 * osw[1][e]); }
                asm volatile("s_waitcnt lgkmcnt(0)" ::: "memory"); }
        }
    }
}
__global__ void __launch_bounds__(512) dbg_checks_b(Args args, int which) {
    unsigned char* ws = args.ws; unsigned* ctl = WSP(unsigned, WS_CTL);
    const int lane = threadIdx.x & 63, wid = threadIdx.x >> 6;
    const int* rows = dbgt_0_dbg_rows; const int* cols = dbgt_24_cols;
    if (blockIdx.x != 0 || wid >= 4) return;
    const int r = rows[wid];
    if (which == 6 && wid == 3) { const half_t* y = WSP(half_t, WS_Y) + (size_t)r * DM; const int* cc = dbgt_25_cc;
        for (int i = 0; i < 6; ++i) { const int c = cc[i]; float a = 0.f; for (int k = lane; k < DM; k += 64) a += h2f(y + k) * (k < 512 ? args.in[17][k] : args.in[18][k - 512]) * args.in[19][(size_t)k * DM + c];
            const float dot = wave_sum(a), xr = args.in[0][(size_t)r * DM + c], got = h2f(WSP(half_t, WS_H1) + (size_t)r * DM + c);
            if (lane == 0 && !(fabsf(got - (dot + xr)) <= 0.03f + 0.03f * fabsf(dot + xr))) atomicAdd(ctl + CW_DBG + 2, 1u << i); } }
    if (which == 6) { const half_t* y = WSP(half_t, WS_Y) + (size_t)r * DM;
        { float s0 = 0.f, s1 = 0.f; for (int k = lane; k < 512; k += 64) { const float a = h2f(y + k), b = h2f(y + 512 + k); s0 += a * a; s1 += b * b; } s0 = wave_sum(s0); s1 = wave_sum(s1);
          if (lane == 0) { dbg_flag(ctl, 20, s0 / 512.f, 1.f); dbg_flag(ctl, 21, s1 / 512.f, 1.f); } }
        { const int c = cols[wid], k = rows[wid] & 1023; if (lane == 0) dbg_flag(ctl, 22, 100.f * h2f(WSP(half_t, WS_WO) + (size_t)c * DM + k), 100.f * args.in[19][(size_t)k * DM + c] * (k < 512 ? args.in[17][k] : args.in[18][k - 512])); }
        for (int i = 0; i < 4; ++i) { const int c = cols[i]; float a = 0.f; for (int k = lane; k < DM; k += 64) a += h2f(y + k) * (k < 512 ? args.in[17][k] : args.in[18][k - 512]) * args.in[19][(size_t)k * DM + c];
            const float dot = wave_sum(a), xr = args.in[0][(size_t)r * DM + c], got = h2f(WSP(half_t, WS_H1) + (size_t)r * DM + c); a = dot + xr;
            if (lane == 0) { dbg_flag(ctl, 16, got, a);
                if ((wid == 0 && i == 0) || (wid == 3 && i == 3)) { int hcode = 9; auto near = [](float p, float q) { return fabsf(p - q) <= 0.03f + 0.03f * fabsf(q); };
                    if (near(got, dot + xr)) hcode = 1; else if (near(got, dot)) hcode = 2; else if (near(got, xr)) hcode = 3; else if (near(got, 2.f * xr + dot)) hcode = 4; else if (!(got == got)) hcode = 5; else if (near(got, 0.f)) hcode = 6;
                    atomicAdd(ctl + CW_DBG + 1, (unsigned)(wid == 0 ? 10 * hcode : hcode)); } } } }
    if (which == 7) { const half_t* h1 = WSP(half_t, WS_H1) + (size_t)r * DM; float ss = 0.f; for (int k = lane; k < DM; k += 64) { const float a = h2f(h1 + k); ss += a * a; } ss = wave_sum(ss); const float rs = 1.f / sqrtf(ss / DM + NORM_EPS);
        const int* c4 = dbgt_23_c4;
        for (int i = 0; i < 4; ++i) { const int c = c4[i]; float a = 0.f; for (int k = lane; k < DM; k += 64) a += h2f(h1 + k) * args.in[20][k] * args.in[21][(size_t)k * DFF + c];
            a = fmaxf(wave_sum(a) * rs, 0.f); if (lane == 0) dbg_flag(ctl, 17, h2f(WSP(half_t, WS_A2) + (size_t)r * DFF + c), a * a); } }
    if (which == 8) { const half_t* a2 = WSP(half_t, WS_A2) + (size_t)r * DFF;
        for (int i = 0; i < 4; ++i) { const int c = cols[i]; float a = 0.f; for (int k = lane; k < DFF; k += 64) a += h2f(a2 + k) * args.in[22][(size_t)k * DM + c];
            a = wave_sum(a) + h2f(WSP(half_t, WS_H1) + (size_t)r * DM + c); if (lane == 0) dbg_flag(ctl, 18, h2f(WSP(half_t, WS_H2) + (size_t)r * DM + c), a); } }
    if (which == 9) { const half_t* h2 = WSP(half_t, WS_H2) + (size_t)r * DM; float ss = 0.f; for (int k = lane; k < DM; k += 64) { const float a = h2f(h2 + k); ss += a * a; } ss = wave_sum(ss); const float rs = 1.f / sqrtf(ss / DM + NORM_EPS);
        for (int i = 0; i < 4; ++i) { const int c = cols[i]; if (lane == 0) dbg_flag(ctl, 19, args.out[(size_t)r * DM + c], h2f(h2 + c) * rs * args.in[23][c]); } }
}
__global__ void __launch_bounds__(512) dbg_fill(Args args) {
    unsigned char* ws = args.ws; unsigned* ctl = WSP(unsigned, WS_CTL);
#ifndef DBG_SKIP
#define DBG_SKIP 0
#endif
    const unsigned m = __hip_atomic_load(ctl + CW_DBG, __ATOMIC_RELAXED, __HIP_MEMORY_SCOPE_AGENT) & ~((1u << DBG_SKIP) - 1u);
#ifdef DBG_VALUE
    const int code = (int)__hip_atomic_load(ctl + CW_DBG + 2, __ATOMIC_RELAXED, __HIP_MEMORY_SCOPE_AGENT); (void)m;
#else
    const int code = m ? __builtin_ctz(m) : 0;
#endif
    const float a = sqrtf((float)code);
    for (size_t i = (size_t)blockIdx.x * 512 + threadIdx.x; i < (size_t)MROWS * DM / 4; i += (size_t)gridDim.x * 512) ((f32x4*)args.out)[i] = (f32x4){a, a, a, a};
}
#endif

extern "C" void kernel_launch(void* const* d_in, const int* in_sizes, int n_in, void* d_out, int out_size, void* d_ws, size_t ws_size, hipStream_t stream) {
    static int grid = 0;
    if (grid == 0) {
        if (n_in != 24 || out_size != MROWS * DM || ws_size < WS_END) { fprintf(stderr, "kernel_launch: unexpected problem (n_in %d, out %d, ws %zu)\n", n_in, out_size, ws_size); grid = -1; return; }
        int dev = 0, cus = 0, per_cu = 0;
        if (hipGetDevice(&dev) != hipSuccess || hipDeviceGetAttribute(&cus, hipDeviceAttributeMultiprocessorCount, dev) != hipSuccess) { grid = -1; return; }
        if (hipFuncSetAttribute((const void*)hymba_fwd, hipFuncAttributeMaxDynamicSharedMemorySize, LDS_BYTES) != hipSuccess) { fprintf(stderr, "kernel_launch: hipFuncSetAttribute failed\n"); grid = -1; return; }
        if (hipOccupancyMaxActiveBlocksPerMultiprocessor(&per_cu, (const void*)hymba_fwd, 512, LDS_BYTES) != hipSuccess || per_cu < 1) fprintf(stderr, "kernel_launch: occupancy query says %d\n", per_cu);
        (void)hipGetLastError();
        grid = cus;
#if DBG_CHECK
        (void)hipFuncSetAttribute((const void*)dbg_checks_a, hipFuncAttributeMaxDynamicSharedMemorySize, 98304);
#endif
    }
    if (grid < 0) return;
    (void)hipMemsetAsync((char*)d_ws + WS_CTL, 0, CTL_ZERO_BYTES, stream);
    Args a{};
    for (int i = 0; i < 24; ++i) a.in[i] = (const float*)d_in[i];
    a.out = (float*)d_out; a.ws = (unsigned char*)d_ws;
#if DBG_CHECK == 1
    a.ph_lo = 0; a.ph_hi = 5; a.li = 0; hipLaunchKernelGGL(hymba_fwd, dim3(grid), dim3(512), LDS_BYTES, stream, a);
    hipLaunchKernelGGL(dbg_checks_a, dim3(1), dim3(512), 98304, stream, a);
    hipLaunchKernelGGL(dbg_fill, dim3(1024), dim3(512), 0, stream, a);
#elif DBG_CHECK == 2
    a.ph_lo = 0; a.ph_hi = 7; a.li = 0; hipLaunchKernelGGL(hymba_fwd, dim3(grid), dim3(512), LDS_BYTES, stream, a);
    hipLaunchKernelGGL(dbg_checks_b, dim3(1), dim3(512), 0, stream, a, 6);
    a.ph_lo = 7; a.ph_hi = 8; a.li = 1; hipLaunchKernelGGL(hymba_fwd, dim3(grid), dim3(512), LDS_BYTES, stream, a);
    hipLaunchKernelGGL(dbg_checks_b, dim3(1), dim3(512), 0, stream, a, 7);
    a.ph_lo = 8; a.ph_hi = 9; a.li = 2; hipLaunchKernelGGL(hymba_fwd, dim3(grid), dim3(512), LDS_BYTES, stream, a);
    hipLaunchKernelGGL(dbg_checks_b, dim3(1), dim3(512), 0, stream, a, 8);
    a.ph_lo = 9; a.ph_hi = 10; a.li = 3; hipLaunchKernelGGL(hymba_fwd, dim3(grid), dim3(512), LDS_BYTES, stream, a);
    hipLaunchKernelGGL(dbg_checks_b, dim3(1), dim3(512), 0, stream, a, 9);
    hipLaunchKernelGGL(dbg_fill, dim3(1024), dim3(512), 0, stream, a);
#elif MK_N_LAUNCHES == 1
    a.ph_lo = 0; a.ph_hi = 10; a.li = 0;
    hipLaunchKernelGGL(hymba_fwd, dim3(grid), dim3(512), LDS_BYTES, stream, a);
#else
    for (int p = 0; p < 10; ++p) { a.ph_lo = p; a.ph_hi = p + 1; a.li = p; hipLaunchKernelGGL(hymba_fwd, dim3(grid), dim3(512), LDS_BYTES, stream, a); }
#endif
}
```

```cpp
#include <hip/hip_runtime.h>
#include <cstdio>
#include <cstdint>

#ifndef DBG_CHECK
#define DBG_CHECK 0
#endif
#ifndef REPEAT_PHASE
#define REPEAT_PHASE -1
#endif
#ifndef ABL
#define ABL 0
#endif
#ifndef MK_N_LAUNCHES
#define MK_N_LAUNCHES 1
#endif

#define LAS __attribute__((address_space(3)))
typedef _Float16 half_t;
typedef _Float16 half8 __attribute__((ext_vector_type(8)));
typedef _Float16 half2v __attribute__((ext_vector_type(2)));
typedef float f32x4 __attribute__((ext_vector_type(4)));
typedef float f32x16 __attribute__((ext_vector_type(16)));
typedef unsigned u32x4 __attribute__((ext_vector_type(4)));
typedef unsigned u32x2 __attribute__((ext_vector_type(2)));
typedef short v4i16 __attribute__((ext_vector_type(4)));

constexpr int BATCH = 16, SEQ = 4096, DM = 1024, MROWS = BATCH * SEQ;
constexpr int IN_COLS = 1720, NIN = 1792;
constexpr int DFF = 4096;
constexpr float NORM_EPS = 1e-6f;
constexpr float LOG2E = 1.4426950408889634f;
constexpr float QS_N = 0.125f * LOG2E;
constexpr float QS_M = 0.10206207261596577f * LOG2E;

constexpr size_t MiB = 1u << 20;
constexpr size_t WS_CTL = 0, CTL_ZERO_BYTES = 1 * MiB;
constexpr size_t WS_WIN = 1 * MiB, WS_WUQ = 5 * MiB, WS_WUKV = 6 * MiB, WS_WC1 = 7 * MiB, WS_WO = 9 * MiB, WS_WUP = 11 * MiB, WS_WDN = 19 * MiB;
constexpr size_t WS_ROPEM = 27 * MiB, WS_ROPEN = 27 * MiB + 512 * 1024, WS_B1P = 27 * MiB + 768 * 1024;
constexpr size_t WS_KC = 28 * MiB, WS_VC = 29 * MiB;
constexpr size_t WS_RS1 = 32 * MiB, WS_SSQ = 33 * MiB, WS_SSKV = 34 * MiB, WS_SSM = 35 * MiB, WS_SSN = 37 * MiB, WS_SS2 = 39 * MiB, WS_SS3 = 43 * MiB;
constexpr size_t WS_GATE = 47 * MiB, WS_KPE = 53 * MiB;
constexpr size_t WS_CQ = 64 * MiB, WS_T1 = 96 * MiB, WS_QN = 128 * MiB, WS_KVT = 192 * MiB  ;
constexpr size_t WS_QM = 288 * MiB, WS_KNM = 384 * MiB, WS_VM = 448 * MiB, WS_HIDP = 512 * MiB;
constexpr size_t WS_A2 = 64 * MiB;
constexpr size_t WS_XH = 576 * MiB, WS_H2 = 576 * MiB, WS_Y = 704 * MiB, WS_H1 = 832 * MiB, WS_END = 960 * MiB;
constexpr size_t KVT_STRIDE = 16 * MiB / 2;

constexpr int CW_QHEAD = 64;
constexpr int CW_BAR = 4096;

constexpr int LDS_BYTES = 163840;
constexpr int LDS_MISC = 163840 - 256;

#define XB_TMO      128
#define XB_XCNT(j)  (256  + 64 * (j))
#define XB_XSUB(j)  (1280 + 64 * (j))
#define XB_XGEN(j)  (2304 + 64 * (j))
#define XB_TOP      3328
#define XB_TOPGEN   3392
#define XCD_BAR_WORDS 3456
#define XB_SPIN_CAP (1u << 22)

__device__ __forceinline__ unsigned xb_ld(unsigned* p)              { return __hip_atomic_load(p, __ATOMIC_RELAXED, __HIP_MEMORY_SCOPE_AGENT); }
__device__ __forceinline__ unsigned xb_add(unsigned* p, unsigned v) { return __hip_atomic_fetch_add(p, v, __ATOMIC_RELAXED, __HIP_MEMORY_SCOPE_AGENT); }
__device__ __forceinline__ unsigned xb_xcc_id() { return (unsigned)__builtin_amdgcn_s_getreg((3 << 11) | 20) & 0xFu; }
#define XB_SPIN(cond, bar) do { unsigned _sp = 0; while (cond) { __builtin_amdgcn_s_sleep(1); \
    if ((++_sp & 255u) == 0u) { if (xb_ld(&(bar)[XB_TMO])) break; if (_sp > XB_SPIN_CAP) { atomicAdd(&(bar)[XB_TMO], 1u); break; } } } } while (0)

struct XcdBarrier { unsigned* bar; unsigned x; volatile LAS unsigned* st; };

__device__ __forceinline__ XcdBarrier xcd_barrier_post(unsigned* bar, volatile LAS unsigned* st) {
    XcdBarrier b; b.bar = bar; b.x = xb_xcc_id(); b.st = st;
    if (threadIdx.x == 0) (void)xb_add(&bar[XB_XCNT(b.x)], 1u);
    return b;
}
__device__ __forceinline__ void xcd_barrier_complete(unsigned* bar, unsigned x, unsigned& nloc, unsigned& nx) {
    const unsigned G = gridDim.x * gridDim.y * gridDim.z;
    unsigned sum, cnt, mine, sp = 0u;
    for (;;) {
        sum = 0u; cnt = 0u; mine = 0u;
#pragma unroll
        for (unsigned j = 0; j < 16; ++j) { const unsigned c = xb_ld(&bar[XB_XCNT(j)]); sum += c; cnt += (c > 0u) ? 1u : 0u; mine = (j == x) ? c : mine; }
        if (sum == G) break;
        __builtin_amdgcn_s_sleep(1);
        if ((++sp & 255u) == 0u) { if (xb_ld(&bar[XB_TMO])) break; if (sp > XB_SPIN_CAP) { atomicAdd(&bar[XB_TMO], 1u); break; } }
    }
    nloc = mine > 0u ? mine : 1u; nx = cnt > 0u ? cnt : 1u;
}
__device__ __forceinline__ void xcd_barrier(const XcdBarrier& b) {
    asm volatile("s_waitcnt vmcnt(0)" ::: "memory");
    __syncthreads();
    if (threadIdx.x == 0) {
        unsigned* bar = b.bar;
        __builtin_amdgcn_s_waitcnt(0);
        unsigned nloc = b.st[0], nx = b.st[1];
        if (nloc == 0u) { xcd_barrier_complete(bar, b.x, nloc, nx); b.st[0] = nloc; b.st[1] = nx; }
        const unsigned old = xb_add(&bar[XB_XSUB(b.x)], 1u);
        const unsigned gen = old / nloc;
        if (old + 1u == (gen + 1u) * nloc) {
            __builtin_amdgcn_fence(__ATOMIC_RELEASE, "agent");
            asm volatile("s_waitcnt vmcnt(0)" ::: "memory");
            const unsigned og = xb_add(&bar[XB_TOP], 1u);
            const unsigned tg = og / nx;
            if (og + 1u == (tg + 1u) * nx) xb_add(&bar[XB_TOPGEN], 1u);
            else XB_SPIN(xb_ld(&bar[XB_TOPGEN]) == tg, bar);
            __builtin_amdgcn_fence(__ATOMIC_ACQUIRE, "agent");
            xb_add(&bar[XB_XGEN(b.x)], 1u);
            asm volatile("s_waitcnt vmcnt(0)" ::: "memory");
        } else {
            XB_SPIN(xb_ld(&bar[XB_XGEN(b.x)]) == gen, bar);
            __builtin_amdgcn_fence(__ATOMIC_ACQUIRE, "agent");
            asm volatile("s_waitcnt vmcnt(0)" ::: "memory");
        }
    }
    __syncthreads();
}

__device__ __forceinline__ unsigned pk_rne(float a, float b) { half2v v = {(_Float16)a, (_Float16)b}; return __builtin_bit_cast(unsigned, v); }
__device__ __forceinline__ unsigned pk_rtz(float a, float b) { auto v = __builtin_amdgcn_cvt_pkrtz(a, b); return __builtin_bit_cast(unsigned, v); }
__device__ __forceinline__ u32x4 pk8(const float* v) { u32x4 w; w.x = pk_rne(v[0], v[1]); w.y = pk_rne(v[2], v[3]); w.z = pk_rne(v[4], v[5]); w.w = pk_rne(v[6], v[7]); return w; }
__device__ __forceinline__ void unpk8(u32x4 w, float* v) {
    const half8 h = __builtin_bit_cast(half8, w);
#pragma unroll
    for (int i = 0; i < 8; ++i) v[i] = (float)h[i];
}
__device__ __forceinline__ float wave_sum(float v) {
#pragma unroll
    for (int o = 1; o < 64; o <<= 1) v += __shfl_xor(v, o);
    return v;
}
__device__ __forceinline__ void rope4(float* v, const float2* cs) {
#pragma unroll
    for (int p = 0; p < 4; ++p) { const float2 t = cs[p]; const float x1 = v[2 * p], x2 = v[2 * p + 1]; v[2 * p] = x1 * t.x - x2 * t.y; v[2 * p + 1] = x2 * t.x + x1 * t.y; }
}

__host__ __device__ __forceinline__ size_t k_off(int tok, int d)   { return (size_t)(((tok >> 6) * 8 + (d >> 3)) * 512 + (tok & 63) * 8 + (d & 7)); }
__host__ __device__ __forceinline__ size_t v_off(int tok, int d)   { return (size_t)((tok >> 6) * 4096 + ((d >> 5) * 8 + ((tok & 63) >> 3)) * 256 + (tok & 7) * 32 + (d & 31)); }
__host__ __device__ __forceinline__ size_t kpe_off(int tok, int p) { return (size_t)(((tok >> 6) * 4 + (p >> 3)) * 512 + (tok & 63) * 8 + (p & 7)); }

namespace pg8 {
constexpr int BM = 256, BK = 64, HALF = 128, HTB = HALF * BK * 2, NXCD = 8, WGM = 8;
__host__ __device__ __forceinline__ int lds_byte(int r, int c) { const int st = (r >> 4) * 2 + (c >> 5), rr = r & 15, cc = c & 31, ob = rr * 64 + cc * 2; return st * 1024 + (ob ^ (((ob >> 9) & 1) << 5)); }
__host__ __device__ __forceinline__ void stage_rc(int b, int& R, int& C) { const int st = b / 1024, sb = b % 1024, swz = sb ^ (((sb >> 9) & 1) << 5); R = (st >> 1) * 16 + swz / 64; C = (st & 1) * 32 + (swz % 64) / 2; }
__host__ __device__ __forceinline__ int perm32(int rho) { const int n = rho >> 4, i = rho & 15; return 8 * (i >> 2) + 4 * n + (i & 3); }

struct Unit { int pm, pn; size_t aoff, boff; };
struct Gemm { const half_t* A; const half_t* Bt; int K, lda, ldb; };

struct StaticOrder {
    int nM, nN, nwg, G, c; size_t tA, tB;
    __device__ void init(int M, int N, int G_, int c_, int lda, int ldb) { nM = M / BM; nN = N / BM; nwg = nM * nN; G = G_; c = c_; tA = (size_t)BM * lda * 2; tB = (size_t)BM * ldb * 2; }
    __device__ bool next(int i, Unit& u) const {
        const long L = (long)i * G + c; if (L >= nwg) return false;
        int wgid = (int)L; { const int q = nwg / NXCD, r = nwg % NXCD, xcd = wgid % NXCD, off = wgid / NXCD; wgid = (xcd < r ? xcd * (q + 1) : r * (q + 1) + (xcd - r) * q) + off; }
        const int nig = WGM * nN, gid = wgid / nig, fm = gid * WGM, gsz = (nM - fm) < WGM ? (nM - fm) : WGM;
        u.pm = fm + ((wgid % nig) % gsz); u.pn = (wgid % nig) / gsz; u.aoff = (size_t)u.pm * tA; u.boff = (size_t)u.pn * tB; return true;
    }
};
struct Cmp1Order {
    int G, c;
    __device__ bool next(int i, Unit& u) const {
        const int L = i * G + c; if (L >= 256) return false;
        const int kv = L >> 7, slab = (L >> 2) & 31, ch = L & 3;
        u.pm = L; u.pn = 0; u.aoff = (size_t)kv * (16 * MiB) + (size_t)slab * (512 * 1024) + (size_t)ch * 1024; u.boff = (size_t)kv * (256 * 2048 * 2) + (size_t)ch * 1024; return true;
    }
};

template <class Epi, class Sched, bool MIDK = false>
__device__ __forceinline__ void gemm_phase(LAS unsigned char* lds, const Gemm g, const Sched& S, const Epi& E) {
    int tid_ = threadIdx.x; asm volatile("" : "+v"(tid_));
    const int tid = tid_, wid = __builtin_amdgcn_readfirstlane(tid >> 6), lane = tid & 63, wr = wid >> 2, wc = wid & 3, fr = lane & 15, fq = lane >> 4;
    const int K = g.K, nt = K / BK;
    unsigned voffA[2], voffB[2];
#pragma unroll
    for (int i = 0; i < 2; ++i) { int R, C; stage_rc(tid * 16 + i * 8192, R, C); const int Rb = (R & ~31) + perm32(R & 31);
        voffA[i] = (unsigned)(R * g.lda + C) * 2u; voffB[i] = (unsigned)(Rb * g.ldb + C) * 2u; }
    const size_t kstep = (size_t)(BK * 2);
    const size_t hstepA = (size_t)HALF * g.lda * 2, hstepB = (size_t)HALF * g.ldb * 2;
    const unsigned ldsw = (unsigned)wid * 1024u;
    const int aoff = lds_byte(wr * 64 + fr, fq * 8), boff = lds_byte(wc * 32 + fr, fq * 8);
#define PG8_SA(b, h) (((b) * 2 + (h)) * HTB)
#define PG8_SB(b, h) ((4 + (b) * 2 + (h)) * HTB)
#define PG8_STAGE(bufoff, gbase, voff) do { _Pragma("unroll") for (int _i = 0; _i < 2; ++_i) \
        __builtin_amdgcn_global_load_lds((const unsigned*)((const char*)(gbase) + (voff)[_i]), (LAS unsigned*)(lds + (bufoff) + ldsw + _i * 8192), 16, 0, 0); } while (0)
#define PG8_LDA(dst, b, h) do { _Pragma("unroll") for (int m = 0; m < 4; ++m) _Pragma("unroll") for (int k = 0; k < 2; ++k) dst[m][k] = *(const LAS half8*)(lds + PG8_SA(b, h) + aoff + m * 2048 + k * 1024); } while (0)
#define PG8_LDB(dst, b, h) do { _Pragma("unroll") for (int n = 0; n < 2; ++n) _Pragma("unroll") for (int k = 0; k < 2; ++k) dst[n][k] = *(const LAS half8*)(lds + PG8_SB(b, h) + boff + n * 2048 + k * 1024); } while (0)
#define PG8_MMA(ai, bj, At, Bt) do { __builtin_amdgcn_s_setprio(1); _Pragma("unroll") for (int m = 0; m < 4; ++m) _Pragma("unroll") for (int n = 0; n < 2; ++n) _Pragma("unroll") for (int k = 0; k < 2; ++k) \
        acc[ai][bj][m][n] = __builtin_amdgcn_mfma_f32_16x16x32_f16(Bt[n][k], At[m][k], acc[ai][bj][m][n], 0, 0, 0); __builtin_amdgcn_s_setprio(0); } while (0)
#define PG8_WAIT_V(n) asm volatile("s_waitcnt vmcnt(" #n ")" ::: "memory")
#define PG8_WAIT_L(n) asm volatile("s_waitcnt lgkmcnt(" #n ")" ::: "memory")
#define PG8_BAR __builtin_amdgcn_s_barrier()
#define PG8_SCHED __builtin_amdgcn_sched_barrier(0)
    Unit cur, nxt; int ui = 0;
    if (!S.next(0, cur)) return;
    f32x4 acc[2][2][4][2];
#pragma unroll
    for (int a = 0; a < 2; ++a)
#pragma unroll
        for (int b = 0; b < 2; ++b)
#pragma unroll
            for (int m = 0; m < 4; ++m)
#pragma unroll
                for (int n = 0; n < 2; ++n) acc[a][b][m][n] = (f32x4){0.f, 0.f, 0.f, 0.f};
    half8 At[4][2], B0[2][2], B1[2][2];
    const char* cA = (const char*)g.A + cur.aoff; const char* cB = (const char*)g.Bt + cur.boff;
    PG8_STAGE(PG8_SB(0, 0), cB, voffB); PG8_STAGE(PG8_SB(0, 1), cB + hstepB, voffB); PG8_STAGE(PG8_SA(0, 0), cA, voffA); PG8_STAGE(PG8_SA(0, 1), cA + hstepA, voffA);
    if (wr == 1) PG8_BAR;
    PG8_WAIT_V(2); PG8_BAR;
    PG8_STAGE(PG8_SB(1, 0), cB + kstep, voffB); PG8_STAGE(PG8_SA(1, 0), cA + kstep, voffA); PG8_STAGE(PG8_SB(1, 1), cB + hstepB + kstep, voffB);
    PG8_WAIT_V(6); PG8_BAR;
    for (;;) {
        const bool has_next = S.next(ui + 1, nxt);
        const char* nA = has_next ? (const char*)g.A + nxt.aoff : cA; const char* nB = has_next ? (const char*)g.Bt + nxt.boff : cB;
        for (int t = 0; t < nt; t += 2) {
            if constexpr (MIDK) { if (t == nt / 2) E.midk(acc, cur, wr); }
            const bool last = (t == nt - 2);
            const char* a1 = cA + (size_t)(t + 1) * kstep;
            const char* a2 = last ? nA : cA + (size_t)(t + 2) * kstep; const char* b2 = last ? nB : cB + (size_t)(t + 2) * kstep;
            const char* a3 = a2 + kstep; const char* b3 = b2 + kstep;
            PG8_LDB(B0, 0, 0); PG8_LDB(B1, 0, 1); PG8_SCHED; PG8_LDA(At, 0, 0); PG8_STAGE(PG8_SA(1, 1), a1 + hstepA, voffA);
            PG8_WAIT_V(8); PG8_WAIT_L(0); PG8_BAR; PG8_MMA(0, 0, At, B0); PG8_MMA(0, 1, At, B1); PG8_BAR; PG8_SCHED;
            PG8_LDA(At, 0, 1); PG8_STAGE(PG8_SB(0, 0), b2, voffB); PG8_STAGE(PG8_SB(0, 1), b2 + hstepB, voffB); PG8_STAGE(PG8_SA(0, 0), a2, voffA);
            PG8_WAIT_V(8); PG8_WAIT_L(0); PG8_BAR; PG8_MMA(1, 0, At, B0); PG8_MMA(1, 1, At, B1); PG8_BAR; PG8_SCHED;
            PG8_LDB(B0, 1, 0); PG8_LDB(B1, 1, 1); PG8_SCHED; PG8_LDA(At, 1, 0); PG8_STAGE(PG8_SA(0, 1), a2 + hstepA, voffA);
            PG8_WAIT_V(8); PG8_WAIT_L(0); PG8_BAR; PG8_MMA(0, 0, At, B0); PG8_MMA(0, 1, At, B1); PG8_BAR; PG8_SCHED;
            PG8_LDA(At, 1, 1); PG8_STAGE(PG8_SB(1, 0), b3, voffB); PG8_STAGE(PG8_SB(1, 1), b3 + hstepB, voffB); PG8_STAGE(PG8_SA(1, 0), a3, voffA);
            PG8_WAIT_V(8); PG8_WAIT_L(0); PG8_BAR; PG8_MMA(1, 0, At, B0); PG8_MMA(1, 1, At, B1); PG8_BAR; PG8_SCHED;
        }
        if (wr == 0) PG8_BAR;
        E(acc, cur, wr, wc, fr, fq);
        if (!has_next) break;
#pragma unroll
        for (int a = 0; a < 2; ++a)
#pragma unroll
            for (int b = 0; b < 2; ++b)
#pragma unroll
                for (int m = 0; m < 4; ++m)
#pragma unroll
                    for (int n = 0; n < 2; ++n) acc[a][b][m][n] = (f32x4){0.f, 0.f, 0.f, 0.f};
        cur = nxt; cA = nA; cB = nB; ++ui;
        if (wr == 1) PG8_BAR;
    }
    PG8_WAIT_V(0);
    PG8_BAR;
#undef PG8_SA
#undef PG8_SB
#undef PG8_STAGE
#undef PG8_LDA
#undef PG8_LDB
#undef PG8_MMA
#undef PG8_WAIT_V
#undef PG8_WAIT_L
#undef PG8_BAR
#undef PG8_SCHED
}
}

typedef f32x4 AccT[2][2][4][2];
#define EPI_IDS() int t_ = threadIdx.x; asm volatile("" : "+v"(t_)); const int fr = t_ & 15, fq = (t_ >> 4) & 3; (void)fr_; (void)fq_
#define EPI_ROW(ai, m) (u.pm * 256 + (ai) * 128 + wr * 64 + (m) * 16 + fr)
#define EPI_GET8(v, ai, bj, m, s) do { const f32x4 _a = acc[ai][bj][m][0], _b = acc[ai][bj][m][1]; v[0] = _a[0] * (s); v[1] = _a[1] * (s); v[2] = _a[2] * (s); v[3] = _a[3] * (s); v[4] = _b[0] * (s); v[5] = _b[1] * (s); v[6] = _b[2] * (s); v[7] = _b[3] * (s); } while (0)
__device__ __forceinline__ void rope4v(float* v, const f32x4& c01, const f32x4& c23) {
    const float cs[8] = {c01[0], c01[1], c01[2], c01[3], c23[0], c23[1], c23[2], c23[3]};
#pragma unroll
    for (int p = 0; p < 4; ++p) { const float x1 = v[2 * p], x2 = v[2 * p + 1]; v[2 * p] = x1 * cs[2 * p] - x2 * cs[2 * p + 1]; v[2 * p + 1] = x2 * cs[2 * p] + x1 * cs[2 * p + 1]; }
}
__device__ __forceinline__ float sum4(const f32x4& a) { return (a[0] + a[1]) + (a[2] + a[3]); }
__device__ __forceinline__ float relu_s(float x) { float r; asm("v_max_f32_e32 %0, 0, %1" : "=v"(r) : "v"(x)); return r; }
constexpr int LDS_RED = 131072;

struct EpiIn {
    const float* rs1; half_t* CQ; half_t* T1; half_t* KPE; float* GATE; float* SSQ; float* SSKV; half_t* QN; half_t* KVT; const float2* ropeM; const float2* ropeN;
    __device__ __forceinline__ void operator()(const AccT& acc, const pg8::Unit& u, int wr, int wc, int fr_, int fq_) const {
        EPI_IDS();
        const int pn = u.pn;
        const bool ropem = (pn == 1 && wc == 0), ropen = (pn >= 2 && pn != 4 && (wc & 1) == 0);
#pragma unroll
        for (int ai = 0; ai < 2; ++ai) {
            float rsv[4]; f32x4 rc[4][2];
#pragma unroll
            for (int m = 0; m < 4; ++m) { const int row = EPI_ROW(ai, m), pos = row & (SEQ - 1); rsv[m] = rs1[row];
                if (ropem) { const f32x4* p = (const f32x4*)(ropeM + (size_t)pos * 16 + fq * 4); rc[m][0] = p[0]; rc[m][1] = p[1]; }
                else if (ropen) { const f32x4* p = (const f32x4*)(ropeN + (size_t)pos * 8 + (fq & 1) * 4); rc[m][0] = p[0]; rc[m][1] = p[1]; } }
#pragma unroll
            for (int m = 0; m < 4; ++m) { const int row = EPI_ROW(ai, m), pos = row & (SEQ - 1), b = row >> 12; const float rs = rsv[m];
                float v[8];
                if (pn == 0) {
                    float ss = 0.f;
#pragma unroll
                    for (int bj = 0; bj < 2; ++bj) { EPI_GET8(v, ai, bj, m, rs);
#pragma unroll
                        for (int i = 0; i < 8; ++i) ss += v[i] * v[i];
                        *(u32x4*)(CQ + (size_t)row * 256 + bj * 128 + wc * 32 + fq * 8) = pk8(v); }
                    ss += __shfl_xor(ss, 16); ss += __shfl_xor(ss, 32);
                    if (fq == 0) SSQ[(size_t)row * 4 + wc] = ss;
                } else if (pn == 1) {
                    { EPI_GET8(v, ai, 0, m, rs); float ss = 0.f;
#pragma unroll
                        for (int i = 0; i < 8; ++i) ss += v[i] * v[i];
                        *(u32x4*)(T1 + (size_t)row * 256 + wc * 32 + fq * 8) = pk8(v);
                        ss += __shfl_xor(ss, 16); ss += __shfl_xor(ss, 32);
                        if (fq == 0) SSKV[(size_t)row * 4 + wc] = ss; }
                    { EPI_GET8(v, ai, 1, m, rs);
                        if (wc == 0) { rope4v(v, rc[m][0], rc[m][1]); const u32x4 w = pk8(v);
                            *(u32x4*)(T1 + (size_t)row * 256 + 128 + fq * 8) = w; *(u32x4*)(KPE + (size_t)b * SEQ * 32 + kpe_off(pos, fq * 8)) = w; }
                        else { if (wc == 1 && fq < 3) { float* gp = GATE + (size_t)row * 24 + fq * 8;
#pragma unroll
                                for (int i = 0; i < 8; ++i) v[i] = 1.f / (1.f + __expf(-v[i]));
                                *(f32x4*)gp = (f32x4){v[0], v[1], v[2], v[3]}; *(f32x4*)(gp + 4) = (f32x4){v[4], v[5], v[6], v[7]}; }
                            *(u32x4*)(T1 + (size_t)row * 256 + 128 + wc * 32 + fq * 8) = (u32x4){0u, 0u, 0u, 0u}; } }
                } else if (pn < 4) {
#pragma unroll
                    for (int bj = 0; bj < 2; ++bj) { EPI_GET8(v, ai, bj, m, rs); const int head = (pn - 2) * 4 + 2 * bj + (wc >> 1), off = 32 * (wc & 1) + 8 * fq;
                        if ((wc & 1) == 0 && fq < 2) rope4v(v, rc[m][0], rc[m][1]);
#pragma unroll
                        for (int i = 0; i < 8; ++i) v[i] *= QS_N;
                        *(u32x4*)(QN + (size_t)row * 512 + head * 64 + off) = pk8(v); }
                } else {
#pragma unroll
                    for (int bj = 0; bj < 2; ++bj) { EPI_GET8(v, ai, bj, m, rs); const int g = wc >> 1, d = 32 * (wc & 1) + 8 * fq;
                        if (pn > 4 && bj == 0 && (wc & 1) == 0 && fq < 2) rope4v(v, rc[m][0], rc[m][1]);
                        half_t* base = KVT + (size_t)((pn - 4) * 2 + bj) * KVT_STRIDE + (size_t)(b * 2 + g) * SEQ * 64;
                        *(u32x4*)(base + (pn == 4 ? (size_t)pos * 64 + d : (bj == 0 ? k_off(pos, d) : v_off(pos, d)))) = pk8(v); }
                }
            }
        }
    }
};

struct EpiUq {
    const float* SSQ; half_t* QM; const float2* ropeM;
    __device__ __forceinline__ void operator()(const AccT& acc, const pg8::Unit& u, int wr, int wc, int fr_, int fq_) const {
        EPI_IDS();
        const bool pe0 = ((8 * u.pn + wc) % 3 == 2), pe1 = ((8 * u.pn + 4 + wc) % 3 == 2);
#pragma unroll
        for (int ai = 0; ai < 2; ++ai) {
            f32x4 s4[4];
#pragma unroll
            for (int m = 0; m < 4; ++m) s4[m] = *(const f32x4*)(SSQ + (size_t)EPI_ROW(ai, m) * 4);
#pragma unroll
            for (int m = 0; m < 4; ++m) { const int row = EPI_ROW(ai, m);
                const float rs = __builtin_amdgcn_rsqf(sum4(s4[m]) * (1.f / 256.f) + NORM_EPS) * QS_M;
                float v[8];
#pragma unroll
                for (int bj = 0; bj < 2; ++bj) { EPI_GET8(v, ai, bj, m, rs); const int sidx = 8 * u.pn + 4 * bj + wc;
                    if (bj == 0 ? pe0 : pe1) { const f32x4* p = (const f32x4*)(ropeM + (size_t)(row & (SEQ - 1)) * 16 + fq * 4); rope4v(v, p[0], p[1]); }
                    *(u32x4*)(QM + (size_t)row * 768 + sidx * 32 + fq * 8) = pk8(v); }
            }
        }
    }
};
struct EpiUkv {
    const float* SSKV; half_t* KNM; half_t* VM;
    __device__ __forceinline__ void operator()(const AccT& acc, const pg8::Unit& u, int wr, int wc, int fr_, int fq_) const {
        EPI_IDS();
#pragma unroll
        for (int ai = 0; ai < 2; ++ai) {
            f32x4 s4[4];
#pragma unroll
            for (int m = 0; m < 4; ++m) s4[m] = *(const f32x4*)(SSKV + (size_t)EPI_ROW(ai, m) * 4);
#pragma unroll
            for (int m = 0; m < 4; ++m) { const int row = EPI_ROW(ai, m), pos = row & (SEQ - 1), b = row >> 12;
                const float rs = __builtin_amdgcn_rsqf(sum4(s4[m]) * (1.f / 128.f) + NORM_EPS);
                float v[8];
#pragma unroll
                for (int bj = 0; bj < 2; ++bj) { EPI_GET8(v, ai, bj, m, rs); const int c = (u.pn & 1) * 256 + bj * 128 + wc * 32 + fq * 8, head = c >> 6, d = c & 63;
                    half_t* base = ((u.pn < 2) ? KNM : VM) + (size_t)(b * 8 + head) * SEQ * 64;
                    *(u32x4*)(base + ((u.pn < 2) ? k_off(pos, d) : v_off(pos, d))) = pk8(v); }
            }
        }
    }
};
struct EpiC1 {
    float* HIDP;
    __device__ __forceinline__ void operator()(const AccT& acc, const pg8::Unit& u, int wr, int wc, int fr_, int fq_) const {
        EPI_IDS();
#pragma unroll
        for (int ai = 0; ai < 2; ++ai)
#pragma unroll
            for (int m = 0; m < 4; ++m) { const int rl = ai * 128 + wr * 64 + m * 16 + fr; float* p = HIDP + ((size_t)u.pm * 256 + rl) * 128 + wc * 32 + fq * 8;
                *(f32x4*)p = acc[ai][0][m][0]; *(f32x4*)(p + 4) = acc[ai][0][m][1]; }
    }
};
__device__ __forceinline__ float rstd8(const float* p, float inv_n) {
    const f32x4 a = *(const f32x4*)p, b = *(const f32x4*)(p + 4);
    return __builtin_amdgcn_rsqf((sum4(a) + sum4(b)) * inv_n + NORM_EPS);
}
struct EpiWo {
    const half_t* XH; half_t* H1; float* SS2; const float* SSM; const float* SSN; LAS float* red;
    __device__ __forceinline__ void midk(AccT& acc, const pg8::Unit& u, int wr) const {
        int t_ = threadIdx.x; asm volatile("" : "+v"(t_)); const int fr = t_ & 15;
#pragma unroll
        for (int ai = 0; ai < 2; ++ai) {
            f32x4 sm[4][2], sn[4][2];
#pragma unroll
            for (int m = 0; m < 4; ++m) { const int row = EPI_ROW(ai, m); sm[m][0] = *(const f32x4*)(SSM + (size_t)row * 8); sm[m][1] = *(const f32x4*)(SSM + (size_t)row * 8 + 4); sn[m][0] = *(const f32x4*)(SSN + (size_t)row * 8); sn[m][1] = *(const f32x4*)(SSN + (size_t)row * 8 + 4); }
#pragma unroll
            for (int m = 0; m < 4; ++m) {
                const float ratio = __builtin_amdgcn_rsqf((sum4(sm[m][0]) + sum4(sm[m][1])) * (1.f / 512.f) + NORM_EPS) / __builtin_amdgcn_rsqf((sum4(sn[m][0]) + sum4(sn[m][1])) * (1.f / 512.f) + NORM_EPS);
#pragma unroll
                for (int bj = 0; bj < 2; ++bj)
#pragma unroll
                    for (int n = 0; n < 2; ++n) acc[ai][bj][m][n] *= ratio; }
        }
    }
    __device__ __forceinline__ void operator()(const AccT& acc, const pg8::Unit& u, int wr, int wc, int fr_, int fq_) const {
        EPI_IDS();
#pragma unroll
        for (int ai = 0; ai < 2; ++ai) {
            f32x4 sn[4][2]; u32x4 xr[4][2];
#pragma unroll
            for (int m = 0; m < 4; ++m) { const int row = EPI_ROW(ai, m); sn[m][0] = *(const f32x4*)(SSN + (size_t)row * 8); sn[m][1] = *(const f32x4*)(SSN + (size_t)row * 8 + 4);
#pragma unroll
                for (int bj = 0; bj < 2; ++bj) xr[m][bj] = *(const u32x4*)(XH + (size_t)row * DM + u.pn * 256 + bj * 128 + wc * 32 + fq * 8); }
#pragma unroll
            for (int m = 0; m < 4; ++m) { const int row = EPI_ROW(ai, m);
                const float rn = __builtin_amdgcn_rsqf((sum4(sn[m][0]) + sum4(sn[m][1])) * (1.f / 512.f) + NORM_EPS);
                float v[8], x[8], ss = 0.f;
#pragma unroll
                for (int bj = 0; bj < 2; ++bj) { EPI_GET8(v, ai, bj, m, rn); unpk8(xr[m][bj], x);
#pragma unroll
                    for (int i = 0; i < 8; ++i) { v[i] += x[i]; ss += v[i] * v[i]; }
                    *(u32x4*)(H1 + (size_t)row * DM + u.pn * 256 + bj * 128 + wc * 32 + fq * 8) = pk8(v); }
                ss += __shfl_xor(ss, 16); ss += __shfl_xor(ss, 32);
                if (fq == 0) red[(ai * 128 + wr * 64 + m * 16 + fr) * 4 + wc] = ss;
            }
        }
        asm volatile("s_waitcnt lgkmcnt(0)" ::: "memory"); __builtin_amdgcn_s_barrier();
        if (t_ < 256) { const f32x4 r4 = *(const LAS f32x4*)(red + t_ * 4); SS2[(size_t)(u.pm * 256 + t_) * 4 + u.pn] = sum4(r4); }
    }
};
__device__ __forceinline__ float rstd16(const float* p, float inv_n) {
    const f32x4 a = *(const f32x4*)p, b = *(const f32x4*)(p + 4), c = *(const f32x4*)(p + 8), d = *(const f32x4*)(p + 12);
    return __builtin_amdgcn_rsqf(((sum4(a) + sum4(b)) + (sum4(c) + sum4(d))) * inv_n + NORM_EPS);
}
struct EpiUp {
    const float* SS2; half_t* A2;
    __device__ __forceinline__ void operator()(const AccT& acc, const pg8::Unit& u, int wr, int wc, int fr_, int fq_) const {
        EPI_IDS();
#pragma unroll
        for (int ai = 0; ai < 2; ++ai) {
            f32x4 s[4];
#pragma unroll
            for (int m = 0; m < 4; ++m) s[m] = *(const f32x4*)(SS2 + (size_t)EPI_ROW(ai, m) * 4);
#pragma unroll
            for (int m = 0; m < 4; ++m) { const int row = EPI_ROW(ai, m);
                const float rs = __builtin_amdgcn_rsqf(sum4(s[m]) * (1.f / 1024.f) + NORM_EPS);
                const float rs2 = rs * rs;
#pragma unroll
                for (int bj = 0; bj < 2; ++bj) { u32x4 w;
#pragma unroll
                    for (int n = 0; n < 2; ++n) { const f32x4 a = acc[ai][bj][m][n];
                        typedef float f32x2 __attribute__((ext_vector_type(2)));
                        f32x2 x0 = {relu_s(a[0]), relu_s(a[1])}, x1 = {relu_s(a[2]), relu_s(a[3])};
                        x0 = x0 * x0 * rs2; x1 = x1 * x1 * rs2;
                        w[2 * n] = pk_rne(x0[0], x0[1]); w[2 * n + 1] = pk_rne(x1[0], x1[1]); }
                    __builtin_nontemporal_store(w, (u32x4*)(A2 + (size_t)row * DFF + u.pn * 256 + bj * 128 + wc * 32 + fq * 8)); }
            }
        }
    }
};
struct EpiDn {
    const half_t* H1; half_t* H2; float* SS3; LAS float* red;
    __device__ __forceinline__ void operator()(const AccT& acc, const pg8::Unit& u, int wr, int wc, int fr_, int fq_) const {
        EPI_IDS();
#pragma unroll
        for (int ai = 0; ai < 2; ++ai) {
            u32x4 xr[4][2];
#pragma unroll
            for (int m = 0; m < 4; ++m)
#pragma unroll
                for (int bj = 0; bj < 2; ++bj) xr[m][bj] = *(const u32x4*)(H1 + (size_t)EPI_ROW(ai, m) * DM + u.pn * 256 + bj * 128 + wc * 32 + fq * 8);
#pragma unroll
            for (int m = 0; m < 4; ++m) { const int row = EPI_ROW(ai, m);
                float v[8], x[8], ss = 0.f;
#pragma unroll
                for (int bj = 0; bj < 2; ++bj) { EPI_GET8(v, ai, bj, m, 1.f); unpk8(xr[m][bj], x);
#pragma unroll
                    for (int i = 0; i < 8; ++i) { v[i] += x[i]; ss += v[i] * v[i]; }
                    *(u32x4*)(H2 + (size_t)row * DM + u.pn * 256 + bj * 128 + wc * 32 + fq * 8) = pk8(v); }
                ss += __shfl_xor(ss, 16); ss += __shfl_xor(ss, 32);
                if (fq == 0) red[(ai * 128 + wr * 64 + m * 16 + fr) * 4 + wc] = ss;
            }
        }
        asm volatile("s_waitcnt lgkmcnt(0)" ::: "memory"); __builtin_amdgcn_s_barrier();
        if (t_ < 256) { const f32x4 r4 = *(const LAS f32x4*)(red + t_ * 4); SS3[(size_t)(u.pm * 256 + t_) * 4 + u.pn] = sum4(r4); }
    }
};

constexpr int AT_KB = 0, AT_VB = 12288, AT_BUF = 20480;
constexpr int AT_SUB = 3;
constexpr int AT_STAGE = AT_SUB * AT_BUF;
constexpr int AT_IMP = 2 * AT_STAGE;
constexpr int AT_IMPW = 8 * 2 * 68 * 4;
constexpr int AT_SEL = AT_IMP + 8 * AT_IMPW;
constexpr int AT_QIDX = AT_SEL + 8 * 64;

struct TileRegs { u32x4 k, kp, v; };
__device__ __forceinline__ void tile_load(TileRegs& r, const half_t* Kt, const half_t* KPt, const half_t* Vt, int tid, int wid, int lane) {
    r.k = *(const u32x4*)(Kt + (size_t)(tid & 63) * 64 + wid * 8);
    if (KPt != nullptr && tid < 256) r.kp = *(const u32x4*)(KPt + (size_t)(tid & 63) * 32 + wid * 8);
    r.v = *(const u32x4*)(Vt + (size_t)(16 * (wid & 3) + (lane >> 2)) * 64 + (wid >> 2) * 32 + (lane & 3) * 8);
}
__device__ __forceinline__ void tile_store(const TileRegs& r, LAS unsigned char* buf, bool haspe, int tid, int wid, int lane) {
    *(LAS u32x4*)(buf + AT_KB + wid * 1024 + lane * 16) = r.k;
    if (haspe && tid < 256) *(LAS u32x4*)(buf + AT_KB + (8 + wid) * 1024 + lane * 16) = r.kp;
    *(LAS u32x4*)(buf + AT_VB + wid * 1024 + lane * 16) = r.v;
}
__device__ __forceinline__ float xhalf_max(float v) { const auto rr = __builtin_amdgcn_permlane32_swap(__float_as_uint(v), __float_as_uint(v), false, false); return fmaxf(__uint_as_float(rr[0]), __uint_as_float(rr[1])); }
__device__ __forceinline__ float xhalf_sum(float v) { const auto rr = __builtin_amdgcn_permlane32_swap(__float_as_uint(v), __float_as_uint(v), false, false); return __uint_as_float(rr[0]) + __uint_as_float(rr[1]); }
template <int NKS, int AB = 0>
__device__ __forceinline__ void tile_qk(const LAS unsigned char* kb, const half8 (&qf)[NKS], const f32x16& cinit, f32x16& p0, f32x16& p1) {
    if (AB & 1) { p0 = cinit; p1 = cinit; p0[0] += (float)qf[0][0]; p1[3] += (float)qf[1][1]; if (!(AB & 8)) { const half8 a = *(const LAS half8*)kb; p0[1] += (float)a[0]; } return; }
    half8 kf[2 * NKS];
#pragma unroll
    for (int ks = 0; ks < NKS; ++ks) { kf[2 * ks] = *(const LAS half8*)(kb + ks * 2048); kf[2 * ks + 1] = *(const LAS half8*)(kb + ks * 2048 + 512); }
    __builtin_amdgcn_sched_barrier(0);
    p0 = __builtin_amdgcn_mfma_f32_32x32x16_f16(kf[0], qf[0], cinit, 0, 0, 0);
    p1 = __builtin_amdgcn_mfma_f32_32x32x16_f16(kf[1], qf[0], cinit, 0, 0, 0);
#pragma unroll
    for (int ks = 1; ks < NKS; ++ks) {
        p0 = __builtin_amdgcn_mfma_f32_32x32x16_f16(kf[2 * ks], qf[ks], p0, 0, 0, 0);
        p1 = __builtin_amdgcn_mfma_f32_32x32x16_f16(kf[2 * ks + 1], qf[ks], p1, 0, 0, 0);
    }
}
__device__ __forceinline__ void tile_emask(f32x16& p0, f32x16& p1, int hiL, int loL) {
#pragma unroll
    for (int r = 0; r < 16; ++r) { const int c = (r & 3) + 8 * (r >> 2);
        if (!(c <= hiL && c >= loL)) p0[r] = -INFINITY;
        if (!(c + 32 <= hiL && c + 32 >= loL)) p1[r] = -INFINITY; }
}
__device__ __forceinline__ float tile_rowmax(const f32x16& p0, const f32x16& p1) {
    float a = fmaxf(fmaxf(p0[0], p0[1]), p0[2]), b = fmaxf(fmaxf(p1[0], p1[1]), p1[2]);
#pragma unroll
    for (int r = 3; r < 15; r += 2) { a = fmaxf(fmaxf(a, p0[r]), p0[r + 1]); b = fmaxf(fmaxf(b, p1[r]), p1[r + 1]); }
    a = fmaxf(fmaxf(a, p0[15]), fmaxf(b, p1[15]));
    return xhalf_max(a);
}
struct VFrags { v4i16 f[16]; };
__device__ __forceinline__ void vfrag_load(VFrags& V, const LAS unsigned char* vb) {
#pragma unroll
    for (int i = 0; i < 8; ++i) {
        V.f[2 * i]     = __builtin_amdgcn_ds_read_tr16_b64_v4i16((LAS v4i16*)(vb + (i >> 2) * 4096 + (i & 3) * 1024));
        V.f[2 * i + 1] = __builtin_amdgcn_ds_read_tr16_b64_v4i16((LAS v4i16*)(vb + (i >> 2) * 4096 + (i & 3) * 1024 + 512));
    }
}
__device__ __forceinline__ void tile_pv(const f32x16& p0, const f32x16& p1, const VFrags& V, f32x16 (&o)[2]) {
    u32x4 pw[4];
#pragma unroll
    for (int s = 0; s < 2; ++s) {
        pw[s]     = (u32x4){pk_rtz(p0[8 * s], p0[8 * s + 1]), pk_rtz(p0[8 * s + 2], p0[8 * s + 3]), pk_rtz(p0[8 * s + 4], p0[8 * s + 5]), pk_rtz(p0[8 * s + 6], p0[8 * s + 7])};
        pw[2 + s] = (u32x4){pk_rtz(p1[8 * s], p1[8 * s + 1]), pk_rtz(p1[8 * s + 2], p1[8 * s + 3]), pk_rtz(p1[8 * s + 4], p1[8 * s + 5]), pk_rtz(p1[8 * s + 6], p1[8 * s + 7])};
    }
    typedef short s8 __attribute__((ext_vector_type(8)));
#pragma unroll
    for (int db = 0; db < 2; ++db)
#pragma unroll
        for (int ks = 0; ks < 4; ++ks) {
            const v4i16 lo = V.f[2 * (db * 4 + ks)], hi = V.f[2 * (db * 4 + ks) + 1];
            const s8 t = {lo[0], lo[1], lo[2], lo[3], hi[0], hi[1], hi[2], hi[3]};
            o[db] = __builtin_amdgcn_mfma_f32_32x32x16_f16(__builtin_bit_cast(half8, t), __builtin_bit_cast(half8, pw[ks]), o[db], 0, 0, 0);
        }
}
constexpr float SM_THR = 6.f;
struct SmState { f32x16 negm; float mref, l; };
__device__ __forceinline__ void sm_reset(SmState& S) { S.negm = (f32x16){0.f}; S.mref = 0.f; S.l = 0.f; }
template <int AB = 0>
__device__ __forceinline__ void tile_softmax_pv(f32x16& p0, f32x16& p1, const LAS unsigned char* vb, f32x16 (&o)[2], SmState& S, bool first) {
    VFrags V; if (!(AB & 4)) vfrag_load(V, vb);
    if (!(AB & 2)) {
        const float tm = tile_rowmax(p0, p1);
        const bool need = first ? (tm > -INFINITY) : (tm > SM_THR);
        if (__any(need)) {
            const float delta = need ? tm : 0.f, alpha = __builtin_amdgcn_exp2f(-delta);
            S.mref += delta; S.l *= alpha;
#pragma unroll
            for (int r = 0; r < 16; ++r) { p0[r] -= delta; p1[r] -= delta; o[0][r] *= alpha; o[1][r] *= alpha; S.negm[r] = -S.mref; }
        }
        float s0 = 0.f, s1 = 0.f, s2 = 0.f, s3 = 0.f;
#pragma unroll
        for (int r = 0; r < 16; ++r) { p0[r] = __builtin_amdgcn_exp2f(p0[r]); p1[r] = __builtin_amdgcn_exp2f(p1[r]); }
#pragma unroll
        for (int r = 0; r < 16; r += 2) { s0 += p0[r]; s1 += p0[r + 1]; s2 += p1[r]; s3 += p1[r + 1]; }
        S.l += (s0 + s1) + (s2 + s3);
    }
    if (!(AB & 4)) tile_pv(p0, p1, V, o); else { _Pragma("unroll") for (int r = 0; r < 16; ++r) { o[0][r & 3] += p0[r]; o[1][r & 3] += p1[r]; } }
}

__device__ __forceinline__ void glds16(const void* gsrc, unsigned lds_dst) { unsigned keep;
    asm volatile("s_mov_b32 %0, m0\n\ts_mov_b32 m0, %2\n\ts_nop 0\n\tglobal_load_lds_dwordx4 %1, off\n\ts_mov_b32 m0, %0" : "=&s"(keep) : "v"(gsrc), "s"(lds_dst) : "memory"); }
__device__ __forceinline__ unsigned lds_addr(const LAS unsigned char* p) { return (unsigned)__builtin_amdgcn_readfirstlane((int)(unsigned)(size_t)p); }
__device__ __forceinline__ void tile_dma(const half_t* Kt, const half_t* KPt, const half_t* Vt, LAS unsigned char* sub, bool haspe, int wid, int lane) {
    const unsigned base = lds_addr(sub);
    glds16(Kt + wid * 512 + lane * 8, base + AT_KB + wid * 1024);
    if (haspe && wid < 4) glds16(KPt + wid * 512 + lane * 8, base + AT_KB + (8 + wid) * 1024);
    glds16(Vt + wid * 512 + lane * 8, base + AT_VB + wid * 1024);
}
#ifndef AT_STAGGER
#define AT_STAGGER 7
#endif
#ifndef AT_STAGGER_MASK
#define AT_STAGGER_MASK 4
#endif
#define AT_WAITBAR() do { asm volatile("s_waitcnt vmcnt(0) lgkmcnt(0)" ::: "memory"); __builtin_amdgcn_s_barrier(); } while (0)
#define KV_STREAM(NT, DMAT, COMPT) do { \
    const int nt__ = (NT), nst__ = (nt__ + AT_SUB - 1) / AT_SUB; \
    _Pragma("unroll") for (int j_ = 0; j_ < AT_SUB; ++j_) if (j_ < nt__) { DMAT(j_, lds + j_ * AT_BUF); } \
    AT_WAITBAR(); \
    for (int s_ = 0; s_ < nst__; ++s_) { \
        LAS unsigned char* cb_ = lds + (s_ & 1) * AT_STAGE; LAS unsigned char* nb_ = lds + ((s_ + 1) & 1) * AT_STAGE; \
        _Pragma("unroll") for (int j_ = 0; j_ < AT_SUB; ++j_) { const int tn_ = (s_ + 1) * AT_SUB + j_; if (tn_ < nt__) { DMAT(tn_, nb_ + j_ * AT_BUF); } } \
        _Pragma("unroll") for (int j_ = 0; j_ < AT_SUB; ++j_) { const int tc_ = s_ * AT_SUB + j_; if (tc_ < nt__) { COMPT(tc_, cb_ + j_ * AT_BUF); } } \
        AT_WAITBAR(); \
    } } while (0)

struct AttnPtrs {
    const half_t* QM; const half_t* KNM; const half_t* KPE; const half_t* VM;
    const half_t* QN; const half_t* KC; const half_t* VC; const half_t* KS; const half_t* VS; const half_t* KW; const half_t* VW; const float* GATE;
    half_t* Y; float* SSM; float* SSN;
};

template <int AB = 0>
__device__ __forceinline__ void mla_unit(const AttnPtrs& P, int bh, int qb, LAS unsigned char* lds, bool nostore = false) {
    int tid_ = threadIdx.x; asm volatile("" : "+v"(tid_));
    const int tid = tid_, lane = tid & 63, wid = __builtin_amdgcn_readfirstlane(tid >> 6), q = lane & 31, h = lane >> 5;
    const int b = bh >> 3, hd = bh & 7, q0 = qb * 256, qpos = q0 + wid * 32 + q;
    const size_t trow = (size_t)b * SEQ + qpos;
    half8 qf[6];
#pragma unroll
    for (int ks = 0; ks < 6; ++ks) qf[ks] = *(const half8*)(P.QM + trow * 768 + hd * 96 + ks * 16 + h * 8);
#pragma unroll
    for (int ks = 0; ks < 6; ++ks) asm volatile("" : "+v"(qf[ks]));
    const half_t* Kb = P.KNM + (size_t)bh * SEQ * 64; const half_t* Vb = P.VM + (size_t)bh * SEQ * 64; const half_t* KPb = P.KPE + (size_t)b * SEQ * 32;
    const int ntiles = 4 * qb + 4, my_last = 4 * qb + (wid >> 1);
    f32x16 o[2]; o[0] = (f32x16){0.f}; o[1] = (f32x16){0.f};
    SmState S; sm_reset(S);
    const int koff = h * 1024 + q * 16, voff = (4 * h + ((lane & 15) >> 2)) * 64 + ((lane >> 4) & 1) * 32 + (lane & 3) * 8;
#define MLA_LOAD(t, sub) if (!(AB & 16)) tile_dma(Kb + (size_t)(t) * 4096, KPb + (size_t)(t) * 2048, Vb + (size_t)(t) * 4096, sub, true, wid, lane)
#define MLA_COMP(t, buf) do { if ((t) <= my_last) { f32x16 p0, p1; \
        tile_qk<6, AB>((buf) + AT_KB + koff, qf, S.negm, p0, p1); \
        if ((t) == my_last) tile_emask(p0, p1, qpos - 64 * (t) - 4 * h, -1000); \
        tile_softmax_pv<AB>(p0, p1, (buf) + AT_VB + voff, o, S, (t) == 0); } } while (0)
    KV_STREAM(ntiles, MLA_LOAD, MLA_COMP);
#undef MLA_LOAD
#undef MLA_COMP
    const float l = xhalf_sum(S.l);
    const float inv = 1.f / l;
    if (nostore && !(l == 123.456f)) return;
    float ss = 0.f;
    half_t* yrow = P.Y + trow * DM + hd * 64;
#pragma unroll
    for (int db = 0; db < 2; ++db)
#pragma unroll
        for (int c = 0; c < 4; ++c) { const float a0 = o[db][4 * c] * inv, a1 = o[db][4 * c + 1] * inv, a2 = o[db][4 * c + 2] * inv, a3 = o[db][4 * c + 3] * inv;
            ss += (a0 * a0 + a1 * a1) + (a2 * a2 + a3 * a3);
            *(u32x2*)(yrow + db * 32 + 8 * c + 4 * h) = (u32x2){pk_rne(a0, a1), pk_rne(a2, a3)}; }
    ss = xhalf_sum(ss);
    if (h == 0) P.SSM[trow * 8 + hd] = ss;
}

template <int NKS_unused = 4>
__device__ __forceinline__ void nsa_stream_begin(TileRegs& tr, const half_t* Kt, const half_t* Vt, LAS unsigned char* lds, int tid, int wid, int lane) {
    tile_load(tr, Kt, nullptr, Vt, tid, wid, lane);
    tile_store(tr, lds, false, tid, wid, lane);
    __syncthreads();
}
__device__ __forceinline__ void nsa_unit(const AttnPtrs& P, int bg, int qb, LAS unsigned char* lds) {
    int tid_ = threadIdx.x; asm volatile("" : "+v"(tid_));
    const int tid = tid_, lane = tid & 63, wid = __builtin_amdgcn_readfirstlane(tid >> 6), j = lane & 31, h = lane >> 5;
    const int b = bg >> 1, g = bg & 1, q0 = qb * 64, cur = qb, qi = j >> 2, hh = j & 3, qrel = wid * 8 + qi, qpos = q0 + qrel, head = g * 4 + hh;
    const size_t trow = (size_t)b * SEQ + qpos;
    half8 qf[4];
#pragma unroll
    for (int ks = 0; ks < 4; ++ks) qf[ks] = *(const half8*)(P.QN + trow * 512 + head * 64 + ks * 16 + h * 8);
    float g0 = P.GATE[trow * 24 + head], g1 = P.GATE[trow * 24 + 8 + head], g2 = P.GATE[trow * 24 + 16 + head];
#pragma unroll
    for (int ks = 0; ks < 4; ++ks) asm volatile("" : "+v"(qf[ks]));
    asm volatile("" : "+v"(g0), "+v"(g1), "+v"(g2));
    const int koff = h * 1024 + j * 16, voff = (4 * h + ((lane & 15) >> 2)) * 64 + ((lane >> 4) & 1) * 32 + (lane & 3) * 8;
    f32x16 acc[2]; acc[0] = (f32x16){0.f}; acc[1] = (f32x16){0.f};
    f32x16 o[2];
    LAS float* impw = (LAS float*)(lds + AT_IMP + wid * AT_IMPW);
    unsigned long long selmask = (2ull << cur) - 1ull;

    const int ncmp = ((q0 + 32) >> 4) / 64 + 1;
    const half_t* Kc = P.KC + (size_t)bg * 256 * 64; const half_t* Vc = P.VC + (size_t)bg * 256 * 64;
    float m = -1e30f, l = 0.f; const f32x16 zero16 = (f32x16){0.f};
#define CMP_LOAD(t, sub) tile_dma(Kc + (size_t)(t) * 4096, nullptr, Vc + (size_t)(t) * 4096, sub, false, wid, lane)
#define CMP1_COMP(t, buf) do { f32x16 p0, p1; \
        tile_qk<4>((buf) + AT_KB + koff, qf, zero16, p0, p1); \
        tile_emask(p0, p1, ((qpos - 31 - 1024 * (t)) >> 4) - 4 * h, -1000); \
        const float tm = tile_rowmax(p0, p1), mn = fmaxf(m, tm), alpha = __builtin_amdgcn_exp2f(m - mn); \
        float sum = 0.f; \
        _Pragma("unroll") for (int r = 0; r < 16; ++r) sum += __builtin_amdgcn_exp2f(p0[r] - mn) + __builtin_amdgcn_exp2f(p1[r] - mn); \
        l = l * alpha + sum; m = mn; } while (0)
    KV_STREAM(ncmp, CMP_LOAD, CMP1_COMP);
    l = xhalf_sum(l);
    const float invl = (l > 0.f) ? 1.f / l : 0.f;
    o[0] = (f32x16){0.f}; o[1] = (f32x16){0.f};
#define CMP2_COMP(t, buf) do { f32x16 p0, p1; \
        VFrags V; vfrag_load(V, (buf) + AT_VB + voff); \
        tile_qk<4>((buf) + AT_KB + koff, qf, zero16, p0, p1); \
        tile_emask(p0, p1, ((qpos - 31 - 1024 * (t)) >> 4) - 4 * h, -1000); \
        _Pragma("unroll") for (int r = 0; r < 16; ++r) { p0[r] = __builtin_amdgcn_exp2f(p0[r] - m) * invl; p1[r] = __builtin_amdgcn_exp2f(p1[r] - m) * invl; } \
        if (cur >= 16) { \
            _Pragma("unroll") for (int kb = 0; kb < 2; ++kb) \
            _Pragma("unroll") for (int c = 0; c < 4; ++c) { \
                const f32x16& p = kb ? p1 : p0; \
                float C = (p[4 * c] + p[4 * c + 1]) + (p[4 * c + 2] + 0.5f * p[4 * c + 3]), D = 0.5f * p[4 * c + 3]; \
                C += __shfl_xor(C, 1); C += __shfl_xor(C, 2); D += __shfl_xor(D, 1); D += __shfl_xor(D, 2); \
                const int jb = 16 * (t) + 8 * kb + 2 * c + h; \
                if (hh == 0) { impw[qi * 136 + jb] = C; impw[qi * 136 + 68 + jb + 1] = D; } } } \
        tile_pv(p0, p1, V, o); } while (0)
    KV_STREAM(ncmp, CMP_LOAD, CMP2_COMP);
#undef CMP_LOAD
#undef CMP1_COMP
#undef CMP2_COMP
#pragma unroll
    for (int r = 0; r < 16; ++r) { acc[0][r] = g0 * o[0][r]; acc[1][r] = g0 * o[1][r]; }

    if (cur >= 16) {
        const int tq = lane >> 3, e = lane & 7;
        float v[8];
#pragma unroll
        for (int i = 0; i < 8; ++i) { const int jb = e + 8 * i; const float s = impw[tq * 136 + jb] + impw[tq * 136 + 68 + jb];
            v[i] = (jb >= 1 && jb <= cur - 2) ? s : -1.f; }
        unsigned selb = 0u;
        for (int it = 0; it < 13; ++it) {
            float lm = v[0];
#pragma unroll
            for (int i = 1; i < 8; ++i) lm = fmaxf(lm, v[i]);
            float gm = fmaxf(lm, __shfl_xor(lm, 1)); gm = fmaxf(gm, __shfl_xor(gm, 2)); gm = fmaxf(gm, __shfl_xor(gm, 4));
            int cj = 99;
#pragma unroll
            for (int i = 7; i >= 0; --i) cj = (v[i] == gm) ? (e + 8 * i) : cj;
            int gj = min(cj, __shfl_xor(cj, 1)); gj = min(gj, __shfl_xor(gj, 2)); gj = min(gj, __shfl_xor(gj, 4));
#pragma unroll
            for (int i = 0; i < 8; ++i) if (gj == e + 8 * i) { v[i] = -2.f; selb |= 1u << i; }
        }
        unsigned lo = 0u, hi = 0u;
#pragma unroll
        for (int i = 0; i < 4; ++i) { lo |= ((selb >> i) & 1u) << (e + 8 * i); hi |= ((selb >> (i + 4)) & 1u) << (e + 8 * i); }
        lo |= __shfl_xor(lo, 1); lo |= __shfl_xor(lo, 2); lo |= __shfl_xor(lo, 4);
        hi |= __shfl_xor(hi, 1); hi |= __shfl_xor(hi, 2); hi |= __shfl_xor(hi, 4);
        unsigned long long mk = ((unsigned long long)hi << 32) | lo;
        mk |= 1ull | (1ull << cur) | (1ull << (cur - 1));
        LAS unsigned long long* selw = (LAS unsigned long long*)(lds + AT_SEL + wid * 64);
        if (e == 0) selw[tq] = mk;
        selmask = selw[qi];
    }

    {
        const half_t* Ks = P.KS + (size_t)bg * SEQ * 64; const half_t* Vs = P.VS + (size_t)bg * SEQ * 64;
        SmState S; sm_reset(S); bool seen = false; o[0] = (f32x16){0.f}; o[1] = (f32x16){0.f};
#define SLC_LOAD(t, sub) tile_dma(Ks + (size_t)(t) * 4096, nullptr, Vs + (size_t)(t) * 4096, sub, false, wid, lane)
#define SLC_COMP(t, buf) do { const bool rowsel = (selmask >> (t)) & 1ull; \
            if (__any(rowsel)) { f32x16 p0, p1, ci; \
                _Pragma("unroll") for (int r = 0; r < 16; ++r) ci[r] = rowsel ? S.negm[r] : -INFINITY;     \
                tile_qk<4>((buf) + AT_KB + koff, qf, ci, p0, p1); \
                if ((t) == cur) tile_emask(p0, p1, qrel - 4 * h, -1000); \
                tile_softmax_pv(p0, p1, (buf) + AT_VB + voff, o, S, !seen); seen = seen || rowsel; } } while (0)
        KV_STREAM(cur + 1, SLC_LOAD, SLC_COMP);
#undef SLC_LOAD
#undef SLC_COMP
        const float sc = g1 / xhalf_sum(S.l);
#pragma unroll
        for (int r = 0; r < 16; ++r) { acc[0][r] += sc * o[0][r]; acc[1][r] += sc * o[1][r]; }
    }
    {
        const int t0 = (cur >= 8) ? cur - 8 : 0;
        const half_t* Kw = P.KW + ((size_t)bg * SEQ + (size_t)t0 * 64) * 64; const half_t* Vw = P.VW + ((size_t)bg * SEQ + (size_t)t0 * 64) * 64;
        SmState S; sm_reset(S); o[0] = (f32x16){0.f}; o[1] = (f32x16){0.f};
#define WIN_LOAD(i, sub) tile_dma(Kw + (size_t)(i) * 4096, nullptr, Vw + (size_t)(i) * 4096, sub, false, wid, lane)
#define WIN_COMP(i, buf) do { const int t = t0 + (i); f32x16 p0, p1; \
            tile_qk<4>((buf) + AT_KB + koff, qf, S.negm, p0, p1); \
            if (t == cur) tile_emask(p0, p1, qrel - 4 * h, -1000); \
            else if (t == cur - 8) tile_emask(p0, p1, 1000, qrel + 1 - 4 * h); \
            tile_softmax_pv(p0, p1, (buf) + AT_VB + voff, o, S, (i) == 0); } while (0)
        KV_STREAM(cur - t0 + 1, WIN_LOAD, WIN_COMP);
#undef WIN_LOAD
#undef WIN_COMP
        const float sc = g2 / xhalf_sum(S.l);
#pragma unroll
        for (int r = 0; r < 16; ++r) { acc[0][r] += sc * o[0][r]; acc[1][r] += sc * o[1][r]; }
    }
    float ss = 0.f;
    half_t* yrow = P.Y + trow * DM + 512 + head * 64;
#pragma unroll
    for (int db = 0; db < 2; ++db)
#pragma unroll
        for (int c = 0; c < 4; ++c) { const float a0 = acc[db][4 * c], a1 = acc[db][4 * c + 1], a2 = acc[db][4 * c + 2], a3 = acc[db][4 * c + 3];
            ss += (a0 * a0 + a1 * a1) + (a2 * a2 + a3 * a3);
            *(u32x2*)(yrow + db * 32 + 8 * c + 4 * h) = (u32x2){pk_rne(a0, a1), pk_rne(a2, a3)}; }
    ss = xhalf_sum(ss);
    if (h == 0) P.SSN[trow * 8 + head] = ss;
}

struct Args { const float* in[24]; float* out; unsigned char* ws; int ph_lo, ph_hi, li, pad; };

template <class SrcFn>
__device__ __forceinline__ void conv_wt(const float* W, int Ksrc, int Nsrc, const float* gain, const float* gain2, int ksplit, half_t* WT, int Ndst, int Kdst, SrcFn src, LAS float* scr, int gw, int ngw, int lane) {
    const int nblk = Ndst / 32, nitems = nblk * (Kdst / 64);
    for (int it = gw; it < nitems; it += ngw) {
        const int kb = it / nblk, nb = it % nblk, k0 = 64 * kb, n0 = 32 * nb;
        const int sc = src(n0 + (lane & 31));
#pragma unroll 8
        for (int i = 0; i < 32; ++i) { const int kk = 2 * i + (lane >> 5), k = k0 + kk;
            float v = 0.f; if (sc >= 0 && k < Ksrc) { v = W[(size_t)k * Nsrc + sc]; if (gain) v *= (k < ksplit ? gain[k] : gain2[k - ksplit]); }
            scr[kk * 33 + (lane & 31)] = v; }
        asm volatile("s_waitcnt lgkmcnt(0)" ::: "memory");
        const int c = lane & 7;
#pragma unroll
        for (int jj = 0; jj < 4; ++jj) { const int n = (lane >> 3) + 8 * jj; const LAS float* s = scr + (8 * c) * 33 + n; float v[8];
#pragma unroll
            for (int e = 0; e < 8; ++e) v[e] = s[e * 33];
            *(u32x4*)(WT + (size_t)(n0 + n) * Kdst + k0 + 8 * c) = pk8(v); }
        asm volatile("s_waitcnt lgkmcnt(0)" ::: "memory");
    }
}
__device__ __forceinline__ int src_win(int n) {
    const int t = n >> 8, c = n & 255;
    if (t == 0) return c;
    if (t == 1) { if (c < 128) return 256 + c;
                  if (c < 160) { const int p = c - 128; return 384 + (p >> 1) + 16 * (p & 1); }
                  if (c < 184) return 1696 + (c - 160);
                  return -1; }
    if (t < 4) { const int hd = (t - 2) * 4 + (c >> 6), p = c & 63; const int d = (p < 16) ? (p >> 1) + 8 * (p & 1) : p; return 416 + hd * 64 + d; }
    const int br = (t - 4) * 2 + (c >> 7), g = (c >> 6) & 1, p = c & 63;
    const bool roped = (br == 2 || br == 4);
    const int d = (roped && p < 16) ? (p >> 1) + 8 * (p & 1) : p;
    return 928 + br * 128 + g * 64 + d;
}
__device__ __forceinline__ int src_wuq(int n) { const int hd = n / 96, p = n % 96; return (p < 64) ? hd * 96 + p : hd * 96 + 64 + ((p - 64) >> 1) + 16 * ((p - 64) & 1); }
__device__ __forceinline__ int src_wukv(int n) { return (n < 512) ? (n >> 6) * 128 + (n & 63) : ((n - 512) >> 6) * 128 + 64 + (n & 63); }

#define PH_IDS() int tid_ = threadIdx.x; asm volatile("" : "+v"(tid_)); const int tid = tid_, lane = tid & 63, wid = __builtin_amdgcn_readfirstlane(tid >> 6); \
    const int G = gridDim.x, gt = blockIdx.x * 512 + tid, ngt = G * 512, gw = blockIdx.x * 8 + wid, ngw = G * 8; (void)lane; (void)gt; (void)ngt; (void)gw; (void)ngw; (void)G
#define WSP(T, off) ((T*)(ws + (off)))


__global__ void __launch_bounds__(512, 2) hymba_fwd(Args args) {
    extern __shared__ __attribute__((aligned(16))) unsigned char lds_raw[];
    LAS unsigned char* lds = (LAS unsigned char*)lds_raw;
    unsigned char* ws = args.ws;
    volatile LAS unsigned* MISC = (volatile LAS unsigned*)(lds + LDS_MISC);
    if (threadIdx.x < 16) MISC[threadIdx.x] = 0u;
    __syncthreads();
    XcdBarrier bar = xcd_barrier_post(WSP(unsigned, WS_CTL) + CW_BAR + args.li * XCD_BAR_WORDS, MISC + 8);
#if defined(DBG_STAMP)
#define STAMP_FIRST() STAMP(0)
#define STAMP(k) do { if (blockIdx.x == 0 && threadIdx.x == 0) ((unsigned long long*)(WSP(unsigned, WS_CTL) + 160))[k] = __builtin_amdgcn_s_memrealtime(); } while (0)
#else
#define STAMP_FIRST() do { } while (0)
#define STAMP(k) do { } while (0)
#endif
    const int lo = args.ph_lo, hi = args.ph_hi;
    STAMP_FIRST();
#define IN(k) (lo <= (k) && (k) < hi)
#define REP_BEGIN(k) for (int rep_ = 0; rep_ < ((k) == REPEAT_PHASE ? 2 : 1); ++rep_) {
#define REP_END(k) if ((k) == REPEAT_PHASE && rep_ == 0) xcd_barrier(bar); }
#define SEAM(k) do { if (IN(k) && IN((k) + 1 + ((k) == 4))) xcd_barrier(bar); STAMP((k) + 1); } while (0)

    if (IN(0)) { REP_BEGIN(0)
        PH_IDS();
        LAS float* scr = (LAS float*)(lds + wid * 8448);
        const int BIG = 1 << 30;
        conv_wt(args.in[2], 1024, IN_COLS, args.in[1], nullptr, BIG, WSP(half_t, WS_WIN), NIN, 1024, [](int n) { return src_win(n); }, scr, gw, ngw, lane);
        conv_wt(args.in[4], 256, 768, args.in[3], nullptr, BIG, WSP(half_t, WS_WUQ), 768, 256, [](int n) { return src_wuq(n); }, scr, gw, ngw, lane);
        conv_wt(args.in[6], 128, 1024, args.in[5], nullptr, BIG, WSP(half_t, WS_WUKV), 1024, 256, [](int n) { return src_wukv(n); }, scr, gw, ngw, lane);
        conv_wt(args.in[8], 2048, 128, nullptr, nullptr, BIG, WSP(half_t, WS_WC1), 256, 2048, [](int n) { return n < 128 ? n : -1; }, scr, gw, ngw, lane);
        conv_wt(args.in[13], 2048, 128, nullptr, nullptr, BIG, WSP(half_t, WS_WC1) + 256 * 2048, 256, 2048, [](int n) { return n < 128 ? n : -1; }, scr, gw, ngw, lane);
        conv_wt(args.in[19], 1024, 1024, args.in[17], args.in[18], 512, WSP(half_t, WS_WO), 1024, 1024, [](int n) { return n; }, scr, gw, ngw, lane);
        conv_wt(args.in[21], 1024, 4096, args.in[20], nullptr, BIG, WSP(half_t, WS_WUP), 4096, 1024, [](int n) { return n; }, scr, gw, ngw, lane);
        conv_wt(args.in[22], 4096, 1024, nullptr, nullptr, BIG, WSP(half_t, WS_WDN), 1024, 4096, [](int n) { return n; }, scr, gw, ngw, lane);
        { float2* ROPEM = WSP(float2, WS_ROPEM); float2* ROPEN = WSP(float2, WS_ROPEN);
          for (int it = gt; it < SEQ * 16; it += ngt) { const int pos = it >> 4, i = it & 15; const float inv = expf(-logf(500000.f) * (float)(2 * i) / 32.f), a = (float)pos * inv; ROPEM[it] = make_float2(cosf(a), sinf(a)); }
          for (int it = gt; it < SEQ * 8; it += ngt) { const int pos = it >> 3, i = it & 7; const float inv = expf(-logf(500000.f) * (float)(2 * i) / 16.f), a = (float)pos * inv; ROPEN[it] = make_float2(cosf(a), sinf(a)); } }
        if (gw < 256) { const int kv = gw >> 7, jj = gw & 127; const float* pe = args.in[kv ? 12 : 7]; const float* w1 = args.in[kv ? 13 : 8]; const float* b1 = args.in[kv ? 14 : 9];
            float s = 0.f; for (int k = lane; k < 2048; k += 64) s += pe[k] * w1[(size_t)k * 128 + jj];
            s = wave_sum(s); if (lane == 0) WSP(float, WS_B1P)[gw] = b1[jj] + s; }
        { const float* x = args.in[0]; half_t* XH = WSP(half_t, WS_XH); float* RS1 = WSP(float, WS_RS1);
          for (int r0 = gw * 4; r0 < MROWS; r0 += ngw * 4) {
            f32x4 v[4][4]; float s[4];
#pragma unroll
            for (int rr = 0; rr < 4; ++rr) { const f32x4* xr = (const f32x4*)(x + (size_t)(r0 + rr) * DM) + lane;
#pragma unroll
                for (int jv = 0; jv < 4; ++jv) v[rr][jv] = xr[64 * jv]; }
#pragma unroll
            for (int rr = 0; rr < 4; ++rr) { float t = 0.f;
#pragma unroll
                for (int jv = 0; jv < 4; ++jv) t += (v[rr][jv][0] * v[rr][jv][0] + v[rr][jv][1] * v[rr][jv][1]) + (v[rr][jv][2] * v[rr][jv][2] + v[rr][jv][3] * v[rr][jv][3]);
                s[rr] = t; }
#pragma unroll
            for (int o = 1; o < 64; o <<= 1) {
#pragma unroll
                for (int rr = 0; rr < 4; ++rr) s[rr] += __shfl_xor(s[rr], o); }
#pragma unroll
            for (int rr = 0; rr < 4; ++rr) { u32x2* o8 = (u32x2*)(XH + (size_t)(r0 + rr) * DM) + lane;
#pragma unroll
                for (int jv = 0; jv < 4; ++jv) o8[64 * jv] = (u32x2){pk_rne(v[rr][jv][0], v[rr][jv][1]), pk_rne(v[rr][jv][2], v[rr][jv][3])};
                if (lane == 0) RS1[r0 + rr] = __builtin_amdgcn_rsqf(s[rr] * (1.f / DM) + NORM_EPS); }
          } }
    REP_END(0) }
    SEAM(0);
    if (IN(1)) { REP_BEGIN(1)
        pg8::Gemm g{WSP(half_t, WS_XH), WSP(half_t, WS_WIN), 1024, 1024, 1024}; pg8::StaticOrder S; S.init(MROWS, NIN, gridDim.x, (int)blockIdx.x, 1024, 1024);
        EpiIn E{WSP(float, WS_RS1), WSP(half_t, WS_CQ), WSP(half_t, WS_T1), WSP(half_t, WS_KPE), WSP(float, WS_GATE), WSP(float, WS_SSQ), WSP(float, WS_SSKV), WSP(half_t, WS_QN), WSP(half_t, WS_KVT), WSP(float2, WS_ROPEM), WSP(float2, WS_ROPEN)};
        pg8::gemm_phase(lds, g, S, E);
    REP_END(1) }
    SEAM(1);
    if (IN(2)) { REP_BEGIN(2)
        { pg8::Gemm g{WSP(half_t, WS_CQ), WSP(half_t, WS_WUQ), 256, 256, 256}; pg8::StaticOrder S; S.init(MROWS, 768, gridDim.x, (int)blockIdx.x, 256, 256); EpiUq E{WSP(float, WS_SSQ), WSP(half_t, WS_QM), WSP(float2, WS_ROPEM)}; pg8::gemm_phase(lds, g, S, E); }
        { pg8::Gemm g{WSP(half_t, WS_T1), WSP(half_t, WS_WUKV), 256, 256, 256}; pg8::StaticOrder S; S.init(MROWS, 1024, gridDim.x, (int)blockIdx.x, 256, 256); EpiUkv E{WSP(float, WS_SSKV), WSP(half_t, WS_KNM), WSP(half_t, WS_VM)}; pg8::gemm_phase(lds, g, S, E); }
        { pg8::Gemm g{WSP(half_t, WS_KVT), WSP(half_t, WS_WC1), 512, 1024, 2048}; pg8::Cmp1Order S{(int)gridDim.x, (int)blockIdx.x}; EpiC1 E{WSP(float, WS_HIDP)}; pg8::gemm_phase(lds, g, S, E); }
    REP_END(2) }
    SEAM(2);
    if (IN(3)) { REP_BEGIN(3)
        PH_IDS();
        const float* B1P = WSP(float, WS_B1P); const float* HIDP = WSP(float, WS_HIDP); const float2* ROPEN = WSP(float2, WS_ROPEN);
        LAS float* hl = (LAS float*)(lds + wid * 1024);
        for (int it = gw; it < 2 * 32 * 128; it += ngw) {
            const int kv = it >> 12, slab = (it >> 7) & 31, n0 = (it & 127) * 2;
            const float* w2 = args.in[kv ? 15 : 10]; const float* b2 = args.in[kv ? 16 : 11];
#pragma unroll
            for (int rr = 0; rr < 2; ++rr)
#pragma unroll
                for (int c = 0; c < 2; ++c) { const int col = lane + 64 * c; float s = B1P[kv * 128 + col];
#pragma unroll
                    for (int ch = 0; ch < 4; ++ch) s += HIDP[((size_t)((kv * 32 + slab) * 4 + ch) * 256 + n0 + rr) * 128 + col];
                    const float z = 0.7978845608028654f * (s + 0.044715f * s * s * s), th = 1.f - 2.f / (1.f + __expf(2.f * z));
                    hl[rr * 128 + col] = 0.5f * s * (1.f + th); }
            asm volatile("s_waitcnt lgkmcnt(0)" ::: "memory");
            const int dsrc = (kv == 0 && lane < 16) ? (lane >> 1) + 8 * (lane & 1) : lane;
            float a0 = b2[dsrc], a1 = a0;
            for (int k = 0; k < 128; ++k) { const float w = w2[k * 64 + dsrc]; a0 += hl[k] * w; a1 += hl[128 + k] * w; }
            if (kv == 0) {
                const float p0 = __shfl_xor(a0, 1), p1 = __shfl_xor(a1, 1);
                if (lane < 16) { const int pr = lane >> 1; const int e1 = 16 * (n0 + 1) + 31; const float2 c0 = ROPEN[(size_t)(16 * n0 + 31) * 8 + pr], c1 = ROPEN[(size_t)(e1 > 4095 ? 4095 : e1) * 8 + pr];
                    a0 = (lane & 1) ? (a0 * c0.x + p0 * c0.y) : (a0 * c0.x - p0 * c0.y);
                    a1 = (lane & 1) ? (a1 * c1.x + p1 * c1.y) : (a1 * c1.x - p1 * c1.y); }
            }
            if (n0 + 1 >= 255) a1 = 0.f;
            half_t* dst = (kv ? WSP(half_t, WS_VC) : WSP(half_t, WS_KC)) + (size_t)slab * 256 * 64;
            dst[kv ? v_off(n0, lane) : k_off(n0, lane)] = (half_t)a0; dst[kv ? v_off(n0 + 1, lane) : k_off(n0 + 1, lane)] = (half_t)a1;
            asm volatile("s_waitcnt lgkmcnt(0)" ::: "memory");
        }
    REP_END(3) }
    SEAM(3);
    if (IN(4)) {
        half_t* KVT = WSP(half_t, WS_KVT);
        const AttnPtrs P{WSP(half_t, WS_QM), WSP(half_t, WS_KNM), WSP(half_t, WS_KPE), WSP(half_t, WS_VM), WSP(half_t, WS_QN), WSP(half_t, WS_KC), WSP(half_t, WS_VC),
                         KVT + 2 * KVT_STRIDE, KVT + 3 * KVT_STRIDE, KVT + 4 * KVT_STRIDE, KVT + 5 * KVT_STRIDE, WSP(float, WS_GATE), WSP(half_t, WS_Y), WSP(float, WS_SSM), WSP(float, WS_SSN)};
        volatile LAS int* qw = (volatile LAS int*)(lds + AT_QIDX);
        REP_BEGIN(4)
        unsigned* qhead = WSP(unsigned, WS_CTL) + CW_QHEAD + 64 * rep_;
        for (;;) {
            if (threadIdx.x == 0) *qw = (int)__hip_atomic_fetch_add(qhead, 1u, __ATOMIC_RELAXED, __HIP_MEMORY_SCOPE_AGENT);
            __syncthreads();
            const int qi = __builtin_amdgcn_readfirstlane(*qw);
            __syncthreads();
            if (qi >= 4096) break;
            const int L = qi >> 8, r = qi & 255;
#ifdef REP_FILTER
            if (rep_ == 1 && ((REP_FILTER == 1) != (r < 128))) continue;
#endif
            if (r < 128) { if (rep_ == 1) mla_unit<ABL>(P, r, 15 - L, lds, true); else mla_unit<0>(P, r, 15 - L, lds); }
            else { const int r2 = r - 128; nsa_unit(P, r2 & 31, 63 - 4 * L - (r2 >> 5), lds); }
        }
        REP_END(4)
    }
    SEAM(4);
    if (IN(6)) { REP_BEGIN(6) pg8::Gemm g{WSP(half_t, WS_Y), WSP(half_t, WS_WO), 1024, 1024, 1024}; pg8::StaticOrder S; S.init(MROWS, 1024, gridDim.x, (int)blockIdx.x, 1024, 1024); EpiWo E{WSP(half_t, WS_XH), WSP(half_t, WS_H1), WSP(float, WS_SS2), WSP(float, WS_SSM), WSP(float, WS_SSN), (LAS float*)(lds + LDS_RED)}; pg8::gemm_phase<EpiWo, pg8::StaticOrder, true>(lds, g, S, E); REP_END(6) }
    SEAM(6);
    if (IN(7)) { REP_BEGIN(7) pg8::Gemm g{WSP(half_t, WS_H1), WSP(half_t, WS_WUP), 1024, 1024, 1024}; pg8::StaticOrder S; S.init(MROWS, DFF, gridDim.x, (int)blockIdx.x, 1024, 1024); EpiUp E{WSP(float, WS_SS2), WSP(half_t, WS_A2)}; pg8::gemm_phase(lds, g, S, E); REP_END(7) }
    SEAM(7);
    if (IN(8)) { REP_BEGIN(8) pg8::Gemm g{WSP(half_t, WS_A2), WSP(half_t, WS_WDN), 4096, 4096, 4096}; pg8::StaticOrder S; S.init(MROWS, 1024, gridDim.x, (int)blockIdx.x, 4096, 4096); EpiDn E{WSP(half_t, WS_H1), WSP(half_t, WS_H2), WSP(float, WS_SS3), (LAS float*)(lds + LDS_RED)}; pg8::gemm_phase(lds, g, S, E); REP_END(8) }
    SEAM(8);
    if (IN(9)) { REP_BEGIN(9)
        PH_IDS();
        const float* gf = args.in[23]; const float* SS3 = WSP(float, WS_SS3); const half_t* H2 = WSP(half_t, WS_H2);
        const f32x4 ga0 = *(const f32x4*)(gf + lane * 8), gb0 = *(const f32x4*)(gf + lane * 8 + 4), ga1 = *(const f32x4*)(gf + 512 + lane * 8), gb1 = *(const f32x4*)(gf + 512 + lane * 8 + 4);
        for (int r0 = gw * 4; r0 < MROWS; r0 += ngw * 4) {
            u32x4 hv[4][2]; float rs[4];
#pragma unroll
            for (int rr = 0; rr < 4; ++rr) { const u32x4* hr = (const u32x4*)(H2 + (size_t)(r0 + rr) * DM) + lane; hv[rr][0] = hr[0]; hv[rr][1] = hr[64]; rs[rr] = __builtin_amdgcn_rsqf(sum4(*(const f32x4*)(SS3 + (size_t)(r0 + rr) * 4)) * (1.f / 1024.f) + NORM_EPS); }
#pragma unroll
            for (int rr = 0; rr < 4; ++rr) { f32x4* orow = (f32x4*)(args.out + (size_t)(r0 + rr) * DM); float v[8];
                unpk8(hv[rr][0], v);
                orow[lane * 2] = (f32x4){v[0] * rs[rr] * ga0[0], v[1] * rs[rr] * ga0[1], v[2] * rs[rr] * ga0[2], v[3] * rs[rr] * ga0[3]};
                orow[lane * 2 + 1] = (f32x4){v[4] * rs[rr] * gb0[0], v[5] * rs[rr] * gb0[1], v[6] * rs[rr] * gb0[2], v[7] * rs[rr] * gb0[3]};
                unpk8(hv[rr][1], v);
                orow[128 + lane * 2] = (f32x4){v[0] * rs[rr] * ga1[0], v[1] * rs[rr] * ga1[1], v[2] * rs[rr] * ga1[2], v[3] * rs[rr] * ga1[3]};
                orow[128 + lane * 2 + 1] = (f32x4){v[4] * rs[rr] * gb1[0], v[5] * rs[rr] * gb1[1], v[6] * rs[rr] * gb1[2], v[7] * rs[rr] * gb1[3]}; }
        }
    REP_END(9) }
    STAMP(10);
#undef IN
#undef SEAM
}

#if DBG_CHECK
constexpr int CW_DBG = 96;
__device__ __forceinline__ void dbg_flag(unsigned* ctl, int id, float got, float ref) {
    const float d = fabsf(got - ref);
    if (!(d <= 0.03f + 0.03f * fabsf(ref))) atomicOr(ctl + CW_DBG, 1u << id);
}
__device__ __forceinline__ float h2f(const half_t* p) { return (float)(*p); }
__device__ float dbg_rope_cs(int pos, int i, int dim, bool want_sin) { const float inv = expf(-logf(500000.f) * (float)(2 * i) / (float)dim), a = (float)pos * inv; return want_sin ? sinf(a) : cosf(a); }
__device__ float dbg_u(const Args& args, int row, int co, int lane) {
    const float* x = args.in[0] + (size_t)row * DM; const float* g = args.in[1]; const float* w = args.in[2];
    float ss = 0.f, acc = 0.f;
    for (int k = lane; k < DM; k += 64) { const float xv = x[k]; ss += xv * xv; acc += xv * g[k] * w[(size_t)k * IN_COLS + co]; }
    ss = wave_sum(ss); acc = wave_sum(acc);
    return acc * (1.f / sqrtf(ss / DM + NORM_EPS));
}
__device__ const int dbgt_0_dbg_rows[4] = {0, 4096 + 6, 30000, 65535};
__device__ const int dbgt_1_cs[3] = {0, 77, 255};
__device__ const int dbgt_2_cs[2] = {5, 127};
__device__ const int dbgt_3_ps[4] = {0, 1, 14, 31};
__device__ const int dbgt_4_is[3] = {0, 13, 23};
__device__ const int dbgt_5_hs[4] = {0, 3, 5, 7};
__device__ const int dbgt_6_ps[4] = {0, 1, 14, 40};
__device__ const int dbgt_7_brs[7] = {0, 1, 2, 2, 3, 4, 5};
__device__ const int dbgt_8_gs[7] = {0, 1, 0, 1, 0, 1, 1};
__device__ const int dbgt_9_ps[7] = {3, 20, 1, 50, 9, 14, 63};
__device__ const int dbgt_10_hs[4] = {0, 2, 5, 7};
__device__ const int dbgt_11_ps[4] = {3, 64, 77, 95};
__device__ const int dbgt_12_slabs[3] = {0, 17, 31};
__device__ const int dbgt_13_ns[3] = {0, 100, 254};
__device__ const int dbgt_14_ps[4] = {0, 1, 15, 40};
__device__ const int dbgt_15_bs[5] = {0, 0, 5, 15, 9};
__device__ const int dbgt_16_hs[5] = {0, 3, 7, 2, 5};
__device__ const int dbgt_17_qs[5] = {0, 100, 2047, 4095, 1234};
__device__ const int dbgt_18_bs[6] = {0, 3, 7, 15, 11, 2};
__device__ const int dbgt_19_gs[6] = {0, 1, 0, 1, 1, 0};
__device__ const int dbgt_20_hhs[6] = {0, 2, 3, 1, 0, 2};
__device__ const int dbgt_21_qs[6] = {5, 700, 1030, 4095, 2500, 3071};
__device__ const int dbgt_22_dd[3] = {0, 33, 63};
__device__ const int dbgt_23_c4[4] = {0, 1300, 2777, 4095};
__device__ const int dbgt_24_cols[4] = {0, 300, 777, 1023};
__device__ const int dbgt_25_cc[6] = {768, 896, 800, 776, 775, 1023};
__global__ void __launch_bounds__(512) dbg_checks_a(Args args) {
    extern __shared__ __attribute__((aligned(16))) unsigned char lds_raw[]; LAS unsigned char* lds = (LAS unsigned char*)lds_raw;
    unsigned char* ws = args.ws; unsigned* ctl = WSP(unsigned, WS_CTL);
    const int lane = threadIdx.x & 63, wid = threadIdx.x >> 6;
    const int* rows = dbgt_0_dbg_rows;
    const half_t* XH = WSP(half_t, WS_XH);
    if (blockIdx.x == 0) {
        if (wid == 0) for (int s = 0; s < 4; ++s) { const int r = rows[s]; const float* x = args.in[0] + (size_t)r * DM; float ss = 0.f; for (int k = lane; k < DM; k += 64) ss += x[k] * x[k]; ss = wave_sum(ss);
            if (lane == 0) { dbg_flag(ctl, 1, WSP(float, WS_RS1)[r], 1.f / sqrtf(ss / DM + NORM_EPS)); dbg_flag(ctl, 1, h2f(XH + (size_t)r * DM + 517), x[517]); } }
        if (wid == 1) for (int s = 0; s < 4; ++s) { const int r = rows[s], pos = r & 4095, b = r >> 12;
            { const int* cs = dbgt_1_cs; for (int i = 0; i < 3; ++i) { const float u = dbg_u(args, r, cs[i], lane); if (lane == 0) dbg_flag(ctl, 2, h2f(WSP(half_t, WS_CQ) + (size_t)r * 256 + cs[i]), u); } }
            { const int* cs = dbgt_2_cs; for (int i = 0; i < 2; ++i) { const float u = dbg_u(args, r, 256 + cs[i], lane); if (lane == 0) dbg_flag(ctl, 3, h2f(WSP(half_t, WS_T1) + (size_t)r * 256 + cs[i]), u); } }
            { const int* ps = dbgt_3_ps; for (int i = 0; i < 4; ++i) { const int p = ps[i], pr = p >> 1; const float x1 = dbg_u(args, r, 384 + pr, lane), x2 = dbg_u(args, r, 384 + pr + 16, lane);
                const float c = dbg_rope_cs(pos, pr, 32, false), sn = dbg_rope_cs(pos, pr, 32, true); const float ref = (p & 1) ? (x2 * c + x1 * sn) : (x1 * c - x2 * sn);
                if (lane == 0) dbg_flag(ctl, 4, h2f(WSP(half_t, WS_KPE) + (size_t)b * SEQ * 32 + kpe_off(pos, p)), ref); } }
            { const int* is = dbgt_4_is; for (int i = 0; i < 3; ++i) { const float u = dbg_u(args, r, 1696 + is[i], lane); if (lane == 0) dbg_flag(ctl, 5, WSP(float, WS_GATE)[(size_t)r * 24 + is[i]], 1.f / (1.f + expf(-u))); } }
            { const int* hs = dbgt_5_hs; const int* ps = dbgt_6_ps; for (int i = 0; i < 4; ++i) { const int hd = hs[i], p = ps[i]; float ref;
                if (p < 16) { const int pr = p >> 1; const float x1 = dbg_u(args, r, 416 + hd * 64 + pr, lane), x2 = dbg_u(args, r, 416 + hd * 64 + pr + 8, lane);
                    const float c = dbg_rope_cs(pos, pr, 16, false), sn = dbg_rope_cs(pos, pr, 16, true); ref = (p & 1) ? (x2 * c + x1 * sn) : (x1 * c - x2 * sn); }
                else ref = dbg_u(args, r, 416 + hd * 64 + p, lane);
                if (lane == 0) dbg_flag(ctl, 6, h2f(WSP(half_t, WS_QN) + (size_t)r * 512 + hd * 64 + p), ref * QS_N); } }
            { const int* brs = dbgt_7_brs; const int* gs = dbgt_8_gs; const int* ps = dbgt_9_ps;
              for (int i = 0; i < 7; ++i) { const int br = brs[i], g = gs[i], p = ps[i]; const int base = 928 + br * 128 + g * 64; float ref;
                if ((br == 2 || br == 4) && p < 16) { const int pr = p >> 1; const float x1 = dbg_u(args, r, base + pr, lane), x2 = dbg_u(args, r, base + pr + 8, lane);
                    const float c = dbg_rope_cs(pos, pr, 16, false), sn = dbg_rope_cs(pos, pr, 16, true); ref = (p & 1) ? (x2 * c + x1 * sn) : (x1 * c - x2 * sn); }
                else ref = dbg_u(args, r, base + p, lane);
                if (lane == 0) dbg_flag(ctl, 7, h2f(WSP(half_t, WS_KVT) + (size_t)br * KVT_STRIDE + (size_t)(b * 2 + g) * SEQ * 64 + (br < 2 ? (size_t)pos * 64 + p : ((br & 1) ? v_off(pos, p) : k_off(pos, p)))), ref); } }
        }
        if (wid == 2) for (int s = 0; s < 4; ++s) { const int r = rows[s], pos = r & 4095, b = r >> 12;
            const half_t* cq = WSP(half_t, WS_CQ) + (size_t)r * 256; const half_t* t1 = WSP(half_t, WS_T1) + (size_t)r * 256;
            float sq = 0.f, skv = 0.f; for (int k = lane; k < 256; k += 64) { const float a = h2f(cq + k); sq += a * a; } for (int k = lane; k < 128; k += 64) { const float a = h2f(t1 + k); skv += a * a; }
            sq = wave_sum(sq); skv = wave_sum(skv); const float rq = 1.f / sqrtf(sq / 256.f + NORM_EPS), rkv = 1.f / sqrtf(skv / 128.f + NORM_EPS);
            const int* hs = dbgt_10_hs; const int* ps = dbgt_11_ps;
            for (int i = 0; i < 4; ++i) { const int hd = hs[i], p = ps[i]; float ref;
                auto qcol = [&](int col) { float a = 0.f; for (int k = lane; k < 256; k += 64) a += h2f(cq + k) * args.in[3][k] * args.in[4][(size_t)k * 768 + col]; return wave_sum(a) * rq; };
                if (p < 64) ref = qcol(hd * 96 + p);
                else { const int pp = p - 64, pr = pp >> 1; const float x1 = qcol(hd * 96 + 64 + pr), x2 = qcol(hd * 96 + 64 + pr + 16);
                    const float c = dbg_rope_cs(pos, pr, 32, false), sn = dbg_rope_cs(pos, pr, 32, true); ref = (pp & 1) ? (x2 * c + x1 * sn) : (x1 * c - x2 * sn); }
                if (lane == 0) dbg_flag(ctl, 8, h2f(WSP(half_t, WS_QM) + (size_t)r * 768 + hd * 96 + p), ref * QS_M); }
            for (int i = 0; i < 4; ++i) { const int hd = hs[i], d = ps[i] & 63;
                auto kvcol = [&](int col) { float a = 0.f; for (int k = lane; k < 128; k += 64) a += h2f(t1 + k) * args.in[5][k] * args.in[6][(size_t)k * 1024 + col]; return wave_sum(a) * rkv; };
                const float kr = kvcol(hd * 128 + d), vr = kvcol(hd * 128 + 64 + d);
                if (lane == 0) { dbg_flag(ctl, 9, h2f(WSP(half_t, WS_KNM) + (size_t)(b * 8 + hd) * SEQ * 64 + k_off(pos, d)), kr); dbg_flag(ctl, 10, h2f(WSP(half_t, WS_VM) + (size_t)(b * 8 + hd) * SEQ * 64 + v_off(pos, d)), vr); } }
        }
        if (wid == 3 || wid == 4) { const int kv = wid - 3; const int* slabs = dbgt_12_slabs; const int* ns = dbgt_13_ns;
            LAS float* hid = (LAS float*)(lds + 65536 + kv * 1024);
            const float* pe = args.in[kv ? 12 : 7]; const float* w1 = args.in[kv ? 13 : 8]; const float* b1 = args.in[kv ? 14 : 9]; const float* w2 = args.in[kv ? 15 : 10]; const float* b2 = args.in[kv ? 16 : 11];
            for (int s = 0; s < 3; ++s) { const int slab = slabs[s], n = ns[s]; const half_t* tok = WSP(half_t, WS_KVT) + (size_t)kv * KVT_STRIDE + ((size_t)slab * SEQ + 16 * n) * 64;
                for (int jj = 0; jj < 2; ++jj) { const int j = lane + 64 * jj; float a = b1[j]; for (int k = 0; k < 2048; ++k) a += (h2f(tok + k) + pe[k]) * w1[(size_t)k * 128 + j];
                    const float z = 0.7978845608028654f * (a + 0.044715f * a * a * a); hid[j] = 0.5f * a * (1.f + tanhf(z)); }
                asm volatile("s_waitcnt lgkmcnt(0)" ::: "memory");
                float o = b2[lane]; for (int j = 0; j < 128; ++j) o += hid[j] * w2[j * 64 + lane];
                const int* ps = dbgt_14_ps;
                for (int i = 0; i < 4; ++i) { const int p = ps[i]; float ref;
                    if (kv == 0 && p < 16) { const int pr = p >> 1; const float x1 = __shfl(o, pr), x2 = __shfl(o, pr + 8); const int pos = 16 * n + 31;
                        const float c = dbg_rope_cs(pos, pr, 16, false), sn = dbg_rope_cs(pos, pr, 16, true); ref = (p & 1) ? (x2 * c + x1 * sn) : (x1 * c - x2 * sn); }
                    else ref = __shfl(o, p);
                    if (lane == 0) dbg_flag(ctl, 11 + kv, h2f((kv ? WSP(half_t, WS_VC) : WSP(half_t, WS_KC)) + (size_t)slab * 256 * 64 + (kv ? v_off(n, p) : k_off(n, p))), ref); }
                asm volatile("s_waitcnt lgkmcnt(0)" ::: "memory"); }
        }
        if (wid == 5) { const int* bs = dbgt_15_bs; const int* hs = dbgt_16_hs; const int* qs = dbgt_17_qs;
            for (int s = 0; s < 5; ++s) { const int b = bs[s], hd = hs[s], q = qs[s]; const size_t r = (size_t)b * SEQ + q;
                const half_t* qv = WSP(half_t, WS_QM) + r * 768 + hd * 96; const half_t* Kn = WSP(half_t, WS_KNM) + (size_t)(b * 8 + hd) * SEQ * 64; const half_t* Kp = WSP(half_t, WS_KPE) + (size_t)b * SEQ * 32; const half_t* V = WSP(half_t, WS_VM) + (size_t)(b * 8 + hd) * SEQ * 64;
                float mx = -1e30f;
                for (int k = lane; k <= q; k += 64) { float sc = 0.f; for (int d = 0; d < 64; ++d) sc += h2f(qv + d) * h2f(Kn + k_off(k, d)); for (int d = 0; d < 32; ++d) sc += h2f(qv + 64 + d) * h2f(Kp + kpe_off(k, d)); mx = fmaxf(mx, sc); }
                for (int o = 1; o < 64; o <<= 1) mx = fmaxf(mx, __shfl_xor(mx, o));
                float l = 0.f, o0 = 0.f, o1 = 0.f, o2 = 0.f;
                for (int k = lane; k <= q; k += 64) { float sc = 0.f; for (int d = 0; d < 64; ++d) sc += h2f(qv + d) * h2f(Kn + k_off(k, d)); for (int d = 0; d < 32; ++d) sc += h2f(qv + 64 + d) * h2f(Kp + kpe_off(k, d));
                    const float p = exp2f(sc - mx); l += p; o0 += p * h2f(V + v_off(k, 0)); o1 += p * h2f(V + v_off(k, 33)); o2 += p * h2f(V + v_off(k, 63)); }
                l = wave_sum(l); o0 = wave_sum(o0); o1 = wave_sum(o1); o2 = wave_sum(o2);
                if (lane == 0) { const half_t* y = WSP(half_t, WS_Y) + r * DM + hd * 64; dbg_flag(ctl, 13, h2f(y + 0), o0 / l); dbg_flag(ctl, 13, h2f(y + 33), o1 / l); dbg_flag(ctl, 13, h2f(y + 63), o2 / l); } }
        }
        if (wid == 6 || wid == 7) { const int* bs = dbgt_18_bs; const int* gs = dbgt_19_gs; const int* hhs = dbgt_20_hhs; const int* qs = dbgt_21_qs;
            LAS float* pc = (LAS float*)(lds + 70000 + (wid - 6) * 8192);
            for (int s = wid - 6; s < 6; s += 2) { const int b = bs[s], g = gs[s], hh = hhs[s], q = qs[s], cur = q >> 6; const size_t r = (size_t)b * SEQ + q; const int bg = b * 2 + g;
                const half_t* Kc = WSP(half_t, WS_KC) + (size_t)bg * 256 * 64; const half_t* Vc = WSP(half_t, WS_VC) + (size_t)bg * 256 * 64;
                for (int h4 = 0; h4 < 4; ++h4) { const half_t* qv = WSP(half_t, WS_QN) + r * 512 + (g * 4 + h4) * 64;
                    float sc[4]; float mx = -1e30f;
                    for (int i = 0; i < 4; ++i) { const int n = lane + 64 * i; float a = -INFINITY; if (n < 255 && 16 * n + 31 <= q) { a = 0.f; for (int d = 0; d < 64; ++d) a += h2f(qv + d) * h2f(Kc + k_off(n, d)); } sc[i] = a; mx = fmaxf(mx, a); }
                    for (int o = 1; o < 64; o <<= 1) mx = fmaxf(mx, __shfl_xor(mx, o));
                    float l = 0.f; for (int i = 0; i < 4; ++i) { sc[i] = exp2f(sc[i] - mx); l += sc[i]; } l = wave_sum(l);
                    for (int i = 0; i < 4; ++i) pc[h4 * 256 + lane + 64 * i] = (l > 0.f) ? sc[i] / l : 0.f; }
                asm volatile("s_waitcnt lgkmcnt(0)" ::: "memory");
                { float imp = 0.f; const int jb = lane;
                  for (int n = 0; n < 255; ++n) { const int cs = 16 * n, ss0 = 64 * jb; const int lo2 = cs > ss0 ? cs : ss0, hi2 = (cs + 32 < ss0 + 64) ? cs + 32 : ss0 + 64; const int ov = hi2 - lo2; if (ov > 0) { const float w = (float)ov / 32.f; for (int h4 = 0; h4 < 4; ++h4) imp += pc[h4 * 256 + n] * w; } }
                  const bool forced = (jb == 0) || (jb == cur) || (jb == cur - 1), causal = jb * 64 <= q;
                  pc[1024 + jb] = forced ? 1e9f : (causal ? imp : -1e9f); }
                asm volatile("s_waitcnt lgkmcnt(0)" ::: "memory");
                if (lane == 0) { for (int jb = 0; jb < 64; ++jb) pc[1088 + jb] = 0.f; for (int it = 0; it < 16; ++it) { int best = -1; float bv = -INFINITY; for (int jb = 0; jb < 64; ++jb) if (pc[1088 + jb] == 0.f && pc[1024 + jb] > bv) { bv = pc[1024 + jb]; best = jb; } pc[1088 + best] = 1.f; } }
                asm volatile("s_waitcnt lgkmcnt(0)" ::: "memory");
                const half_t* qv = WSP(half_t, WS_QN) + r * 512 + (g * 4 + hh) * 64; const int* dd = dbgt_22_dd;
                float oc[3] = {0.f, 0.f, 0.f};
                for (int i = 0; i < 4; ++i) { const int n = lane + 64 * i; if (n < 255) { const float p = pc[hh * 256 + n]; for (int e = 0; e < 3; ++e) oc[e] += p * h2f(Vc + v_off(n, dd[e])); } }
                for (int e = 0; e < 3; ++e) oc[e] = wave_sum(oc[e]);
                float osw[2][3];
                for (int br = 0; br < 2; ++br) { const half_t* Kx = WSP(half_t, WS_KVT) + (size_t)(2 + 2 * br) * KVT_STRIDE + (size_t)bg * SEQ * 64; const half_t* Vx = WSP(half_t, WS_KVT) + (size_t)(3 + 2 * br) * KVT_STRIDE + (size_t)bg * SEQ * 64;
                    float mx = -1e30f;
                    for (int k = lane; k <= q; k += 64) { const bool ok = br ? (q - k < 512) : (pc[1088 + (k >> 6)] != 0.f); if (!ok) continue; float a = 0.f; for (int d = 0; d < 64; ++d) a += h2f(qv + d) * h2f(Kx + k_off(k, d)); mx = fmaxf(mx, a); }
                    for (int o = 1; o < 64; o <<= 1) mx = fmaxf(mx, __shfl_xor(mx, o));
                    float l = 0.f, a3[3] = {0.f, 0.f, 0.f};
                    for (int k = lane; k <= q; k += 64) { const bool ok = br ? (q - k < 512) : (pc[1088 + (k >> 6)] != 0.f); if (!ok) continue; float a = 0.f; for (int d = 0; d < 64; ++d) a += h2f(qv + d) * h2f(Kx + k_off(k, d));
                        const float p = exp2f(a - mx); l += p; for (int e = 0; e < 3; ++e) a3[e] += p * h2f(Vx + v_off(k, dd[e])); }
                    l = wave_sum(l); for (int e = 0; e < 3; ++e) osw[br][e] = wave_sum(a3[e]) / l; }
                if (lane == 0) { const float* gt = WSP(float, WS_GATE) + r * 24; const int head = g * 4 + hh; const float g0 = gt[head], g1 = gt[8 + head], g2 = gt[16 + head];
                    for (int e = 0; e < 3; ++e) dbg_flag(ctl, q < 1024 ? 14 : 15, h2f(WSP(half_t, WS_Y) + r * DM + 512 + head * 64 + dd[e]), g0 * oc[e] + g1 * osw[0][e] + g2 * osw[1][e]); }
                asm volatile("s_waitcnt lgkmcnt(0)" ::: "memory"); }
        }
    }
}
__global__ void __launch_bounds__(512) dbg_checks_b(Args args, int which) {
    unsigned char* ws = args.ws; unsigned* ctl = WSP(unsigned, WS_CTL);
    const int lane = threadIdx.x & 63, wid = threadIdx.x >> 6;
    const int* rows = dbgt_0_dbg_rows; const int* cols = dbgt_24_cols;
    if (blockIdx.x != 0 || wid >= 4) return;
    const int r = rows[wid];
    if (which == 6 && wid == 3) { const half_t* y = WSP(half_t, WS_Y) + (size_t)r * DM; const int* cc = dbgt_25_cc;
        for (int i = 0; i < 6; ++i) { const int c = cc[i]; float a = 0.f; for (int k = lane; k < DM; k += 64) a += h2f(y + k) * (k < 512 ? args.in[17][k] : args.in[18][k - 512]) * args.in[19][(size_t)k * DM + c];
            const float dot = wave_sum(a), xr = args.in[0][(size_t)r * DM + c], got = h2f(WSP(half_t, WS_H1) + (size_t)r * DM + c);
            if (lane == 0 && !(fabsf(got - (dot + xr)) <= 0.03f + 0.03f * fabsf(dot + xr))) atomicAdd(ctl + CW_DBG + 2, 1u << i); } }
    if (which == 6) { const half_t* y = WSP(half_t, WS_Y) + (size_t)r * DM;
        { float s0 = 0.f, s1 = 0.f; for (int k = lane; k < 512; k += 64) { const float a = h2f(y + k), b = h2f(y + 512 + k); s0 += a * a; s1 += b * b; } s0 = wave_sum(s0); s1 = wave_sum(s1);
          if (lane == 0) { dbg_flag(ctl, 20, s0 / 512.f, 1.f); dbg_flag(ctl, 21, s1 / 512.f, 1.f); } }
        { const int c = cols[wid], k = rows[wid] & 1023; if (lane == 0) dbg_flag(ctl, 22, 100.f * h2f(WSP(half_t, WS_WO) + (size_t)c * DM + k), 100.f * args.in[19][(size_t)k * DM + c] * (k < 512 ? args.in[17][k] : args.in[18][k - 512])); }
        for (int i = 0; i < 4; ++i) { const int c = cols[i]; float a = 0.f; for (int k = lane; k < DM; k += 64) a += h2f(y + k) * (k < 512 ? args.in[17][k] : args.in[18][k - 512]) * args.in[19][(size_t)k * DM + c];
            const float dot = wave_sum(a), xr = args.in[0][(size_t)r * DM + c], got = h2f(WSP(half_t, WS_H1) + (size_t)r * DM + c); a = dot + xr;
            if (lane == 0) { dbg_flag(ctl, 16, got, a);
                if ((wid == 0 && i == 0) || (wid == 3 && i == 3)) { int hcode = 9; auto near = [](float p, float q) { return fabsf(p - q) <= 0.03f + 0.03f * fabsf(q); };
                    if (near(got, dot + xr)) hcode = 1; else if (near(got, dot)) hcode = 2; else if (near(got, xr)) hcode = 3; else if (near(got, 2.f * xr + dot)) hcode = 4; else if (!(got == got)) hcode = 5; else if (near(got, 0.f)) hcode = 6;
                    atomicAdd(ctl + CW_DBG + 1, (unsigned)(wid == 0 ? 10 * hcode : hcode)); } } } }
    if (which == 7) { const half_t* h1 = WSP(half_t, WS_H1) + (size_t)r * DM; float ss = 0.f; for (int k = lane; k < DM; k += 64) { const float a = h2f(h1 + k); ss += a * a; } ss = wave_sum(ss); const float rs = 1.f / sqrtf(ss / DM + NORM_EPS);
        const int* c4 = dbgt_23_c4;
        for (int i = 0; i < 4; ++i) { const int c = c4[i]; float a = 0.f; for (int k = lane; k < DM; k += 64) a += h2f(h1 + k) * args.in[20][k] * args.in[21][(size_t)k * DFF + c];
            a = fmaxf(wave_sum(a) * rs, 0.f); if (lane == 0) dbg_flag(ctl, 17, h2f(WSP(half_t, WS_A2) + (size_t)r * DFF + c), a * a); } }
    if (which == 8) { const half_t* a2 = WSP(half_t, WS_A2) + (size_t)r * DFF;
        for (int i = 0; i < 4; ++i) { const int c = cols[i]; float a = 0.f; for (int k = lane; k < DFF; k += 64) a += h2f(a2 + k) * args.in[22][(size_t)k * DM + c];
            a = wave_sum(a) + h2f(WSP(half_t, WS_H1) + (size_t)r * DM + c); if (lane == 0) dbg_flag(ctl, 18, h2f(WSP(half_t, WS_H2) + (size_t)r * DM + c), a); } }
    if (which == 9) { const half_t* h2 = WSP(half_t, WS_H2) + (size_t)r * DM; float ss = 0.f; for (int k = lane; k < DM; k += 64) { const float a = h2f(h2 + k); ss += a * a; } ss = wave_sum(ss); const float rs = 1.f / sqrtf(ss / DM + NORM_EPS);
        for (int i = 0; i < 4; ++i) { const int c = cols[i]; if (lane == 0) dbg_flag(ctl, 19, args.out[(size_t)r * DM + c], h2f(h2 + c) * rs * args.in[23][c]); } }
}
__global__ void __launch_bounds__(512) dbg_fill(Args args) {
    unsigned char* ws = args.ws; unsigned* ctl = WSP(unsigned, WS_CTL);
#ifndef DBG_SKIP
#define DBG_SKIP 0
#endif
    const unsigned m = __hip_atomic_load(ctl + CW_DBG, __ATOMIC_RELAXED, __HIP_MEMORY_SCOPE_AGENT) & ~((1u << DBG_SKIP) - 1u);
#ifdef DBG_STAMP
    const unsigned long long* ts = (const unsigned long long*)(ctl + 160); (void)m;
    const int code = (int)((ts[DBG_T1B] - ts[DBG_T1A]) / 4000ull);
    const float vbig = (float)((ts[DBG_T2B] - ts[DBG_T2A]) / 100ull);
    if (blockIdx.x == 0 && threadIdx.x == 0) { args.out[(size_t)MROWS * DM - 1] = vbig; }
#elif defined(DBG_VALUE)
    const int code = (int)__hip_atomic_load(ctl + CW_DBG + 2, __ATOMIC_RELAXED, __HIP_MEMORY_SCOPE_AGENT); (void)m;
#else
    const int code = m ? __builtin_ctz(m) : 0;
#endif
    const float a = sqrtf((float)code);
#ifdef DBG_STAMP
    const size_t nfill = (size_t)MROWS * DM / 4 - 1;
    if (blockIdx.x == 0 && threadIdx.x == 1) { args.out[(size_t)MROWS * DM - 4] = a; args.out[(size_t)MROWS * DM - 3] = a; args.out[(size_t)MROWS * DM - 2] = a; }
#else
    const size_t nfill = (size_t)MROWS * DM / 4;
#endif
    for (size_t i = (size_t)blockIdx.x * 512 + threadIdx.x; i < nfill; i += (size_t)gridDim.x * 512) ((f32x4*)args.out)[i] = (f32x4){a, a, a, a};
}
#endif

extern "C" void kernel_launch(void* const* d_in, const int* in_sizes, int n_in, void* d_out, int out_size, void* d_ws, size_t ws_size, hipStream_t stream) {
    static int grid = 0;
    if (grid == 0) {
        if (n_in != 24 || out_size != MROWS * DM || ws_size < WS_END) { fprintf(stderr, "kernel_launch: unexpected problem (n_in %d, out %d, ws %zu)\n", n_in, out_size, ws_size); grid = -1; return; }
        int dev = 0, cus = 0, per_cu = 0;
        if (hipGetDevice(&dev) != hipSuccess || hipDeviceGetAttribute(&cus, hipDeviceAttributeMultiprocessorCount, dev) != hipSuccess) { grid = -1; return; }
        if (hipFuncSetAttribute((const void*)hymba_fwd, hipFuncAttributeMaxDynamicSharedMemorySize, LDS_BYTES) != hipSuccess) { fprintf(stderr, "kernel_launch: hipFuncSetAttribute failed\n"); grid = -1; return; }
        if (hipOccupancyMaxActiveBlocksPerMultiprocessor(&per_cu, (const void*)hymba_fwd, 512, LDS_BYTES) != hipSuccess || per_cu < 1) fprintf(stderr, "kernel_launch: occupancy query says %d\n", per_cu);
        (void)hipGetLastError();
        grid = cus;
#if DBG_CHECK
        (void)hipFuncSetAttribute((const void*)dbg_checks_a, hipFuncAttributeMaxDynamicSharedMemorySize, 98304);
#endif
    }
    if (grid < 0) return;
    (void)hipMemsetAsync((char*)d_ws + WS_CTL, 0, CTL_ZERO_BYTES, stream);
    Args a{};
    for (int i = 0; i < 24; ++i) a.in[i] = (const float*)d_in[i];
    a.out = (float*)d_out; a.ws = (unsigned char*)d_ws;
#if DBG_CHECK == 1
    a.ph_lo = 0; a.ph_hi = 5; a.li = 0; hipLaunchKernelGGL(hymba_fwd, dim3(grid), dim3(512), LDS_BYTES, stream, a);
    hipLaunchKernelGGL(dbg_checks_a, dim3(1), dim3(512), 98304, stream, a);
    hipLaunchKernelGGL(dbg_fill, dim3(1024), dim3(512), 0, stream, a);
#elif DBG_CHECK == 2
    a.ph_lo = 0; a.ph_hi = 7; a.li = 0; hipLaunchKernelGGL(hymba_fwd, dim3(grid), dim3(512), LDS_BYTES, stream, a);
    hipLaunchKernelGGL(dbg_checks_b, dim3(1), dim3(512), 0, stream, a, 6);
    a.ph_lo = 7; a.ph_hi = 8; a.li = 1; hipLaunchKernelGGL(hymba_fwd, dim3(grid), dim3(512), LDS_BYTES, stream, a);
    hipLaunchKernelGGL(dbg_checks_b, dim3(1), dim3(512), 0, stream, a, 7);
    a.ph_lo = 8; a.ph_hi = 9; a.li = 2; hipLaunchKernelGGL(hymba_fwd, dim3(grid), dim3(512), LDS_BYTES, stream, a);
    hipLaunchKernelGGL(dbg_checks_b, dim3(1), dim3(512), 0, stream, a, 8);
    a.ph_lo = 9; a.ph_hi = 10; a.li = 3; hipLaunchKernelGGL(hymba_fwd, dim3(grid), dim3(512), LDS_BYTES, stream, a);
    hipLaunchKernelGGL(dbg_checks_b, dim3(1), dim3(512), 0, stream, a, 9);
    hipLaunchKernelGGL(dbg_fill, dim3(1024), dim3(512), 0, stream, a);
#elif DBG_CHECK == 3
    a.ph_lo = 0; a.ph_hi = 10; a.li = 0; hipLaunchKernelGGL(hymba_fwd, dim3(grid), dim3(512), LDS_BYTES, stream, a);
    hipLaunchKernelGGL(dbg_fill, dim3(1024), dim3(512), 0, stream, a);
#elif MK_N_LAUNCHES == 1
    a.ph_lo = 0; a.ph_hi = 10; a.li = 0;
    hipLaunchKernelGGL(hymba_fwd, dim3(grid), dim3(512), LDS_BYTES, stream, a);
#else
    for (int p = 0; p < 10; ++p) { a.ph_lo = p; a.ph_hi = p + 1; a.li = p; hipLaunchKernelGGL(hymba_fwd, dim3(grid), dim3(512), LDS_BYTES, stream, a); }
#endif
}
```

```cpp
#include <hip/hip_runtime.h>
#include <cstdio>
#include <cstdint>

#ifndef DBG_CHECK
#define DBG_CHECK 0
#endif
#ifndef REPEAT_PHASE
#define REPEAT_PHASE -1
#endif
#ifndef ABL
#define ABL 0
#endif
#ifndef MK_N_LAUNCHES
#define MK_N_LAUNCHES 1
#endif

#define LAS __attribute__((address_space(3)))
typedef _Float16 half_t;
typedef _Float16 half8 __attribute__((ext_vector_type(8)));
typedef _Float16 half2v __attribute__((ext_vector_type(2)));
typedef float f32x4 __attribute__((ext_vector_type(4)));
typedef float f32x16 __attribute__((ext_vector_type(16)));
typedef unsigned u32x4 __attribute__((ext_vector_type(4)));
typedef unsigned u32x2 __attribute__((ext_vector_type(2)));
typedef short v4i16 __attribute__((ext_vector_type(4)));

constexpr int BATCH = 16, SEQ = 4096, DM = 1024, MROWS = BATCH * SEQ;
constexpr int IN_COLS = 1720, NIN = 1792;
constexpr int DFF = 4096;
constexpr float NORM_EPS = 1e-6f;
constexpr float LOG2E = 1.4426950408889634f;
constexpr float QS_N = 0.125f * LOG2E;
constexpr float QS_M = 0.10206207261596577f * LOG2E;

constexpr size_t MiB = 1u << 20;
constexpr size_t WS_CTL = 0, CTL_ZERO_BYTES = 1 * MiB;
constexpr size_t WS_WIN = 1 * MiB, WS_WUQ = 5 * MiB, WS_WUKV = 6 * MiB, WS_WC1 = 7 * MiB, WS_WO = 9 * MiB, WS_WUP = 11 * MiB, WS_WDN = 19 * MiB;
constexpr size_t WS_ROPEM = 27 * MiB, WS_ROPEN = 27 * MiB + 512 * 1024, WS_B1P = 27 * MiB + 768 * 1024;
constexpr size_t WS_KC = 28 * MiB, WS_VC = 29 * MiB;
constexpr size_t WS_RS1 = 32 * MiB, WS_SSQ = 33 * MiB, WS_SSKV = 34 * MiB, WS_SSM = 35 * MiB, WS_SSN = 37 * MiB, WS_SS2 = 39 * MiB, WS_SS3 = 43 * MiB;
constexpr size_t WS_GATE = 47 * MiB, WS_KPE = 53 * MiB;
constexpr size_t WS_CQ = 64 * MiB, WS_T1 = 96 * MiB, WS_QN = 128 * MiB, WS_KVT = 192 * MiB  ;
constexpr size_t WS_QM = 288 * MiB, WS_KNM = 384 * MiB, WS_VM = 448 * MiB, WS_HIDP = 512 * MiB;
constexpr size_t WS_A2 = 64 * MiB;
constexpr size_t WS_XH = 576 * MiB, WS_H2 = 576 * MiB, WS_Y = 704 * MiB, WS_H1 = 832 * MiB, WS_END = 960 * MiB;
constexpr size_t KVT_STRIDE = 16 * MiB / 2;

constexpr int CW_QHEAD = 64;
constexpr int CW_BAR = 4096;

constexpr int LDS_BYTES = 163840;
constexpr int LDS_MISC = 163840 - 256;

#define XB_TMO      128
#define XB_XCNT(j)  (256  + 64 * (j))
#define XB_XSUB(j)  (1280 + 64 * (j))
#define XB_XGEN(j)  (2304 + 64 * (j))
#define XB_TOP      3328
#define XB_TOPGEN   3392
#define XCD_BAR_WORDS 3456
#define XB_SPIN_CAP (1u << 22)

__device__ __forceinline__ unsigned xb_ld(unsigned* p)              { return __hip_atomic_load(p, __ATOMIC_RELAXED, __HIP_MEMORY_SCOPE_AGENT); }
__device__ __forceinline__ unsigned xb_add(unsigned* p, unsigned v) { return __hip_atomic_fetch_add(p, v, __ATOMIC_RELAXED, __HIP_MEMORY_SCOPE_AGENT); }
__device__ __forceinline__ unsigned xb_xcc_id() { return (unsigned)__builtin_amdgcn_s_getreg((3 << 11) | 20) & 0xFu; }
#define XB_SPIN(cond, bar) do { unsigned _sp = 0; while (cond) { __builtin_amdgcn_s_sleep(1); \
    if ((++_sp & 255u) == 0u) { if (xb_ld(&(bar)[XB_TMO])) break; if (_sp > XB_SPIN_CAP) { atomicAdd(&(bar)[XB_TMO], 1u); break; } } } } while (0)

struct XcdBarrier { unsigned* bar; unsigned x; volatile LAS unsigned* st; };

__device__ __forceinline__ XcdBarrier xcd_barrier_post(unsigned* bar, volatile LAS unsigned* st) {
    XcdBarrier b; b.bar = bar; b.x = xb_xcc_id(); b.st = st;
    if (threadIdx.x == 0) (void)xb_add(&bar[XB_XCNT(b.x)], 1u);
    return b;
}
__device__ __forceinline__ void xcd_barrier_complete(unsigned* bar, unsigned x, unsigned& nloc, unsigned& nx) {
    const unsigned G = gridDim.x * gridDim.y * gridDim.z;
    unsigned sum, cnt, mine, sp = 0u;
    for (;;) {
        sum = 0u; cnt = 0u; mine = 0u;
#pragma unroll
        for (unsigned j = 0; j < 16; ++j) { const unsigned c = xb_ld(&bar[XB_XCNT(j)]); sum += c; cnt += (c > 0u) ? 1u : 0u; mine = (j == x) ? c : mine; }
        if (sum == G) break;
        __builtin_amdgcn_s_sleep(1);
        if ((++sp & 255u) == 0u) { if (xb_ld(&bar[XB_TMO])) break; if (sp > XB_SPIN_CAP) { atomicAdd(&bar[XB_TMO], 1u); break; } }
    }
    nloc = mine > 0u ? mine : 1u; nx = cnt > 0u ? cnt : 1u;
}
__device__ __forceinline__ void xcd_barrier(const XcdBarrier& b) {
    asm volatile("s_waitcnt vmcnt(0)" ::: "memory");
    __syncthreads();
    if (threadIdx.x == 0) {
        unsigned* bar = b.bar;
        __builtin_amdgcn_s_waitcnt(0);
        unsigned nloc = b.st[0], nx = b.st[1];
        if (nloc == 0u) { xcd_barrier_complete(bar, b.x, nloc, nx); b.st[0] = nloc; b.st[1] = nx; }
        const unsigned old = xb_add(&bar[XB_XSUB(b.x)], 1u);
        const unsigned gen = old / nloc;
        if (old + 1u == (gen + 1u) * nloc) {
            __builtin_amdgcn_fence(__ATOMIC_RELEASE, "agent");
            asm volatile("s_waitcnt vmcnt(0)" ::: "memory");
            const unsigned og = xb_add(&bar[XB_TOP], 1u);
            const unsigned tg = og / nx;
            if (og + 1u == (tg + 1u) * nx) xb_add(&bar[XB_TOPGEN], 1u);
            else XB_SPIN(xb_ld(&bar[XB_TOPGEN]) == tg, bar);
            __builtin_amdgcn_fence(__ATOMIC_ACQUIRE, "agent");
            xb_add(&bar[XB_XGEN(b.x)], 1u);
            asm volatile("s_waitcnt vmcnt(0)" ::: "memory");
        } else {
            XB_SPIN(xb_ld(&bar[XB_XGEN(b.x)]) == gen, bar);
            __builtin_amdgcn_fence(__ATOMIC_ACQUIRE, "agent");
            asm volatile("s_waitcnt vmcnt(0)" ::: "memory");
        }
    }
    __syncthreads();
}

__device__ __forceinline__ unsigned pk_rne(float a, float b) { half2v v = {(_Float16)a, (_Float16)b}; return __builtin_bit_cast(unsigned, v); }
__device__ __forceinline__ unsigned pk_rtz(float a, float b) { auto v = __builtin_amdgcn_cvt_pkrtz(a, b); return __builtin_bit_cast(unsigned, v); }
__device__ __forceinline__ u32x4 pk8(const float* v) { u32x4 w; w.x = pk_rne(v[0], v[1]); w.y = pk_rne(v[2], v[3]); w.z = pk_rne(v[4], v[5]); w.w = pk_rne(v[6], v[7]); return w; }
__device__ __forceinline__ void unpk8(u32x4 w, float* v) {
    const half8 h = __builtin_bit_cast(half8, w);
#pragma unroll
    for (int i = 0; i < 8; ++i) v[i] = (float)h[i];
}
__device__ __forceinline__ float wave_sum(float v) {
#pragma unroll
    for (int o = 1; o < 64; o <<= 1) v += __shfl_xor(v, o);
    return v;
}
__device__ __forceinline__ void rope4(float* v, const float2* cs) {
#pragma unroll
    for (int p = 0; p < 4; ++p) { const float2 t = cs[p]; const float x1 = v[2 * p], x2 = v[2 * p + 1]; v[2 * p] = x1 * t.x - x2 * t.y; v[2 * p + 1] = x2 * t.x + x1 * t.y; }
}

__host__ __device__ __forceinline__ size_t k_off(int tok, int d)   { return (size_t)(((tok >> 6) * 8 + (d >> 3)) * 512 + (tok & 63) * 8 + (d & 7)); }
__host__ __device__ __forceinline__ size_t v_off(int tok, int d)   { return (size_t)((tok >> 6) * 4096 + ((d >> 5) * 8 + ((tok & 63) >> 3)) * 256 + (tok & 7) * 32 + (d & 31)); }
__host__ __device__ __forceinline__ size_t kpe_off(int tok, int p) { return (size_t)(((tok >> 6) * 4 + (p >> 3)) * 512 + (tok & 63) * 8 + (p & 7)); }

namespace pg8 {
constexpr int BM = 256, BK = 64, HALF = 128, HTB = HALF * BK * 2, NXCD = 8, WGM = 8;
__host__ __device__ __forceinline__ int lds_byte(int r, int c) { const int st = (r >> 4) * 2 + (c >> 5), rr = r & 15, cc = c & 31, ob = rr * 64 + cc * 2; return st * 1024 + (ob ^ (((ob >> 9) & 1) << 5)); }
__host__ __device__ __forceinline__ void stage_rc(int b, int& R, int& C) { const int st = b / 1024, sb = b % 1024, swz = sb ^ (((sb >> 9) & 1) << 5); R = (st >> 1) * 16 + swz / 64; C = (st & 1) * 32 + (swz % 64) / 2; }
__host__ __device__ __forceinline__ int perm32(int rho) { const int n = rho >> 4, i = rho & 15; return 8 * (i >> 2) + 4 * n + (i & 3); }

struct Unit { int pm, pn; size_t aoff, boff; };
struct Gemm { const half_t* A; const half_t* Bt; int K, lda, ldb; };

struct StaticOrder {
    int nM, nN, nwg, G, c; size_t tA, tB;
    __device__ void init(int M, int N, int G_, int c_, int lda, int ldb) { nM = M / BM; nN = N / BM; nwg = nM * nN; G = G_; c = c_; tA = (size_t)BM * lda * 2; tB = (size_t)BM * ldb * 2; }
    __device__ bool next(int i, Unit& u) const {
        const long L = (long)i * G + c; if (L >= nwg) return false;
        int wgid = (int)L; { const int q = nwg / NXCD, r = nwg % NXCD, xcd = wgid % NXCD, off = wgid / NXCD; wgid = (xcd < r ? xcd * (q + 1) : r * (q + 1) + (xcd - r) * q) + off; }
        const int nig = WGM * nN, gid = wgid / nig, fm = gid * WGM, gsz = (nM - fm) < WGM ? (nM - fm) : WGM;
        u.pm = fm + ((wgid % nig) % gsz); u.pn = (wgid % nig) / gsz; u.aoff = (size_t)u.pm * tA; u.boff = (size_t)u.pn * tB; return true;
    }
};
struct Cmp1Order {
    int G, c;
    __device__ bool next(int i, Unit& u) const {
        const int L = i * G + c; if (L >= 256) return false;
        const int kv = L >> 7, slab = (L >> 2) & 31, ch = L & 3;
        u.pm = L; u.pn = 0; u.aoff = (size_t)kv * (16 * MiB) + (size_t)slab * (512 * 1024) + (size_t)ch * 1024; u.boff = (size_t)kv * (256 * 2048 * 2) + (size_t)ch * 1024; return true;
    }
};

template <class Epi, class Sched, bool MIDK = false>
__device__ __forceinline__ void gemm_phase(LAS unsigned char* lds, const Gemm g, const Sched& S, const Epi& E) {
    int tid_ = threadIdx.x; asm volatile("" : "+v"(tid_));
    const int tid = tid_, wid = __builtin_amdgcn_readfirstlane(tid >> 6), lane = tid & 63, wr = wid >> 2, wc = wid & 3, fr = lane & 15, fq = lane >> 4;
    const int K = g.K, nt = K / BK;
    unsigned voffA[2], voffB[2];
#pragma unroll
    for (int i = 0; i < 2; ++i) { int R, C; stage_rc(tid * 16 + i * 8192, R, C); const int Rb = (R & ~31) + perm32(R & 31);
        voffA[i] = (unsigned)(R * g.lda + C) * 2u; voffB[i] = (unsigned)(Rb * g.ldb + C) * 2u; }
    const size_t kstep = (size_t)(BK * 2);
    const size_t hstepA = (size_t)HALF * g.lda * 2, hstepB = (size_t)HALF * g.ldb * 2;
    const unsigned ldsw = (unsigned)wid * 1024u;
    const int aoff = lds_byte(wr * 64 + fr, fq * 8), boff = lds_byte(wc * 32 + fr, fq * 8);
#define PG8_SA(b, h) (((b) * 2 + (h)) * HTB)
#define PG8_SB(b, h) ((4 + (b) * 2 + (h)) * HTB)
#define PG8_STAGE(bufoff, gbase, voff) do { _Pragma("unroll") for (int _i = 0; _i < 2; ++_i) \
        __builtin_amdgcn_global_load_lds((const unsigned*)((const char*)(gbase) + (voff)[_i]), (LAS unsigned*)(lds + (bufoff) + ldsw + _i * 8192), 16, 0, 0); } while (0)
#define PG8_LDA(dst, b, h) do { _Pragma("unroll") for (int m = 0; m < 4; ++m) _Pragma("unroll") for (int k = 0; k < 2; ++k) dst[m][k] = *(const LAS half8*)(lds + PG8_SA(b, h) + aoff + m * 2048 + k * 1024); } while (0)
#define PG8_LDB(dst, b, h) do { _Pragma("unroll") for (int n = 0; n < 2; ++n) _Pragma("unroll") for (int k = 0; k < 2; ++k) dst[n][k] = *(const LAS half8*)(lds + PG8_SB(b, h) + boff + n * 2048 + k * 1024); } while (0)
#define PG8_MMA(ai, bj, At, Bt) do { __builtin_amdgcn_s_setprio(1); _Pragma("unroll") for (int m = 0; m < 4; ++m) _Pragma("unroll") for (int n = 0; n < 2; ++n) _Pragma("unroll") for (int k = 0; k < 2; ++k) \
        acc[ai][bj][m][n] = __builtin_amdgcn_mfma_f32_16x16x32_f16(Bt[n][k], At[m][k], acc[ai][bj][m][n], 0, 0, 0); __builtin_amdgcn_s_setprio(0); } while (0)
#define PG8_WAIT_V(n) asm volatile("s_waitcnt vmcnt(" #n ")" ::: "memory")
#define PG8_WAIT_L(n) asm volatile("s_waitcnt lgkmcnt(" #n ")" ::: "memory")
#define PG8_BAR __builtin_amdgcn_s_barrier()
#define PG8_SCHED __builtin_amdgcn_sched_barrier(0)
    Unit cur, nxt; int ui = 0;
    if (!S.next(0, cur)) return;
    f32x4 acc[2][2][4][2];
#pragma unroll
    for (int a = 0; a < 2; ++a)
#pragma unroll
        for (int b = 0; b < 2; ++b)
#pragma unroll
            for (int m = 0; m < 4; ++m)
#pragma unroll
                for (int n = 0; n < 2; ++n) acc[a][b][m][n] = (f32x4){0.f, 0.f, 0.f, 0.f};
    half8 At[4][2], B0[2][2], B1[2][2];
    const char* cA = (const char*)g.A + cur.aoff; const char* cB = (const char*)g.Bt + cur.boff;
    PG8_STAGE(PG8_SB(0, 0), cB, voffB); PG8_STAGE(PG8_SB(0, 1), cB + hstepB, voffB); PG8_STAGE(PG8_SA(0, 0), cA, voffA); PG8_STAGE(PG8_SA(0, 1), cA + hstepA, voffA);
    if (wr == 1) PG8_BAR;
    PG8_WAIT_V(2); PG8_BAR;
    PG8_STAGE(PG8_SB(1, 0), cB + kstep, voffB); PG8_STAGE(PG8_SA(1, 0), cA + kstep, voffA); PG8_STAGE(PG8_SB(1, 1), cB + hstepB + kstep, voffB);
    PG8_WAIT_V(6); PG8_BAR;
    for (;;) {
        const bool has_next = S.next(ui + 1, nxt);
        const char* nA = has_next ? (const char*)g.A + nxt.aoff : cA; const char* nB = has_next ? (const char*)g.Bt + nxt.boff : cB;
        for (int t = 0; t < nt; t += 2) {
            if constexpr (MIDK) { if (t == nt / 2) E.midk(acc, cur, wr); }
            const bool last = (t == nt - 2);
            const char* a1 = cA + (size_t)(t + 1) * kstep;
            const char* a2 = last ? nA : cA + (size_t)(t + 2) * kstep; const char* b2 = last ? nB : cB + (size_t)(t + 2) * kstep;
            const char* a3 = a2 + kstep; const char* b3 = b2 + kstep;
            PG8_LDB(B0, 0, 0); PG8_LDB(B1, 0, 1); PG8_SCHED; PG8_LDA(At, 0, 0); PG8_STAGE(PG8_SA(1, 1), a1 + hstepA, voffA);
            PG8_WAIT_V(8); PG8_WAIT_L(0); PG8_BAR; PG8_MMA(0, 0, At, B0); PG8_MMA(0, 1, At, B1); PG8_BAR; PG8_SCHED;
            PG8_LDA(At, 0, 1); PG8_STAGE(PG8_SB(0, 0), b2, voffB); PG8_STAGE(PG8_SB(0, 1), b2 + hstepB, voffB); PG8_STAGE(PG8_SA(0, 0), a2, voffA);
            PG8_WAIT_V(8); PG8_WAIT_L(0); PG8_BAR; PG8_MMA(1, 0, At, B0); PG8_MMA(1, 1, At, B1); PG8_BAR; PG8_SCHED;
            PG8_LDB(B0, 1, 0); PG8_LDB(B1, 1, 1); PG8_SCHED; PG8_LDA(At, 1, 0); PG8_STAGE(PG8_SA(0, 1), a2 + hstepA, voffA);
            PG8_WAIT_V(8); PG8_WAIT_L(0); PG8_BAR; PG8_MMA(0, 0, At, B0); PG8_MMA(0, 1, At, B1); PG8_BAR; PG8_SCHED;
            PG8_LDA(At, 1, 1); PG8_STAGE(PG8_SB(1, 0), b3, voffB); PG8_STAGE(PG8_SB(1, 1), b3 + hstepB, voffB); PG8_STAGE(PG8_SA(1, 0), a3, voffA);
            PG8_WAIT_V(8); PG8_WAIT_L(0); PG8_BAR; PG8_MMA(1, 0, At, B0); PG8_MMA(1, 1, At, B1); PG8_BAR; PG8_SCHED;
        }
        if (wr == 0) PG8_BAR;
        E(acc, cur, wr, wc, fr, fq);
        if (!has_next) break;
#pragma unroll
        for (int a = 0; a < 2; ++a)
#pragma unroll
            for (int b = 0; b < 2; ++b)
#pragma unroll
                for (int m = 0; m < 4; ++m)
#pragma unroll
                    for (int n = 0; n < 2; ++n) acc[a][b][m][n] = (f32x4){0.f, 0.f, 0.f, 0.f};
        cur = nxt; cA = nA; cB = nB; ++ui;
        if (wr == 1) PG8_BAR;
    }
    PG8_WAIT_V(0);
    PG8_BAR;
#undef PG8_SA
#undef PG8_SB
#undef PG8_STAGE
#undef PG8_LDA
#undef PG8_LDB
#undef PG8_MMA
#undef PG8_WAIT_V
#undef PG8_WAIT_L
#undef PG8_BAR
#undef PG8_SCHED
}
}

typedef f32x4 AccT[2][2][4][2];
#define EPI_IDS() int t_ = threadIdx.x; asm volatile("" : "+v"(t_)); const int fr = t_ & 15, fq = (t_ >> 4) & 3; (void)fr_; (void)fq_
#define EPI_ROW(ai, m) (u.pm * 256 + (ai) * 128 + wr * 64 + (m) * 16 + fr)
#define EPI_GET8(v, ai, bj, m, s) do { const f32x4 _a = acc[ai][bj][m][0], _b = acc[ai][bj][m][1]; v[0] = _a[0] * (s); v[1] = _a[1] * (s); v[2] = _a[2] * (s); v[3] = _a[3] * (s); v[4] = _b[0] * (s); v[5] = _b[1] * (s); v[6] = _b[2] * (s); v[7] = _b[3] * (s); } while (0)
__device__ __forceinline__ void rope4v(float* v, const f32x4& c01, const f32x4& c23) {
    const float cs[8] = {c01[0], c01[1], c01[2], c01[3], c23[0], c23[1], c23[2], c23[3]};
#pragma unroll
    for (int p = 0; p < 4; ++p) { const float x1 = v[2 * p], x2 = v[2 * p + 1]; v[2 * p] = x1 * cs[2 * p] - x2 * cs[2 * p + 1]; v[2 * p + 1] = x2 * cs[2 * p] + x1 * cs[2 * p + 1]; }
}
__device__ __forceinline__ float sum4(const f32x4& a) { return (a[0] + a[1]) + (a[2] + a[3]); }
__device__ __forceinline__ float relu_s(float x) { float r; asm("v_max_f32_e32 %0, 0, %1" : "=v"(r) : "v"(x)); return r; }
constexpr int LDS_RED = 131072;

struct EpiIn {
    const float* rs1; half_t* CQ; half_t* T1; half_t* KPE; float* GATE; float* SSQ; float* SSKV; half_t* QN; half_t* KVT; const float2* ropeM; const float2* ropeN;
    __device__ __forceinline__ void operator()(const AccT& acc, const pg8::Unit& u, int wr, int wc, int fr_, int fq_) const {
        EPI_IDS();
        const int pn = u.pn;
        const bool ropem = (pn == 1 && wc == 0), ropen = (pn >= 2 && pn != 4 && (wc & 1) == 0);
#pragma unroll
        for (int ai = 0; ai < 2; ++ai) {
            float rsv[4]; f32x4 rc[4][2];
#pragma unroll
            for (int m = 0; m < 4; ++m) { const int row = EPI_ROW(ai, m), pos = row & (SEQ - 1); rsv[m] = rs1[row];
                if (ropem) { const f32x4* p = (const f32x4*)(ropeM + (size_t)pos * 16 + fq * 4); rc[m][0] = p[0]; rc[m][1] = p[1]; }
                else if (ropen) { const f32x4* p = (const f32x4*)(ropeN + (size_t)pos * 8 + (fq & 1) * 4); rc[m][0] = p[0]; rc[m][1] = p[1]; } }
#pragma unroll
            for (int m = 0; m < 4; ++m) { const int row = EPI_ROW(ai, m), pos = row & (SEQ - 1), b = row >> 12; const float rs = rsv[m];
                float v[8];
                if (pn == 0) {
                    float ss = 0.f;
#pragma unroll
                    for (int bj = 0; bj < 2; ++bj) { EPI_GET8(v, ai, bj, m, rs);
#pragma unroll
                        for (int i = 0; i < 8; ++i) ss += v[i] * v[i];
                        *(u32x4*)(CQ + (size_t)row * 256 + bj * 128 + wc * 32 + fq * 8) = pk8(v); }
                    ss += __shfl_xor(ss, 16); ss += __shfl_xor(ss, 32);
                    if (fq == 0) SSQ[(size_t)row * 4 + wc] = ss;
                } else if (pn == 1) {
                    { EPI_GET8(v, ai, 0, m, rs); float ss = 0.f;
#pragma unroll
                        for (int i = 0; i < 8; ++i) ss += v[i] * v[i];
                        *(u32x4*)(T1 + (size_t)row * 256 + wc * 32 + fq * 8) = pk8(v);
                        ss += __shfl_xor(ss, 16); ss += __shfl_xor(ss, 32);
                        if (fq == 0) SSKV[(size_t)row * 4 + wc] = ss; }
                    { EPI_GET8(v, ai, 1, m, rs);
                        if (wc == 0) { rope4v(v, rc[m][0], rc[m][1]); const u32x4 w = pk8(v);
                            *(u32x4*)(T1 + (size_t)row * 256 + 128 + fq * 8) = w; *(u32x4*)(KPE + (size_t)b * SEQ * 32 + kpe_off(pos, fq * 8)) = w; }
                        else { if (wc == 1 && fq < 3) { float* gp = GATE + (size_t)row * 24 + fq * 8;
#pragma unroll
                                for (int i = 0; i < 8; ++i) v[i] = 1.f / (1.f + __expf(-v[i]));
                                *(f32x4*)gp = (f32x4){v[0], v[1], v[2], v[3]}; *(f32x4*)(gp + 4) = (f32x4){v[4], v[5], v[6], v[7]}; }
                            *(u32x4*)(T1 + (size_t)row * 256 + 128 + wc * 32 + fq * 8) = (u32x4){0u, 0u, 0u, 0u}; } }
                } else if (pn < 4) {
#pragma unroll
                    for (int bj = 0; bj < 2; ++bj) { EPI_GET8(v, ai, bj, m, rs); const int head = (pn - 2) * 4 + 2 * bj + (wc >> 1), off = 32 * (wc & 1) + 8 * fq;
                        if ((wc & 1) == 0 && fq < 2) rope4v(v, rc[m][0], rc[m][1]);
#pragma unroll
                        for (int i = 0; i < 8; ++i) v[i] *= QS_N;
                        *(u32x4*)(QN + (size_t)row * 512 + head * 64 + off) = pk8(v); }
                } else {
#pragma unroll
                    for (int bj = 0; bj < 2; ++bj) { EPI_GET8(v, ai, bj, m, rs); const int g = wc >> 1, d = 32 * (wc & 1) + 8 * fq;
                        if (pn > 4 && bj == 0 && (wc & 1) == 0 && fq < 2) rope4v(v, rc[m][0], rc[m][1]);
                        half_t* base = KVT + (size_t)((pn - 4) * 2 + bj) * KVT_STRIDE + (size_t)(b * 2 + g) * SEQ * 64;
                        *(u32x4*)(base + (pn == 4 ? (size_t)pos * 64 + d : (bj == 0 ? k_off(pos, d) : v_off(pos, d)))) = pk8(v); }
                }
            }
        }
    }
};

struct EpiUq {
    const float* SSQ; half_t* QM; const float2* ropeM;
    __device__ __forceinline__ void operator()(const AccT& acc, const pg8::Unit& u, int wr, int wc, int fr_, int fq_) const {
        EPI_IDS();
        const bool pe0 = ((8 * u.pn + wc) % 3 == 2), pe1 = ((8 * u.pn + 4 + wc) % 3 == 2);
#pragma unroll
        for (int ai = 0; ai < 2; ++ai) {
            f32x4 s4[4];
#pragma unroll
            for (int m = 0; m < 4; ++m) s4[m] = *(const f32x4*)(SSQ + (size_t)EPI_ROW(ai, m) * 4);
#pragma unroll
            for (int m = 0; m < 4; ++m) { const int row = EPI_ROW(ai, m);
                const float rs = __builtin_amdgcn_rsqf(sum4(s4[m]) * (1.f / 256.f) + NORM_EPS) * QS_M;
                float v[8];
#pragma unroll
                for (int bj = 0; bj < 2; ++bj) { EPI_GET8(v, ai, bj, m, rs); const int sidx = 8 * u.pn + 4 * bj + wc;
                    if (bj == 0 ? pe0 : pe1) { const f32x4* p = (const f32x4*)(ropeM + (size_t)(row & (SEQ - 1)) * 16 + fq * 4); rope4v(v, p[0], p[1]); }
                    *(u32x4*)(QM + (size_t)row * 768 + sidx * 32 + fq * 8) = pk8(v); }
            }
        }
    }
};
struct EpiUkv {
    const float* SSKV; half_t* KNM; half_t* VM;
    __device__ __forceinline__ void operator()(const AccT& acc, const pg8::Unit& u, int wr, int wc, int fr_, int fq_) const {
        EPI_IDS();
#pragma unroll
        for (int ai = 0; ai < 2; ++ai) {
            f32x4 s4[4];
#pragma unroll
            for (int m = 0; m < 4; ++m) s4[m] = *(const f32x4*)(SSKV + (size_t)EPI_ROW(ai, m) * 4);
#pragma unroll
            for (int m = 0; m < 4; ++m) { const int row = EPI_ROW(ai, m), pos = row & (SEQ - 1), b = row >> 12;
                const float rs = __builtin_amdgcn_rsqf(sum4(s4[m]) * (1.f / 128.f) + NORM_EPS);
                float v[8];
#pragma unroll
                for (int bj = 0; bj < 2; ++bj) { EPI_GET8(v, ai, bj, m, rs); const int c = (u.pn & 1) * 256 + bj * 128 + wc * 32 + fq * 8, head = c >> 6, d = c & 63;
                    half_t* base = ((u.pn < 2) ? KNM : VM) + (size_t)(b * 8 + head) * SEQ * 64;
                    *(u32x4*)(base + ((u.pn < 2) ? k_off(pos, d) : v_off(pos, d))) = pk8(v); }
            }
        }
    }
};
struct EpiC1 {
    float* HIDP;
    __device__ __forceinline__ void operator()(const AccT& acc, const pg8::Unit& u, int wr, int wc, int fr_, int fq_) const {
        EPI_IDS();
#pragma unroll
        for (int ai = 0; ai < 2; ++ai)
#pragma unroll
            for (int m = 0; m < 4; ++m) { const int rl = ai * 128 + wr * 64 + m * 16 + fr; float* p = HIDP + ((size_t)u.pm * 256 + rl) * 128 + wc * 32 + fq * 8;
                *(f32x4*)p = acc[ai][0][m][0]; *(f32x4*)(p + 4) = acc[ai][0][m][1]; }
    }
};
__device__ __forceinline__ float rstd8(const float* p, float inv_n) {
    const f32x4 a = *(const f32x4*)p, b = *(const f32x4*)(p + 4);
    return __builtin_amdgcn_rsqf((sum4(a) + sum4(b)) * inv_n + NORM_EPS);
}
struct EpiWo {
    const half_t* XH; half_t* H1; float* SS2; const float* SSM; const float* SSN; LAS float* red;
    __device__ __forceinline__ void midk(AccT& acc, const pg8::Unit& u, int wr) const {
        int t_ = threadIdx.x; asm volatile("" : "+v"(t_)); const int fr = t_ & 15;
#pragma unroll
        for (int ai = 0; ai < 2; ++ai) {
            f32x4 sm[4][2], sn[4][2];
#pragma unroll
            for (int m = 0; m < 4; ++m) { const int row = EPI_ROW(ai, m); sm[m][0] = *(const f32x4*)(SSM + (size_t)row * 8); sm[m][1] = *(const f32x4*)(SSM + (size_t)row * 8 + 4); sn[m][0] = *(const f32x4*)(SSN + (size_t)row * 8); sn[m][1] = *(const f32x4*)(SSN + (size_t)row * 8 + 4); }
#pragma unroll
            for (int m = 0; m < 4; ++m) {
                const float ratio = __builtin_amdgcn_rsqf((sum4(sm[m][0]) + sum4(sm[m][1])) * (1.f / 512.f) + NORM_EPS) / __builtin_amdgcn_rsqf((sum4(sn[m][0]) + sum4(sn[m][1])) * (1.f / 512.f) + NORM_EPS);
#pragma unroll
                for (int bj = 0; bj < 2; ++bj)
#pragma unroll
                    for (int n = 0; n < 2; ++n) acc[ai][bj][m][n] *= ratio; }
        }
    }
    __device__ __forceinline__ void operator()(const AccT& acc, const pg8::Unit& u, int wr, int wc, int fr_, int fq_) const {
        EPI_IDS();
#pragma unroll
        for (int ai = 0; ai < 2; ++ai) {
            f32x4 sn[4][2]; u32x4 xr[4][2];
#pragma unroll
            for (int m = 0; m < 4; ++m) { const int row = EPI_ROW(ai, m); sn[m][0] = *(const f32x4*)(SSN + (size_t)row * 8); sn[m][1] = *(const f32x4*)(SSN + (size_t)row * 8 + 4);
#pragma unroll
                for (int bj = 0; bj < 2; ++bj) xr[m][bj] = *(const u32x4*)(XH + (size_t)row * DM + u.pn * 256 + bj * 128 + wc * 32 + fq * 8); }
#pragma unroll
            for (int m = 0; m < 4; ++m) { const int row = EPI_ROW(ai, m);
                const float rn = __builtin_amdgcn_rsqf((sum4(sn[m][0]) + sum4(sn[m][1])) * (1.f / 512.f) + NORM_EPS);
                float v[8], x[8], ss = 0.f;
#pragma unroll
                for (int bj = 0; bj < 2; ++bj) { EPI_GET8(v, ai, bj, m, rn); unpk8(xr[m][bj], x);
#pragma unroll
                    for (int i = 0; i < 8; ++i) { v[i] += x[i]; ss += v[i] * v[i]; }
                    *(u32x4*)(H1 + (size_t)row * DM + u.pn * 256 + bj * 128 + wc * 32 + fq * 8) = pk8(v); }
                ss += __shfl_xor(ss, 16); ss += __shfl_xor(ss, 32);
                if (fq == 0) red[(ai * 128 + wr * 64 + m * 16 + fr) * 4 + wc] = ss;
            }
        }
        asm volatile("s_waitcnt lgkmcnt(0)" ::: "memory"); __builtin_amdgcn_s_barrier();
        if (t_ < 256) { const f32x4 r4 = *(const LAS f32x4*)(red + t_ * 4); SS2[(size_t)(u.pm * 256 + t_) * 4 + u.pn] = sum4(r4); }
    }
};
__device__ __forceinline__ float rstd16(const float* p, float inv_n) {
    const f32x4 a = *(const f32x4*)p, b = *(const f32x4*)(p + 4), c = *(const f32x4*)(p + 8), d = *(const f32x4*)(p + 12);
    return __builtin_amdgcn_rsqf(((sum4(a) + sum4(b)) + (sum4(c) + sum4(d))) * inv_n + NORM_EPS);
}
struct EpiUp {
    const float* SS2; half_t* A2;
    __device__ __forceinline__ void operator()(const AccT& acc, const pg8::Unit& u, int wr, int wc, int fr_, int fq_) const {
        EPI_IDS();
#pragma unroll
        for (int ai = 0; ai < 2; ++ai) {
            f32x4 s[4];
#pragma unroll
            for (int m = 0; m < 4; ++m) s[m] = *(const f32x4*)(SS2 + (size_t)EPI_ROW(ai, m) * 4);
#pragma unroll
            for (int m = 0; m < 4; ++m) { const int row = EPI_ROW(ai, m);
                const float rs = __builtin_amdgcn_rsqf(sum4(s[m]) * (1.f / 1024.f) + NORM_EPS);
                const float rs2 = rs * rs;
#pragma unroll
                for (int bj = 0; bj < 2; ++bj) { u32x4 w;
#pragma unroll
                    for (int n = 0; n < 2; ++n) { const f32x4 a = acc[ai][bj][m][n];
                        typedef float f32x2 __attribute__((ext_vector_type(2)));
                        f32x2 x0 = {relu_s(a[0]), relu_s(a[1])}, x1 = {relu_s(a[2]), relu_s(a[3])};
                        x0 = x0 * x0 * rs2; x1 = x1 * x1 * rs2;
                        w[2 * n] = pk_rne(x0[0], x0[1]); w[2 * n + 1] = pk_rne(x1[0], x1[1]); }
                    __builtin_nontemporal_store(w, (u32x4*)(A2 + (size_t)row * DFF + u.pn * 256 + bj * 128 + wc * 32 + fq * 8)); }
            }
        }
    }
};
struct EpiDn {
    const half_t* H1; half_t* H2; float* SS3; LAS float* red;
    __device__ __forceinline__ void operator()(const AccT& acc, const pg8::Unit& u, int wr, int wc, int fr_, int fq_) const {
        EPI_IDS();
#pragma unroll
        for (int ai = 0; ai < 2; ++ai) {
            u32x4 xr[4][2];
#pragma unroll
            for (int m = 0; m < 4; ++m)
#pragma unroll
                for (int bj = 0; bj < 2; ++bj) xr[m][bj] = *(const u32x4*)(H1 + (size_t)EPI_ROW(ai, m) * DM + u.pn * 256 + bj * 128 + wc * 32 + fq * 8);
#pragma unroll
            for (int m = 0; m < 4; ++m) { const int row = EPI_ROW(ai, m);
                float v[8], x[8], ss = 0.f;
#pragma unroll
                for (int bj = 0; bj < 2; ++bj) { EPI_GET8(v, ai, bj, m, 1.f); unpk8(xr[m][bj], x);
#pragma unroll
                    for (int i = 0; i < 8; ++i) { v[i] += x[i]; ss += v[i] * v[i]; }
                    *(u32x4*)(H2 + (size_t)row * DM + u.pn * 256 + bj * 128 + wc * 32 + fq * 8) = pk8(v); }
                ss += __shfl_xor(ss, 16); ss += __shfl_xor(ss, 32);
                if (fq == 0) red[(ai * 128 + wr * 64 + m * 16 + fr) * 4 + wc] = ss;
            }
        }
        asm volatile("s_waitcnt lgkmcnt(0)" ::: "memory"); __builtin_amdgcn_s_barrier();
        if (t_ < 256) { const f32x4 r4 = *(const LAS f32x4*)(red + t_ * 4); SS3[(size_t)(u.pm * 256 + t_) * 4 + u.pn] = sum4(r4); }
    }
};

constexpr int AT_KB = 0, AT_VB = 12288, AT_BUF = 20480;
constexpr int AT_SUB = 3;
constexpr int AT_STAGE = AT_SUB * AT_BUF;
constexpr int AT_IMP = 2 * AT_STAGE;
constexpr int AT_IMPW = 8 * 2 * 68 * 4;
constexpr int AT_SEL = AT_IMP + 8 * AT_IMPW;
constexpr int AT_QIDX = AT_SEL + 8 * 64;

struct TileRegs { u32x4 k, kp, v; };
__device__ __forceinline__ void tile_load(TileRegs& r, const half_t* Kt, const half_t* KPt, const half_t* Vt, int tid, int wid, int lane) {
    r.k = *(const u32x4*)(Kt + (size_t)(tid & 63) * 64 + wid * 8);
    if (KPt != nullptr && tid < 256) r.kp = *(const u32x4*)(KPt + (size_t)(tid & 63) * 32 + wid * 8);
    r.v = *(const u32x4*)(Vt + (size_t)(16 * (wid & 3) + (lane >> 2)) * 64 + (wid >> 2) * 32 + (lane & 3) * 8);
}
__device__ __forceinline__ void tile_store(const TileRegs& r, LAS unsigned char* buf, bool haspe, int tid, int wid, int lane) {
    *(LAS u32x4*)(buf + AT_KB + wid * 1024 + lane * 16) = r.k;
    if (haspe && tid < 256) *(LAS u32x4*)(buf + AT_KB + (8 + wid) * 1024 + lane * 16) = r.kp;
    *(LAS u32x4*)(buf + AT_VB + wid * 1024 + lane * 16) = r.v;
}
__device__ __forceinline__ float xhalf_max(float v) { const auto rr = __builtin_amdgcn_permlane32_swap(__float_as_uint(v), __float_as_uint(v), false, false); return fmaxf(__uint_as_float(rr[0]), __uint_as_float(rr[1])); }
__device__ __forceinline__ float xhalf_sum(float v) { const auto rr = __builtin_amdgcn_permlane32_swap(__float_as_uint(v), __float_as_uint(v), false, false); return __uint_as_float(rr[0]) + __uint_as_float(rr[1]); }
template <int NKS, int AB = 0>
__device__ __forceinline__ void tile_qk(const LAS unsigned char* kb, const half8 (&qf)[NKS], const f32x16& cinit, f32x16& p0, f32x16& p1) {
    if (AB & 1) { p0 = cinit; p1 = cinit; p0[0] += (float)qf[0][0]; p1[3] += (float)qf[1][1]; if (!(AB & 8)) { const half8 a = *(const LAS half8*)kb; p0[1] += (float)a[0]; } return; }
    half8 kf[2 * NKS];
#pragma unroll
    for (int ks = 0; ks < NKS; ++ks) { kf[2 * ks] = *(const LAS half8*)(kb + ks * 2048); kf[2 * ks + 1] = *(const LAS half8*)(kb + ks * 2048 + 512); }
    __builtin_amdgcn_sched_barrier(0);
    p0 = __builtin_amdgcn_mfma_f32_32x32x16_f16(kf[0], qf[0], cinit, 0, 0, 0);
    p1 = __builtin_amdgcn_mfma_f32_32x32x16_f16(kf[1], qf[0], cinit, 0, 0, 0);
#pragma unroll
    for (int ks = 1; ks < NKS; ++ks) {
        p0 = __builtin_amdgcn_mfma_f32_32x32x16_f16(kf[2 * ks], qf[ks], p0, 0, 0, 0);
        p1 = __builtin_amdgcn_mfma_f32_32x32x16_f16(kf[2 * ks + 1], qf[ks], p1, 0, 0, 0);
    }
}
__device__ __forceinline__ void tile_emask(f32x16& p0, f32x16& p1, int hiL, int loL) {
#pragma unroll
    for (int r = 0; r < 16; ++r) { const int c = (r & 3) + 8 * (r >> 2);
        if (!(c <= hiL && c >= loL)) p0[r] = -INFINITY;
        if (!(c + 32 <= hiL && c + 32 >= loL)) p1[r] = -INFINITY; }
}
__device__ __forceinline__ float tile_rowmax(const f32x16& p0, const f32x16& p1) {
    float a = fmaxf(fmaxf(p0[0], p0[1]), p0[2]), b = fmaxf(fmaxf(p1[0], p1[1]), p1[2]);
#pragma unroll
    for (int r = 3; r < 15; r += 2) { a = fmaxf(fmaxf(a, p0[r]), p0[r + 1]); b = fmaxf(fmaxf(b, p1[r]), p1[r + 1]); }
    a = fmaxf(fmaxf(a, p0[15]), fmaxf(b, p1[15]));
    return xhalf_max(a);
}
struct VFrags { v4i16 f[16]; };
__device__ __forceinline__ void vfrag_load(VFrags& V, const LAS unsigned char* vb) {
#pragma unroll
    for (int i = 0; i < 8; ++i) {
        V.f[2 * i]     = __builtin_amdgcn_ds_read_tr16_b64_v4i16((LAS v4i16*)(vb + (i >> 2) * 4096 + (i & 3) * 1024));
        V.f[2 * i + 1] = __builtin_amdgcn_ds_read_tr16_b64_v4i16((LAS v4i16*)(vb + (i >> 2) * 4096 + (i & 3) * 1024 + 512));
    }
}
__device__ __forceinline__ void tile_pv(const f32x16& p0, const f32x16& p1, const VFrags& V, f32x16 (&o)[2]) {
    u32x4 pw[4];
#pragma unroll
    for (int s = 0; s < 2; ++s) {
        pw[s]     = (u32x4){pk_rtz(p0[8 * s], p0[8 * s + 1]), pk_rtz(p0[8 * s + 2], p0[8 * s + 3]), pk_rtz(p0[8 * s + 4], p0[8 * s + 5]), pk_rtz(p0[8 * s + 6], p0[8 * s + 7])};
        pw[2 + s] = (u32x4){pk_rtz(p1[8 * s], p1[8 * s + 1]), pk_rtz(p1[8 * s + 2], p1[8 * s + 3]), pk_rtz(p1[8 * s + 4], p1[8 * s + 5]), pk_rtz(p1[8 * s + 6], p1[8 * s + 7])};
    }
    typedef short s8 __attribute__((ext_vector_type(8)));
#pragma unroll
    for (int db = 0; db < 2; ++db)
#pragma unroll
        for (int ks = 0; ks < 4; ++ks) {
            const v4i16 lo = V.f[2 * (db * 4 + ks)], hi = V.f[2 * (db * 4 + ks) + 1];
            const s8 t = {lo[0], lo[1], lo[2], lo[3], hi[0], hi[1], hi[2], hi[3]};
            o[db] = __builtin_amdgcn_mfma_f32_32x32x16_f16(__builtin_bit_cast(half8, t), __builtin_bit_cast(half8, pw[ks]), o[db], 0, 0, 0);
        }
}
constexpr float SM_THR = 6.f;
struct SmState { f32x16 negm; float mref, l; };
__device__ __forceinline__ void sm_reset(SmState& S) { S.negm = (f32x16){0.f}; S.mref = 0.f; S.l = 0.f; }
template <int AB = 0>
__device__ __forceinline__ void tile_softmax_pv(f32x16& p0, f32x16& p1, const LAS unsigned char* vb, f32x16 (&o)[2], SmState& S, bool first) {
    VFrags V; if (!(AB & 4)) vfrag_load(V, vb);
    if (!(AB & 2)) {
        const float tm = tile_rowmax(p0, p1);
        const bool need = first ? (tm > -INFINITY) : (tm > SM_THR);
        if (__any(need)) {
            const float delta = need ? tm : 0.f, alpha = __builtin_amdgcn_exp2f(-delta);
            S.mref += delta; S.l *= alpha;
#pragma unroll
            for (int r = 0; r < 16; ++r) { p0[r] -= delta; p1[r] -= delta; o[0][r] *= alpha; o[1][r] *= alpha; S.negm[r] = -S.mref; }
        }
        float s0 = 0.f, s1 = 0.f, s2 = 0.f, s3 = 0.f;
#pragma unroll
        for (int r = 0; r < 16; ++r) { p0[r] = __builtin_amdgcn_exp2f(p0[r]); p1[r] = __builtin_amdgcn_exp2f(p1[r]); }
#pragma unroll
        for (int r = 0; r < 16; r += 2) { s0 += p0[r]; s1 += p0[r + 1]; s2 += p1[r]; s3 += p1[r + 1]; }
        S.l += (s0 + s1) + (s2 + s3);
    }
    if (!(AB & 4)) tile_pv(p0, p1, V, o); else { _Pragma("unroll") for (int r = 0; r < 16; ++r) { o[0][r & 3] += p0[r]; o[1][r & 3] += p1[r]; } }
}

__device__ __forceinline__ void glds16(const void* gsrc, unsigned lds_dst) { unsigned keep;
    asm volatile("s_mov_b32 %0, m0\n\ts_mov_b32 m0, %2\n\ts_nop 0\n\tglobal_load_lds_dwordx4 %1, off\n\ts_mov_b32 m0, %0" : "=&s"(keep) : "v"(gsrc), "s"(lds_dst) : "memory"); }
__device__ __forceinline__ unsigned lds_addr(const LAS unsigned char* p) { return (unsigned)__builtin_amdgcn_readfirstlane((int)(unsigned)(size_t)p); }
__device__ __forceinline__ void tile_dma(const half_t* Kt, const half_t* KPt, const half_t* Vt, LAS unsigned char* sub, bool haspe, int wid, int lane) {
    const unsigned base = lds_addr(sub);
    glds16(Kt + wid * 512 + lane * 8, base + AT_KB + wid * 1024);
    if (haspe && wid < 4) glds16(KPt + wid * 512 + lane * 8, base + AT_KB + (8 + wid) * 1024);
    glds16(Vt + wid * 512 + lane * 8, base + AT_VB + wid * 1024);
}
#ifndef AT_STAGGER
#define AT_STAGGER 7
#endif
#ifndef AT_STAGGER_MASK
#define AT_STAGGER_MASK 4
#endif
#define AT_WAITBAR() do { asm volatile("s_waitcnt vmcnt(0) lgkmcnt(0)" ::: "memory"); __builtin_amdgcn_s_barrier(); } while (0)
#define KV_STREAM(NT, DMAT, COMPT) do { \
    const int nt__ = (NT), nst__ = (nt__ + AT_SUB - 1) / AT_SUB; \
    _Pragma("unroll") for (int j_ = 0; j_ < AT_SUB; ++j_) if (j_ < nt__) { DMAT(j_, lds + j_ * AT_BUF); } \
    AT_WAITBAR(); \
    for (int s_ = 0; s_ < nst__; ++s_) { \
        LAS unsigned char* cb_ = lds + (s_ & 1) * AT_STAGE; LAS unsigned char* nb_ = lds + ((s_ + 1) & 1) * AT_STAGE; \
        _Pragma("unroll") for (int j_ = 0; j_ < AT_SUB; ++j_) { const int tn_ = (s_ + 1) * AT_SUB + j_; if (tn_ < nt__) { DMAT(tn_, nb_ + j_ * AT_BUF); } } \
        _Pragma("unroll") for (int j_ = 0; j_ < AT_SUB; ++j_) { const int tc_ = s_ * AT_SUB + j_; if (tc_ < nt__) { COMPT(tc_, cb_ + j_ * AT_BUF); } } \
        AT_WAITBAR(); \
    } } while (0)

struct AttnPtrs {
    const half_t* QM; const half_t* KNM; const half_t* KPE; const half_t* VM;
    const half_t* QN; const half_t* KC; const half_t* VC; const half_t* KS; const half_t* VS; const half_t* KW; const half_t* VW; const float* GATE;
    half_t* Y; float* SSM; float* SSN;
};

template <int AB = 0>
__device__ __forceinline__ void mla_unit(const AttnPtrs& P, int bh, int qb, LAS unsigned char* lds, bool nostore = false) {
    int tid_ = threadIdx.x; asm volatile("" : "+v"(tid_));
    const int tid = tid_, lane = tid & 63, wid = __builtin_amdgcn_readfirstlane(tid >> 6), q = lane & 31, h = lane >> 5;
    const int b = bh >> 3, hd = bh & 7, q0 = qb * 256, qpos = q0 + wid * 32 + q;
    const size_t trow = (size_t)b * SEQ + qpos;
    half8 qf[6];
#pragma unroll
    for (int ks = 0; ks < 6; ++ks) qf[ks] = *(const half8*)(P.QM + trow * 768 + hd * 96 + ks * 16 + h * 8);
#pragma unroll
    for (int ks = 0; ks < 6; ++ks) asm volatile("" : "+v"(qf[ks]));
    const half_t* Kb = P.KNM + (size_t)bh * SEQ * 64; const half_t* Vb = P.VM + (size_t)bh * SEQ * 64; const half_t* KPb = P.KPE + (size_t)b * SEQ * 32;
    const int ntiles = 4 * qb + 4, my_last = 4 * qb + (wid >> 1);
    f32x16 o[2]; o[0] = (f32x16){0.f}; o[1] = (f32x16){0.f};
    SmState S; sm_reset(S);
    const int koff = h * 1024 + q * 16, voff = (4 * h + ((lane & 15) >> 2)) * 64 + ((lane >> 4) & 1) * 32 + (lane & 3) * 8;
#define MLA_LOAD(t, sub) if (!(AB & 16)) tile_dma(Kb + (size_t)(t) * 4096, KPb + (size_t)(t) * 2048, Vb + (size_t)(t) * 4096, sub, true, wid, lane)
#define MLA_COMP(t, buf) do { if ((t) <= my_last) { f32x16 p0, p1; \
        tile_qk<6, AB>((buf) + AT_KB + koff, qf, S.negm, p0, p1); \
        if ((t) == my_last) tile_emask(p0, p1, qpos - 64 * (t) - 4 * h, -1000); \
        tile_softmax_pv<AB>(p0, p1, (buf) + AT_VB + voff, o, S, (t) == 0); } } while (0)
    KV_STREAM(ntiles, MLA_LOAD, MLA_COMP);
#undef MLA_LOAD
#undef MLA_COMP
    const float l = xhalf_sum(S.l);
    const float inv = 1.f / l;
    if (nostore && !(l == 123.456f)) return;
    float ss = 0.f;
    half_t* yrow = P.Y + trow * DM + hd * 64;
#pragma unroll
    for (int db = 0; db < 2; ++db)
#pragma unroll
        for (int c = 0; c < 4; ++c) { const float a0 = o[db][4 * c] * inv, a1 = o[db][4 * c + 1] * inv, a2 = o[db][4 * c + 2] * inv, a3 = o[db][4 * c + 3] * inv;
            ss += (a0 * a0 + a1 * a1) + (a2 * a2 + a3 * a3);
            *(u32x2*)(yrow + db * 32 + 8 * c + 4 * h) = (u32x2){pk_rne(a0, a1), pk_rne(a2, a3)}; }
    ss = xhalf_sum(ss);
    if (h == 0) P.SSM[trow * 8 + hd] = ss;
}

template <int NKS_unused = 4>
__device__ __forceinline__ void nsa_stream_begin(TileRegs& tr, const half_t* Kt, const half_t* Vt, LAS unsigned char* lds, int tid, int wid, int lane) {
    tile_load(tr, Kt, nullptr, Vt, tid, wid, lane);
    tile_store(tr, lds, false, tid, wid, lane);
    __syncthreads();
}
__device__ __forceinline__ void nsa_unit(const AttnPtrs& P, int bg, int qb, LAS unsigned char* lds) {
    int tid_ = threadIdx.x; asm volatile("" : "+v"(tid_));
    const int tid = tid_, lane = tid & 63, wid = __builtin_amdgcn_readfirstlane(tid >> 6), j = lane & 31, h = lane >> 5;
    const int b = bg >> 1, g = bg & 1, q0 = qb * 64, cur = qb, qi = j >> 2, hh = j & 3, qrel = wid * 8 + qi, qpos = q0 + qrel, head = g * 4 + hh;
    const size_t trow = (size_t)b * SEQ + qpos;
    half8 qf[4];
#pragma unroll
    for (int ks = 0; ks < 4; ++ks) qf[ks] = *(const half8*)(P.QN + trow * 512 + head * 64 + ks * 16 + h * 8);
    float g0 = P.GATE[trow * 24 + head], g1 = P.GATE[trow * 24 + 8 + head], g2 = P.GATE[trow * 24 + 16 + head];
#pragma unroll
    for (int ks = 0; ks < 4; ++ks) asm volatile("" : "+v"(qf[ks]));
    asm volatile("" : "+v"(g0), "+v"(g1), "+v"(g2));
    const int koff = h * 1024 + j * 16, voff = (4 * h + ((lane & 15) >> 2)) * 64 + ((lane >> 4) & 1) * 32 + (lane & 3) * 8;
    f32x16 acc[2]; acc[0] = (f32x16){0.f}; acc[1] = (f32x16){0.f};
    f32x16 o[2];
    LAS float* impw = (LAS float*)(lds + AT_IMP + wid * AT_IMPW);
    unsigned long long selmask = (2ull << cur) - 1ull;

    const int ncmp = ((q0 + 32) >> 4) / 64 + 1;
    const half_t* Kc = P.KC + (size_t)bg * 256 * 64; const half_t* Vc = P.VC + (size_t)bg * 256 * 64;
    float m = -1e30f, l = 0.f; const f32x16 zero16 = (f32x16){0.f};
#define CMP_LOAD(t, sub) tile_dma(Kc + (size_t)(t) * 4096, nullptr, Vc + (size_t)(t) * 4096, sub, false, wid, lane)
#define CMP1_COMP(t, buf) do { f32x16 p0, p1; \
        tile_qk<4>((buf) + AT_KB + koff, qf, zero16, p0, p1); \
        tile_emask(p0, p1, ((qpos - 31 - 1024 * (t)) >> 4) - 4 * h, -1000); \
        const float tm = tile_rowmax(p0, p1), mn = fmaxf(m, tm), alpha = __builtin_amdgcn_exp2f(m - mn); \
        float sum = 0.f; \
        _Pragma("unroll") for (int r = 0; r < 16; ++r) sum += __builtin_amdgcn_exp2f(p0[r] - mn) + __builtin_amdgcn_exp2f(p1[r] - mn); \
        l = l * alpha + sum; m = mn; } while (0)
    KV_STREAM(ncmp, CMP_LOAD, CMP1_COMP);
    l = xhalf_sum(l);
    const float invl = (l > 0.f) ? 1.f / l : 0.f;
    o[0] = (f32x16){0.f}; o[1] = (f32x16){0.f};
#define CMP2_COMP(t, buf) do { f32x16 p0, p1; \
        VFrags V; vfrag_load(V, (buf) + AT_VB + voff); \
        tile_qk<4>((buf) + AT_KB + koff, qf, zero16, p0, p1); \
        tile_emask(p0, p1, ((qpos - 31 - 1024 * (t)) >> 4) - 4 * h, -1000); \
        _Pragma("unroll") for (int r = 0; r < 16; ++r) { p0[r] = __builtin_amdgcn_exp2f(p0[r] - m) * invl; p1[r] = __builtin_amdgcn_exp2f(p1[r] - m) * invl; } \
        if (cur >= 16) { \
            _Pragma("unroll") for (int kb = 0; kb < 2; ++kb) \
            _Pragma("unroll") for (int c = 0; c < 4; ++c) { \
                const f32x16& p = kb ? p1 : p0; \
                float C = (p[4 * c] + p[4 * c + 1]) + (p[4 * c + 2] + 0.5f * p[4 * c + 3]), D = 0.5f * p[4 * c + 3]; \
                C += __shfl_xor(C, 1); C += __shfl_xor(C, 2); D += __shfl_xor(D, 1); D += __shfl_xor(D, 2); \
                const int jb = 16 * (t) + 8 * kb + 2 * c + h; \
                if (hh == 0) { impw[qi * 136 + jb] = C; impw[qi * 136 + 68 + jb + 1] = D; } } } \
        tile_pv(p0, p1, V, o); } while (0)
    KV_STREAM(ncmp, CMP_LOAD, CMP2_COMP);
#undef CMP_LOAD
#undef CMP1_COMP
#undef CMP2_COMP
#pragma unroll
    for (int r = 0; r < 16; ++r) { acc[0][r] = g0 * o[0][r]; acc[1][r] = g0 * o[1][r]; }

    if (cur >= 16) {
        const int tq = lane >> 3, e = lane & 7;
        float v[8];
#pragma unroll
        for (int i = 0; i < 8; ++i) { const int jb = e + 8 * i; const float s = impw[tq * 136 + jb] + impw[tq * 136 + 68 + jb];
            v[i] = (jb >= 1 && jb <= cur - 2) ? s : -1.f; }
        unsigned selb = 0u;
        for (int it = 0; it < 13; ++it) {
            float lm = v[0];
#pragma unroll
            for (int i = 1; i < 8; ++i) lm = fmaxf(lm, v[i]);
            float gm = fmaxf(lm, __shfl_xor(lm, 1)); gm = fmaxf(gm, __shfl_xor(gm, 2)); gm = fmaxf(gm, __shfl_xor(gm, 4));
            int cj = 99;
#pragma unroll
            for (int i = 7; i >= 0; --i) cj = (v[i] == gm) ? (e + 8 * i) : cj;
            int gj = min(cj, __shfl_xor(cj, 1)); gj = min(gj, __shfl_xor(gj, 2)); gj = min(gj, __shfl_xor(gj, 4));
#pragma unroll
            for (int i = 0; i < 8; ++i) if (gj == e + 8 * i) { v[i] = -2.f; selb |= 1u << i; }
        }
        unsigned lo = 0u, hi = 0u;
#pragma unroll
        for (int i = 0; i < 4; ++i) { lo |= ((selb >> i) & 1u) << (e + 8 * i); hi |= ((selb >> (i + 4)) & 1u) << (e + 8 * i); }
        lo |= __shfl_xor(lo, 1); lo |= __shfl_xor(lo, 2); lo |= __shfl_xor(lo, 4);
        hi |= __shfl_xor(hi, 1); hi |= __shfl_xor(hi, 2); hi |= __shfl_xor(hi, 4);
        unsigned long long mk = ((unsigned long long)hi << 32) | lo;
        mk |= 1ull | (1ull << cur) | (1ull << (cur - 1));
        LAS unsigned long long* selw = (LAS unsigned long long*)(lds + AT_SEL + wid * 64);
        if (e == 0) selw[tq] = mk;
        selmask = selw[qi];
    }

    {
        const half_t* Ks = P.KS + (size_t)bg * SEQ * 64; const half_t* Vs = P.VS + (size_t)bg * SEQ * 64;
        SmState S; sm_reset(S); bool seen = false; o[0] = (f32x16){0.f}; o[1] = (f32x16){0.f};
#define SLC_LOAD(t, sub) tile_dma(Ks + (size_t)(t) * 4096, nullptr, Vs + (size_t)(t) * 4096, sub, false, wid, lane)
#define SLC_COMP(t, buf) do { const bool rowsel = (selmask >> (t)) & 1ull; \
            if (__any(rowsel)) { f32x16 p0, p1, ci; \
                _Pragma("unroll") for (int r = 0; r < 16; ++r) ci[r] = rowsel ? S.negm[r] : -INFINITY;     \
                tile_qk<4>((buf) + AT_KB + koff, qf, ci, p0, p1); \
                if ((t) == cur) tile_emask(p0, p1, qrel - 4 * h, -1000); \
                tile_softmax_pv(p0, p1, (buf) + AT_VB + voff, o, S, !seen); seen = seen || rowsel; } } while (0)
        KV_STREAM(cur + 1, SLC_LOAD, SLC_COMP);
#undef SLC_LOAD
#undef SLC_COMP
        const float sc = g1 / xhalf_sum(S.l);
#pragma unroll
        for (int r = 0; r < 16; ++r) { acc[0][r] += sc * o[0][r]; acc[1][r] += sc * o[1][r]; }
    }
    {
        const int t0 = (cur >= 8) ? cur - 8 : 0;
        const half_t* Kw = P.KW + ((size_t)bg * SEQ + (size_t)t0 * 64) * 64; const half_t* Vw = P.VW + ((size_t)bg * SEQ + (size_t)t0 * 64) * 64;
        SmState S; sm_reset(S); o[0] = (f32x16){0.f}; o[1] = (f32x16){0.f};
#define WIN_LOAD(i, sub) tile_dma(Kw + (size_t)(i) * 4096, nullptr, Vw + (size_t)(i) * 4096, sub, false, wid, lane)
#define WIN_COMP(i, buf) do { const int t = t0 + (i); f32x16 p0, p1; \
            tile_qk<4>((buf) + AT_KB + koff, qf, S.negm, p0, p1); \
            if (t == cur) tile_emask(p0, p1, qrel - 4 * h, -1000); \
            else if (t == cur - 8) tile_emask(p0, p1, 1000, qrel + 1 - 4 * h); \
            tile_softmax_pv(p0, p1, (buf) + AT_VB + voff, o, S, (i) == 0); } while (0)
        KV_STREAM(cur - t0 + 1, WIN_LOAD, WIN_COMP);
#undef WIN_LOAD
#undef WIN_COMP
        const float sc = g2 / xhalf_sum(S.l);
#pragma unroll
        for (int r = 0; r < 16; ++r) { acc[0][r] += sc * o[0][r]; acc[1][r] += sc * o[1][r]; }
    }
    float ss = 0.f;
    half_t* yrow = P.Y + trow * DM + 512 + head * 64;
#pragma unroll
    for (int db = 0; db < 2; ++db)
#pragma unroll
        for (int c = 0; c < 4; ++c) { const float a0 = acc[db][4 * c], a1 = acc[db][4 * c + 1], a2 = acc[db][4 * c + 2], a3 = acc[db][4 * c + 3];
            ss += (a0 * a0 + a1 * a1) + (a2 * a2 + a3 * a3);
            *(u32x2*)(yrow + db * 32 + 8 * c + 4 * h) = (u32x2){pk_rne(a0, a1), pk_rne(a2, a3)}; }
    ss = xhalf_sum(ss);
    if (h == 0) P.SSN[trow * 8 + head] = ss;
}

struct Args { const float* in[24]; float* out; unsigned char* ws; int ph_lo, ph_hi, li, pad; };

template <class SrcFn>
__device__ __forceinline__ void conv_wt(const float* W, int Ksrc, int Nsrc, const float* gain, const float* gain2, int ksplit, half_t* WT, int Ndst, int Kdst, SrcFn src, LAS float* scr, int gw, int ngw, int lane) {
    const int nblk = Ndst / 32, nitems = nblk * (Kdst / 64);
    for (int it = gw; it < nitems; it += ngw) {
        const int kb = it / nblk, nb = it % nblk, k0 = 64 * kb, n0 = 32 * nb;
        const int sc = src(n0 + (lane & 31));
#pragma unroll 8
        for (int i = 0; i < 32; ++i) { const int kk = 2 * i + (lane >> 5), k = k0 + kk;
            const int kc = k < Ksrc ? k : Ksrc - 1, scc = sc >= 0 ? sc : 0;
            float v = W[(size_t)kc * Nsrc + scc];
            if (gain) v *= (gain2 && kc >= ksplit) ? gain2[kc - ksplit] : gain[kc];
            scr[kk * 33 + (lane & 31)] = (sc >= 0 && k < Ksrc) ? v : 0.f; }
        asm volatile("s_waitcnt lgkmcnt(0)" ::: "memory");
        const int c = lane & 7;
#pragma unroll
        for (int jj = 0; jj < 4; ++jj) { const int n = (lane >> 3) + 8 * jj; const LAS float* s = scr + (8 * c) * 33 + n; float v[8];
#pragma unroll
            for (int e = 0; e < 8; ++e) v[e] = s[e * 33];
            *(u32x4*)(WT + (size_t)(n0 + n) * Kdst + k0 + 8 * c) = pk8(v); }
        asm volatile("s_waitcnt lgkmcnt(0)" ::: "memory");
    }
}
__device__ __forceinline__ int src_win(int n) {
    const int t = n >> 8, c = n & 255;
    if (t == 0) return c;
    if (t == 1) { if (c < 128) return 256 + c;
                  if (c < 160) { const int p = c - 128; return 384 + (p >> 1) + 16 * (p & 1); }
                  if (c < 184) return 1696 + (c - 160);
                  return -1; }
    if (t < 4) { const int hd = (t - 2) * 4 + (c >> 6), p = c & 63; const int d = (p < 16) ? (p >> 1) + 8 * (p & 1) : p; return 416 + hd * 64 + d; }
    const int br = (t - 4) * 2 + (c >> 7), g = (c >> 6) & 1, p = c & 63;
    const bool roped = (br == 2 || br == 4);
    const int d = (roped && p < 16) ? (p >> 1) + 8 * (p & 1) : p;
    return 928 + br * 128 + g * 64 + d;
}
__device__ __forceinline__ int src_wuq(int n) { const int hd = n / 96, p = n % 96; return (p < 64) ? hd * 96 + p : hd * 96 + 64 + ((p - 64) >> 1) + 16 * ((p - 64) & 1); }
__device__ __forceinline__ int src_wukv(int n) { return (n < 512) ? (n >> 6) * 128 + (n & 63) : ((n - 512) >> 6) * 128 + 64 + (n & 63); }

#define PH_IDS() int tid_ = threadIdx.x; asm volatile("" : "+v"(tid_)); const int tid = tid_, lane = tid & 63, wid = __builtin_amdgcn_readfirstlane(tid >> 6); \
    const int G = gridDim.x, gt = blockIdx.x * 512 + tid, ngt = G * 512, gw = blockIdx.x * 8 + wid, ngw = G * 8; (void)lane; (void)gt; (void)ngt; (void)gw; (void)ngw; (void)G
#define WSP(T, off) ((T*)(ws + (off)))


__global__ void __launch_bounds__(512, 2) hymba_fwd(Args args) {
    extern __shared__ __attribute__((aligned(16))) unsigned char lds_raw[];
    LAS unsigned char* lds = (LAS unsigned char*)lds_raw;
    unsigned char* ws = args.ws;
    volatile LAS unsigned* MISC = (volatile LAS unsigned*)(lds + LDS_MISC);
    if (threadIdx.x < 16) MISC[threadIdx.x] = 0u;
    __syncthreads();
    XcdBarrier bar = xcd_barrier_post(WSP(unsigned, WS_CTL) + CW_BAR + args.li * XCD_BAR_WORDS, MISC + 8);
#if defined(DBG_STAMP)
#define STAMP_FIRST() STAMP(0)
#define STAMP(k) do { if (blockIdx.x == 0 && threadIdx.x == 0) ((unsigned long long*)(WSP(unsigned, WS_CTL) + 160))[k] = __builtin_amdgcn_s_memrealtime(); } while (0)
#else
#define STAMP_FIRST() do { } while (0)
#define STAMP(k) do { } while (0)
#endif
    const int lo = args.ph_lo, hi = args.ph_hi;
    STAMP_FIRST();
#define IN(k) (lo <= (k) && (k) < hi)
#define REP_BEGIN(k) for (int rep_ = 0; rep_ < ((k) == REPEAT_PHASE ? 2 : 1); ++rep_) {
#define REP_END(k) if ((k) == REPEAT_PHASE && rep_ == 0) xcd_barrier(bar); }
#define SEAM(k) do { if (IN(k) && IN((k) + 1 + ((k) == 4))) xcd_barrier(bar); STAMP((k) + 1); } while (0)

    if (IN(0)) { REP_BEGIN(0)
        PH_IDS();
        LAS float* scr = (LAS float*)(lds + wid * 8448);
        const int BIG = 1 << 30;
        for (int step_ = 0; step_ < 2; ++step_) {
        if (((step_ ^ wid) & 1) == 0) {
        conv_wt(args.in[2], 1024, IN_COLS, args.in[1], nullptr, BIG, WSP(half_t, WS_WIN), NIN, 1024, [](int n) { return src_win(n); }, scr, gw, ngw, lane);
        conv_wt(args.in[4], 256, 768, args.in[3], nullptr, BIG, WSP(half_t, WS_WUQ), 768, 256, [](int n) { return src_wuq(n); }, scr, gw, ngw, lane);
        conv_wt(args.in[6], 128, 1024, args.in[5], nullptr, BIG, WSP(half_t, WS_WUKV), 1024, 256, [](int n) { return src_wukv(n); }, scr, gw, ngw, lane);
        conv_wt(args.in[8], 2048, 128, nullptr, nullptr, BIG, WSP(half_t, WS_WC1), 256, 2048, [](int n) { return n < 128 ? n : -1; }, scr, gw, ngw, lane);
        conv_wt(args.in[13], 2048, 128, nullptr, nullptr, BIG, WSP(half_t, WS_WC1) + 256 * 2048, 256, 2048, [](int n) { return n < 128 ? n : -1; }, scr, gw, ngw, lane);
        conv_wt(args.in[19], 1024, 1024, args.in[17], args.in[18], 512, WSP(half_t, WS_WO), 1024, 1024, [](int n) { return n; }, scr, gw, ngw, lane);
        conv_wt(args.in[21], 1024, 4096, args.in[20], nullptr, BIG, WSP(half_t, WS_WUP), 4096, 1024, [](int n) { return n; }, scr, gw, ngw, lane);
        conv_wt(args.in[22], 4096, 1024, nullptr, nullptr, BIG, WSP(half_t, WS_WDN), 1024, 4096, [](int n) { return n; }, scr, gw, ngw, lane);
        { float2* ROPEM = WSP(float2, WS_ROPEM); float2* ROPEN = WSP(float2, WS_ROPEN);
          for (int it = gt; it < SEQ * 16; it += ngt) { const int pos = it >> 4, i = it & 15; const float inv = expf(-logf(500000.f) * (float)(2 * i) / 32.f), a = (float)pos * inv; ROPEM[it] = make_float2(cosf(a), sinf(a)); }
          for (int it = gt; it < SEQ * 8; it += ngt) { const int pos = it >> 3, i = it & 7; const float inv = expf(-logf(500000.f) * (float)(2 * i) / 16.f), a = (float)pos * inv; ROPEN[it] = make_float2(cosf(a), sinf(a)); } }
        if (gw < 256) { const int kv = gw >> 7, jj = gw & 127; const float* pe = args.in[kv ? 12 : 7]; const float* w1 = args.in[kv ? 13 : 8]; const float* b1 = args.in[kv ? 14 : 9];
            float s = 0.f; for (int k = lane; k < 2048; k += 64) s += pe[k] * w1[(size_t)k * 128 + jj];
            s = wave_sum(s); if (lane == 0) WSP(float, WS_B1P)[gw] = b1[jj] + s; }
        } else
        { const float* x = args.in[0]; half_t* XH = WSP(half_t, WS_XH); float* RS1 = WSP(float, WS_RS1);
          for (int r0 = gw * 4; r0 < MROWS; r0 += ngw * 4) {
            f32x4 v[4][4]; float s[4];
#pragma unroll
            for (int rr = 0; rr < 4; ++rr) { const f32x4* xr = (const f32x4*)(x + (size_t)(r0 + rr) * DM) + lane;
#pragma unroll
                for (int jv = 0; jv < 4; ++jv) v[rr][jv] = xr[64 * jv]; }
#pragma unroll
            for (int rr = 0; rr < 4; ++rr) { float t = 0.f;
#pragma unroll
                for (int jv = 0; jv < 4; ++jv) t += (v[rr][jv][0] * v[rr][jv][0] + v[rr][jv][1] * v[rr][jv][1]) + (v[rr][jv][2] * v[rr][jv][2] + v[rr][jv][3] * v[rr][jv][3]);
                s[rr] = t; }
#pragma unroll
            for (int o = 1; o < 64; o <<= 1) {
#pragma unroll
                for (int rr = 0; rr < 4; ++rr) s[rr] += __shfl_xor(s[rr], o); }
#pragma unroll
            for (int rr = 0; rr < 4; ++rr) { u32x2* o8 = (u32x2*)(XH + (size_t)(r0 + rr) * DM) + lane;
#pragma unroll
                for (int jv = 0; jv < 4; ++jv) o8[64 * jv] = (u32x2){pk_rne(v[rr][jv][0], v[rr][jv][1]), pk_rne(v[rr][jv][2], v[rr][jv][3])};
                if (lane == 0) RS1[r0 + rr] = __builtin_amdgcn_rsqf(s[rr] * (1.f / DM) + NORM_EPS); }
          } }
        }
    REP_END(0) }
    SEAM(0);
    if (IN(1)) { REP_BEGIN(1)
        pg8::Gemm g{WSP(half_t, WS_XH), WSP(half_t, WS_WIN), 1024, 1024, 1024}; pg8::StaticOrder S; S.init(MROWS, NIN, gridDim.x, (int)blockIdx.x, 1024, 1024);
        EpiIn E{WSP(float, WS_RS1), WSP(half_t, WS_CQ), WSP(half_t, WS_T1), WSP(half_t, WS_KPE), WSP(float, WS_GATE), WSP(float, WS_SSQ), WSP(float, WS_SSKV), WSP(half_t, WS_QN), WSP(half_t, WS_KVT), WSP(float2, WS_ROPEM), WSP(float2, WS_ROPEN)};
        pg8::gemm_phase(lds, g, S, E);
    REP_END(1) }
    SEAM(1);
    if (IN(2)) { REP_BEGIN(2)
        { pg8::Gemm g{WSP(half_t, WS_CQ), WSP(half_t, WS_WUQ), 256, 256, 256}; pg8::StaticOrder S; S.init(MROWS, 768, gridDim.x, (int)blockIdx.x, 256, 256); EpiUq E{WSP(float, WS_SSQ), WSP(half_t, WS_QM), WSP(float2, WS_ROPEM)}; pg8::gemm_phase(lds, g, S, E); }
        { pg8::Gemm g{WSP(half_t, WS_T1), WSP(half_t, WS_WUKV), 256, 256, 256}; pg8::StaticOrder S; S.init(MROWS, 1024, gridDim.x, (int)blockIdx.x, 256, 256); EpiUkv E{WSP(float, WS_SSKV), WSP(half_t, WS_KNM), WSP(half_t, WS_VM)}; pg8::gemm_phase(lds, g, S, E); }
        { pg8::Gemm g{WSP(half_t, WS_KVT), WSP(half_t, WS_WC1), 512, 1024, 2048}; pg8::Cmp1Order S{(int)gridDim.x, (int)blockIdx.x}; EpiC1 E{WSP(float, WS_HIDP)}; pg8::gemm_phase(lds, g, S, E); }
    REP_END(2) }
    SEAM(2);
    if (IN(3)) { REP_BEGIN(3)
        PH_IDS();
        const float* B1P = WSP(float, WS_B1P); const float* HIDP = WSP(float, WS_HIDP); const float2* ROPEN = WSP(float2, WS_ROPEN);
        LAS float* w2s = (LAS float*)lds;
        LAS float* hl = (LAS float*)(lds + 65536 + wid * 4096);
        for (int i = tid; i < 2 * 128 * 64; i += 512) { const int kv = i >> 13, k = (i >> 6) & 127, p = i & 63; const int dsrc = (kv == 0 && p < 16) ? (p >> 1) + 8 * (p & 1) : p;
            w2s[i] = args.in[kv ? 15 : 10][k * 64 + dsrc]; }
        __syncthreads();
        for (int it = gw; it < 2 * 32 * 32; it += ngw) {
            const int kv = it >> 10, slab = (it >> 5) & 31, n0 = (it & 31) * 8;
            const float* b2 = args.in[kv ? 16 : 11];
            float hv[8][2][4];
#pragma unroll
            for (int rr = 0; rr < 8; ++rr)
#pragma unroll
                for (int c = 0; c < 2; ++c)
#pragma unroll
                    for (int ch = 0; ch < 4; ++ch) hv[rr][c][ch] = HIDP[((size_t)((kv * 32 + slab) * 4 + ch) * 256 + n0 + rr) * 128 + lane + 64 * c];
#pragma unroll
            for (int rr = 0; rr < 8; ++rr)
#pragma unroll
                for (int c = 0; c < 2; ++c) { const int col = lane + 64 * c; const float s = B1P[kv * 128 + col] + ((hv[rr][c][0] + hv[rr][c][1]) + (hv[rr][c][2] + hv[rr][c][3]));
                    const float z = 0.7978845608028654f * (s + 0.044715f * s * s * s), th = 1.f - 2.f / (1.f + __expf(2.f * z));
                    hl[rr * 128 + col] = 0.5f * s * (1.f + th); }
            asm volatile("s_waitcnt lgkmcnt(0)" ::: "memory");
            const int dsrc = (kv == 0 && lane < 16) ? (lane >> 1) + 8 * (lane & 1) : lane;
            float a[8];
#pragma unroll
            for (int rr = 0; rr < 8; ++rr) a[rr] = b2[dsrc];
            const LAS float* wk = w2s + kv * 8192 + lane;
#pragma unroll 4
            for (int k = 0; k < 128; k += 4) {
                const float w0 = wk[k * 64], w1 = wk[(k + 1) * 64], w2v = wk[(k + 2) * 64], w3 = wk[(k + 3) * 64];
#pragma unroll
                for (int rr = 0; rr < 8; ++rr) { const f32x4 hh = *(const LAS f32x4*)(hl + rr * 128 + k); a[rr] += (hh[0] * w0 + hh[1] * w1) + (hh[2] * w2v + hh[3] * w3); }
            }
            half_t* dst = (kv ? WSP(half_t, WS_VC) : WSP(half_t, WS_KC)) + (size_t)slab * 256 * 64;
#pragma unroll
            for (int rr = 0; rr < 8; ++rr) { const int n = n0 + rr; float v = a[rr];
                if (kv == 0) { const float pp = __shfl_xor(v, 1);
                    if (lane < 16) { const int e1 = 16 * n + 31; const float2 cs = ROPEN[(size_t)(e1 > 4095 ? 4095 : e1) * 8 + (lane >> 1)];
                        v = (lane & 1) ? (v * cs.x + pp * cs.y) : (v * cs.x - pp * cs.y); } }
                if (n >= 255) v = 0.f;
                dst[kv ? v_off(n, lane) : k_off(n, lane)] = (half_t)v; }
            asm volatile("s_waitcnt lgkmcnt(0)" ::: "memory");
        }
    REP_END(3) }
    SEAM(3);
    if (IN(4)) {
        half_t* KVT = WSP(half_t, WS_KVT);
        const AttnPtrs P{WSP(half_t, WS_QM), WSP(half_t, WS_KNM), WSP(half_t, WS_KPE), WSP(half_t, WS_VM), WSP(half_t, WS_QN), WSP(half_t, WS_KC), WSP(half_t, WS_VC),
                         KVT + 2 * KVT_STRIDE, KVT + 3 * KVT_STRIDE, KVT + 4 * KVT_STRIDE, KVT + 5 * KVT_STRIDE, WSP(float, WS_GATE), WSP(half_t, WS_Y), WSP(float, WS_SSM), WSP(float, WS_SSN)};
        volatile LAS int* qw = (volatile LAS int*)(lds + AT_QIDX);
        REP_BEGIN(4)
        unsigned* qhead = WSP(unsigned, WS_CTL) + CW_QHEAD + 64 * rep_;
        for (;;) {
            if (threadIdx.x == 0) *qw = (int)__hip_atomic_fetch_add(qhead, 1u, __ATOMIC_RELAXED, __HIP_MEMORY_SCOPE_AGENT);
            __syncthreads();
            const int qi = __builtin_amdgcn_readfirstlane(*qw);
            __syncthreads();
            if (qi >= 4096) break;
            const int L = qi >> 8, r = qi & 255;
#ifdef REP_FILTER
            if (rep_ == 1 && ((REP_FILTER == 1) != (r < 128))) continue;
#endif
            if (r < 128) { if (rep_ == 1) mla_unit<ABL>(P, r, 15 - L, lds, true); else mla_unit<0>(P, r, 15 - L, lds); }
            else { const int r2 = r - 128; nsa_unit(P, r2 & 31, 63 - 4 * L - (r2 >> 5), lds); }
        }
        REP_END(4)
    }
    SEAM(4);
    if (IN(6)) { REP_BEGIN(6) pg8::Gemm g{WSP(half_t, WS_Y), WSP(half_t, WS_WO), 1024, 1024, 1024}; pg8::StaticOrder S; S.init(MROWS, 1024, gridDim.x, (int)blockIdx.x, 1024, 1024); EpiWo E{WSP(half_t, WS_XH), WSP(half_t, WS_H1), WSP(float, WS_SS2), WSP(float, WS_SSM), WSP(float, WS_SSN), (LAS float*)(lds + LDS_RED)}; pg8::gemm_phase<EpiWo, pg8::StaticOrder, true>(lds, g, S, E); REP_END(6) }
    SEAM(6);
    if (IN(7)) { REP_BEGIN(7) pg8::Gemm g{WSP(half_t, WS_H1), WSP(half_t, WS_WUP), 1024, 1024, 1024}; pg8::StaticOrder S; S.init(MROWS, DFF, gridDim.x, (int)blockIdx.x, 1024, 1024); EpiUp E{WSP(float, WS_SS2), WSP(half_t, WS_A2)}; pg8::gemm_phase(lds, g, S, E); REP_END(7) }
    SEAM(7);
    if (IN(8)) { REP_BEGIN(8) pg8::Gemm g{WSP(half_t, WS_A2), WSP(half_t, WS_WDN), 4096, 4096, 4096}; pg8::StaticOrder S; S.init(MROWS, 1024, gridDim.x, (int)blockIdx.x, 4096, 4096); EpiDn E{WSP(half_t, WS_H1), WSP(half_t, WS_H2), WSP(float, WS_SS3), (LAS float*)(lds + LDS_RED)}; pg8::gemm_phase(lds, g, S, E); REP_END(8) }
    SEAM(8);
    if (IN(9)) { REP_BEGIN(9)
        PH_IDS();
        const float* gf = args.in[23]; const float* SS3 = WSP(float, WS_SS3); const half_t* H2 = WSP(half_t, WS_H2);
        const f32x4 ga0 = *(const f32x4*)(gf + lane * 8), gb0 = *(const f32x4*)(gf + lane * 8 + 4), ga1 = *(const f32x4*)(gf + 512 + lane * 8), gb1 = *(const f32x4*)(gf + 512 + lane * 8 + 4);
        for (int r0 = gw * 4; r0 < MROWS; r0 += ngw * 4) {
            u32x4 hv[4][2]; float rs[4];
#pragma unroll
            for (int rr = 0; rr < 4; ++rr) { const u32x4* hr = (const u32x4*)(H2 + (size_t)(r0 + rr) * DM) + lane; hv[rr][0] = hr[0]; hv[rr][1] = hr[64]; rs[rr] = __builtin_amdgcn_rsqf(sum4(*(const f32x4*)(SS3 + (size_t)(r0 + rr) * 4)) * (1.f / 1024.f) + NORM_EPS); }
#pragma unroll
            for (int rr = 0; rr < 4; ++rr) { f32x4* orow = (f32x4*)(args.out + (size_t)(r0 + rr) * DM); float v[8];
                unpk8(hv[rr][0], v);
                orow[lane * 2] = (f32x4){v[0] * rs[rr] * ga0[0], v[1] * rs[rr] * ga0[1], v[2] * rs[rr] * ga0[2], v[3] * rs[rr] * ga0[3]};
                orow[lane * 2 + 1] = (f32x4){v[4] * rs[rr] * gb0[0], v[5] * rs[rr] * gb0[1], v[6] * rs[rr] * gb0[2], v[7] * rs[rr] * gb0[3]};
                unpk8(hv[rr][1], v);
                orow[128 + lane * 2] = (f32x4){v[0] * rs[rr] * ga1[0], v[1] * rs[rr] * ga1[1], v[2] * rs[rr] * ga1[2], v[3] * rs[rr] * ga1[3]};
                orow[128 + lane * 2 + 1] = (f32x4){v[4] * rs[rr] * gb1[0], v[5] * rs[rr] * gb1[1], v[6] * rs[rr] * gb1[2], v[7] * rs[rr] * gb1[3]}; }
        }
    REP_END(9) }
    STAMP(10);
#undef IN
#undef SEAM
}

#if DBG_CHECK
constexpr int CW_DBG = 96;
__device__ __forceinline__ void dbg_flag(unsigned* ctl, int id, float got, float ref) {
    const float d = fabsf(got - ref);
    if (!(d <= 0.03f + 0.03f * fabsf(ref))) atomicOr(ctl + CW_DBG, 1u << id);
}
__device__ __forceinline__ float h2f(const half_t* p) { return (float)(*p); }
__device__ float dbg_rope_cs(int pos, int i, int dim, bool want_sin) { const float inv = expf(-logf(500000.f) * (float)(2 * i) / (float)dim), a = (float)pos * inv; return want_sin ? sinf(a) : cosf(a); }
__device__ float dbg_u(const Args& args, int row, int co, int lane) {
    const float* x = args.in[0] + (size_t)row * DM; const float* g = args.in[1]; const float* w = args.in[2];
    float ss = 0.f, acc = 0.f;
    for (int k = lane; k < DM; k += 64) { const float xv = x[k]; ss += xv * xv; acc += xv * g[k] * w[(size_t)k * IN_COLS + co]; }
    ss = wave_sum(ss); acc = wave_sum(acc);
    return acc * (1.f / sqrtf(ss / DM + NORM_EPS));
}
__device__ const int dbgt_0_dbg_rows[4] = {0, 4096 + 6, 30000, 65535};
__device__ const int dbgt_1_cs[3] = {0, 77, 255};
__device__ const int dbgt_2_cs[2] = {5, 127};
__device__ const int dbgt_3_ps[4] = {0, 1, 14, 31};
__device__ const int dbgt_4_is[3] = {0, 13, 23};
__device__ const int dbgt_5_hs[4] = {0, 3, 5, 7};
__device__ const int dbgt_6_ps[4] = {0, 1, 14, 40};
__device__ const int dbgt_7_brs[7] = {0, 1, 2, 2, 3, 4, 5};
__device__ const int dbgt_8_gs[7] = {0, 1, 0, 1, 0, 1, 1};
__device__ const int dbgt_9_ps[7] = {3, 20, 1, 50, 9, 14, 63};
__device__ const int dbgt_10_hs[4] = {0, 2, 5, 7};
__device__ const int dbgt_11_ps[4] = {3, 64, 77, 95};
__device__ const int dbgt_12_slabs[3] = {0, 17, 31};
__device__ const int dbgt_13_ns[3] = {0, 100, 254};
__device__ const int dbgt_14_ps[4] = {0, 1, 15, 40};
__device__ const int dbgt_15_bs[5] = {0, 0, 5, 15, 9};
__device__ const int dbgt_16_hs[5] = {0, 3, 7, 2, 5};
__device__ const int dbgt_17_qs[5] = {0, 100, 2047, 4095, 1234};
__device__ const int dbgt_18_bs[6] = {0, 3, 7, 15, 11, 2};
__device__ const int dbgt_19_gs[6] = {0, 1, 0, 1, 1, 0};
__device__ const int dbgt_20_hhs[6] = {0, 2, 3, 1, 0, 2};
__device__ const int dbgt_21_qs[6] = {5, 700, 1030, 4095, 2500, 3071};
__device__ const int dbgt_22_dd[3] = {0, 33, 63};
__device__ const int dbgt_23_c4[4] = {0, 1300, 2777, 4095};
__device__ const int dbgt_24_cols[4] = {0, 300, 777, 1023};
__device__ const int dbgt_25_cc[6] = {768, 896, 800, 776, 775, 1023};
__global__ void __launch_bounds__(512) dbg_checks_a(Args args) {
    extern __shared__ __attribute__((aligned(16))) unsigned char lds_raw[]; LAS unsigned char* lds = (LAS unsigned char*)lds_raw;
    unsigned char* ws = args.ws; unsigned* ctl = WSP(unsigned, WS_CTL);
    const int lane = threadIdx.x & 63, wid = threadIdx.x >> 6;
    const int* rows = dbgt_0_dbg_rows;
    const half_t* XH = WSP(half_t, WS_XH);
    if (blockIdx.x == 0) {
        if (wid == 0) for (int s = 0; s < 4; ++s) { const int r = rows[s]; const float* x = args.in[0] + (size_t)r * DM; float ss = 0.f; for (int k = lane; k < DM; k += 64) ss += x[k] * x[k]; ss = wave_sum(ss);
            if (lane == 0) { dbg_flag(ctl, 1, WSP(float, WS_RS1)[r], 1.f / sqrtf(ss / DM + NORM_EPS)); dbg_flag(ctl, 1, h2f(XH + (size_t)r * DM + 517), x[517]); } }
        if (wid == 1) for (int s = 0; s < 4; ++s) { const int r = rows[s], pos = r & 4095, b = r >> 12;
            { const int* cs = dbgt_1_cs; for (int i = 0; i < 3; ++i) { const float u = dbg_u(args, r, cs[i], lane); if (lane == 0) dbg_flag(ctl, 2, h2f(WSP(half_t, WS_CQ) + (size_t)r * 256 + cs[i]), u); } }
            { const int* cs = dbgt_2_cs; for (int i = 0; i < 2; ++i) { const float u = dbg_u(args, r, 256 + cs[i], lane); if (lane == 0) dbg_flag(ctl, 3, h2f(WSP(half_t, WS_T1) + (size_t)r * 256 + cs[i]), u); } }
            { const int* ps = dbgt_3_ps; for (int i = 0; i < 4; ++i) { const int p = ps[i], pr = p >> 1; const float x1 = dbg_u(args, r, 384 + pr, lane), x2 = dbg_u(args, r, 384 + pr + 16, lane);
                const float c = dbg_rope_cs(pos, pr, 32, false), sn = dbg_rope_cs(pos, pr, 32, true); const float ref = (p & 1) ? (x2 * c + x1 * sn) : (x1 * c - x2 * sn);
                if (lane == 0) dbg_flag(ctl, 4, h2f(WSP(half_t, WS_KPE) + (size_t)b * SEQ * 32 + kpe_off(pos, p)), ref); } }
            { const int* is = dbgt_4_is; for (int i = 0; i < 3; ++i) { const float u = dbg_u(args, r, 1696 + is[i], lane); if (lane == 0) dbg_flag(ctl, 5, WSP(float, WS_GATE)[(size_t)r * 24 + is[i]], 1.f / (1.f + expf(-u))); } }
            { const int* hs = dbgt_5_hs; const int* ps = dbgt_6_ps; for (int i = 0; i < 4; ++i) { const int hd = hs[i], p = ps[i]; float ref;
                if (p < 16) { const int pr = p >> 1; const float x1 = dbg_u(args, r, 416 + hd * 64 + pr, lane), x2 = dbg_u(args, r, 416 + hd * 64 + pr + 8, lane);
                    const float c = dbg_rope_cs(pos, pr, 16, false), sn = dbg_rope_cs(pos, pr, 16, true); ref = (p & 1) ? (x2 * c + x1 * sn) : (x1 * c - x2 * sn); }
                else ref = dbg_u(args, r, 416 + hd * 64 + p, lane);
                if (lane == 0) dbg_flag(ctl, 6, h2f(WSP(half_t, WS_QN) + (size_t)r * 512 + hd * 64 + p), ref * QS_N); } }
            { const int* brs = dbgt_7_brs; const int* gs = dbgt_8_gs; const int* ps = dbgt_9_ps;
              for (int i = 0; i < 7; ++i) { const int br = brs[i], g = gs[i], p = ps[i]; const int base = 928 + br * 128 + g * 64; float ref;
                if ((br == 2 || br == 4) && p < 16) { const int pr = p >> 1; const float x1 = dbg_u(args, r, base + pr, lane), x2 = dbg_u(args, r, base + pr + 8, lane);
                    const float c = dbg_rope_cs(pos, pr, 16, false), sn = dbg_rope_cs(pos, pr, 16, true); ref = (p & 1) ? (x2 * c + x1 * sn) : (x1 * c - x2 * sn); }
                else ref = dbg_u(args, r, base + p, lane);
                if (lane == 0) dbg_flag(ctl, 7, h2f(WSP(half_t, WS_KVT) + (size_t)br * KVT_STRIDE + (size_t)(b * 2 + g) * SEQ * 64 + (br < 2 ? (size_t)pos * 64 + p : ((br & 1) ? v_off(pos, p) : k_off(pos, p)))), ref); } }
        }
        if (wid == 2) for (int s = 0; s < 4; ++s) { const int r = rows[s], pos = r & 4095, b = r >> 12;
            const half_t* cq = WSP(half_t, WS_CQ) + (size_t)r * 256; const half_t* t1 = WSP(half_t, WS_T1) + (size_t)r * 256;
            float sq = 0.f, skv = 0.f; for (int k = lane; k < 256; k += 64) { const float a = h2f(cq + k); sq += a * a; } for (int k = lane; k < 128; k += 64) { const float a = h2f(t1 + k); skv += a * a; }
            sq = wave_sum(sq); skv = wave_sum(skv); const float rq = 1.f / sqrtf(sq / 256.f + NORM_EPS), rkv = 1.f / sqrtf(skv / 128.f + NORM_EPS);
            const int* hs = dbgt_10_hs; const int* ps = dbgt_11_ps;
            for (int i = 0; i < 4; ++i) { const int hd = hs[i], p = ps[i]; float ref;
                auto qcol = [&](int col) { float a = 0.f; for (int k = lane; k < 256; k += 64) a += h2f(cq + k) * args.in[3][k] * args.in[4][(size_t)k * 768 + col]; return wave_sum(a) * rq; };
                if (p < 64) ref = qcol(hd * 96 + p);
                else { const int pp = p - 64, pr = pp >> 1; const float x1 = qcol(hd * 96 + 64 + pr), x2 = qcol(hd * 96 + 64 + pr + 16);
                    const float c = dbg_rope_cs(pos, pr, 32, false), sn = dbg_rope_cs(pos, pr, 32, true); ref = (pp & 1) ? (x2 * c + x1 * sn) : (x1 * c - x2 * sn); }
                if (lane == 0) dbg_flag(ctl, 8, h2f(WSP(half_t, WS_QM) + (size_t)r * 768 + hd * 96 + p), ref * QS_M); }
            for (int i = 0; i < 4; ++i) { const int hd = hs[i], d = ps[i] & 63;
                auto kvcol = [&](int col) { float a = 0.f; for (int k = lane; k < 128; k += 64) a += h2f(t1 + k) * args.in[5][k] * args.in[6][(size_t)k * 1024 + col]; return wave_sum(a) * rkv; };
                const float kr = kvcol(hd * 128 + d), vr = kvcol(hd * 128 + 64 + d);
                if (lane == 0) { dbg_flag(ctl, 9, h2f(WSP(half_t, WS_KNM) + (size_t)(b * 8 + hd) * SEQ * 64 + k_off(pos, d)), kr); dbg_flag(ctl, 10, h2f(WSP(half_t, WS_VM) + (size_t)(b * 8 + hd) * SEQ * 64 + v_off(pos, d)), vr); } }
        }
        if (wid == 3 || wid == 4) { const int kv = wid - 3; const int* slabs = dbgt_12_slabs; const int* ns = dbgt_13_ns;
            LAS float* hid = (LAS float*)(lds + 65536 + kv * 1024);
            const float* pe = args.in[kv ? 12 : 7]; const float* w1 = args.in[kv ? 13 : 8]; const float* b1 = args.in[kv ? 14 : 9]; const float* w2 = args.in[kv ? 15 : 10]; const float* b2 = args.in[kv ? 16 : 11];
            for (int s = 0; s < 3; ++s) { const int slab = slabs[s], n = ns[s]; const half_t* tok = WSP(half_t, WS_KVT) + (size_t)kv * KVT_STRIDE + ((size_t)slab * SEQ + 16 * n) * 64;
                for (int jj = 0; jj < 2; ++jj) { const int j = lane + 64 * jj; float a = b1[j]; for (int k = 0; k < 2048; ++k) a += (h2f(tok + k) + pe[k]) * w1[(size_t)k * 128 + j];
                    const float z = 0.7978845608028654f * (a + 0.044715f * a * a * a); hid[j] = 0.5f * a * (1.f + tanhf(z)); }
                asm volatile("s_waitcnt lgkmcnt(0)" ::: "memory");
                float o = b2[lane]; for (int j = 0; j < 128; ++j) o += hid[j] * w2[j * 64 + lane];
                const int* ps = dbgt_14_ps;
                for (int i = 0; i < 4; ++i) { const int p = ps[i]; float ref;
                    if (kv == 0 && p < 16) { const int pr = p >> 1; const float x1 = __shfl(o, pr), x2 = __shfl(o, pr + 8); const int pos = 16 * n + 31;
                        const float c = dbg_rope_cs(pos, pr, 16, false), sn = dbg_rope_cs(pos, pr, 16, true); ref = (p & 1) ? (x2 * c + x1 * sn) : (x1 * c - x2 * sn); }
                    else ref = __shfl(o, p);
                    if (lane == 0) dbg_flag(ctl, 11 + kv, h2f((kv ? WSP(half_t, WS_VC) : WSP(half_t, WS_KC)) + (size_t)slab * 256 * 64 + (kv ? v_off(n, p) : k_off(n, p))), ref); }
                asm volatile("s_waitcnt lgkmcnt(0)" ::: "memory"); }
        }
        if (wid == 5) { const int* bs = dbgt_15_bs; const int* hs = dbgt_16_hs; const int* qs = dbgt_17_qs;
            for (int s = 0; s < 5; ++s) { const int b = bs[s], hd = hs[s], q = qs[s]; const size_t r = (size_t)b * SEQ + q;
                const half_t* qv = WSP(half_t, WS_QM) + r * 768 + hd * 96; const half_t* Kn = WSP(half_t, WS_KNM) + (size_t)(b * 8 + hd) * SEQ * 64; const half_t* Kp = WSP(half_t, WS_KPE) + (size_t)b * SEQ * 32; const half_t* V = WSP(half_t, WS_VM) + (size_t)(b * 8 + hd) * SEQ * 64;
                float mx = -1e30f;
                for (int k = lane; k <= q; k += 64) { float sc = 0.f; for (int d = 0; d < 64; ++d) sc += h2f(qv + d) * h2f(Kn + k_off(k, d)); for (int d = 0; d < 32; ++d) sc += h2f(qv + 64 + d) * h2f(Kp + kpe_off(k, d)); mx = fmaxf(mx, sc); }
                for (int o = 1; o < 64; o <<= 1) mx = fmaxf(mx, __shfl_xor(mx, o));
                float l = 0.f, o0 = 0.f, o1 = 0.f, o2 = 0.f;
                for (int k = lane; k <= q; k += 64) { float sc = 0.f; for (int d = 0; d < 64; ++d) sc += h2f(qv + d) * h2f(Kn + k_off(k, d)); for (int d = 0; d < 32; ++d) sc += h2f(qv + 64 + d) * h2f(Kp + kpe_off(k, d));
                    const float p = exp2f(sc - mx); l += p; o0 += p * h2f(V + v_off(k, 0)); o1 += p * h2f(V + v_off(k, 33)); o2 += p * h2f(V + v_off(k, 63)); }
                l = wave_sum(l); o0 = wave_sum(o0); o1 = wave_sum(o1); o2 = wave_sum(o2);
                if (lane == 0) { const half_t* y = WSP(half_t, WS_Y) + r * DM + hd * 64; dbg_flag(ctl, 13, h2f(y + 0), o0 / l); dbg_flag(ctl, 13, h2f(y + 33), o1 / l); dbg_flag(ctl, 13, h2f(y + 63), o2 / l); } }
        }
        if (wid == 6 || wid == 7) { const int* bs = dbgt_18_bs; const int* gs = dbgt_19_gs; const int* hhs = dbgt_20_hhs; const int* qs = dbgt_21_qs;
            LAS float* pc = (LAS float*)(lds + 70000 + (wid - 6) * 8192);
            for (int s = wid - 6; s < 6; s += 2) { const int b = bs[s], g = gs[s], hh = hhs[s], q = qs[s], cur = q >> 6; const size_t r = (size_t)b * SEQ + q; const int bg = b * 2 + g;
                const half_t* Kc = WSP(half_t, WS_KC) + (size_t)bg * 256 * 64; const half_t* Vc = WSP(half_t, WS_VC) + (size_t)bg * 256 * 64;
                for (int h4 = 0; h4 < 4; ++h4) { const half_t* qv = WSP(half_t, WS_QN) + r * 512 + (g * 4 + h4) * 64;
                    float sc[4]; float mx = -1e30f;
                    for (int i = 0; i < 4; ++i) { const int n = lane + 64 * i; float a = -INFINITY; if (n < 255 && 16 * n + 31 <= q) { a = 0.f; for (int d = 0; d < 64; ++d) a += h2f(qv + d) * h2f(Kc + k_off(n, d)); } sc[i] = a; mx = fmaxf(mx, a); }
                    for (int o = 1; o < 64; o <<= 1) mx = fmaxf(mx, __shfl_xor(mx, o));
                    float l = 0.f; for (int i = 0; i < 4; ++i) { sc[i] = exp2f(sc[i] - mx); l += sc[i]; } l = wave_sum(l);
                    for (int i = 0; i < 4; ++i) pc[h4 * 256 + lane + 64 * i] = (l > 0.f) ? sc[i] / l : 0.f; }
                asm volatile("s_waitcnt lgkmcnt(0)" ::: "memory");
                { float imp = 0.f; const int jb = lane;
                  for (int n = 0; n < 255; ++n) { const int cs = 16 * n, ss0 = 64 * jb; const int lo2 = cs > ss0 ? cs : ss0, hi2 = (cs + 32 < ss0 + 64) ? cs + 32 : ss0 + 64; const int ov = hi2 - lo2; if (ov > 0) { const float w = (float)ov / 32.f; for (int h4 = 0; h4 < 4; ++h4) imp += pc[h4 * 256 + n] * w; } }
                  const bool forced = (jb == 0) || (jb == cur) || (jb == cur - 1), causal = jb * 64 <= q;
                  pc[1024 + jb] = forced ? 1e9f : (causal ? imp : -1e9f); }
                asm volatile("s_waitcnt lgkmcnt(0)" ::: "memory");
                if (lane == 0) { for (int jb = 0; jb < 64; ++jb) pc[1088 + jb] = 0.f; for (int it = 0; it < 16; ++it) { int best = -1; float bv = -INFINITY; for (int jb = 0; jb < 64; ++jb) if (pc[1088 + jb] == 0.f && pc[1024 + jb] > bv) { bv = pc[1024 + jb]; best = jb; } pc[1088 + best] = 1.f; } }
                asm volatile("s_waitcnt lgkmcnt(0)" ::: "memory");
                const half_t* qv = WSP(half_t, WS_QN) + r * 512 + (g * 4 + hh) * 64; const int* dd = dbgt_22_dd;
                float oc[3] = {0.f, 0.f, 0.f};
                for (int i = 0; i < 4; ++i) { const int n = lane + 64 * i; if (n < 255) { const float p = pc[hh * 256 + n]; for (int e = 0; e < 3; ++e) oc[e] += p * h2f(Vc + v_off(n, dd[e])); } }
                for (int e = 0; e < 3; ++e) oc[e] = wave_sum(oc[e]);
                float osw[2][3];
                for (int br = 0; br < 2; ++br) { const half_t* Kx = WSP(half_t, WS_KVT) + (size_t)(2 + 2 * br) * KVT_STRIDE + (size_t)bg * SEQ * 64; const half_t* Vx = WSP(half_t, WS_KVT) + (size_t)(3 + 2 * br) * KVT_STRIDE + (size_t)bg * SEQ * 64;
                    float mx = -1e30f;
                    for (int k = lane; k <= q; k += 64) { const bool ok = br ? (q - k < 512) : (pc[1088 + (k >> 6)] != 0.f); if (!ok) continue; float a = 0.f; for (int d = 0; d < 64; ++d) a += h2f(qv + d) * h2f(Kx + k_off(k, d)); mx = fmaxf(mx, a); }
                    for (int o = 1; o < 64; o <<= 1) mx = fmaxf(mx, __shfl_xor(mx, o));
                    float l = 0.f, a3[3] = {0.f, 0.f, 0.f};
                    for (int k = lane; k <= q; k += 64) { const bool ok = br ? (q - k < 512) : (pc[1088 + (k >> 6)] != 0.f); if (!ok) continue; float a = 0.f; for (int d = 0; d < 64; ++d) a += h2f(qv + d) * h2f(Kx + k_off(k, d));
                        const float p = exp2f(a - mx); l += p; for (int e = 0; e < 3; ++e) a3[e] += p * h2f(Vx + v_off(k, dd[e])); }
                    l = wave_sum(l); for (int e = 0; e < 3; ++e) osw[br][e] = wave_sum(a3[e]) / l; }
                if (lane == 0) { const float* gt = WSP(float, WS_GATE) + r * 24; const int head = g * 4 + hh; const float g0 = gt[head], g1 = gt[8 + head], g2 = gt[16 + head];
                    for (int e = 0; e < 3; ++e) dbg_flag(ctl, q < 1024 ? 14 : 15, h2f(WSP(half_t, WS_Y) + r * DM + 512 + head * 64 + dd[e]), g0 * oc[e] + g1 * osw[0][e] + g2 * osw[1][e]); }
                asm volatile("s_waitcnt lgkmcnt(0)" ::: "memory"); }
        }
    }
}
__global__ void __launch_bounds__(512) dbg_checks_b(Args args, int which) {
    unsigned char* ws = args.ws; unsigned* ctl = WSP(unsigned, WS_CTL);
    const int lane = threadIdx.x & 63, wid = threadIdx.x >> 6;
    const int* rows = dbgt_0_dbg_rows; const int* cols = dbgt_24_cols;
    if (blockIdx.x != 0 || wid >= 4) return;
    const int r = rows[wid];
    if (which == 6 && wid == 3) { const half_t* y = WSP(half_t, WS_Y) + (size_t)r * DM; const int* cc = dbgt_25_cc;
        for (int i = 0; i < 6; ++i) { const int c = cc[i]; float a = 0.f; for (int k = lane; k < DM; k += 64) a += h2f(y + k) * (k < 512 ? args.in[17][k] : args.in[18][k - 512]) * args.in[19][(size_t)k * DM + c];
            const float dot = wave_sum(a), xr = args.in[0][(size_t)r * DM + c], got = h2f(WSP(half_t, WS_H1) + (size_t)r * DM + c);
            if (lane == 0 && !(fabsf(got - (dot + xr)) <= 0.03f + 0.03f * fabsf(dot + xr))) atomicAdd(ctl + CW_DBG + 2, 1u << i); } }
    if (which == 6) { const half_t* y = WSP(half_t, WS_Y) + (size_t)r * DM;
        { float s0 = 0.f, s1 = 0.f; for (int k = lane; k < 512; k += 64) { const float a = h2f(y + k), b = h2f(y + 512 + k); s0 += a * a; s1 += b * b; } s0 = wave_sum(s0); s1 = wave_sum(s1);
          if (lane == 0) { dbg_flag(ctl, 20, s0 / 512.f, 1.f); dbg_flag(ctl, 21, s1 / 512.f, 1.f); } }
        { const int c = cols[wid], k = rows[wid] & 1023; if (lane == 0) dbg_flag(ctl, 22, 100.f * h2f(WSP(half_t, WS_WO) + (size_t)c * DM + k), 100.f * args.in[19][(size_t)k * DM + c] * (k < 512 ? args.in[17][k] : args.in[18][k - 512])); }
        for (int i = 0; i < 4; ++i) { const int c = cols[i]; float a = 0.f; for (int k = lane; k < DM; k += 64) a += h2f(y + k) * (k < 512 ? args.in[17][k] : args.in[18][k - 512]) * args.in[19][(size_t)k * DM + c];
            const float dot = wave_sum(a), xr = args.in[0][(size_t)r * DM + c], got = h2f(WSP(half_t, WS_H1) + (size_t)r * DM + c); a = dot + xr;
            if (lane == 0) { dbg_flag(ctl, 16, got, a);
                if ((wid == 0 && i == 0) || (wid == 3 && i == 3)) { int hcode = 9; auto near = [](float p, float q) { return fabsf(p - q) <= 0.03f + 0.03f * fabsf(q); };
                    if (near(got, dot + xr)) hcode = 1; else if (near(got, dot)) hcode = 2; else if (near(got, xr)) hcode = 3; else if (near(got, 2.f * xr + dot)) hcode = 4; else if (!(got == got)) hcode = 5; else if (near(got, 0.f)) hcode = 6;
                    atomicAdd(ctl + CW_DBG + 1, (unsigned)(wid == 0 ? 10 * hcode : hcode)); } } } }
    if (which == 7) { const half_t* h1 = WSP(half_t, WS_H1) + (size_t)r * DM; float ss = 0.f; for (int k = lane; k < DM; k += 64) { const float a = h2f(h1 + k); ss += a * a; } ss = wave_sum(ss); const float rs = 1.f / sqrtf(ss / DM + NORM_EPS);
        const int* c4 = dbgt_23_c4;
        for (int i = 0; i < 4; ++i) { const int c = c4[i]; float a = 0.f; for (int k = lane; k < DM; k += 64) a += h2f(h1 + k) * args.in[20][k] * args.in[21][(size_t)k * DFF + c];
            a = fmaxf(wave_sum(a) * rs, 0.f); if (lane == 0) dbg_flag(ctl, 17, h2f(WSP(half_t, WS_A2) + (size_t)r * DFF + c), a * a); } }
    if (which == 8) { const half_t* a2 = WSP(half_t, WS_A2) + (size_t)r * DFF;
        for (int i = 0; i < 4; ++i) { const int c = cols[i]; float a = 0.f; for (int k = lane; k < DFF; k += 64) a += h2f(a2 + k) * args.in[22][(size_t)k * DM + c];
            a = wave_sum(a) + h2f(WSP(half_t, WS_H1) + (size_t)r * DM + c); if (lane == 0) dbg_flag(ctl, 18, h2f(WSP(half_t, WS_H2) + (size_t)r * DM + c), a); } }
    if (which == 9) { const half_t* h2 = WSP(half_t, WS_H2) + (size_t)r * DM; float ss = 0.f; for (int k = lane; k < DM; k += 64) { const float a = h2f(h2 + k); ss += a * a; } ss = wave_sum(ss); const float rs = 1.f / sqrtf(ss / DM + NORM_EPS);
        for (int i = 0; i < 4; ++i) { const int c = cols[i]; if (lane == 0) dbg_flag(ctl, 19, args.out[(size_t)r * DM + c], h2f(h2 + c) * rs * args.in[23][c]); } }
}
__global__ void __launch_bounds__(512) dbg_fill(Args args) {
    unsigned char* ws = args.ws; unsigned* ctl = WSP(unsigned, WS_CTL);
#ifndef DBG_SKIP
#define DBG_SKIP 0
#endif
    const unsigned m = __hip_atomic_load(ctl + CW_DBG, __ATOMIC_RELAXED, __HIP_MEMORY_SCOPE_AGENT) & ~((1u << DBG_SKIP) - 1u);
#ifdef DBG_STAMP
    const unsigned long long* ts = (const unsigned long long*)(ctl + 160); (void)m;
    const int code = (int)((ts[DBG_T1B] - ts[DBG_T1A]) / 4000ull);
    const float vbig = (float)((ts[DBG_T2B] - ts[DBG_T2A]) / 100ull);
    if (blockIdx.x == 0 && threadIdx.x == 0) { args.out[(size_t)MROWS * DM - 1] = vbig; }
#elif defined(DBG_VALUE)
    const int code = (int)__hip_atomic_load(ctl + CW_DBG + 2, __ATOMIC_RELAXED, __HIP_MEMORY_SCOPE_AGENT); (void)m;
#else
    const int code = m ? __builtin_ctz(m) : 0;
#endif
    const float a = sqrtf((float)code);
#ifdef DBG_STAMP
    const size_t nfill = (size_t)MROWS * DM / 4 - 1;
    if (blockIdx.x == 0 && threadIdx.x == 1) { args.out[(size_t)MROWS * DM - 4] = a; args.out[(size_t)MROWS * DM - 3] = a; args.out[(size_t)MROWS * DM - 2] = a; }
#else
    const size_t nfill = (size_t)MROWS * DM / 4;
#endif
    for (size_t i = (size_t)blockIdx.x * 512 + threadIdx.x; i < nfill; i += (size_t)gridDim.x * 512) ((f32x4*)args.out)[i] = (f32x4){a, a, a, a};
}
#endif

extern "C" void kernel_launch(void* const* d_in, const int* in_sizes, int n_in, void* d_out, int out_size, void* d_ws, size_t ws_size, hipStream_t stream) {
    static int grid = 0;
    if (grid == 0) {
        if (n_in != 24 || out_size != MROWS * DM || ws_size < WS_END) { fprintf(stderr, "kernel_launch: unexpected problem (n_in %d, out %d, ws %zu)\n", n_in, out_size, ws_size); grid = -1; return; }
        int dev = 0, cus = 0, per_cu = 0;
        if (hipGetDevice(&dev) != hipSuccess || hipDeviceGetAttribute(&cus, hipDeviceAttributeMultiprocessorCount, dev) != hipSuccess) { grid = -1; return; }
        if (hipFuncSetAttribute((const void*)hymba_fwd, hipFuncAttributeMaxDynamicSharedMemorySize, LDS_BYTES) != hipSuccess) { fprintf(stderr, "kernel_launch: hipFuncSetAttribute failed\n"); grid = -1; return; }
        if (hipOccupancyMaxActiveBlocksPerMultiprocessor(&per_cu, (const void*)hymba_fwd, 512, LDS_BYTES) != hipSuccess || per_cu < 1) fprintf(stderr, "kernel_launch: occupancy query says %d\n", per_cu);
        (void)hipGetLastError();
        grid = cus;
#if DBG_CHECK
        (void)hipFuncSetAttribute((const void*)dbg_checks_a, hipFuncAttributeMaxDynamicSharedMemorySize, 98304);
#endif
    }
    if (grid < 0) return;
    (void)hipMemsetAsync((char*)d_ws + WS_CTL, 0, CTL_ZERO_BYTES, stream);
    Args a{};
    for (int i = 0; i < 24; ++i) a.in[i] = (const float*)d_in[i];
    a.out = (float*)d_out; a.ws = (unsigned char*)d_ws;
#if DBG_CHECK == 1
    a.ph_lo = 0; a.ph_hi = 5; a.li = 0; hipLaunchKernelGGL(hymba_fwd, dim3(grid), dim3(512), LDS_BYTES, stream, a);
    hipLaunchKernelGGL(dbg_checks_a, dim3(1), dim3(512), 98304, stream, a);
    hipLaunchKernelGGL(dbg_fill, dim3(1024), dim3(512), 0, stream, a);
#elif DBG_CHECK == 2
    a.ph_lo = 0; a.ph_hi = 7; a.li = 0; hipLaunchKernelGGL(hymba_fwd, dim3(grid), dim3(512), LDS_BYTES, stream, a);
    hipLaunchKernelGGL(dbg_checks_b, dim3(1), dim3(512), 0, stream, a, 6);
    a.ph_lo = 7; a.ph_hi = 8; a.li = 1; hipLaunchKernelGGL(hymba_fwd, dim3(grid), dim3(512), LDS_BYTES, stream, a);
    hipLaunchKernelGGL(dbg_checks_b, dim3(1), dim3(512), 0, stream, a, 7);
    a.ph_lo = 8; a.ph_hi = 9; a.li = 2; hipLaunchKernelGGL(hymba_fwd, dim3(grid), dim3(512), LDS_BYTES, stream, a);
    hipLaunchKernelGGL(dbg_checks_b, dim3(1), dim3(512), 0, stream, a, 8);
    a.ph_lo = 9; a.ph_hi = 10; a.li = 3; hipLaunchKernelGGL(hymba_fwd, dim3(grid), dim3(512), LDS_BYTES, stream, a);
    hipLaunchKernelGGL(dbg_checks_b, dim3(1), dim3(512), 0, stream, a, 9);
    hipLaunchKernelGGL(dbg_fill, dim3(1024), dim3(512), 0, stream, a);
#elif DBG_CHECK == 3
    a.ph_lo = 0; a.ph_hi = 10; a.li = 0; hipLaunchKernelGGL(hymba_fwd, dim3(grid), dim3(512), LDS_BYTES, stream, a);
    hipLaunchKernelGGL(dbg_fill, dim3(1024), dim3(512), 0, stream, a);
#elif MK_N_LAUNCHES == 1
    a.ph_lo = 0; a.ph_hi = 10; a.li = 0;
    hipLaunchKernelGGL(hymba_fwd, dim3(grid), dim3(512), LDS_BYTES, stream, a);
#else
    for (int p = 0; p < 10; ++p) { a.ph_lo = p; a.ph_hi = p + 1; a.li = p; hipLaunchKernelGGL(hymba_fwd, dim3(grid), dim3(512), LDS_BYTES, stream, a); }
#endif
}
```

```cpp
#include <hip/hip_runtime.h>
#include <cstdio>
#include <cstdint>

#ifndef DBG_CHECK
#define DBG_CHECK 0
#endif
#ifndef REPEAT_PHASE
#define REPEAT_PHASE -1
#endif
#ifndef ABL
#define ABL 0
#endif
#ifndef MK_N_LAUNCHES
#define MK_N_LAUNCHES 1
#endif

#define LAS __attribute__((address_space(3)))
typedef _Float16 half_t;
typedef _Float16 half8 __attribute__((ext_vector_type(8)));
typedef _Float16 half2v __attribute__((ext_vector_type(2)));
typedef float f32x4 __attribute__((ext_vector_type(4)));
typedef float f32x16 __attribute__((ext_vector_type(16)));
typedef unsigned u32x4 __attribute__((ext_vector_type(4)));
typedef unsigned u32x2 __attribute__((ext_vector_type(2)));
typedef short v4i16 __attribute__((ext_vector_type(4)));

constexpr int BATCH = 16, SEQ = 4096, DM = 1024, MROWS = BATCH * SEQ;
constexpr int IN_COLS = 1720, NIN = 1792;
constexpr int DFF = 4096;
constexpr float NORM_EPS = 1e-6f;
constexpr float LOG2E = 1.4426950408889634f;
constexpr float QS_N = 0.125f * LOG2E;
constexpr float QS_M = 0.10206207261596577f * LOG2E;

constexpr size_t MiB = 1u << 20;
constexpr size_t WS_CTL = 0, CTL_ZERO_BYTES = 1 * MiB;
constexpr size_t WS_WIN = 1 * MiB, WS_WUQ = 5 * MiB, WS_WUKV = 6 * MiB, WS_WC1 = 7 * MiB, WS_WO = 9 * MiB, WS_WUP = 11 * MiB, WS_WDN = 19 * MiB;
constexpr size_t WS_ROPEM = 27 * MiB, WS_ROPEN = 27 * MiB + 512 * 1024, WS_B1P = 27 * MiB + 768 * 1024;
constexpr size_t WS_KC = 28 * MiB, WS_VC = 29 * MiB;
constexpr size_t WS_RS1 = 32 * MiB, WS_SSQ = 33 * MiB, WS_SSKV = 34 * MiB, WS_SSM = 35 * MiB, WS_SSN = 37 * MiB, WS_SS2 = 39 * MiB, WS_SS3 = 43 * MiB;
constexpr size_t WS_GATE = 47 * MiB, WS_KPE = 53 * MiB;
constexpr size_t WS_CQ = 64 * MiB, WS_T1 = 96 * MiB, WS_QN = 128 * MiB, WS_KVT = 192 * MiB  ;
constexpr size_t WS_QM = 288 * MiB, WS_KNM = 384 * MiB, WS_VM = 448 * MiB, WS_HIDP = 512 * MiB;
constexpr size_t WS_A2 = 64 * MiB;
constexpr size_t WS_XH = 576 * MiB, WS_H2 = 576 * MiB, WS_Y = 704 * MiB, WS_H1 = 832 * MiB, WS_END = 960 * MiB;
constexpr size_t KVT_STRIDE = 16 * MiB / 2;

constexpr int CW_QHEAD = 64;
constexpr int CW_BAR = 4096;

constexpr int LDS_BYTES = 163840;
constexpr int LDS_MISC = 163840 - 256;

#define XB_TMO      128
#define XB_XCNT(j)  (256  + 64 * (j))
#define XB_XSUB(j)  (1280 + 64 * (j))
#define XB_XGEN(j)  (2304 + 64 * (j))
#define XB_TOP      3328
#define XB_TOPGEN   3392
#define XCD_BAR_WORDS 3456
#define XB_SPIN_CAP (1u << 22)

__device__ __forceinline__ unsigned xb_ld(unsigned* p)              { return __hip_atomic_load(p, __ATOMIC_RELAXED, __HIP_MEMORY_SCOPE_AGENT); }
__device__ __forceinline__ unsigned xb_add(unsigned* p, unsigned v) { return __hip_atomic_fetch_add(p, v, __ATOMIC_RELAXED, __HIP_MEMORY_SCOPE_AGENT); }
__device__ __forceinline__ unsigned xb_xcc_id() { return (unsigned)__builtin_amdgcn_s_getreg((3 << 11) | 20) & 0xFu; }
#define XB_SPIN(cond, bar) do { unsigned _sp = 0; while (cond) { __builtin_amdgcn_s_sleep(1); \
    if ((++_sp & 255u) == 0u) { if (xb_ld(&(bar)[XB_TMO])) break; if (_sp > XB_SPIN_CAP) { atomicAdd(&(bar)[XB_TMO], 1u); break; } } } } while (0)

struct XcdBarrier { unsigned* bar; unsigned x; volatile LAS unsigned* st; };

__device__ __forceinline__ XcdBarrier xcd_barrier_post(unsigned* bar, volatile LAS unsigned* st) {
    XcdBarrier b; b.bar = bar; b.x = xb_xcc_id(); b.st = st;
    if (threadIdx.x == 0) (void)xb_add(&bar[XB_XCNT(b.x)], 1u);
    return b;
}
__device__ __forceinline__ void xcd_barrier_complete(unsigned* bar, unsigned x, unsigned& nloc, unsigned& nx) {
    const unsigned G = gridDim.x * gridDim.y * gridDim.z;
    unsigned sum, cnt, mine, sp = 0u;
    for (;;) {
        sum = 0u; cnt = 0u; mine = 0u;
#pragma unroll
        for (unsigned j = 0; j < 16; ++j) { const unsigned c = xb_ld(&bar[XB_XCNT(j)]); sum += c; cnt += (c > 0u) ? 1u : 0u; mine = (j == x) ? c : mine; }
        if (sum == G) break;
        __builtin_amdgcn_s_sleep(1);
        if ((++sp & 255u) == 0u) { if (xb_ld(&bar[XB_TMO])) break; if (sp > XB_SPIN_CAP) { atomicAdd(&bar[XB_TMO], 1u); break; } }
    }
    nloc = mine > 0u ? mine : 1u; nx = cnt > 0u ? cnt : 1u;
}
__device__ __forceinline__ void xcd_barrier(const XcdBarrier& b) {
    asm volatile("s_waitcnt vmcnt(0)" ::: "memory");
    __syncthreads();
    if (threadIdx.x == 0) {
        unsigned* bar = b.bar;
        __builtin_amdgcn_s_waitcnt(0);
        unsigned nloc = b.st[0], nx = b.st[1];
        if (nloc == 0u) { xcd_barrier_complete(bar, b.x, nloc, nx); b.st[0] = nloc; b.st[1] = nx; }
        const unsigned old = xb_add(&bar[XB_XSUB(b.x)], 1u);
        const unsigned gen = old / nloc;
        if (old + 1u == (gen + 1u) * nloc) {
            __builtin_amdgcn_fence(__ATOMIC_RELEASE, "agent");
            asm volatile("s_waitcnt vmcnt(0)" ::: "memory");
            const unsigned og = xb_add(&bar[XB_TOP], 1u);
            const unsigned tg = og / nx;
            if (og + 1u == (tg + 1u) * nx) xb_add(&bar[XB_TOPGEN], 1u);
            else XB_SPIN(xb_ld(&bar[XB_TOPGEN]) == tg, bar);
            __builtin_amdgcn_fence(__ATOMIC_ACQUIRE, "agent");
            xb_add(&bar[XB_XGEN(b.x)], 1u);
            asm volatile("s_waitcnt vmcnt(0)" ::: "memory");
        } else {
            XB_SPIN(xb_ld(&bar[XB_XGEN(b.x)]) == gen, bar);
            __builtin_amdgcn_fence(__ATOMIC_ACQUIRE, "agent");
            asm volatile("s_waitcnt vmcnt(0)" ::: "memory");
        }
    }
    __syncthreads();
}

__device__ __forceinline__ unsigned pk_rne(float a, float b) { half2v v = {(_Float16)a, (_Float16)b}; return __builtin_bit_cast(unsigned, v); }
__device__ __forceinline__ unsigned pk_rtz(float a, float b) { auto v = __builtin_amdgcn_cvt_pkrtz(a, b); return __builtin_bit_cast(unsigned, v); }
__device__ __forceinline__ u32x4 pk8(const float* v) { u32x4 w; w.x = pk_rne(v[0], v[1]); w.y = pk_rne(v[2], v[3]); w.z = pk_rne(v[4], v[5]); w.w = pk_rne(v[6], v[7]); return w; }
__device__ __forceinline__ void unpk8(u32x4 w, float* v) {
    const half8 h = __builtin_bit_cast(half8, w);
#pragma unroll
    for (int i = 0; i < 8; ++i) v[i] = (float)h[i];
}
__device__ __forceinline__ float wave_sum(float v) {
#pragma unroll
    for (int o = 1; o < 64; o <<= 1) v += __shfl_xor(v, o);
    return v;
}
__device__ __forceinline__ void rope4(float* v, const float2* cs) {
#pragma unroll
    for (int p = 0; p < 4; ++p) { const float2 t = cs[p]; const float x1 = v[2 * p], x2 = v[2 * p + 1]; v[2 * p] = x1 * t.x - x2 * t.y; v[2 * p + 1] = x2 * t.x + x1 * t.y; }
}

__host__ __device__ __forceinline__ size_t k_off(int tok, int d)   { return (size_t)(((tok >> 6) * 8 + (d >> 3)) * 512 + (tok & 63) * 8 + (d & 7)); }
__host__ __device__ __forceinline__ size_t v_off(int tok, int d)   { return (size_t)((tok >> 6) * 4096 + ((d >> 5) * 8 + ((tok & 63) >> 3)) * 256 + (tok & 7) * 32 + (d & 31)); }
__host__ __device__ __forceinline__ size_t kpe_off(int tok, int p) { return (size_t)(((tok >> 6) * 4 + (p >> 3)) * 512 + (tok & 63) * 8 + (p & 7)); }

namespace pg8 {
constexpr int BM = 256, BK = 64, HALF = 128, HTB = HALF * BK * 2, NXCD = 8, WGM = 8;
__host__ __device__ __forceinline__ int lds_byte(int r, int c) { const int st = (r >> 4) * 2 + (c >> 5), rr = r & 15, cc = c & 31, ob = rr * 64 + cc * 2; return st * 1024 + (ob ^ (((ob >> 9) & 1) << 5)); }
__host__ __device__ __forceinline__ void stage_rc(int b, int& R, int& C) { const int st = b / 1024, sb = b % 1024, swz = sb ^ (((sb >> 9) & 1) << 5); R = (st >> 1) * 16 + swz / 64; C = (st & 1) * 32 + (swz % 64) / 2; }
__host__ __device__ __forceinline__ int perm32(int rho) { const int n = rho >> 4, i = rho & 15; return 8 * (i >> 2) + 4 * n + (i & 3); }

struct Unit { int pm, pn; size_t aoff, boff; };
struct Gemm { const half_t* A; const half_t* Bt; int K, lda, ldb; };

struct StaticOrder {
    int nM, nN, nwg, G, c; size_t tA, tB;
    __device__ void init(int M, int N, int G_, int c_, int lda, int ldb) { nM = M / BM; nN = N / BM; nwg = nM * nN; G = G_; c = c_; tA = (size_t)BM * lda * 2; tB = (size_t)BM * ldb * 2; }
    __device__ bool next(int i, Unit& u) const {
        const long L = (long)i * G + c; if (L >= nwg) return false;
        int wgid = (int)L; { const int q = nwg / NXCD, r = nwg % NXCD, xcd = wgid % NXCD, off = wgid / NXCD; wgid = (xcd < r ? xcd * (q + 1) : r * (q + 1) + (xcd - r) * q) + off; }
        const int nig = WGM * nN, gid = wgid / nig, fm = gid * WGM, gsz = (nM - fm) < WGM ? (nM - fm) : WGM;
        u.pm = fm + ((wgid % nig) % gsz); u.pn = (wgid % nig) / gsz; u.aoff = (size_t)u.pm * tA; u.boff = (size_t)u.pn * tB; return true;
    }
};
struct Cmp1Order {
    int G, c;
    __device__ bool next(int i, Unit& u) const {
        const int L = i * G + c; if (L >= 256) return false;
        const int kv = L >> 7, slab = (L >> 2) & 31, ch = L & 3;
        u.pm = L; u.pn = 0; u.aoff = (size_t)kv * (16 * MiB) + (size_t)slab * (512 * 1024) + (size_t)ch * 1024; u.boff = (size_t)kv * (256 * 2048 * 2) + (size_t)ch * 1024; return true;
    }
};

template <class Epi, class Sched, bool MIDK = false>
__device__ __forceinline__ void gemm_phase(LAS unsigned char* lds, const Gemm g, const Sched& S, const Epi& E) {
    int tid_ = threadIdx.x; asm volatile("" : "+v"(tid_));
    const int tid = tid_, wid = __builtin_amdgcn_readfirstlane(tid >> 6), lane = tid & 63, wr = wid >> 2, wc = wid & 3, fr = lane & 15, fq = lane >> 4;
    const int K = g.K, nt = K / BK;
    unsigned voffA[2], voffB[2];
#pragma unroll
    for (int i = 0; i < 2; ++i) { int R, C; stage_rc(tid * 16 + i * 8192, R, C); const int Rb = (R & ~31) + perm32(R & 31);
        voffA[i] = (unsigned)(R * g.lda + C) * 2u; voffB[i] = (unsigned)(Rb * g.ldb + C) * 2u; }
    const size_t kstep = (size_t)(BK * 2);
    const size_t hstepA = (size_t)HALF * g.lda * 2, hstepB = (size_t)HALF * g.ldb * 2;
    const unsigned ldsw = (unsigned)wid * 1024u;
    const int aoff = lds_byte(wr * 64 + fr, fq * 8), boff = lds_byte(wc * 32 + fr, fq * 8);
#define PG8_SA(b, h) (((b) * 2 + (h)) * HTB)
#define PG8_SB(b, h) ((4 + (b) * 2 + (h)) * HTB)
#define PG8_STAGE(bufoff, gbase, voff) do { _Pragma("unroll") for (int _i = 0; _i < 2; ++_i) \
        __builtin_amdgcn_global_load_lds((const unsigned*)((const char*)(gbase) + (voff)[_i]), (LAS unsigned*)(lds + (bufoff) + ldsw + _i * 8192), 16, 0, 0); } while (0)
#define PG8_LDA(dst, b, h) do { _Pragma("unroll") for (int m = 0; m < 4; ++m) _Pragma("unroll") for (int k = 0; k < 2; ++k) dst[m][k] = *(const LAS half8*)(lds + PG8_SA(b, h) + aoff + m * 2048 + k * 1024); } while (0)
#define PG8_LDB(dst, b, h) do { _Pragma("unroll") for (int n = 0; n < 2; ++n) _Pragma("unroll") for (int k = 0; k < 2; ++k) dst[n][k] = *(const LAS half8*)(lds + PG8_SB(b, h) + boff + n * 2048 + k * 1024); } while (0)
#define PG8_MMA(ai, bj, At, Bt) do { __builtin_amdgcn_s_setprio(1); _Pragma("unroll") for (int m = 0; m < 4; ++m) _Pragma("unroll") for (int n = 0; n < 2; ++n) _Pragma("unroll") for (int k = 0; k < 2; ++k) \
        acc[ai][bj][m][n] = __builtin_amdgcn_mfma_f32_16x16x32_f16(Bt[n][k], At[m][k], acc[ai][bj][m][n], 0, 0, 0); __builtin_amdgcn_s_setprio(0); } while (0)
#define PG8_WAIT_V(n) asm volatile("s_waitcnt vmcnt(" #n ")" ::: "memory")
#define PG8_WAIT_L(n) asm volatile("s_waitcnt lgkmcnt(" #n ")" ::: "memory")
#define PG8_BAR __builtin_amdgcn_s_barrier()
#define PG8_SCHED __builtin_amdgcn_sched_barrier(0)
    Unit cur, nxt; int ui = 0;
    if (!S.next(0, cur)) return;
    f32x4 acc[2][2][4][2];
#pragma unroll
    for (int a = 0; a < 2; ++a)
#pragma unroll
        for (int b = 0; b < 2; ++b)
#pragma unroll
            for (int m = 0; m < 4; ++m)
#pragma unroll
                for (int n = 0; n < 2; ++n) acc[a][b][m][n] = (f32x4){0.f, 0.f, 0.f, 0.f};
    half8 At[4][2], B0[2][2], B1[2][2];
    const char* cA = (const char*)g.A + cur.aoff; const char* cB = (const char*)g.Bt + cur.boff;
    PG8_STAGE(PG8_SB(0, 0), cB, voffB); PG8_STAGE(PG8_SB(0, 1), cB + hstepB, voffB); PG8_STAGE(PG8_SA(0, 0), cA, voffA); PG8_STAGE(PG8_SA(0, 1), cA + hstepA, voffA);
    if (wr == 1) PG8_BAR;
    PG8_WAIT_V(2); PG8_BAR;
    PG8_STAGE(PG8_SB(1, 0), cB + kstep, voffB); PG8_STAGE(PG8_SA(1, 0), cA + kstep, voffA); PG8_STAGE(PG8_SB(1, 1), cB + hstepB + kstep, voffB);
    PG8_WAIT_V(6); PG8_BAR;
    for (;;) {
        const bool has_next = S.next(ui + 1, nxt);
        const char* nA = has_next ? (const char*)g.A + nxt.aoff : cA; const char* nB = has_next ? (const char*)g.Bt + nxt.boff : cB;
        for (int t = 0; t < nt; t += 2) {
            if constexpr (MIDK) { if (t == nt / 2) E.midk(acc, cur, wr); }
            const bool last = (t == nt - 2);
            const char* a1 = cA + (size_t)(t + 1) * kstep;
            const char* a2 = last ? nA : cA + (size_t)(t + 2) * kstep; const char* b2 = last ? nB : cB + (size_t)(t + 2) * kstep;
            const char* a3 = a2 + kstep; const char* b3 = b2 + kstep;
            PG8_LDB(B0, 0, 0); PG8_LDB(B1, 0, 1); PG8_SCHED; PG8_LDA(At, 0, 0); PG8_STAGE(PG8_SA(1, 1), a1 + hstepA, voffA);
            PG8_WAIT_V(8); PG8_WAIT_L(0); PG8_BAR; PG8_MMA(0, 0, At, B0); PG8_MMA(0, 1, At, B1); PG8_BAR; PG8_SCHED;
            PG8_LDA(At, 0, 1); PG8_STAGE(PG8_SB(0, 0), b2, voffB); PG8_STAGE(PG8_SB(0, 1), b2 + hstepB, voffB); PG8_STAGE(PG8_SA(0, 0), a2, voffA);
            PG8_WAIT_V(8); PG8_WAIT_L(0); PG8_BAR; PG8_MMA(1, 0, At, B0); PG8_MMA(1, 1, At, B1); PG8_BAR; PG8_SCHED;
            PG8_LDB(B0, 1, 0); PG8_LDB(B1, 1, 1); PG8_SCHED; PG8_LDA(At, 1, 0); PG8_STAGE(PG8_SA(0, 1), a2 + hstepA, voffA);
            PG8_WAIT_V(8); PG8_WAIT_L(0); PG8_BAR; PG8_MMA(0, 0, At, B0); PG8_MMA(0, 1, At, B1); PG8_BAR; PG8_SCHED;
            PG8_LDA(At, 1, 1); PG8_STAGE(PG8_SB(1, 0), b3, voffB); PG8_STAGE(PG8_SB(1, 1), b3 + hstepB, voffB); PG8_STAGE(PG8_SA(1, 0), a3, voffA);
            PG8_WAIT_V(8); PG8_WAIT_L(0); PG8_BAR; PG8_MMA(1, 0, At, B0); PG8_MMA(1, 1, At, B1); PG8_BAR; PG8_SCHED;
        }
        if (wr == 0) PG8_BAR;
        E(acc, cur, wr, wc, fr, fq);
        if (!has_next) break;
#pragma unroll
        for (int a = 0; a < 2; ++a)
#pragma unroll
            for (int b = 0; b < 2; ++b)
#pragma unroll
                for (int m = 0; m < 4; ++m)
#pragma unroll
                    for (int n = 0; n < 2; ++n) acc[a][b][m][n] = (f32x4){0.f, 0.f, 0.f, 0.f};
        cur = nxt; cA = nA; cB = nB; ++ui;
        if (wr == 1) PG8_BAR;
    }
    PG8_WAIT_V(0);
    PG8_BAR;
#undef PG8_SA
#undef PG8_SB
#undef PG8_STAGE
#undef PG8_LDA
#undef PG8_LDB
#undef PG8_MMA
#undef PG8_WAIT_V
#undef PG8_WAIT_L
#undef PG8_BAR
#undef PG8_SCHED
}
}

typedef f32x4 AccT[2][2][4][2];
#define EPI_IDS() int t_ = threadIdx.x; asm volatile("" : "+v"(t_)); const int fr = t_ & 15, fq = (t_ >> 4) & 3; (void)fr_; (void)fq_
#define EPI_ROW(ai, m) (u.pm * 256 + (ai) * 128 + wr * 64 + (m) * 16 + fr)
#define EPI_GET8(v, ai, bj, m, s) do { const f32x4 _a = acc[ai][bj][m][0], _b = acc[ai][bj][m][1]; v[0] = _a[0] * (s); v[1] = _a[1] * (s); v[2] = _a[2] * (s); v[3] = _a[3] * (s); v[4] = _b[0] * (s); v[5] = _b[1] * (s); v[6] = _b[2] * (s); v[7] = _b[3] * (s); } while (0)
__device__ __forceinline__ void rope4v(float* v, const f32x4& c01, const f32x4& c23) {
    const float cs[8] = {c01[0], c01[1], c01[2], c01[3], c23[0], c23[1], c23[2], c23[3]};
#pragma unroll
    for (int p = 0; p < 4; ++p) { const float x1 = v[2 * p], x2 = v[2 * p + 1]; v[2 * p] = x1 * cs[2 * p] - x2 * cs[2 * p + 1]; v[2 * p + 1] = x2 * cs[2 * p] + x1 * cs[2 * p + 1]; }
}
__device__ __forceinline__ float sum4(const f32x4& a) { return (a[0] + a[1]) + (a[2] + a[3]); }
__device__ __forceinline__ float relu_s(float x) { float r; asm("v_max_f32_e32 %0, 0, %1" : "=v"(r) : "v"(x)); return r; }
constexpr int LDS_RED = 131072;

struct EpiIn {
    const float* rs1; half_t* CQ; half_t* T1; half_t* KPE; float* GATE; float* SSQ; float* SSKV; half_t* QN; half_t* KVT; const float2* ropeM; const float2* ropeN;
    __device__ __forceinline__ void operator()(const AccT& acc, const pg8::Unit& u, int wr, int wc, int fr_, int fq_) const {
        EPI_IDS();
        const int pn = u.pn;
        const bool ropem = (pn == 1 && wc == 0), ropen = (pn >= 2 && pn != 4 && (wc & 1) == 0);
#pragma unroll
        for (int ai = 0; ai < 2; ++ai) {
            float rsv[4]; f32x4 rc[4][2];
#pragma unroll
            for (int m = 0; m < 4; ++m) { const int row = EPI_ROW(ai, m), pos = row & (SEQ - 1); rsv[m] = rs1[row];
                if (ropem) { const f32x4* p = (const f32x4*)(ropeM + (size_t)pos * 16 + fq * 4); rc[m][0] = p[0]; rc[m][1] = p[1]; }
                else if (ropen) { const f32x4* p = (const f32x4*)(ropeN + (size_t)pos * 8 + (fq & 1) * 4); rc[m][0] = p[0]; rc[m][1] = p[1]; } }
#pragma unroll
            for (int m = 0; m < 4; ++m) { const int row = EPI_ROW(ai, m), pos = row & (SEQ - 1), b = row >> 12; const float rs = rsv[m];
                float v[8];
                if (pn == 0) {
                    float ss = 0.f;
#pragma unroll
                    for (int bj = 0; bj < 2; ++bj) { EPI_GET8(v, ai, bj, m, rs);
#pragma unroll
                        for (int i = 0; i < 8; ++i) ss += v[i] * v[i];
                        *(u32x4*)(CQ + (size_t)row * 256 + bj * 128 + wc * 32 + fq * 8) = pk8(v); }
                    ss += __shfl_xor(ss, 16); ss += __shfl_xor(ss, 32);
                    if (fq == 0) SSQ[(size_t)row * 4 + wc] = ss;
                } else if (pn == 1) {
                    { EPI_GET8(v, ai, 0, m, rs); float ss = 0.f;
#pragma unroll
                        for (int i = 0; i < 8; ++i) ss += v[i] * v[i];
                        *(u32x4*)(T1 + (size_t)row * 256 + wc * 32 + fq * 8) = pk8(v);
                        ss += __shfl_xor(ss, 16); ss += __shfl_xor(ss, 32);
                        if (fq == 0) SSKV[(size_t)row * 4 + wc] = ss; }
                    { EPI_GET8(v, ai, 1, m, rs);
                        if (wc == 0) { rope4v(v, rc[m][0], rc[m][1]); const u32x4 w = pk8(v);
                            *(u32x4*)(T1 + (size_t)row * 256 + 128 + fq * 8) = w; *(u32x4*)(KPE + (size_t)b * SEQ * 32 + kpe_off(pos, fq * 8)) = w; }
                        else { if (wc == 1 && fq < 3) { float* gp = GATE + (size_t)row * 24 + fq * 8;
#pragma unroll
                                for (int i = 0; i < 8; ++i) v[i] = 1.f / (1.f + __expf(-v[i]));
                                *(f32x4*)gp = (f32x4){v[0], v[1], v[2], v[3]}; *(f32x4*)(gp + 4) = (f32x4){v[4], v[5], v[6], v[7]}; }
                            *(u32x4*)(T1 + (size_t)row * 256 + 128 + wc * 32 + fq * 8) = (u32x4){0u, 0u, 0u, 0u}; } }
                } else if (pn < 4) {
#pragma unroll
                    for (int bj = 0; bj < 2; ++bj) { EPI_GET8(v, ai, bj, m, rs); const int head = (pn - 2) * 4 + 2 * bj + (wc >> 1), off = 32 * (wc & 1) + 8 * fq;
                        if ((wc & 1) == 0 && fq < 2) rope4v(v, rc[m][0], rc[m][1]);
#pragma unroll
                        for (int i = 0; i < 8; ++i) v[i] *= QS_N;
                        *(u32x4*)(QN + (size_t)row * 512 + head * 64 + off) = pk8(v); }
                } else {
#pragma unroll
                    for (int bj = 0; bj < 2; ++bj) { EPI_GET8(v, ai, bj, m, rs); const int g = wc >> 1, d = 32 * (wc & 1) + 8 * fq;
                        if (pn > 4 && bj == 0 && (wc & 1) == 0 && fq < 2) rope4v(v, rc[m][0], rc[m][1]);
                        half_t* base = KVT + (size_t)((pn - 4) * 2 + bj) * KVT_STRIDE + (size_t)(b * 2 + g) * SEQ * 64;
                        *(u32x4*)(base + (pn == 4 ? (size_t)pos * 64 + d : (bj == 0 ? k_off(pos, d) : v_off(pos, d)))) = pk8(v); }
                }
            }
        }
    }
};

struct EpiUq {
    const float* SSQ; half_t* QM; const float2* ropeM;
    __device__ __forceinline__ void operator()(const AccT& acc, const pg8::Unit& u, int wr, int wc, int fr_, int fq_) const {
        EPI_IDS();
        const bool pe0 = ((8 * u.pn + wc) % 3 == 2), pe1 = ((8 * u.pn + 4 + wc) % 3 == 2);
#pragma unroll
        for (int ai = 0; ai < 2; ++ai) {
            f32x4 s4[4];
#pragma unroll
            for (int m = 0; m < 4; ++m) s4[m] = *(const f32x4*)(SSQ + (size_t)EPI_ROW(ai, m) * 4);
#pragma unroll
            for (int m = 0; m < 4; ++m) { const int row = EPI_ROW(ai, m);
                const float rs = __builtin_amdgcn_rsqf(sum4(s4[m]) * (1.f / 256.f) + NORM_EPS) * QS_M;
                float v[8];
#pragma unroll
                for (int bj = 0; bj < 2; ++bj) { EPI_GET8(v, ai, bj, m, rs); const int sidx = 8 * u.pn + 4 * bj + wc;
                    if (bj == 0 ? pe0 : pe1) { const f32x4* p = (const f32x4*)(ropeM + (size_t)(row & (SEQ - 1)) * 16 + fq * 4); rope4v(v, p[0], p[1]); }
                    *(u32x4*)(QM + (size_t)row * 768 + sidx * 32 + fq * 8) = pk8(v); }
            }
        }
    }
};
struct EpiUkv {
    const float* SSKV; half_t* KNM; half_t* VM;
    __device__ __forceinline__ void operator()(const AccT& acc, const pg8::Unit& u, int wr, int wc, int fr_, int fq_) const {
        EPI_IDS();
#pragma unroll
        for (int ai = 0; ai < 2; ++ai) {
            f32x4 s4[4];
#pragma unroll
            for (int m = 0; m < 4; ++m) s4[m] = *(const f32x4*)(SSKV + (size_t)EPI_ROW(ai, m) * 4);
#pragma unroll
            for (int m = 0; m < 4; ++m) { const int row = EPI_ROW(ai, m), pos = row & (SEQ - 1), b = row >> 12;
                const float rs = __builtin_amdgcn_rsqf(sum4(s4[m]) * (1.f / 128.f) + NORM_EPS);
                float v[8];
#pragma unroll
                for (int bj = 0; bj < 2; ++bj) { EPI_GET8(v, ai, bj, m, rs); const int c = (u.pn & 1) * 256 + bj * 128 + wc * 32 + fq * 8, head = c >> 6, d = c & 63;
                    half_t* base = ((u.pn < 2) ? KNM : VM) + (size_t)(b * 8 + head) * SEQ * 64;
                    *(u32x4*)(base + ((u.pn < 2) ? k_off(pos, d) : v_off(pos, d))) = pk8(v); }
            }
        }
    }
};
struct EpiC1 {
    float* HIDP;
    __device__ __forceinline__ void operator()(const AccT& acc, const pg8::Unit& u, int wr, int wc, int fr_, int fq_) const {
        EPI_IDS();
#pragma unroll
        for (int ai = 0; ai < 2; ++ai)
#pragma unroll
            for (int m = 0; m < 4; ++m) { const int rl = ai * 128 + wr * 64 + m * 16 + fr; float* p = HIDP + ((size_t)u.pm * 256 + rl) * 128 + wc * 32 + fq * 8;
                *(f32x4*)p = acc[ai][0][m][0]; *(f32x4*)(p + 4) = acc[ai][0][m][1]; }
    }
};
__device__ __forceinline__ float rstd8(const float* p, float inv_n) {
    const f32x4 a = *(const f32x4*)p, b = *(const f32x4*)(p + 4);
    return __builtin_amdgcn_rsqf((sum4(a) + sum4(b)) * inv_n + NORM_EPS);
}
struct EpiWo {
    const half_t* XH; half_t* H1; float* SS2; const float* SSM; const float* SSN; LAS float* red;
    __device__ __forceinline__ void midk(AccT& acc, const pg8::Unit& u, int wr) const {
        int t_ = threadIdx.x; asm volatile("" : "+v"(t_)); const int fr = t_ & 15;
#pragma unroll
        for (int ai = 0; ai < 2; ++ai) {
            f32x4 sm[4][2], sn[4][2];
#pragma unroll
            for (int m = 0; m < 4; ++m) { const int row = EPI_ROW(ai, m); sm[m][0] = *(const f32x4*)(SSM + (size_t)row * 8); sm[m][1] = *(const f32x4*)(SSM + (size_t)row * 8 + 4); sn[m][0] = *(const f32x4*)(SSN + (size_t)row * 8); sn[m][1] = *(const f32x4*)(SSN + (size_t)row * 8 + 4); }
#pragma unroll
            for (int m = 0; m < 4; ++m) {
                const float ratio = __builtin_amdgcn_rsqf((sum4(sm[m][0]) + sum4(sm[m][1])) * (1.f / 512.f) + NORM_EPS) / __builtin_amdgcn_rsqf((sum4(sn[m][0]) + sum4(sn[m][1])) * (1.f / 512.f) + NORM_EPS);
#pragma unroll
                for (int bj = 0; bj < 2; ++bj)
#pragma unroll
                    for (int n = 0; n < 2; ++n) acc[ai][bj][m][n] *= ratio; }
        }
    }
    __device__ __forceinline__ void operator()(const AccT& acc, const pg8::Unit& u, int wr, int wc, int fr_, int fq_) const {
        EPI_IDS();
#pragma unroll
        for (int ai = 0; ai < 2; ++ai) {
            f32x4 sn[4][2]; u32x4 xr[4][2];
#pragma unroll
            for (int m = 0; m < 4; ++m) { const int row = EPI_ROW(ai, m); sn[m][0] = *(const f32x4*)(SSN + (size_t)row * 8); sn[m][1] = *(const f32x4*)(SSN + (size_t)row * 8 + 4);
#pragma unroll
                for (int bj = 0; bj < 2; ++bj) xr[m][bj] = *(const u32x4*)(XH + (size_t)row * DM + u.pn * 256 + bj * 128 + wc * 32 + fq * 8); }
#pragma unroll
            for (int m = 0; m < 4; ++m) { const int row = EPI_ROW(ai, m);
                const float rn = __builtin_amdgcn_rsqf((sum4(sn[m][0]) + sum4(sn[m][1])) * (1.f / 512.f) + NORM_EPS);
                float v[8], x[8], ss = 0.f;
#pragma unroll
                for (int bj = 0; bj < 2; ++bj) { EPI_GET8(v, ai, bj, m, rn); unpk8(xr[m][bj], x);
#pragma unroll
                    for (int i = 0; i < 8; ++i) { v[i] += x[i]; ss += v[i] * v[i]; }
                    *(u32x4*)(H1 + (size_t)row * DM + u.pn * 256 + bj * 128 + wc * 32 + fq * 8) = pk8(v); }
                ss += __shfl_xor(ss, 16); ss += __shfl_xor(ss, 32);
                if (fq == 0) red[(ai * 128 + wr * 64 + m * 16 + fr) * 4 + wc] = ss;
            }
        }
        asm volatile("s_waitcnt lgkmcnt(0)" ::: "memory"); __builtin_amdgcn_s_barrier();
        if (t_ < 256) { const f32x4 r4 = *(const LAS f32x4*)(red + t_ * 4); SS2[(size_t)(u.pm * 256 + t_) * 4 + u.pn] = sum4(r4); }
    }
};
__device__ __forceinline__ float rstd16(const float* p, float inv_n) {
    const f32x4 a = *(const f32x4*)p, b = *(const f32x4*)(p + 4), c = *(const f32x4*)(p + 8), d = *(const f32x4*)(p + 12);
    return __builtin_amdgcn_rsqf(((sum4(a) + sum4(b)) + (sum4(c) + sum4(d))) * inv_n + NORM_EPS);
}
struct EpiUp {
    const float* SS2; half_t* A2;
    __device__ __forceinline__ void operator()(const AccT& acc, const pg8::Unit& u, int wr, int wc, int fr_, int fq_) const {
        EPI_IDS();
#pragma unroll
        for (int ai = 0; ai < 2; ++ai) {
            f32x4 s[4];
#pragma unroll
            for (int m = 0; m < 4; ++m) s[m] = *(const f32x4*)(SS2 + (size_t)EPI_ROW(ai, m) * 4);
#pragma unroll
            for (int m = 0; m < 4; ++m) { const int row = EPI_ROW(ai, m);
                const float rs = __builtin_amdgcn_rsqf(sum4(s[m]) * (1.f / 1024.f) + NORM_EPS);
                const float rs2 = rs * rs;
#pragma unroll
                for (int bj = 0; bj < 2; ++bj) { u32x4 w;
#pragma unroll
                    for (int n = 0; n < 2; ++n) { const f32x4 a = acc[ai][bj][m][n];
                        typedef float f32x2 __attribute__((ext_vector_type(2)));
                        f32x2 x0 = {relu_s(a[0]), relu_s(a[1])}, x1 = {relu_s(a[2]), relu_s(a[3])};
                        x0 = x0 * x0 * rs2; x1 = x1 * x1 * rs2;
                        w[2 * n] = pk_rne(x0[0], x0[1]); w[2 * n + 1] = pk_rne(x1[0], x1[1]); }
                    __builtin_nontemporal_store(w, (u32x4*)(A2 + (size_t)row * DFF + u.pn * 256 + bj * 128 + wc * 32 + fq * 8)); }
            }
        }
    }
};
struct EpiDn {
    const half_t* H1; half_t* H2; float* SS3; LAS float* red;
    __device__ __forceinline__ void operator()(const AccT& acc, const pg8::Unit& u, int wr, int wc, int fr_, int fq_) const {
        EPI_IDS();
#pragma unroll
        for (int ai = 0; ai < 2; ++ai) {
            u32x4 xr[4][2];
#pragma unroll
            for (int m = 0; m < 4; ++m)
#pragma unroll
                for (int bj = 0; bj < 2; ++bj) xr[m][bj] = *(const u32x4*)(H1 + (size_t)EPI_ROW(ai, m) * DM + u.pn * 256 + bj * 128 + wc * 32 + fq * 8);
#pragma unroll
            for (int m = 0; m < 4; ++m) { const int row = EPI_ROW(ai, m);
                float v[8], x[8], ss = 0.f;
#pragma unroll
                for (int bj = 0; bj < 2; ++bj) { EPI_GET8(v, ai, bj, m, 1.f); unpk8(xr[m][bj], x);
#pragma unroll
                    for (int i = 0; i < 8; ++i) { v[i] += x[i]; ss += v[i] * v[i]; }
                    *(u32x4*)(H2 + (size_t)row * DM + u.pn * 256 + bj * 128 + wc * 32 + fq * 8) = pk8(v); }
                ss += __shfl_xor(ss, 16); ss += __shfl_xor(ss, 32);
                if (fq == 0) red[(ai * 128 + wr * 64 + m * 16 + fr) * 4 + wc] = ss;
            }
        }
        asm volatile("s_waitcnt lgkmcnt(0)" ::: "memory"); __builtin_amdgcn_s_barrier();
        if (t_ < 256) { const f32x4 r4 = *(const LAS f32x4*)(red + t_ * 4); SS3[(size_t)(u.pm * 256 + t_) * 4 + u.pn] = sum4(r4); }
    }
};

constexpr int AT_KB = 0, AT_VB = 12288, AT_BUF = 20480;
constexpr int AT_SUB = 3;
constexpr int AT_STAGE = AT_SUB * AT_BUF;
constexpr int AT_IMP = 2 * AT_STAGE;
constexpr int AT_IMPW = 8 * 2 * 68 * 4;
constexpr int AT_SEL = AT_IMP + 8 * AT_IMPW;
constexpr int AT_QIDX = AT_SEL + 8 * 64;

struct TileRegs { u32x4 k, kp, v; };
__device__ __forceinline__ void tile_load(TileRegs& r, const half_t* Kt, const half_t* KPt, const half_t* Vt, int tid, int wid, int lane) {
    r.k = *(const u32x4*)(Kt + (size_t)(tid & 63) * 64 + wid * 8);
    if (KPt != nullptr && tid < 256) r.kp = *(const u32x4*)(KPt + (size_t)(tid & 63) * 32 + wid * 8);
    r.v = *(const u32x4*)(Vt + (size_t)(16 * (wid & 3) + (lane >> 2)) * 64 + (wid >> 2) * 32 + (lane & 3) * 8);
}
__device__ __forceinline__ void tile_store(const TileRegs& r, LAS unsigned char* buf, bool haspe, int tid, int wid, int lane) {
    *(LAS u32x4*)(buf + AT_KB + wid * 1024 + lane * 16) = r.k;
    if (haspe && tid < 256) *(LAS u32x4*)(buf + AT_KB + (8 + wid) * 1024 + lane * 16) = r.kp;
    *(LAS u32x4*)(buf + AT_VB + wid * 1024 + lane * 16) = r.v;
}
__device__ __forceinline__ float xhalf_max(float v) { const auto rr = __builtin_amdgcn_permlane32_swap(__float_as_uint(v), __float_as_uint(v), false, false); return fmaxf(__uint_as_float(rr[0]), __uint_as_float(rr[1])); }
__device__ __forceinline__ float xhalf_sum(float v) { const auto rr = __builtin_amdgcn_permlane32_swap(__float_as_uint(v), __float_as_uint(v), false, false); return __uint_as_float(rr[0]) + __uint_as_float(rr[1]); }
template <int NKS, int AB = 0>
__device__ __forceinline__ void tile_qk(const LAS unsigned char* kb, const half8 (&qf)[NKS], const f32x16& cinit, f32x16& p0, f32x16& p1) {
    if (AB & 1) { p0 = cinit; p1 = cinit; p0[0] += (float)qf[0][0]; p1[3] += (float)qf[1][1]; if (!(AB & 8)) { const half8 a = *(const LAS half8*)kb; p0[1] += (float)a[0]; } return; }
    half8 kf[2 * NKS];
#pragma unroll
    for (int ks = 0; ks < NKS; ++ks) { kf[2 * ks] = *(const LAS half8*)(kb + ks * 2048); kf[2 * ks + 1] = *(const LAS half8*)(kb + ks * 2048 + 512); }
    __builtin_amdgcn_sched_barrier(0);
    p0 = __builtin_amdgcn_mfma_f32_32x32x16_f16(kf[0], qf[0], cinit, 0, 0, 0);
    p1 = __builtin_amdgcn_mfma_f32_32x32x16_f16(kf[1], qf[0], cinit, 0, 0, 0);
#pragma unroll
    for (int ks = 1; ks < NKS; ++ks) {
        p0 = __builtin_amdgcn_mfma_f32_32x32x16_f16(kf[2 * ks], qf[ks], p0, 0, 0, 0);
        p1 = __builtin_amdgcn_mfma_f32_32x32x16_f16(kf[2 * ks + 1], qf[ks], p1, 0, 0, 0);
    }
}
__device__ __forceinline__ void tile_emask(f32x16& p0, f32x16& p1, int hiL, int loL) {
#pragma unroll
    for (int r = 0; r < 16; ++r) { const int c = (r & 3) + 8 * (r >> 2);
        if (!(c <= hiL && c >= loL)) p0[r] = -INFINITY;
        if (!(c + 32 <= hiL && c + 32 >= loL)) p1[r] = -INFINITY; }
}
__device__ __forceinline__ float tile_rowmax(const f32x16& p0, const f32x16& p1) {
    float a = fmaxf(fmaxf(p0[0], p0[1]), p0[2]), b = fmaxf(fmaxf(p1[0], p1[1]), p1[2]);
#pragma unroll
    for (int r = 3; r < 15; r += 2) { a = fmaxf(fmaxf(a, p0[r]), p0[r + 1]); b = fmaxf(fmaxf(b, p1[r]), p1[r + 1]); }
    a = fmaxf(fmaxf(a, p0[15]), fmaxf(b, p1[15]));
    return xhalf_max(a);
}
struct VFrags { v4i16 f[16]; };
__device__ __forceinline__ void vfrag_load(VFrags& V, const LAS unsigned char* vb) {
#pragma unroll
    for (int i = 0; i < 8; ++i) {
        V.f[2 * i]     = __builtin_amdgcn_ds_read_tr16_b64_v4i16((LAS v4i16*)(vb + (i >> 2) * 4096 + (i & 3) * 1024));
        V.f[2 * i + 1] = __builtin_amdgcn_ds_read_tr16_b64_v4i16((LAS v4i16*)(vb + (i >> 2) * 4096 + (i & 3) * 1024 + 512));
    }
}
__device__ __forceinline__ void tile_pv(const f32x16& p0, const f32x16& p1, const VFrags& V, f32x16 (&o)[2]) {
    u32x4 pw[4];
#pragma unroll
    for (int s = 0; s < 2; ++s) {
        pw[s]     = (u32x4){pk_rtz(p0[8 * s], p0[8 * s + 1]), pk_rtz(p0[8 * s + 2], p0[8 * s + 3]), pk_rtz(p0[8 * s + 4], p0[8 * s + 5]), pk_rtz(p0[8 * s + 6], p0[8 * s + 7])};
        pw[2 + s] = (u32x4){pk_rtz(p1[8 * s], p1[8 * s + 1]), pk_rtz(p1[8 * s + 2], p1[8 * s + 3]), pk_rtz(p1[8 * s + 4], p1[8 * s + 5]), pk_rtz(p1[8 * s + 6], p1[8 * s + 7])};
    }
    typedef short s8 __attribute__((ext_vector_type(8)));
#pragma unroll
    for (int db = 0; db < 2; ++db)
#pragma unroll
        for (int ks = 0; ks < 4; ++ks) {
            const v4i16 lo = V.f[2 * (db * 4 + ks)], hi = V.f[2 * (db * 4 + ks) + 1];
            const s8 t = {lo[0], lo[1], lo[2], lo[3], hi[0], hi[1], hi[2], hi[3]};
            o[db] = __builtin_amdgcn_mfma_f32_32x32x16_f16(__builtin_bit_cast(half8, t), __builtin_bit_cast(half8, pw[ks]), o[db], 0, 0, 0);
        }
}
constexpr float SM_THR = 6.f;
struct SmState { f32x16 negm; float mref, l; };
__device__ __forceinline__ void sm_reset(SmState& S) { S.negm = (f32x16){0.f}; S.mref = 0.f; S.l = 0.f; }
template <int AB = 0>
__device__ __forceinline__ void tile_softmax_pv(f32x16& p0, f32x16& p1, const LAS unsigned char* vb, f32x16 (&o)[2], SmState& S, bool first) {
    VFrags V; if (!(AB & 4)) vfrag_load(V, vb);
    if (!(AB & 2)) {
        const float tm = tile_rowmax(p0, p1);
        const bool need = first ? (tm > -INFINITY) : (tm > SM_THR);
        if (__any(need)) {
            const float delta = need ? tm : 0.f, alpha = __builtin_amdgcn_exp2f(-delta);
            S.mref += delta; S.l *= alpha;
#pragma unroll
            for (int r = 0; r < 16; ++r) { p0[r] -= delta; p1[r] -= delta; o[0][r] *= alpha; o[1][r] *= alpha; S.negm[r] = -S.mref; }
        }
        float s0 = 0.f, s1 = 0.f, s2 = 0.f, s3 = 0.f;
#pragma unroll
        for (int r = 0; r < 16; ++r) { p0[r] = __builtin_amdgcn_exp2f(p0[r]); p1[r] = __builtin_amdgcn_exp2f(p1[r]); }
#pragma unroll
        for (int r = 0; r < 16; r += 2) { s0 += p0[r]; s1 += p0[r + 1]; s2 += p1[r]; s3 += p1[r + 1]; }
        S.l += (s0 + s1) + (s2 + s3);
    }
    if (!(AB & 4)) tile_pv(p0, p1, V, o); else { _Pragma("unroll") for (int r = 0; r < 16; ++r) { o[0][r & 3] += p0[r]; o[1][r & 3] += p1[r]; } }
}

__device__ __forceinline__ void glds16(const void* gsrc, unsigned lds_dst) { unsigned keep;
    asm volatile("s_mov_b32 %0, m0\n\ts_mov_b32 m0, %2\n\ts_nop 0\n\tglobal_load_lds_dwordx4 %1, off\n\ts_mov_b32 m0, %0" : "=&s"(keep) : "v"(gsrc), "s"(lds_dst) : "memory"); }
__device__ __forceinline__ unsigned lds_addr(const LAS unsigned char* p) { return (unsigned)__builtin_amdgcn_readfirstlane((int)(unsigned)(size_t)p); }
__device__ __forceinline__ void tile_dma(const half_t* Kt, const half_t* KPt, const half_t* Vt, LAS unsigned char* sub, bool haspe, int wid, int lane) {
    const unsigned base = lds_addr(sub);
    glds16(Kt + wid * 512 + lane * 8, base + AT_KB + wid * 1024);
    if (haspe && wid < 4) glds16(KPt + wid * 512 + lane * 8, base + AT_KB + (8 + wid) * 1024);
    glds16(Vt + wid * 512 + lane * 8, base + AT_VB + wid * 1024);
}
#ifndef AT_STAGGER
#define AT_STAGGER 7
#endif
#ifndef AT_STAGGER_MASK
#define AT_STAGGER_MASK 4
#endif
#define AT_WAITBAR() do { asm volatile("s_waitcnt vmcnt(0) lgkmcnt(0)" ::: "memory"); __builtin_amdgcn_s_barrier(); } while (0)
#define KV_STREAM(NT, DMAT, COMPT) do { \
    const int nt__ = (NT), nst__ = (nt__ + AT_SUB - 1) / AT_SUB; \
    _Pragma("unroll") for (int j_ = 0; j_ < AT_SUB; ++j_) if (j_ < nt__) { DMAT(j_, lds + j_ * AT_BUF); } \
    AT_WAITBAR(); \
    for (int s_ = 0; s_ < nst__; ++s_) { \
        LAS unsigned char* cb_ = lds + (s_ & 1) * AT_STAGE; LAS unsigned char* nb_ = lds + ((s_ + 1) & 1) * AT_STAGE; \
        _Pragma("unroll") for (int j_ = 0; j_ < AT_SUB; ++j_) { const int tn_ = (s_ + 1) * AT_SUB + j_; if (tn_ < nt__) { DMAT(tn_, nb_ + j_ * AT_BUF); } } \
        _Pragma("unroll") for (int j_ = 0; j_ < AT_SUB; ++j_) { const int tc_ = s_ * AT_SUB + j_; if (tc_ < nt__) { COMPT(tc_, cb_ + j_ * AT_BUF); } } \
        AT_WAITBAR(); \
    } } while (0)

struct AttnPtrs {
    const half_t* QM; const half_t* KNM; const half_t* KPE; const half_t* VM;
    const half_t* QN; const half_t* KC; const half_t* VC; const half_t* KS; const half_t* VS; const half_t* KW; const half_t* VW; const float* GATE;
    half_t* Y; float* SSM; float* SSN;
};

template <int AB = 0>
__device__ __forceinline__ void mla_unit(const AttnPtrs& P, int bh, int qb, LAS unsigned char* lds, bool nostore = false) {
    int tid_ = threadIdx.x; asm volatile("" : "+v"(tid_));
    const int tid = tid_, lane = tid & 63, wid = __builtin_amdgcn_readfirstlane(tid >> 6), q = lane & 31, h = lane >> 5;
    const int b = bh >> 3, hd = bh & 7, q0 = qb * 256, qpos = q0 + wid * 32 + q;
    const size_t trow = (size_t)b * SEQ + qpos;
    half8 qf[6];
#pragma unroll
    for (int ks = 0; ks < 6; ++ks) qf[ks] = *(const half8*)(P.QM + trow * 768 + hd * 96 + ks * 16 + h * 8);
#pragma unroll
    for (int ks = 0; ks < 6; ++ks) asm volatile("" : "+v"(qf[ks]));
    const half_t* Kb = P.KNM + (size_t)bh * SEQ * 64; const half_t* Vb = P.VM + (size_t)bh * SEQ * 64; const half_t* KPb = P.KPE + (size_t)b * SEQ * 32;
    const int ntiles = 4 * qb + 4, my_last = 4 * qb + (wid >> 1);
    f32x16 o[2]; o[0] = (f32x16){0.f}; o[1] = (f32x16){0.f};
    SmState S; sm_reset(S);
    const int koff = h * 1024 + q * 16, voff = (4 * h + ((lane & 15) >> 2)) * 64 + ((lane >> 4) & 1) * 32 + (lane & 3) * 8;
#define MLA_LOAD(t, sub) if (!(AB & 16)) tile_dma(Kb + (size_t)(t) * 4096, KPb + (size_t)(t) * 2048, Vb + (size_t)(t) * 4096, sub, true, wid, lane)
#define MLA_COMP(t, buf) do { if ((t) <= my_last) { f32x16 p0, p1; \
        tile_qk<6, AB>((buf) + AT_KB + koff, qf, S.negm, p0, p1); \
        if ((t) == my_last) tile_emask(p0, p1, qpos - 64 * (t) - 4 * h, -1000); \
        tile_softmax_pv<AB>(p0, p1, (buf) + AT_VB + voff, o, S, (t) == 0); } } while (0)
    KV_STREAM(ntiles, MLA_LOAD, MLA_COMP);
#undef MLA_LOAD
#undef MLA_COMP
    const float l = xhalf_sum(S.l);
    const float inv = 1.f / l;
    if (nostore && !(l == 123.456f)) return;
    float ss = 0.f;
    half_t* yrow = P.Y + trow * DM + hd * 64;
#pragma unroll
    for (int db = 0; db < 2; ++db)
#pragma unroll
        for (int c = 0; c < 4; ++c) { const float a0 = o[db][4 * c] * inv, a1 = o[db][4 * c + 1] * inv, a2 = o[db][4 * c + 2] * inv, a3 = o[db][4 * c + 3] * inv;
            ss += (a0 * a0 + a1 * a1) + (a2 * a2 + a3 * a3);
            *(u32x2*)(yrow + db * 32 + 8 * c + 4 * h) = (u32x2){pk_rne(a0, a1), pk_rne(a2, a3)}; }
    ss = xhalf_sum(ss);
    if (h == 0) P.SSM[trow * 8 + hd] = ss;
}

template <int NKS_unused = 4>
__device__ __forceinline__ void nsa_stream_begin(TileRegs& tr, const half_t* Kt, const half_t* Vt, LAS unsigned char* lds, int tid, int wid, int lane) {
    tile_load(tr, Kt, nullptr, Vt, tid, wid, lane);
    tile_store(tr, lds, false, tid, wid, lane);
    __syncthreads();
}
__device__ __forceinline__ void nsa_unit(const AttnPtrs& P, int bg, int qb, LAS unsigned char* lds) {
    int tid_ = threadIdx.x; asm volatile("" : "+v"(tid_));
    const int tid = tid_, lane = tid & 63, wid = __builtin_amdgcn_readfirstlane(tid >> 6), j = lane & 31, h = lane >> 5;
    const int b = bg >> 1, g = bg & 1, q0 = qb * 64, cur = qb, qi = j >> 2, hh = j & 3, qrel = wid * 8 + qi, qpos = q0 + qrel, head = g * 4 + hh;
    const size_t trow = (size_t)b * SEQ + qpos;
    half8 qf[4];
#pragma unroll
    for (int ks = 0; ks < 4; ++ks) qf[ks] = *(const half8*)(P.QN + trow * 512 + head * 64 + ks * 16 + h * 8);
    float g0 = P.GATE[trow * 24 + head], g1 = P.GATE[trow * 24 + 8 + head], g2 = P.GATE[trow * 24 + 16 + head];
#pragma unroll
    for (int ks = 0; ks < 4; ++ks) asm volatile("" : "+v"(qf[ks]));
    asm volatile("" : "+v"(g0), "+v"(g1), "+v"(g2));
    const int koff = h * 1024 + j * 16, voff = (4 * h + ((lane & 15) >> 2)) * 64 + ((lane >> 4) & 1) * 32 + (lane & 3) * 8;
    f32x16 acc[2]; acc[0] = (f32x16){0.f}; acc[1] = (f32x16){0.f};
    f32x16 o[2];
    LAS float* impw = (LAS float*)(lds + AT_IMP + wid * AT_IMPW);
    unsigned long long selmask = (2ull << cur) - 1ull;

    const int ncmp = ((q0 + 32) >> 4) / 64 + 1;
    const half_t* Kc = P.KC + (size_t)bg * 256 * 64; const half_t* Vc = P.VC + (size_t)bg * 256 * 64;
    float m = -1e30f, l = 0.f; const f32x16 zero16 = (f32x16){0.f};
#define CMP_LOAD(t, sub) tile_dma(Kc + (size_t)(t) * 4096, nullptr, Vc + (size_t)(t) * 4096, sub, false, wid, lane)
#define CMP1_COMP(t, buf) do { f32x16 p0, p1; \
        tile_qk<4>((buf) + AT_KB + koff, qf, zero16, p0, p1); \
        tile_emask(p0, p1, ((qpos - 31 - 1024 * (t)) >> 4) - 4 * h, -1000); \
        const float tm = tile_rowmax(p0, p1), mn = fmaxf(m, tm), alpha = __builtin_amdgcn_exp2f(m - mn); \
        float sum = 0.f; \
        _Pragma("unroll") for (int r = 0; r < 16; ++r) sum += __builtin_amdgcn_exp2f(p0[r] - mn) + __builtin_amdgcn_exp2f(p1[r] - mn); \
        l = l * alpha + sum; m = mn; } while (0)
    KV_STREAM(ncmp, CMP_LOAD, CMP1_COMP);
    l = xhalf_sum(l);
    const float invl = (l > 0.f) ? 1.f / l : 0.f;
    o[0] = (f32x16){0.f}; o[1] = (f32x16){0.f};
#define CMP2_COMP(t, buf) do { f32x16 p0, p1; \
        VFrags V; vfrag_load(V, (buf) + AT_VB + voff); \
        tile_qk<4>((buf) + AT_KB + koff, qf, zero16, p0, p1); \
        tile_emask(p0, p1, ((qpos - 31 - 1024 * (t)) >> 4) - 4 * h, -1000); \
        _Pragma("unroll") for (int r = 0; r < 16; ++r) { p0[r] = __builtin_amdgcn_exp2f(p0[r] - m) * invl; p1[r] = __builtin_amdgcn_exp2f(p1[r] - m) * invl; } \
        if (cur >= 16) { \
            _Pragma("unroll") for (int kb = 0; kb < 2; ++kb) \
            _Pragma("unroll") for (int c = 0; c < 4; ++c) { \
                const f32x16& p = kb ? p1 : p0; \
                float C = (p[4 * c] + p[4 * c + 1]) + (p[4 * c + 2] + 0.5f * p[4 * c + 3]), D = 0.5f * p[4 * c + 3]; \
                C += __shfl_xor(C, 1); C += __shfl_xor(C, 2); D += __shfl_xor(D, 1); D += __shfl_xor(D, 2); \
                const int jb = 16 * (t) + 8 * kb + 2 * c + h; \
                if (hh == 0) { impw[qi * 136 + jb] = C; impw[qi * 136 + 68 + jb + 1] = D; } } } \
        tile_pv(p0, p1, V, o); } while (0)
    KV_STREAM(ncmp, CMP_LOAD, CMP2_COMP);
#undef CMP_LOAD
#undef CMP1_COMP
#undef CMP2_COMP
#pragma unroll
    for (int r = 0; r < 16; ++r) { acc[0][r] = g0 * o[0][r]; acc[1][r] = g0 * o[1][r]; }

    if (cur >= 16) {
        const int tq = lane >> 3, e = lane & 7;
        float v[8];
#pragma unroll
        for (int i = 0; i < 8; ++i) { const int jb = e + 8 * i; const float s = impw[tq * 136 + jb] + impw[tq * 136 + 68 + jb];
            v[i] = (jb >= 1 && jb <= cur - 2) ? s : -1.f; }
        unsigned selb = 0u;
        for (int it = 0; it < 13; ++it) {
            float lm = v[0];
#pragma unroll
            for (int i = 1; i < 8; ++i) lm = fmaxf(lm, v[i]);
            float gm = fmaxf(lm, __shfl_xor(lm, 1)); gm = fmaxf(gm, __shfl_xor(gm, 2)); gm = fmaxf(gm, __shfl_xor(gm, 4));
            int cj = 99;
#pragma unroll
            for (int i = 7; i >= 0; --i) cj = (v[i] == gm) ? (e + 8 * i) : cj;
            int gj = min(cj, __shfl_xor(cj, 1)); gj = min(gj, __shfl_xor(gj, 2)); gj = min(gj, __shfl_xor(gj, 4));
#pragma unroll
            for (int i = 0; i < 8; ++i) if (gj == e + 8 * i) { v[i] = -2.f; selb |= 1u << i; }
        }
        unsigned lo = 0u, hi = 0u;
#pragma unroll
        for (int i = 0; i < 4; ++i) { lo |= ((selb >> i) & 1u) << (e + 8 * i); hi |= ((selb >> (i + 4)) & 1u) << (e + 8 * i); }
        lo |= __shfl_xor(lo, 1); lo |= __shfl_xor(lo, 2); lo |= __shfl_xor(lo, 4);
        hi |= __shfl_xor(hi, 1); hi |= __shfl_xor(hi, 2); hi |= __shfl_xor(hi, 4);
        unsigned long long mk = ((unsigned long long)hi << 32) | lo;
        mk |= 1ull | (1ull << cur) | (1ull << (cur - 1));
        LAS unsigned long long* selw = (LAS unsigned long long*)(lds + AT_SEL + wid * 64);
        if (e == 0) selw[tq] = mk;
        selmask = selw[qi];
    }

    {
        const half_t* Ks = P.KS + (size_t)bg * SEQ * 64; const half_t* Vs = P.VS + (size_t)bg * SEQ * 64;
        SmState S; sm_reset(S); bool seen = false; o[0] = (f32x16){0.f}; o[1] = (f32x16){0.f};
#define SLC_LOAD(t, sub) tile_dma(Ks + (size_t)(t) * 4096, nullptr, Vs + (size_t)(t) * 4096, sub, false, wid, lane)
#define SLC_COMP(t, buf) do { const bool rowsel = (selmask >> (t)) & 1ull; \
            if (__any(rowsel)) { f32x16 p0, p1, ci; \
                _Pragma("unroll") for (int r = 0; r < 16; ++r) ci[r] = rowsel ? S.negm[r] : -INFINITY;     \
                tile_qk<4>((buf) + AT_KB + koff, qf, ci, p0, p1); \
                if ((t) == cur) tile_emask(p0, p1, qrel - 4 * h, -1000); \
                tile_softmax_pv(p0, p1, (buf) + AT_VB + voff, o, S, !seen); seen = seen || rowsel; } } while (0)
        KV_STREAM(cur + 1, SLC_LOAD, SLC_COMP);
#undef SLC_LOAD
#undef SLC_COMP
        const float sc = g1 / xhalf_sum(S.l);
#pragma unroll
        for (int r = 0; r < 16; ++r) { acc[0][r] += sc * o[0][r]; acc[1][r] += sc * o[1][r]; }
    }
    {
        const int t0 = (cur >= 8) ? cur - 8 : 0;
        const half_t* Kw = P.KW + ((size_t)bg * SEQ + (size_t)t0 * 64) * 64; const half_t* Vw = P.VW + ((size_t)bg * SEQ + (size_t)t0 * 64) * 64;
        SmState S; sm_reset(S); o[0] = (f32x16){0.f}; o[1] = (f32x16){0.f};
#define WIN_LOAD(i, sub) tile_dma(Kw + (size_t)(i) * 4096, nullptr, Vw + (size_t)(i) * 4096, sub, false, wid, lane)
#define WIN_COMP(i, buf) do { const int t = t0 + (i); f32x16 p0, p1; \
            tile_qk<4>((buf) + AT_KB + koff, qf, S.negm, p0, p1); \
            if (t == cur) tile_emask(p0, p1, qrel - 4 * h, -1000); \
            else if (t == cur - 8) tile_emask(p0, p1, 1000, qrel + 1 - 4 * h); \
            tile_softmax_pv(p0, p1, (buf) + AT_VB + voff, o, S, (i) == 0); } while (0)
        KV_STREAM(cur - t0 + 1, WIN_LOAD, WIN_COMP);
#undef WIN_LOAD
#undef WIN_COMP
        const float sc = g2 / xhalf_sum(S.l);
#pragma unroll
        for (int r = 0; r < 16; ++r) { acc[0][r] += sc * o[0][r]; acc[1][r] += sc * o[1][r]; }
    }
    float ss = 0.f;
    half_t* yrow = P.Y + trow * DM + 512 + head * 64;
#pragma unroll
    for (int db = 0; db < 2; ++db)
#pragma unroll
        for (int c = 0; c < 4; ++c) { const float a0 = acc[db][4 * c], a1 = acc[db][4 * c + 1], a2 = acc[db][4 * c + 2], a3 = acc[db][4 * c + 3];
            ss += (a0 * a0 + a1 * a1) + (a2 * a2 + a3 * a3);
            *(u32x2*)(yrow + db * 32 + 8 * c + 4 * h) = (u32x2){pk_rne(a0, a1), pk_rne(a2, a3)}; }
    ss = xhalf_sum(ss);
    if (h == 0) P.SSN[trow * 8 + head] = ss;
}

struct Args { const float* in[24]; float* out; unsigned char* ws; int ph_lo, ph_hi, li, pad; };

template <class SrcFn>
__device__ __forceinline__ void conv_wt(const float* W, int Ksrc, int Nsrc, const float* gain, const float* gain2, int ksplit, half_t* WT, int Ndst, int Kdst, SrcFn src, LAS float* scr, int gw, int ngw, int lane) {
    const int nblk = Ndst / 32, nitems = nblk * (Kdst / 64);
    for (int it = gw; it < nitems; it += ngw) {
        const int kb = it / nblk, nb = it % nblk, k0 = 64 * kb, n0 = 32 * nb;
        const int sc = src(n0 + (lane & 31));
#pragma unroll 8
        for (int i = 0; i < 32; ++i) { const int kk = 2 * i + (lane >> 5), k = k0 + kk;
            const int kc = k < Ksrc ? k : Ksrc - 1, scc = sc >= 0 ? sc : 0;
            float v = W[(size_t)kc * Nsrc + scc];
            if (gain) v *= (gain2 && kc >= ksplit) ? gain2[kc - ksplit] : gain[kc];
            scr[kk * 33 + (lane & 31)] = (sc >= 0 && k < Ksrc) ? v : 0.f; }
        asm volatile("s_waitcnt lgkmcnt(0)" ::: "memory");
        const int c = lane & 7;
#pragma unroll
        for (int jj = 0; jj < 4; ++jj) { const int n = (lane >> 3) + 8 * jj; const LAS float* s = scr + (8 * c) * 33 + n; float v[8];
#pragma unroll
            for (int e = 0; e < 8; ++e) v[e] = s[e * 33];
            *(u32x4*)(WT + (size_t)(n0 + n) * Kdst + k0 + 8 * c) = pk8(v); }
        asm volatile("s_waitcnt lgkmcnt(0)" ::: "memory");
    }
}
__device__ __forceinline__ int src_win(int n) {
    const int t = n >> 8, c = n & 255;
    if (t == 0) return c;
    if (t == 1) { if (c < 128) return 256 + c;
                  if (c < 160) { const int p = c - 128; return 384 + (p >> 1) + 16 * (p & 1); }
                  if (c < 184) return 1696 + (c - 160);
                  return -1; }
    if (t < 4) { const int hd = (t - 2) * 4 + (c >> 6), p = c & 63; const int d = (p < 16) ? (p >> 1) + 8 * (p & 1) : p; return 416 + hd * 64 + d; }
    const int br = (t - 4) * 2 + (c >> 7), g = (c >> 6) & 1, p = c & 63;
    const bool roped = (br == 2 || br == 4);
    const int d = (roped && p < 16) ? (p >> 1) + 8 * (p & 1) : p;
    return 928 + br * 128 + g * 64 + d;
}
__device__ __forceinline__ int src_wuq(int n) { const int hd = n / 96, p = n % 96; return (p < 64) ? hd * 96 + p : hd * 96 + 64 + ((p - 64) >> 1) + 16 * ((p - 64) & 1); }
__device__ __forceinline__ int src_wukv(int n) { return (n < 512) ? (n >> 6) * 128 + (n & 63) : ((n - 512) >> 6) * 128 + 64 + (n & 63); }

#define PH_IDS() int tid_ = threadIdx.x; asm volatile("" : "+v"(tid_)); const int tid = tid_, lane = tid & 63, wid = __builtin_amdgcn_readfirstlane(tid >> 6); \
    const int G = gridDim.x, gt = blockIdx.x * 512 + tid, ngt = G * 512, gw = blockIdx.x * 8 + wid, ngw = G * 8; (void)lane; (void)gt; (void)ngt; (void)gw; (void)ngw; (void)G
#define WSP(T, off) ((T*)(ws + (off)))


__global__ void __launch_bounds__(512, 2) hymba_fwd(Args args) {
    extern __shared__ __attribute__((aligned(16))) unsigned char lds_raw[];
    LAS unsigned char* lds = (LAS unsigned char*)lds_raw;
    unsigned char* ws = args.ws;
    volatile LAS unsigned* MISC = (volatile LAS unsigned*)(lds + LDS_MISC);
    if (threadIdx.x < 16) MISC[threadIdx.x] = 0u;
    __syncthreads();
    XcdBarrier bar = xcd_barrier_post(WSP(unsigned, WS_CTL) + CW_BAR + args.li * XCD_BAR_WORDS, MISC + 8);
#if defined(DBG_STAMP)
#define STAMP_FIRST() STAMP(0)
#define STAMP(k) do { if (blockIdx.x == 0 && threadIdx.x == 0) ((unsigned long long*)(WSP(unsigned, WS_CTL) + 160))[k] = __builtin_amdgcn_s_memrealtime(); } while (0)
#else
#define STAMP_FIRST() do { } while (0)
#define STAMP(k) do { } while (0)
#endif
    const int lo = args.ph_lo, hi = args.ph_hi;
    STAMP_FIRST();
#define IN(k) (lo <= (k) && (k) < hi)
#define REP_BEGIN(k) for (int rep_ = 0; rep_ < ((k) == REPEAT_PHASE ? 2 : 1); ++rep_) {
#define REP_END(k) if ((k) == REPEAT_PHASE && rep_ == 0) xcd_barrier(bar); }
#define SEAM(k) do { if (IN(k) && IN((k) + 1 + ((k) == 4))) xcd_barrier(bar); STAMP((k) + 1); } while (0)

    if (IN(0)) { REP_BEGIN(0)
        PH_IDS();
        LAS float* scr = (LAS float*)(lds + wid * 8448);
        const int BIG = 1 << 30;
        for (int step_ = 0; step_ < 2; ++step_) {
        if (((step_ ^ wid) & 1) == 0) {
        conv_wt(args.in[2], 1024, IN_COLS, args.in[1], nullptr, BIG, WSP(half_t, WS_WIN), NIN, 1024, [](int n) { return src_win(n); }, scr, (gw + ngw - 0 % ngw) % ngw, ngw, lane);
        conv_wt(args.in[4], 256, 768, args.in[3], nullptr, BIG, WSP(half_t, WS_WUQ), 768, 256, [](int n) { return src_wuq(n); }, scr, (gw + ngw - 896 % ngw) % ngw, ngw, lane);
        conv_wt(args.in[6], 128, 1024, args.in[5], nullptr, BIG, WSP(half_t, WS_WUKV), 1024, 256, [](int n) { return src_wukv(n); }, scr, (gw + ngw - 992 % ngw) % ngw, ngw, lane);
        conv_wt(args.in[8], 2048, 128, nullptr, nullptr, BIG, WSP(half_t, WS_WC1), 256, 2048, [](int n) { return n < 128 ? n : -1; }, scr, (gw + ngw - 1120 % ngw) % ngw, ngw, lane);
        conv_wt(args.in[13], 2048, 128, nullptr, nullptr, BIG, WSP(half_t, WS_WC1) + 256 * 2048, 256, 2048, [](int n) { return n < 128 ? n : -1; }, scr, (gw + ngw - 1376 % ngw) % ngw, ngw, lane);
        conv_wt(args.in[19], 1024, 1024, args.in[17], args.in[18], 512, WSP(half_t, WS_WO), 1024, 1024, [](int n) { return n; }, scr, gw, ngw, lane);
        conv_wt(args.in[21], 1024, 4096, args.in[20], nullptr, BIG, WSP(half_t, WS_WUP), 4096, 1024, [](int n) { return n; }, scr, (gw + ngw - 1632 % ngw) % ngw, ngw, lane);
        conv_wt(args.in[22], 4096, 1024, nullptr, nullptr, BIG, WSP(half_t, WS_WDN), 1024, 4096, [](int n) { return n; }, scr, (gw + ngw - 3680 % ngw) % ngw, ngw, lane);
        { float2* ROPEM = WSP(float2, WS_ROPEM); float2* ROPEN = WSP(float2, WS_ROPEN);
          for (int it = gt; it < SEQ * 16; it += ngt) { const int pos = it >> 4, i = it & 15; const float inv = expf(-logf(500000.f) * (float)(2 * i) / 32.f), a = (float)pos * inv; ROPEM[it] = make_float2(cosf(a), sinf(a)); }
          for (int it = gt; it < SEQ * 8; it += ngt) { const int pos = it >> 3, i = it & 7; const float inv = expf(-logf(500000.f) * (float)(2 * i) / 16.f), a = (float)pos * inv; ROPEN[it] = make_float2(cosf(a), sinf(a)); } }
        if (gw < 256) { const int kv = gw >> 7, jj = gw & 127; const float* pe = args.in[kv ? 12 : 7]; const float* w1 = args.in[kv ? 13 : 8]; const float* b1 = args.in[kv ? 14 : 9];
            float s = 0.f; for (int k = lane; k < 2048; k += 64) s += pe[k] * w1[(size_t)k * 128 + jj];
            s = wave_sum(s); if (lane == 0) WSP(float, WS_B1P)[gw] = b1[jj] + s; }
        } else
        { const float* x = args.in[0]; half_t* XH = WSP(half_t, WS_XH); float* RS1 = WSP(float, WS_RS1);
          for (int r0 = gw * 4; r0 < MROWS; r0 += ngw * 4) {
            f32x4 v[4][4]; float s[4];
#pragma unroll
            for (int rr = 0; rr < 4; ++rr) { const f32x4* xr = (const f32x4*)(x + (size_t)(r0 + rr) * DM) + lane;
#pragma unroll
                for (int jv = 0; jv < 4; ++jv) v[rr][jv] = xr[64 * jv]; }
#pragma unroll
            for (int rr = 0; rr < 4; ++rr) { float t = 0.f;
#pragma unroll
                for (int jv = 0; jv < 4; ++jv) t += (v[rr][jv][0] * v[rr][jv][0] + v[rr][jv][1] * v[rr][jv][1]) + (v[rr][jv][2] * v[rr][jv][2] + v[rr][jv][3] * v[rr][jv][3]);
                s[rr] = t; }
#pragma unroll
            for (int o = 1; o < 64; o <<= 1) {
#pragma unroll
                for (int rr = 0; rr < 4; ++rr) s[rr] += __shfl_xor(s[rr], o); }
#pragma unroll
            for (int rr = 0; rr < 4; ++rr) { u32x2* o8 = (u32x2*)(XH + (size_t)(r0 + rr) * DM) + lane;
#pragma unroll
                for (int jv = 0; jv < 4; ++jv) o8[64 * jv] = (u32x2){pk_rne(v[rr][jv][0], v[rr][jv][1]), pk_rne(v[rr][jv][2], v[rr][jv][3])};
                if (lane == 0) RS1[r0 + rr] = __builtin_amdgcn_rsqf(s[rr] * (1.f / DM) + NORM_EPS); }
          } }
        }
    REP_END(0) }
    SEAM(0);
    if (IN(1)) { REP_BEGIN(1)
        pg8::Gemm g{WSP(half_t, WS_XH), WSP(half_t, WS_WIN), 1024, 1024, 1024}; pg8::StaticOrder S; S.init(MROWS, NIN, gridDim.x, (int)blockIdx.x, 1024, 1024);
        EpiIn E{WSP(float, WS_RS1), WSP(half_t, WS_CQ), WSP(half_t, WS_T1), WSP(half_t, WS_KPE), WSP(float, WS_GATE), WSP(float, WS_SSQ), WSP(float, WS_SSKV), WSP(half_t, WS_QN), WSP(half_t, WS_KVT), WSP(float2, WS_ROPEM), WSP(float2, WS_ROPEN)};
        pg8::gemm_phase(lds, g, S, E);
    REP_END(1) }
    SEAM(1);
    if (IN(2)) { REP_BEGIN(2)
        { pg8::Gemm g{WSP(half_t, WS_CQ), WSP(half_t, WS_WUQ), 256, 256, 256}; pg8::StaticOrder S; S.init(MROWS, 768, gridDim.x, (int)blockIdx.x, 256, 256); EpiUq E{WSP(float, WS_SSQ), WSP(half_t, WS_QM), WSP(float2, WS_ROPEM)}; pg8::gemm_phase(lds, g, S, E); }
        { pg8::Gemm g{WSP(half_t, WS_T1), WSP(half_t, WS_WUKV), 256, 256, 256}; pg8::StaticOrder S; S.init(MROWS, 1024, gridDim.x, (int)blockIdx.x, 256, 256); EpiUkv E{WSP(float, WS_SSKV), WSP(half_t, WS_KNM), WSP(half_t, WS_VM)}; pg8::gemm_phase(lds, g, S, E); }
        { pg8::Gemm g{WSP(half_t, WS_KVT), WSP(half_t, WS_WC1), 512, 1024, 2048}; pg8::Cmp1Order S{(int)gridDim.x, (int)blockIdx.x}; EpiC1 E{WSP(float, WS_HIDP)}; pg8::gemm_phase(lds, g, S, E); }
    REP_END(2) }
    SEAM(2);
    if (IN(3)) { REP_BEGIN(3)
        PH_IDS();
        const float* B1P = WSP(float, WS_B1P); const float* HIDP = WSP(float, WS_HIDP); const float2* ROPEN = WSP(float2, WS_ROPEN);
        LAS float* w2s = (LAS float*)lds;
        LAS float* hl = (LAS float*)(lds + 65536 + wid * 4096);
        for (int i = tid; i < 2 * 128 * 64; i += 512) { const int kv = i >> 13, k = (i >> 6) & 127, p = i & 63; const int dsrc = (kv == 0 && p < 16) ? (p >> 1) + 8 * (p & 1) : p;
            w2s[i] = args.in[kv ? 15 : 10][k * 64 + dsrc]; }
        __syncthreads();
        for (int it = gw; it < 2 * 32 * 32; it += ngw) {
            const int kv = it >> 10, slab = (it >> 5) & 31, n0 = (it & 31) * 8;
            const float* b2 = args.in[kv ? 16 : 11];
            float hv[8][2][4];
#pragma unroll
            for (int rr = 0; rr < 8; ++rr)
#pragma unroll
                for (int c = 0; c < 2; ++c)
#pragma unroll
                    for (int ch = 0; ch < 4; ++ch) hv[rr][c][ch] = HIDP[((size_t)((kv * 32 + slab) * 4 + ch) * 256 + n0 + rr) * 128 + lane + 64 * c];
#pragma unroll
            for (int rr = 0; rr < 8; ++rr)
#pragma unroll
                for (int c = 0; c < 2; ++c) { const int col = lane + 64 * c; const float s = B1P[kv * 128 + col] + ((hv[rr][c][0] + hv[rr][c][1]) + (hv[rr][c][2] + hv[rr][c][3]));
                    const float z = 0.7978845608028654f * (s + 0.044715f * s * s * s), th = 1.f - 2.f / (1.f + __expf(2.f * z));
                    hl[rr * 128 + col] = 0.5f * s * (1.f + th); }
            asm volatile("s_waitcnt lgkmcnt(0)" ::: "memory");
            const int dsrc = (kv == 0 && lane < 16) ? (lane >> 1) + 8 * (lane & 1) : lane;
            float a[8];
#pragma unroll
            for (int rr = 0; rr < 8; ++rr) a[rr] = b2[dsrc];
            const LAS float* wk = w2s + kv * 8192 + lane;
#pragma unroll 4
            for (int k = 0; k < 128; k += 4) {
                const float w0 = wk[k * 64], w1 = wk[(k + 1) * 64], w2v = wk[(k + 2) * 64], w3 = wk[(k + 3) * 64];
#pragma unroll
                for (int rr = 0; rr < 8; ++rr) { const f32x4 hh = *(const LAS f32x4*)(hl + rr * 128 + k); a[rr] += (hh[0] * w0 + hh[1] * w1) + (hh[2] * w2v + hh[3] * w3); }
            }
            half_t* dst = (kv ? WSP(half_t, WS_VC) : WSP(half_t, WS_KC)) + (size_t)slab * 256 * 64;
#pragma unroll
            for (int rr = 0; rr < 8; ++rr) { const int n = n0 + rr; float v = a[rr];
                if (kv == 0) { const float pp = __shfl_xor(v, 1);
                    if (lane < 16) { const int e1 = 16 * n + 31; const float2 cs = ROPEN[(size_t)(e1 > 4095 ? 4095 : e1) * 8 + (lane >> 1)];
                        v = (lane & 1) ? (v * cs.x + pp * cs.y) : (v * cs.x - pp * cs.y); } }
                if (n >= 255) v = 0.f;
                dst[kv ? v_off(n, lane) : k_off(n, lane)] = (half_t)v; }
            asm volatile("s_waitcnt lgkmcnt(0)" ::: "memory");
        }
    REP_END(3) }
    SEAM(3);
    if (IN(4)) {
        half_t* KVT = WSP(half_t, WS_KVT);
        const AttnPtrs P{WSP(half_t, WS_QM), WSP(half_t, WS_KNM), WSP(half_t, WS_KPE), WSP(half_t, WS_VM), WSP(half_t, WS_QN), WSP(half_t, WS_KC), WSP(half_t, WS_VC),
                         KVT + 2 * KVT_STRIDE, KVT + 3 * KVT_STRIDE, KVT + 4 * KVT_STRIDE, KVT + 5 * KVT_STRIDE, WSP(float, WS_GATE), WSP(half_t, WS_Y), WSP(float, WS_SSM), WSP(float, WS_SSN)};
        volatile LAS int* qw = (volatile LAS int*)(lds + AT_QIDX);
        REP_BEGIN(4)
        unsigned* qhead = WSP(unsigned, WS_CTL) + CW_QHEAD + 64 * rep_;
        for (;;) {
            if (threadIdx.x == 0) *qw = (int)__hip_atomic_fetch_add(qhead, 1u, __ATOMIC_RELAXED, __HIP_MEMORY_SCOPE_AGENT);
            __syncthreads();
            const int qi = __builtin_amdgcn_readfirstlane(*qw);
            __syncthreads();
            if (qi >= 4096) break;
            const int L = qi >> 8, r = qi & 255;
#ifdef REP_FILTER
            if (rep_ == 1 && ((REP_FILTER == 1) != (r < 128))) continue;
#endif
            if (r < 128) { if (rep_ == 1) mla_unit<ABL>(P, r, 15 - L, lds, true); else mla_unit<0>(P, r, 15 - L, lds); }
            else { const int r2 = r - 128; nsa_unit(P, r2 & 31, 63 - 4 * L - (r2 >> 5), lds); }
        }
        REP_END(4)
    }
    SEAM(4);
    if (IN(6)) { REP_BEGIN(6) pg8::Gemm g{WSP(half_t, WS_Y), WSP(half_t, WS_WO), 1024, 1024, 1024}; pg8::StaticOrder S; S.init(MROWS, 1024, gridDim.x, (int)blockIdx.x, 1024, 1024); EpiWo E{WSP(half_t, WS_XH), WSP(half_t, WS_H1), WSP(float, WS_SS2), WSP(float, WS_SSM), WSP(float, WS_SSN), (LAS float*)(lds + LDS_RED)}; pg8::gemm_phase<EpiWo, pg8::StaticOrder, true>(lds, g, S, E); REP_END(6) }
    SEAM(6);
    if (IN(7)) { REP_BEGIN(7) pg8::Gemm g{WSP(half_t, WS_H1), WSP(half_t, WS_WUP), 1024, 1024, 1024}; pg8::StaticOrder S; S.init(MROWS, DFF, gridDim.x, (int)blockIdx.x, 1024, 1024); EpiUp E{WSP(float, WS_SS2), WSP(half_t, WS_A2)}; pg8::gemm_phase(lds, g, S, E); REP_END(7) }
    SEAM(7);
    if (IN(8)) { REP_BEGIN(8) pg8::Gemm g{WSP(half_t, WS_A2), WSP(half_t, WS_WDN), 4096, 4096, 4096}; pg8::StaticOrder S; S.init(MROWS, 1024, gridDim.x, (int)blockIdx.x, 4096, 4096); EpiDn E{WSP(half_t, WS_H1), WSP(half_t, WS_H2), WSP(float, WS_SS3), (LAS float*)(lds + LDS_RED)}; pg8::gemm_phase(lds, g, S, E); REP_END(8) }
    SEAM(8);
    if (IN(9)) { REP_BEGIN(9)
        PH_IDS();
        const float* gf = args.in[23]; const float* SS3 = WSP(float, WS_SS3); const half_t* H2 = WSP(half_t, WS_H2);
        const f32x4 ga0 = *(const f32x4*)(gf + lane * 8), gb0 = *(const f32x4*)(gf + lane * 8 + 4), ga1 = *(const f32x4*)(gf + 512 + lane * 8), gb1 = *(const f32x4*)(gf + 512 + lane * 8 + 4);
        for (int r0 = gw * 4; r0 < MROWS; r0 += ngw * 4) {
            u32x4 hv[4][2]; float rs[4];
#pragma unroll
            for (int rr = 0; rr < 4; ++rr) { const u32x4* hr = (const u32x4*)(H2 + (size_t)(r0 + rr) * DM) + lane; hv[rr][0] = hr[0]; hv[rr][1] = hr[64]; rs[rr] = __builtin_amdgcn_rsqf(sum4(*(const f32x4*)(SS3 + (size_t)(r0 + rr) * 4)) * (1.f / 1024.f) + NORM_EPS); }
#pragma unroll
            for (int rr = 0; rr < 4; ++rr) { f32x4* orow = (f32x4*)(args.out + (size_t)(r0 + rr) * DM); float v[8];
                unpk8(hv[rr][0], v);
                orow[lane * 2] = (f32x4){v[0] * rs[rr] * ga0[0], v[1] * rs[rr] * ga0[1], v[2] * rs[rr] * ga0[2], v[3] * rs[rr] * ga0[3]};
                orow[lane * 2 + 1] = (f32x4){v[4] * rs[rr] * gb0[0], v[5] * rs[rr] * gb0[1], v[6] * rs[rr] * gb0[2], v[7] * rs[rr] * gb0[3]};
                unpk8(hv[rr][1], v);
                orow[128 + lane * 2] = (f32x4){v[0] * rs[rr] * ga1[0], v[1] * rs[rr] * ga1[1], v[2] * rs[rr] * ga1[2], v[3] * rs[rr] * ga1[3]};
                orow[128 + lane * 2 + 1] = (f32x4){v[4] * rs[rr] * gb1[0], v[5] * rs[rr] * gb1[1], v[6] * rs[rr] * gb1[2], v[7] * rs[rr] * gb1[3]}; }
        }
    REP_END(9) }
    STAMP(10);
#undef IN
#undef SEAM
}

#if DBG_CHECK
constexpr int CW_DBG = 96;
__device__ __forceinline__ void dbg_flag(unsigned* ctl, int id, float got, float ref) {
    const float d = fabsf(got - ref);
    if (!(d <= 0.03f + 0.03f * fabsf(ref))) atomicOr(ctl + CW_DBG, 1u << id);
}
__device__ __forceinline__ float h2f(const half_t* p) { return (float)(*p); }
__device__ float dbg_rope_cs(int pos, int i, int dim, bool want_sin) { const float inv = expf(-logf(500000.f) * (float)(2 * i) / (float)dim), a = (float)pos * inv; return want_sin ? sinf(a) : cosf(a); }
__device__ float dbg_u(const Args& args, int row, int co, int lane) {
    const float* x = args.in[0] + (size_t)row * DM; const float* g = args.in[1]; const float* w = args.in[2];
    float ss = 0.f, acc = 0.f;
    for (int k = lane; k < DM; k += 64) { const float xv = x[k]; ss += xv * xv; acc += xv * g[k] * w[(size_t)k * IN_COLS + co]; }
    ss = wave_sum(ss); acc = wave_sum(acc);
    return acc * (1.f / sqrtf(ss / DM + NORM_EPS));
}
__device__ const int dbgt_0_dbg_rows[4] = {0, 4096 + 6, 30000, 65535};
__device__ const int dbgt_1_cs[3] = {0, 77, 255};
__device__ const int dbgt_2_cs[2] = {5, 127};
__device__ const int dbgt_3_ps[4] = {0, 1, 14, 31};
__device__ const int dbgt_4_is[3] = {0, 13, 23};
__device__ const int dbgt_5_hs[4] = {0, 3, 5, 7};
__device__ const int dbgt_6_ps[4] = {0, 1, 14, 40};
__device__ const int dbgt_7_brs[7] = {0, 1, 2, 2, 3, 4, 5};
__device__ const int dbgt_8_gs[7] = {0, 1, 0, 1, 0, 1, 1};
__device__ const int dbgt_9_ps[7] = {3, 20, 1, 50, 9, 14, 63};
__device__ const int dbgt_10_hs[4] = {0, 2, 5, 7};
__device__ const int dbgt_11_ps[4] = {3, 64, 77, 95};
__device__ const int dbgt_12_slabs[3] = {0, 17, 31};
__device__ const int dbgt_13_ns[3] = {0, 100, 254};
__device__ const int dbgt_14_ps[4] = {0, 1, 15, 40};
__device__ const int dbgt_15_bs[5] = {0, 0, 5, 15, 9};
__device__ const int dbgt_16_hs[5] = {0, 3, 7, 2, 5};
__device__ const int dbgt_17_qs[5] = {0, 100, 2047, 4095, 1234};
__device__ const int dbgt_18_bs[6] = {0, 3, 7, 15, 11, 2};
__device__ const int dbgt_19_gs[6] = {0, 1, 0, 1, 1, 0};
__device__ const int dbgt_20_hhs[6] = {0, 2, 3, 1, 0, 2};
__device__ const int dbgt_21_qs[6] = {5, 700, 1030, 4095, 2500, 3071};
__device__ const int dbgt_22_dd[3] = {0, 33, 63};
__device__ const int dbgt_23_c4[4] = {0, 1300, 2777, 4095};
__device__ const int dbgt_24_cols[4] = {0, 300, 777, 1023};
__device__ const int dbgt_25_cc[6] = {768, 896, 800, 776, 775, 1023};
__global__ void __launch_bounds__(512) dbg_checks_a(Args args) {
    extern __shared__ __attribute__((aligned(16))) unsigned char lds_raw[]; LAS unsigned char* lds = (LAS unsigned char*)lds_raw;
    unsigned char* ws = args.ws; unsigned* ctl = WSP(unsigned, WS_CTL);
    const int lane = threadIdx.x & 63, wid = threadIdx.x >> 6;
    const int* rows = dbgt_0_dbg_rows;
    const half_t* XH = WSP(half_t, WS_XH);
    if (blockIdx.x == 0) {
        if (wid == 0) for (int s = 0; s < 4; ++s) { const int r = rows[s]; const float* x = args.in[0] + (size_t)r * DM; float ss = 0.f; for (int k = lane; k < DM; k += 64) ss += x[k] * x[k]; ss = wave_sum(ss);
            if (lane == 0) { dbg_flag(ctl, 1, WSP(float, WS_RS1)[r], 1.f / sqrtf(ss / DM + NORM_EPS)); dbg_flag(ctl, 1, h2f(XH + (size_t)r * DM + 517), x[517]); } }
        if (wid == 1) for (int s = 0; s < 4; ++s) { const int r = rows[s], pos = r & 4095, b = r >> 12;
            { const int* cs = dbgt_1_cs; for (int i = 0; i < 3; ++i) { const float u = dbg_u(args, r, cs[i], lane); if (lane == 0) dbg_flag(ctl, 2, h2f(WSP(half_t, WS_CQ) + (size_t)r * 256 + cs[i]), u); } }
            { const int* cs = dbgt_2_cs; for (int i = 0; i < 2; ++i) { const float u = dbg_u(args, r, 256 + cs[i], lane); if (lane == 0) dbg_flag(ctl, 3, h2f(WSP(half_t, WS_T1) + (size_t)r * 256 + cs[i]), u); } }
            { const int* ps = dbgt_3_ps; for (int i = 0; i < 4; ++i) { const int p = ps[i], pr = p >> 1; const float x1 = dbg_u(args, r, 384 + pr, lane), x2 = dbg_u(args, r, 384 + pr + 16, lane);
                const float c = dbg_rope_cs(pos, pr, 32, false), sn = dbg_rope_cs(pos, pr, 32, true); const float ref = (p & 1) ? (x2 * c + x1 * sn) : (x1 * c - x2 * sn);
                if (lane == 0) dbg_flag(ctl, 4, h2f(WSP(half_t, WS_KPE) + (size_t)b * SEQ * 32 + kpe_off(pos, p)), ref); } }
            { const int* is = dbgt_4_is; for (int i = 0; i < 3; ++i) { const float u = dbg_u(args, r, 1696 + is[i], lane); if (lane == 0) dbg_flag(ctl, 5, WSP(float, WS_GATE)[(size_t)r * 24 + is[i]], 1.f / (1.f + expf(-u))); } }
            { const int* hs = dbgt_5_hs; const int* ps = dbgt_6_ps; for (int i = 0; i < 4; ++i) { const int hd = hs[i], p = ps[i]; float ref;
                if (p < 16) { const int pr = p >> 1; const float x1 = dbg_u(args, r, 416 + hd * 64 + pr, lane), x2 = dbg_u(args, r, 416 + hd * 64 + pr + 8, lane);
                    const float c = dbg_rope_cs(pos, pr, 16, false), sn = dbg_rope_cs(pos, pr, 16, true); ref = (p & 1) ? (x2 * c + x1 * sn) : (x1 * c - x2 * sn); }
                else ref = dbg_u(args, r, 416 + hd * 64 + p, lane);
                if (lane == 0) dbg_flag(ctl, 6, h2f(WSP(half_t, WS_QN) + (size_t)r * 512 + hd * 64 + p), ref * QS_N); } }
            { const int* brs = dbgt_7_brs; const int* gs = dbgt_8_gs; const int* ps = dbgt_9_ps;
              for (int i = 0; i < 7; ++i) { const int br = brs[i], g = gs[i], p = ps[i]; const int base = 928 + br * 128 + g * 64; float ref;
                if ((br == 2 || br == 4) && p < 16) { const int pr = p >> 1; const float x1 = dbg_u(args, r, base + pr, lane), x2 = dbg_u(args, r, base + pr + 8, lane);
                    const float c = dbg_rope_cs(pos, pr, 16, false), sn = dbg_rope_cs(pos, pr, 16, true); ref = (p & 1) ? (x2 * c + x1 * sn) : (x1 * c - x2 * sn); }
                else ref = dbg_u(args, r, base + p, lane);
                if (lane == 0) dbg_flag(ctl, 7, h2f(WSP(half_t, WS_KVT) + (size_t)br * KVT_STRIDE + (size_t)(b * 2 + g) * SEQ * 64 + (br < 2 ? (size_t)pos * 64 + p : ((br & 1) ? v_off(pos, p) : k_off(pos, p)))), ref); } }
        }
        if (wid == 2) for (int s = 0; s < 4; ++s) { const int r = rows[s], pos = r & 4095, b = r >> 12;
            const half_t* cq = WSP(half_t, WS_CQ) + (size_t)r * 256; const half_t* t1 = WSP(half_t, WS_T1) + (size_t)r * 256;
            float sq = 0.f, skv = 0.f; for (int k = lane; k < 256; k += 64) { const float a = h2f(cq + k); sq += a * a; } for (int k = lane; k < 128; k += 64) { const float a = h2f(t1 + k); skv += a * a; }
            sq = wave_sum(sq); skv = wave_sum(skv); const float rq = 1.f / sqrtf(sq / 256.f + NORM_EPS), rkv = 1.f / sqrtf(skv / 128.f + NORM_EPS);
            const int* hs = dbgt_10_hs; const int* ps = dbgt_11_ps;
            for (int i = 0; i < 4; ++i) { const int hd = hs[i], p = ps[i]; float ref;
                auto qcol = [&](int col) { float a = 0.f; for (int k = lane; k < 256; k += 64) a += h2f(cq + k) * args.in[3][k] * args.in[4][(size_t)k * 768 + col]; return wave_sum(a) * rq; };
                if (p < 64) ref = qcol(hd * 96 + p);
                else { const int pp = p - 64, pr = pp >> 1; const float x1 = qcol(hd * 96 + 64 + pr), x2 = qcol(hd * 96 + 64 + pr + 16);
                    const float c = dbg_rope_cs(pos, pr, 32, false), sn = dbg_rope_cs(pos, pr, 32, true); ref = (pp & 1) ? (x2 * c + x1 * sn) : (x1 * c - x2 * sn); }
                if (lane == 0) dbg_flag(ctl, 8, h2f(WSP(half_t, WS_QM) + (size_t)r * 768 + hd * 96 + p), ref * QS_M); }
            for (int i = 0; i < 4; ++i) { const int hd = hs[i], d = ps[i] & 63;
                auto kvcol = [&](int col) { float a = 0.f; for (int k = lane; k < 128; k += 64) a += h2f(t1 + k) * args.in[5][k] * args.in[6][(size_t)k * 1024 + col]; return wave_sum(a) * rkv; };
                const float kr = kvcol(hd * 128 + d), vr = kvcol(hd * 128 + 64 + d);
                if (lane == 0) { dbg_flag(ctl, 9, h2f(WSP(half_t, WS_KNM) + (size_t)(b * 8 + hd) * SEQ * 64 + k_off(pos, d)), kr); dbg_flag(ctl, 10, h2f(WSP(half_t, WS_VM) + (size_t)(b * 8 + hd) * SEQ * 64 + v_off(pos, d)), vr); } }
        }
        if (wid == 3 || wid == 4) { const int kv = wid - 3; const int* slabs = dbgt_12_slabs; const int* ns = dbgt_13_ns;
            LAS float* hid = (LAS float*)(lds + 65536 + kv * 1024);
            const float* pe = args.in[kv ? 12 : 7]; const float* w1 = args.in[kv ? 13 : 8]; const float* b1 = args.in[kv ? 14 : 9]; const float* w2 = args.in[kv ? 15 : 10]; const float* b2 = args.in[kv ? 16 : 11];
            for (int s = 0; s < 3; ++s) { const int slab = slabs[s], n = ns[s]; const half_t* tok = WSP(half_t, WS_KVT) + (size_t)kv * KVT_STRIDE + ((size_t)slab * SEQ + 16 * n) * 64;
                for (int jj = 0; jj < 2; ++jj) { const int j = lane + 64 * jj; float a = b1[j]; for (int k = 0; k < 2048; ++k) a += (h2f(tok + k) + pe[k]) * w1[(size_t)k * 128 + j];
                    const float z = 0.7978845608028654f * (a + 0.044715f * a * a * a); hid[j] = 0.5f * a * (1.f + tanhf(z)); }
                asm volatile("s_waitcnt lgkmcnt(0)" ::: "memory");
                float o = b2[lane]; for (int j = 0; j < 128; ++j) o += hid[j] * w2[j * 64 + lane];
                const int* ps = dbgt_14_ps;
                for (int i = 0; i < 4; ++i) { const int p = ps[i]; float ref;
                    if (kv == 0 && p < 16) { const int pr = p >> 1; const float x1 = __shfl(o, pr), x2 = __shfl(o, pr + 8); const int pos = 16 * n + 31;
                        const float c = dbg_rope_cs(pos, pr, 16, false), sn = dbg_rope_cs(pos, pr, 16, true); ref = (p & 1) ? (x2 * c + x1 * sn) : (x1 * c - x2 * sn); }
                    else ref = __shfl(o, p);
                    if (lane == 0) dbg_flag(ctl, 11 + kv, h2f((kv ? WSP(half_t, WS_VC) : WSP(half_t, WS_KC)) + (size_t)slab * 256 * 64 + (kv ? v_off(n, p) : k_off(n, p))), ref); }
                asm volatile("s_waitcnt lgkmcnt(0)" ::: "memory"); }
        }
        if (wid == 5) { const int* bs = dbgt_15_bs; const int* hs = dbgt_16_hs; const int* qs = dbgt_17_qs;
            for (int s = 0; s < 5; ++s) { const int b = bs[s], hd = hs[s], q = qs[s]; const size_t r = (size_t)b * SEQ + q;
                const half_t* qv = WSP(half_t, WS_QM) + r * 768 + hd * 96; const half_t* Kn = WSP(half_t, WS_KNM) + (size_t)(b * 8 + hd) * SEQ * 64; const half_t* Kp = WSP(half_t, WS_KPE) + (size_t)b * SEQ * 32; const half_t* V = WSP(half_t, WS_VM) + (size_t)(b * 8 + hd) * SEQ * 64;
                float mx = -1e30f;
                for (int k = lane; k <= q; k += 64) { float sc = 0.f; for (int d = 0; d < 64; ++d) sc += h2f(qv + d) * h2f(Kn + k_off(k, d)); for (int d = 0; d < 32; ++d) sc += h2f(qv + 64 + d) * h2f(Kp + kpe_off(k, d)); mx = fmaxf(mx, sc); }
                for (int o = 1; o < 64; o <<= 1) mx = fmaxf(mx, __shfl_xor(mx, o));
                float l = 0.f, o0 = 0.f, o1 = 0.f, o2 = 0.f;
                for (int k = lane; k <= q; k += 64) { float sc = 0.f; for (int d = 0; d < 64; ++d) sc += h2f(qv + d) * h2f(Kn + k_off(k, d)); for (int d = 0; d < 32; ++d) sc += h2f(qv + 64 + d) * h2f(Kp + kpe_off(k, d));
                    const float p = exp2f(sc - mx); l += p; o0 += p * h2f(V + v_off(k, 0)); o1 += p * h2f(V + v_off(k, 33)); o2 += p * h2f(V + v_off(k, 63)); }
                l = wave_sum(l); o0 = wave_sum(o0); o1 = wave_sum(o1); o2 = wave_sum(o2);
                if (lane == 0) { const half_t* y = WSP(half_t, WS_Y) + r * DM + hd * 64; dbg_flag(ctl, 13, h2f(y + 0), o0 / l); dbg_flag(ctl, 13, h2f(y + 33), o1 / l); dbg_flag(ctl, 13, h2f(y + 63), o2 / l); } }
        }
        if (wid == 6 || wid == 7) { const int* bs = dbgt_18_bs; const int* gs = dbgt_19_gs; const int* hhs = dbgt_20_hhs; const int* qs = dbgt_21_qs;
            LAS float* pc = (LAS float*)(lds + 70000 + (wid - 6) * 8192);
            for (int s = wid - 6; s < 6; s += 2) { const int b = bs[s], g = gs[s], hh = hhs[s], q = qs[s], cur = q >> 6; const size_t r = (size_t)b * SEQ + q; const int bg = b * 2 + g;
                const half_t* Kc = WSP(half_t, WS_KC) + (size_t)bg * 256 * 64; const half_t* Vc = WSP(half_t, WS_VC) + (size_t)bg * 256 * 64;
                for (int h4 = 0; h4 < 4; ++h4) { const half_t* qv = WSP(half_t, WS_QN) + r * 512 + (g * 4 + h4) * 64;
                    float sc[4]; float mx = -1e30f;
                    for (int i = 0; i < 4; ++i) { const int n = lane + 64 * i; float a = -INFINITY; if (n < 255 && 16 * n + 31 <= q) { a = 0.f; for (int d = 0; d < 64; ++d) a += h2f(qv + d) * h2f(Kc + k_off(n, d)); } sc[i] = a; mx = fmaxf(mx, a); }
                    for (int o = 1; o < 64; o <<= 1) mx = fmaxf(mx, __shfl_xor(mx, o));
                    float l = 0.f; for (int i = 0; i < 4; ++i) { sc[i] = exp2f(sc[i] - mx); l += sc[i]; } l = wave_sum(l);
                    for (int i = 0; i < 4; ++i) pc[h4 * 256 + lane + 64 * i] = (l > 0.f) ? sc[i] / l : 0.f; }
                asm volatile("s_waitcnt lgkmcnt(0)" ::: "memory");
                { float imp = 0.f; const int jb = lane;
                  for (int n = 0; n < 255; ++n) { const int cs = 16 * n, ss0 = 64 * jb; const int lo2 = cs > ss0 ? cs : ss0, hi2 = (cs + 32 < ss0 + 64) ? cs + 32 : ss0 + 64; const int ov = hi2 - lo2; if (ov > 0) { const float w = (float)ov / 32.f; for (int h4 = 0; h4 < 4; ++h4) imp += pc[h4 * 256 + n] * w; } }
                  const bool forced = (jb == 0) || (jb == cur) || (jb == cur - 1), causal = jb * 64 <= q;
                  pc[1024 + jb] = forced ? 1e9f : (causal ? imp : -1e9f); }
                asm volatile("s_waitcnt lgkmcnt(0)" ::: "memory");
                if (lane == 0) { for (int jb = 0; jb < 64; ++jb) pc[1088 + jb] = 0.f; for (int it = 0; it < 16; ++it) { int best = -1; float bv = -INFINITY; for (int jb = 0; jb < 64; ++jb) if (pc[1088 + jb] == 0.f && pc[1024 + jb] > bv) { bv = pc[1024 + jb]; best = jb; } pc[1088 + best] = 1.f; } }
                asm volatile("s_waitcnt lgkmcnt(0)" ::: "memory");
                const half_t* qv = WSP(half_t, WS_QN) + r * 512 + (g * 4 + hh) * 64; const int* dd = dbgt_22_dd;
                float oc[3] = {0.f, 0.f, 0.f};
                for (int i = 0; i < 4; ++i) { const int n = lane + 64 * i; if (n < 255) { const float p = pc[hh * 256 + n]; for (int e = 0; e < 3; ++e) oc[e] += p * h2f(Vc + v_off(n, dd[e])); } }
                for (int e = 0; e < 3; ++e) oc[e] = wave_sum(oc[e]);
                float osw[2][3];
                for (int br = 0; br < 2; ++br) { const half_t* Kx = WSP(half_t, WS_KVT) + (size_t)(2 + 2 * br) * KVT_STRIDE + (size_t)bg * SEQ * 64; const half_t* Vx = WSP(half_t, WS_KVT) + (size_t)(3 + 2 * br) * KVT_STRIDE + (size_t)bg * SEQ * 64;
                    float mx = -1e30f;
                    for (int k = lane; k <= q; k += 64) { const bool ok = br ? (q - k < 512) : (pc[1088 + (k >> 6)] != 0.f); if (!ok) continue; float a = 0.f; for (int d = 0; d < 64; ++d) a += h2f(qv + d) * h2f(Kx + k_off(k, d)); mx = fmaxf(mx, a); }
                    for (int o = 1; o < 64; o <<= 1) mx = fmaxf(mx, __shfl_xor(mx, o));
                    float l = 0.f, a3[3] = {0.f, 0.f, 0.f};
                    for (int k = lane; k <= q; k += 64) { const bool ok = br ? (q - k < 512) : (pc[1088 + (k >> 6)] != 0.f); if (!ok) continue; float a = 0.f; for (int d = 0; d < 64; ++d) a += h2f(qv + d) * h2f(Kx + k_off(k, d));
                        const float p = exp2f(a - mx); l += p; for (int e = 0; e < 3; ++e) a3[e] += p * h2f(Vx + v_off(k, dd[e])); }
                    l = wave_sum(l); for (int e = 0; e < 3; ++e) osw[br][e] = wave_sum(a3[e]) / l; }
                if (lane == 0) { const float* gt = WSP(float, WS_GATE) + r * 24; const int head = g * 4 + hh; const float g0 = gt[head], g1 = gt[8 + head], g2 = gt[16 + head];
                    for (int e = 0; e < 3; ++e) dbg_flag(ctl, q < 1024 ? 14 : 15, h2f(WSP(half_t, WS_Y) + r * DM + 512 + head * 64 + dd[e]), g0 * oc[e] + g1 * osw[0][e] + g2 * osw[1][e]); }
                asm volatile("s_waitcnt lgkmcnt(0)" ::: "memory"); }
        }
    }
}
__global__ void __launch_bounds__(512) dbg_checks_b(Args args, int which) {
    unsigned char* ws = args.ws; unsigned* ctl = WSP(unsigned, WS_CTL);
    const int lane = threadIdx.x & 63, wid = threadIdx.x >> 6;
    const int* rows = dbgt_0_dbg_rows; const int* cols = dbgt_24_cols;
    if (blockIdx.x != 0 || wid >= 4) return;
    const int r = rows[wid];
    if (which == 6 && wid == 3) { const half_t* y = WSP(half_t, WS_Y) + (size_t)r * DM; const int* cc = dbgt_25_cc;
        for (int i = 0; i < 6; ++i) { const int c = cc[i]; float a = 0.f; for (int k = lane; k < DM; k += 64) a += h2f(y + k) * (k < 512 ? args.in[17][k] : args.in[18][k - 512]) * args.in[19][(size_t)k * DM + c];
            const float dot = wave_sum(a), xr = args.in[0][(size_t)r * DM + c], got = h2f(WSP(half_t, WS_H1) + (size_t)r * DM + c);
            if (lane == 0 && !(fabsf(got - (dot + xr)) <= 0.03f + 0.03f * fabsf(dot + xr))) atomicAdd(ctl + CW_DBG + 2, 1u << i); } }
    if (which == 6) { const half_t* y = WSP(half_t, WS_Y) + (size_t)r * DM;
        { float s0 = 0.f, s1 = 0.f; for (int k = lane; k < 512; k += 64) { const float a = h2f(y + k), b = h2f(y + 512 + k); s0 += a * a; s1 += b * b; } s0 = wave_sum(s0); s1 = wave_sum(s1);
          if (lane == 0) { dbg_flag(ctl, 20, s0 / 512.f, 1.f); dbg_flag(ctl, 21, s1 / 512.f, 1.f); } }
        { const int c = cols[wid], k = rows[wid] & 1023; if (lane == 0) dbg_flag(ctl, 22, 100.f * h2f(WSP(half_t, WS_WO) + (size_t)c * DM + k), 100.f * args.in[19][(size_t)k * DM + c] * (k < 512 ? args.in[17][k] : args.in[18][k - 512])); }
        for (int i = 0; i < 4; ++i) { const int c = cols[i]; float a = 0.f; for (int k = lane; k < DM; k += 64) a += h2f(y + k) * (k < 512 ? args.in[17][k] : args.in[18][k - 512]) * args.in[19][(size_t)k * DM + c];
            const float dot = wave_sum(a), xr = args.in[0][(size_t)r * DM + c], got = h2f(WSP(half_t, WS_H1) + (size_t)r * DM + c); a = dot + xr;
            if (lane == 0) { dbg_flag(ctl, 16, got, a);
                if ((wid == 0 && i == 0) || (wid == 3 && i == 3)) { int hcode = 9; auto near = [](float p, float q) { return fabsf(p - q) <= 0.03f + 0.03f * fabsf(q); };
                    if (near(got, dot + xr)) hcode = 1; else if (near(got, dot)) hcode = 2; else if (near(got, xr)) hcode = 3; else if (near(got, 2.f * xr + dot)) hcode = 4; else if (!(got == got)) hcode = 5; else if (near(got, 0.f)) hcode = 6;
                    atomicAdd(ctl + CW_DBG + 1, (unsigned)(wid == 0 ? 10 * hcode : hcode)); } } } }
    if (which == 7) { const half_t* h1 = WSP(half_t, WS_H1) + (size_t)r * DM; float ss = 0.f; for (int k = lane; k < DM; k += 64) { const float a = h2f(h1 + k); ss += a * a; } ss = wave_sum(ss); const float rs = 1.f / sqrtf(ss / DM + NORM_EPS);
        const int* c4 = dbgt_23_c4;
        for (int i = 0; i < 4; ++i) { const int c = c4[i]; float a = 0.f; for (int k = lane; k < DM; k += 64) a += h2f(h1 + k) * args.in[20][k] * args.in[21][(size_t)k * DFF + c];
            a = fmaxf(wave_sum(a) * rs, 0.f); if (lane == 0) dbg_flag(ctl, 17, h2f(WSP(half_t, WS_A2) + (size_t)r * DFF + c), a * a); } }
    if (which == 8) { const half_t* a2 = WSP(half_t, WS_A2) + (size_t)r * DFF;
        for (int i = 0; i < 4; ++i) { const int c = cols[i]; float a = 0.f; for (int k = lane; k < DFF; k += 64) a += h2f(a2 + k) * args.in[22][(size_t)k * DM + c];
            a = wave_sum(a) + h2f(WSP(half_t, WS_H1) + (size_t)r * DM + c); if (lane == 0) dbg_flag(ctl, 18, h2f(WSP(half_t, WS_H2) + (size_t)r * DM + c), a); } }
    if (which == 9) { const half_t* h2 = WSP(half_t, WS_H2) + (size_t)r * DM; float ss = 0.f; for (int k = lane; k < DM; k += 64) { const float a = h2f(h2 + k); ss += a * a; } ss = wave_sum(ss); const float rs = 1.f / sqrtf(ss / DM + NORM_EPS);
        for (int i = 0; i < 4; ++i) { const int c = cols[i]; if (lane == 0) dbg_flag(ctl, 19, args.out[(size_t)r * DM + c], h2f(h2 + c) * rs * args.in[23][c]); } }
}
__global__ void __launch_bounds__(512) dbg_fill(Args args) {
    unsigned char* ws = args.ws; unsigned* ctl = WSP(unsigned, WS_CTL);
#ifndef DBG_SKIP
#define DBG_SKIP 0
#endif
    const unsigned m = __hip_atomic_load(ctl + CW_DBG, __ATOMIC_RELAXED, __HIP_MEMORY_SCOPE_AGENT) & ~((1u << DBG_SKIP) - 1u);
#ifdef DBG_STAMP
    const unsigned long long* ts = (const unsigned long long*)(ctl + 160); (void)m;
    const int code = (int)((ts[DBG_T1B] - ts[DBG_T1A]) / 4000ull);
    const float vbig = (float)((ts[DBG_T2B] - ts[DBG_T2A]) / 100ull);
    if (blockIdx.x == 0 && threadIdx.x == 0) { args.out[(size_t)MROWS * DM - 1] = vbig; }
#elif defined(DBG_VALUE)
    const int code = (int)__hip_atomic_load(ctl + CW_DBG + 2, __ATOMIC_RELAXED, __HIP_MEMORY_SCOPE_AGENT); (void)m;
#else
    const int code = m ? __builtin_ctz(m) : 0;
#endif
    const float a = sqrtf((float)code);
#ifdef DBG_STAMP
    const size_t nfill = (size_t)MROWS * DM / 4 - 1;
    if (blockIdx.x == 0 && threadIdx.x == 1) { args.out[(size_t)MROWS * DM - 4] = a; args.out[(size_t)MROWS * DM - 3] = a; args.out[(size_t)MROWS * DM - 2] = a; }
#else
    const size_t nfill = (size_t)MROWS * DM / 4;
#endif
    for (size_t i = (size_t)blockIdx.x * 512 + threadIdx.x; i < nfill; i += (size_t)gridDim.x * 512) ((f32x4*)args.out)[i] = (f32x4){a, a, a, a};
}
#endif

extern "C" void kernel_launch(void* const* d_in, const int* in_sizes, int n_in, void* d_out, int out_size, void* d_ws, size_t ws_size, hipStream_t stream) {
    static int grid = 0;
    if (grid == 0) {
        if (n_in != 24 || out_size != MROWS * DM || ws_size < WS_END) { fprintf(stderr, "kernel_launch: unexpected problem (n_in %d, out %d, ws %zu)\n", n_in, out_size, ws_size); grid = -1; return; }
        int dev = 0, cus = 0, per_cu = 0;
        if (hipGetDevice(&dev) != hipSuccess || hipDeviceGetAttribute(&cus, hipDeviceAttributeMultiprocessorCount, dev) != hipSuccess) { grid = -1; return; }
        if (hipFuncSetAttribute((const void*)hymba_fwd, hipFuncAttributeMaxDynamicSharedMemorySize, LDS_BYTES) != hipSuccess) { fprintf(stderr, "kernel_launch: hipFuncSetAttribute failed\n"); grid = -1; return; }
        if (hipOccupancyMaxActiveBlocksPerMultiprocessor(&per_cu, (const void*)hymba_fwd, 512, LDS_BYTES) != hipSuccess || per_cu < 1) fprintf(stderr, "kernel_launch: occupancy query says %d\n", per_cu);
        (void)hipGetLastError();
        grid = cus;
#if DBG_CHECK
        (void)hipFuncSetAttribute((const void*)dbg_checks_a, hipFuncAttributeMaxDynamicSharedMemorySize, 98304);
#endif
    }
    if (grid < 0) return;
    (void)hipMemsetAsync((char*)d_ws + WS_CTL, 0, CTL_ZERO_BYTES, stream);
    Args a{};
    for (int i = 0; i < 24; ++i) a.in[i] = (const float*)d_in[i];
    a.out = (float*)d_out; a.ws = (unsigned char*)d_ws;
#if DBG_CHECK == 1
    a.ph_lo = 0; a.ph_hi = 5; a.li = 0; hipLaunchKernelGGL(hymba_fwd, dim3(grid), dim3(512), LDS_BYTES, stream, a);
    hipLaunchKernelGGL(dbg_checks_a, dim3(1), dim3(512), 98304, stream, a);
    hipLaunchKernelGGL(dbg_fill, dim3(1024), dim3(512), 0, stream, a);
#elif DBG_CHECK == 2
    a.ph_lo = 0; a.ph_hi = 7; a.li = 0; hipLaunchKernelGGL(hymba_fwd, dim3(grid), dim3(512), LDS_BYTES, stream, a);
    hipLaunchKernelGGL(dbg_checks_b, dim3(1), dim3(512), 0, stream, a, 6);
    a.ph_lo = 7; a.ph_hi = 8; a.li = 1; hipLaunchKernelGGL(hymba_fwd, dim3(grid), dim3(512), LDS_BYTES, stream, a);
    hipLaunchKernelGGL(dbg_checks_b, dim3(1), dim3(512), 0, stream, a, 7);
    a.ph_lo = 8; a.ph_hi = 9; a.li = 2; hipLaunchKernelGGL(hymba_fwd, dim3(grid), dim3(512), LDS_BYTES, stream, a);
    hipLaunchKernelGGL(dbg_checks_b, dim3(1), dim3(512), 0, stream, a, 8);
    a.ph_lo = 9; a.ph_hi = 10; a.li = 3; hipLaunchKernelGGL(hymba_fwd, dim3(grid), dim3(512), LDS_BYTES, stream, a);
    hipLaunchKernelGGL(dbg_checks_b, dim3(1), dim3(512), 0, stream, a, 9);
    hipLaunchKernelGGL(dbg_fill, dim3(1024), dim3(512), 0, stream, a);
#elif DBG_CHECK == 3
    a.ph_lo = 0; a.ph_hi = 10; a.li = 0; hipLaunchKernelGGL(hymba_fwd, dim3(grid), dim3(512), LDS_BYTES, stream, a);
    hipLaunchKernelGGL(dbg_fill, dim3(1024), dim3(512), 0, stream, a);
#elif MK_N_LAUNCHES == 1
    a.ph_lo = 0; a.ph_hi = 10; a.li = 0;
    hipLaunchKernelGGL(hymba_fwd, dim3(grid), dim3(512), LDS_BYTES, stream, a);
#else
    for (int p = 0; p < 10; ++p) { a.ph_lo = p; a.ph_hi = p + 1; a.li = p; hipLaunchKernelGGL(hymba_fwd, dim3(grid), dim3(512), LDS_BYTES, stream, a); }
#endif
}
```

```cpp
#include <hip/hip_runtime.h>
#include <cstdio>
#include <cstdint>

#ifndef DBG_CHECK
#define DBG_CHECK 0
#endif
#ifndef REPEAT_PHASE
#define REPEAT_PHASE -1
#endif
#ifndef ABL
#define ABL 0
#endif
#ifndef MK_N_LAUNCHES
#define MK_N_LAUNCHES 1
#endif

#define LAS __attribute__((address_space(3)))
typedef _Float16 half_t;
typedef _Float16 half8 __attribute__((ext_vector_type(8)));
typedef _Float16 half2v __attribute__((ext_vector_type(2)));
typedef float f32x4 __attribute__((ext_vector_type(4)));
typedef float f32x16 __attribute__((ext_vector_type(16)));
typedef unsigned u32x4 __attribute__((ext_vector_type(4)));
typedef unsigned u32x2 __attribute__((ext_vector_type(2)));
typedef short v4i16 __attribute__((ext_vector_type(4)));

constexpr int BATCH = 16, SEQ = 4096, DM = 1024, MROWS = BATCH * SEQ;
constexpr int IN_COLS = 1720, NIN = 1792;
constexpr int DFF = 4096;
constexpr float NORM_EPS = 1e-6f;
constexpr float LOG2E = 1.4426950408889634f;
constexpr float QS_N = 0.125f * LOG2E;
constexpr float QS_M = 0.10206207261596577f * LOG2E;

constexpr size_t MiB = 1u << 20;
constexpr size_t WS_CTL = 0, CTL_ZERO_BYTES = 1 * MiB;
constexpr size_t WS_WIN = 1 * MiB, WS_WUQ = 5 * MiB, WS_WUKV = 6 * MiB, WS_WC1 = 7 * MiB, WS_WO = 9 * MiB, WS_WUP = 11 * MiB, WS_WDN = 19 * MiB;
constexpr size_t WS_ROPEM = 27 * MiB, WS_ROPEN = 27 * MiB + 512 * 1024, WS_B1P = 27 * MiB + 768 * 1024;
constexpr size_t WS_KC = 28 * MiB, WS_VC = 29 * MiB;
constexpr size_t WS_RS1 = 32 * MiB, WS_SSQ = 33 * MiB, WS_SSKV = 34 * MiB, WS_SSM = 35 * MiB, WS_SSN = 37 * MiB, WS_SS2 = 39 * MiB, WS_SS3 = 43 * MiB;
constexpr size_t WS_GATE = 47 * MiB, WS_KPE = 53 * MiB;
constexpr size_t WS_CQ = 64 * MiB, WS_T1 = 96 * MiB, WS_QN = 128 * MiB, WS_KVT = 192 * MiB  ;
constexpr size_t WS_QM = 288 * MiB, WS_KNM = 384 * MiB, WS_VM = 448 * MiB, WS_HIDP = 512 * MiB;
constexpr size_t WS_A2 = 64 * MiB;
constexpr size_t WS_XH = 576 * MiB, WS_H2 = 576 * MiB, WS_Y = 704 * MiB, WS_H1 = 832 * MiB, WS_END = 960 * MiB;
constexpr size_t KVT_STRIDE = 16 * MiB / 2;

constexpr int CW_QHEAD = 64;
constexpr int CW_BAR = 4096;

constexpr int LDS_BYTES = 163840;
constexpr int LDS_MISC = 163840 - 256;

#define XB_TMO      128
#define XB_XCNT(j)  (256  + 64 * (j))
#define XB_XSUB(j)  (1280 + 64 * (j))
#define XB_XGEN(j)  (2304 + 64 * (j))
#define XB_TOP      3328
#define XB_TOPGEN   3392
#define XCD_BAR_WORDS 3456
#define XB_SPIN_CAP (1u << 22)

__device__ __forceinline__ unsigned xb_ld(unsigned* p)              { return __hip_atomic_load(p, __ATOMIC_RELAXED, __HIP_MEMORY_SCOPE_AGENT); }
__device__ __forceinline__ unsigned xb_add(unsigned* p, unsigned v) { return __hip_atomic_fetch_add(p, v, __ATOMIC_RELAXED, __HIP_MEMORY_SCOPE_AGENT); }
__device__ __forceinline__ unsigned xb_xcc_id() { return (unsigned)__builtin_amdgcn_s_getreg((3 << 11) | 20) & 0xFu; }
#define XB_SPIN(cond, bar) do { unsigned _sp = 0; while (cond) { __builtin_amdgcn_s_sleep(1); \
    if ((++_sp & 255u) == 0u) { if (xb_ld(&(bar)[XB_TMO])) break; if (_sp > XB_SPIN_CAP) { atomicAdd(&(bar)[XB_TMO], 1u); break; } } } } while (0)

struct XcdBarrier { unsigned* bar; unsigned x; volatile LAS unsigned* st; };

__device__ __forceinline__ XcdBarrier xcd_barrier_post(unsigned* bar, volatile LAS unsigned* st) {
    XcdBarrier b; b.bar = bar; b.x = xb_xcc_id(); b.st = st;
    if (threadIdx.x == 0) (void)xb_add(&bar[XB_XCNT(b.x)], 1u);
    return b;
}
__device__ __forceinline__ void xcd_barrier_complete(unsigned* bar, unsigned x, unsigned& nloc, unsigned& nx) {
    const unsigned G = gridDim.x * gridDim.y * gridDim.z;
    unsigned sum, cnt, mine, sp = 0u;
    for (;;) {
        sum = 0u; cnt = 0u; mine = 0u;
#pragma unroll
        for (unsigned j = 0; j < 16; ++j) { const unsigned c = xb_ld(&bar[XB_XCNT(j)]); sum += c; cnt += (c > 0u) ? 1u : 0u; mine = (j == x) ? c : mine; }
        if (sum == G) break;
        __builtin_amdgcn_s_sleep(1);
        if ((++sp & 255u) == 0u) { if (xb_ld(&bar[XB_TMO])) break; if (sp > XB_SPIN_CAP) { atomicAdd(&bar[XB_TMO], 1u); break; } }
    }
    nloc = mine > 0u ? mine : 1u; nx = cnt > 0u ? cnt : 1u;
}
__device__ __forceinline__ void xcd_barrier(const XcdBarrier& b) {
    asm volatile("s_waitcnt vmcnt(0)" ::: "memory");
    __syncthreads();
    if (threadIdx.x == 0) {
        unsigned* bar = b.bar;
        __builtin_amdgcn_s_waitcnt(0);
        unsigned nloc = b.st[0], nx = b.st[1];
        if (nloc == 0u) { xcd_barrier_complete(bar, b.x, nloc, nx); b.st[0] = nloc; b.st[1] = nx; }
        const unsigned old = xb_add(&bar[XB_XSUB(b.x)], 1u);
        const unsigned gen = old / nloc;
        if (old + 1u == (gen + 1u) * nloc) {
            __builtin_amdgcn_fence(__ATOMIC_RELEASE, "agent");
            asm volatile("s_waitcnt vmcnt(0)" ::: "memory");
            const unsigned og = xb_add(&bar[XB_TOP], 1u);
            const unsigned tg = og / nx;
            if (og + 1u == (tg + 1u) * nx) xb_add(&bar[XB_TOPGEN], 1u);
            else XB_SPIN(xb_ld(&bar[XB_TOPGEN]) == tg, bar);
            __builtin_amdgcn_fence(__ATOMIC_ACQUIRE, "agent");
            xb_add(&bar[XB_XGEN(b.x)], 1u);
            asm volatile("s_waitcnt vmcnt(0)" ::: "memory");
        } else {
            XB_SPIN(xb_ld(&bar[XB_XGEN(b.x)]) == gen, bar);
            __builtin_amdgcn_fence(__ATOMIC_ACQUIRE, "agent");
            asm volatile("s_waitcnt vmcnt(0)" ::: "memory");
        }
    }
    __syncthreads();
}

__device__ __forceinline__ unsigned pk_rne(float a, float b) { half2v v = {(_Float16)a, (_Float16)b}; return __builtin_bit_cast(unsigned, v); }
__device__ __forceinline__ unsigned pk_rtz(float a, float b) { auto v = __builtin_amdgcn_cvt_pkrtz(a, b); return __builtin_bit_cast(unsigned, v); }
__device__ __forceinline__ u32x4 pk8(const float* v) { u32x4 w; w.x = pk_rne(v[0], v[1]); w.y = pk_rne(v[2], v[3]); w.z = pk_rne(v[4], v[5]); w.w = pk_rne(v[6], v[7]); return w; }
__device__ __forceinline__ void unpk8(u32x4 w, float* v) {
    const half8 h = __builtin_bit_cast(half8, w);
#pragma unroll
    for (int i = 0; i < 8; ++i) v[i] = (float)h[i];
}
__device__ __forceinline__ float wave_sum(float v) {
#pragma unroll
    for (int o = 1; o < 64; o <<= 1) v += __shfl_xor(v, o);
    return v;
}
__device__ __forceinline__ void rope4(float* v, const float2* cs) {
#pragma unroll
    for (int p = 0; p < 4; ++p) { const float2 t = cs[p]; const float x1 = v[2 * p], x2 = v[2 * p + 1]; v[2 * p] = x1 * t.x - x2 * t.y; v[2 * p + 1] = x2 * t.x + x1 * t.y; }
}

__host__ __device__ __forceinline__ size_t k_off(int tok, int d)   { return (size_t)(((tok >> 6) * 8 + (d >> 3)) * 512 + (tok & 63) * 8 + (d & 7)); }
__host__ __device__ __forceinline__ size_t v_off(int tok, int d)   { return (size_t)((tok >> 6) * 4096 + ((d >> 5) * 8 + ((tok & 63) >> 3)) * 256 + (tok & 7) * 32 + (d & 31)); }
__host__ __device__ __forceinline__ size_t kpe_off(int tok, int p) { return (size_t)(((tok >> 6) * 4 + (p >> 3)) * 512 + (tok & 63) * 8 + (p & 7)); }

namespace pg8 {
constexpr int BM = 256, BK = 64, HALF = 128, HTB = HALF * BK * 2, NXCD = 8, WGM = 8;
__host__ __device__ __forceinline__ int lds_byte(int r, int c) { const int st = (r >> 4) * 2 + (c >> 5), rr = r & 15, cc = c & 31, ob = rr * 64 + cc * 2; return st * 1024 + (ob ^ (((ob >> 9) & 1) << 5)); }
__host__ __device__ __forceinline__ void stage_rc(int b, int& R, int& C) { const int st = b / 1024, sb = b % 1024, swz = sb ^ (((sb >> 9) & 1) << 5); R = (st >> 1) * 16 + swz / 64; C = (st & 1) * 32 + (swz % 64) / 2; }
__host__ __device__ __forceinline__ int perm32(int rho) { const int n = rho >> 4, i = rho & 15; return 8 * (i >> 2) + 4 * n + (i & 3); }

struct Unit { int pm, pn; size_t aoff, boff; };
struct Gemm { const half_t* A; const half_t* Bt; int K, lda, ldb; };

struct StaticOrder {
    int nM, nN, nwg, G, c; size_t tA, tB;
    __device__ void init(int M, int N, int G_, int c_, int lda, int ldb) { nM = M / BM; nN = N / BM; nwg = nM * nN; G = G_; c = c_; tA = (size_t)BM * lda * 2; tB = (size_t)BM * ldb * 2; }
    __device__ bool next(int i, Unit& u) const {
        const long L = (long)i * G + c; if (L >= nwg) return false;
        int wgid = (int)L; { const int q = nwg / NXCD, r = nwg % NXCD, xcd = wgid % NXCD, off = wgid / NXCD; wgid = (xcd < r ? xcd * (q + 1) : r * (q + 1) + (xcd - r) * q) + off; }
        const int nig = WGM * nN, gid = wgid / nig, fm = gid * WGM, gsz = (nM - fm) < WGM ? (nM - fm) : WGM;
        u.pm = fm + ((wgid % nig) % gsz); u.pn = (wgid % nig) / gsz; u.aoff = (size_t)u.pm * tA; u.boff = (size_t)u.pn * tB; return true;
    }
};
struct Cmp1Order {
    int G, c;
    __device__ bool next(int i, Unit& u) const {
        const int L = i * G + c; if (L >= 256) return false;
        const int kv = L >> 7, slab = (L >> 2) & 31, ch = L & 3;
        u.pm = L; u.pn = 0; u.aoff = (size_t)kv * (16 * MiB) + (size_t)slab * (512 * 1024) + (size_t)ch * 1024; u.boff = (size_t)kv * (256 * 2048 * 2) + (size_t)ch * 1024; return true;
    }
};

template <class Epi, class Sched, bool MIDK = false>
__device__ __forceinline__ void gemm_phase(LAS unsigned char* lds, const Gemm g, const Sched& S, const Epi& E) {
    int tid_ = threadIdx.x; asm volatile("" : "+v"(tid_));
    const int tid = tid_, wid = __builtin_amdgcn_readfirstlane(tid >> 6), lane = tid & 63, wr = wid >> 2, wc = wid & 3, fr = lane & 15, fq = lane >> 4;
    const int K = g.K, nt = K / BK;
    unsigned voffA[2], voffB[2];
#pragma unroll
    for (int i = 0; i < 2; ++i) { int R, C; stage_rc(tid * 16 + i * 8192, R, C); const int Rb = (R & ~31) + perm32(R & 31);
        voffA[i] = (unsigned)(R * g.lda + C) * 2u; voffB[i] = (unsigned)(Rb * g.ldb + C) * 2u; }
    const size_t kstep = (size_t)(BK * 2);
    const size_t hstepA = (size_t)HALF * g.lda * 2, hstepB = (size_t)HALF * g.ldb * 2;
    const unsigned ldsw = (unsigned)wid * 1024u;
    const int aoff = lds_byte(wr * 64 + fr, fq * 8), boff = lds_byte(wc * 32 + fr, fq * 8);
#define PG8_SA(b, h) (((b) * 2 + (h)) * HTB)
#define PG8_SB(b, h) ((4 + (b) * 2 + (h)) * HTB)
#define PG8_STAGE(bufoff, gbase, voff) do { _Pragma("unroll") for (int _i = 0; _i < 2; ++_i) \
        __builtin_amdgcn_global_load_lds((const unsigned*)((const char*)(gbase) + (voff)[_i]), (LAS unsigned*)(lds + (bufoff) + ldsw + _i * 8192), 16, 0, 0); } while (0)
#define PG8_LDA(dst, b, h) do { _Pragma("unroll") for (int m = 0; m < 4; ++m) _Pragma("unroll") for (int k = 0; k < 2; ++k) dst[m][k] = *(const LAS half8*)(lds + PG8_SA(b, h) + aoff + m * 2048 + k * 1024); } while (0)
#define PG8_LDB(dst, b, h) do { _Pragma("unroll") for (int n = 0; n < 2; ++n) _Pragma("unroll") for (int k = 0; k < 2; ++k) dst[n][k] = *(const LAS half8*)(lds + PG8_SB(b, h) + boff + n * 2048 + k * 1024); } while (0)
#define PG8_MMA(ai, bj, At, Bt) do { __builtin_amdgcn_s_setprio(1); _Pragma("unroll") for (int m = 0; m < 4; ++m) _Pragma("unroll") for (int n = 0; n < 2; ++n) _Pragma("unroll") for (int k = 0; k < 2; ++k) \
        acc[ai][bj][m][n] = __builtin_amdgcn_mfma_f32_16x16x32_f16(Bt[n][k], At[m][k], acc[ai][bj][m][n], 0, 0, 0); __builtin_amdgcn_s_setprio(0); } while (0)
#define PG8_WAIT_V(n) asm volatile("s_waitcnt vmcnt(" #n ")" ::: "memory")
#define PG8_WAIT_L(n) asm volatile("s_waitcnt lgkmcnt(" #n ")" ::: "memory")
#define PG8_BAR __builtin_amdgcn_s_barrier()
#define PG8_SCHED __builtin_amdgcn_sched_barrier(0)
    Unit cur, nxt; int ui = 0;
    if (!S.next(0, cur)) return;
    f32x4 acc[2][2][4][2];
#pragma unroll
    for (int a = 0; a < 2; ++a)
#pragma unroll
        for (int b = 0; b < 2; ++b)
#pragma unroll
            for (int m = 0; m < 4; ++m)
#pragma unroll
                for (int n = 0; n < 2; ++n) acc[a][b][m][n] = (f32x4){0.f, 0.f, 0.f, 0.f};
    half8 At[4][2], B0[2][2], B1[2][2];
    const char* cA = (const char*)g.A + cur.aoff; const char* cB = (const char*)g.Bt + cur.boff;
    PG8_STAGE(PG8_SB(0, 0), cB, voffB); PG8_STAGE(PG8_SB(0, 1), cB + hstepB, voffB); PG8_STAGE(PG8_SA(0, 0), cA, voffA); PG8_STAGE(PG8_SA(0, 1), cA + hstepA, voffA);
    if (wr == 1) PG8_BAR;
    PG8_WAIT_V(2); PG8_BAR;
    PG8_STAGE(PG8_SB(1, 0), cB + kstep, voffB); PG8_STAGE(PG8_SA(1, 0), cA + kstep, voffA); PG8_STAGE(PG8_SB(1, 1), cB + hstepB + kstep, voffB);
    PG8_WAIT_V(6); PG8_BAR;
    for (;;) {
        const bool has_next = S.next(ui + 1, nxt);
        const char* nA = has_next ? (const char*)g.A + nxt.aoff : cA; const char* nB = has_next ? (const char*)g.Bt + nxt.boff : cB;
        for (int t = 0; t < nt; t += 2) {
            if constexpr (MIDK) { if (t == nt / 2) E.midk(acc, cur, wr); }
            const bool last = (t == nt - 2);
            const char* a1 = cA + (size_t)(t + 1) * kstep;
            const char* a2 = last ? nA : cA + (size_t)(t + 2) * kstep; const char* b2 = last ? nB : cB + (size_t)(t + 2) * kstep;
            const char* a3 = a2 + kstep; const char* b3 = b2 + kstep;
            PG8_LDB(B0, 0, 0); PG8_LDB(B1, 0, 1); PG8_SCHED; PG8_LDA(At, 0, 0); PG8_STAGE(PG8_SA(1, 1), a1 + hstepA, voffA);
            PG8_WAIT_V(8); PG8_WAIT_L(0); PG8_BAR; PG8_MMA(0, 0, At, B0); PG8_MMA(0, 1, At, B1); PG8_BAR; PG8_SCHED;
            PG8_LDA(At, 0, 1); PG8_STAGE(PG8_SB(0, 0), b2, voffB); PG8_STAGE(PG8_SB(0, 1), b2 + hstepB, voffB); PG8_STAGE(PG8_SA(0, 0), a2, voffA);
            PG8_WAIT_V(8); PG8_WAIT_L(0); PG8_BAR; PG8_MMA(1, 0, At, B0); PG8_MMA(1, 1, At, B1); PG8_BAR; PG8_SCHED;
            PG8_LDB(B0, 1, 0); PG8_LDB(B1, 1, 1); PG8_SCHED; PG8_LDA(At, 1, 0); PG8_STAGE(PG8_SA(0, 1), a2 + hstepA, voffA);
            PG8_WAIT_V(8); PG8_WAIT_L(0); PG8_BAR; PG8_MMA(0, 0, At, B0); PG8_MMA(0, 1, At, B1); PG8_BAR; PG8_SCHED;
            PG8_LDA(At, 1, 1); PG8_STAGE(PG8_SB(1, 0), b3, voffB); PG8_STAGE(PG8_SB(1, 1), b3 + hstepB, voffB); PG8_STAGE(PG8_SA(1, 0), a3, voffA);
            PG8_WAIT_V(8); PG8_WAIT_L(0); PG8_BAR; PG8_MMA(1, 0, At, B0); PG8_MMA(1, 1, At, B1); PG8_BAR; PG8_SCHED;
        }
        if (wr == 0) PG8_BAR;
        E(acc, cur, wr, wc, fr, fq);
        if (!has_next) break;
#pragma unroll
        for (int a = 0; a < 2; ++a)
#pragma unroll
            for (int b = 0; b < 2; ++b)
#pragma unroll
                for (int m = 0; m < 4; ++m)
#pragma unroll
                    for (int n = 0; n < 2; ++n) acc[a][b][m][n] = (f32x4){0.f, 0.f, 0.f, 0.f};
        cur = nxt; cA = nA; cB = nB; ++ui;
        if (wr == 1) PG8_BAR;
    }
    PG8_WAIT_V(0);
    PG8_BAR;
#undef PG8_SA
#undef PG8_SB
#undef PG8_STAGE
#undef PG8_LDA
#undef PG8_LDB
#undef PG8_MMA
#undef PG8_WAIT_V
#undef PG8_WAIT_L
#undef PG8_BAR
#undef PG8_SCHED
}
}

typedef f32x4 AccT[2][2][4][2];
#define EPI_IDS() int t_ = threadIdx.x; asm volatile("" : "+v"(t_)); const int fr = t_ & 15, fq = (t_ >> 4) & 3; (void)fr_; (void)fq_
#define EPI_ROW(ai, m) (u.pm * 256 + (ai) * 128 + wr * 64 + (m) * 16 + fr)
#define EPI_GET8(v, ai, bj, m, s) do { const f32x4 _a = acc[ai][bj][m][0], _b = acc[ai][bj][m][1]; v[0] = _a[0] * (s); v[1] = _a[1] * (s); v[2] = _a[2] * (s); v[3] = _a[3] * (s); v[4] = _b[0] * (s); v[5] = _b[1] * (s); v[6] = _b[2] * (s); v[7] = _b[3] * (s); } while (0)
__device__ __forceinline__ void rope4v(float* v, const f32x4& c01, const f32x4& c23) {
    const float cs[8] = {c01[0], c01[1], c01[2], c01[3], c23[0], c23[1], c23[2], c23[3]};
#pragma unroll
    for (int p = 0; p < 4; ++p) { const float x1 = v[2 * p], x2 = v[2 * p + 1]; v[2 * p] = x1 * cs[2 * p] - x2 * cs[2 * p + 1]; v[2 * p + 1] = x2 * cs[2 * p] + x1 * cs[2 * p + 1]; }
}
__device__ __forceinline__ float sum4(const f32x4& a) { return (a[0] + a[1]) + (a[2] + a[3]); }
__device__ __forceinline__ float relu_s(float x) { float r; asm("v_max_f32_e32 %0, 0, %1" : "=v"(r) : "v"(x)); return r; }
constexpr int LDS_RED = 131072;

struct EpiIn {
    const float* rs1; half_t* CQ; half_t* T1; half_t* KPE; float* GATE; float* SSQ; float* SSKV; half_t* QN; half_t* KVT; const float2* ropeM; const float2* ropeN;
    __device__ __forceinline__ void operator()(const AccT& acc, const pg8::Unit& u, int wr, int wc, int fr_, int fq_) const {
        EPI_IDS();
        const int pn = u.pn;
        const bool ropem = (pn == 1 && wc == 0), ropen = (pn >= 2 && pn != 4 && (wc & 1) == 0);
#pragma unroll
        for (int ai = 0; ai < 2; ++ai) {
            float rsv[4]; f32x4 rc[4][2];
#pragma unroll
            for (int m = 0; m < 4; ++m) { const int row = EPI_ROW(ai, m), pos = row & (SEQ - 1); rsv[m] = rs1[row];
                if (ropem) { const f32x4* p = (const f32x4*)(ropeM + (size_t)pos * 16 + fq * 4); rc[m][0] = p[0]; rc[m][1] = p[1]; }
                else if (ropen) { const f32x4* p = (const f32x4*)(ropeN + (size_t)pos * 8 + (fq & 1) * 4); rc[m][0] = p[0]; rc[m][1] = p[1]; } }
#pragma unroll
            for (int m = 0; m < 4; ++m) { const int row = EPI_ROW(ai, m), pos = row & (SEQ - 1), b = row >> 12; const float rs = rsv[m];
                float v[8];
                if (pn == 0) {
                    float ss = 0.f;
#pragma unroll
                    for (int bj = 0; bj < 2; ++bj) { EPI_GET8(v, ai, bj, m, rs);
#pragma unroll
                        for (int i = 0; i < 8; ++i) ss += v[i] * v[i];
                        *(u32x4*)(CQ + (size_t)row * 256 + bj * 128 + wc * 32 + fq * 8) = pk8(v); }
                    ss += __shfl_xor(ss, 16); ss += __shfl_xor(ss, 32);
                    if (fq == 0) SSQ[(size_t)row * 4 + wc] = ss;
                } else if (pn == 1) {
                    { EPI_GET8(v, ai, 0, m, rs); float ss = 0.f;
#pragma unroll
                        for (int i = 0; i < 8; ++i) ss += v[i] * v[i];
                        *(u32x4*)(T1 + (size_t)row * 256 + wc * 32 + fq * 8) = pk8(v);
                        ss += __shfl_xor(ss, 16); ss += __shfl_xor(ss, 32);
                        if (fq == 0) SSKV[(size_t)row * 4 + wc] = ss; }
                    { EPI_GET8(v, ai, 1, m, rs);
                        if (wc == 0) { rope4v(v, rc[m][0], rc[m][1]); const u32x4 w = pk8(v);
                            *(u32x4*)(T1 + (size_t)row * 256 + 128 + fq * 8) = w; *(u32x4*)(KPE + (size_t)b * SEQ * 32 + kpe_off(pos, fq * 8)) = w; }
                        else { if (wc == 1 && fq < 3) { float* gp = GATE + (size_t)row * 24 + fq * 8;
#pragma unroll
                                for (int i = 0; i < 8; ++i) v[i] = 1.f / (1.f + __expf(-v[i]));
                                *(f32x4*)gp = (f32x4){v[0], v[1], v[2], v[3]}; *(f32x4*)(gp + 4) = (f32x4){v[4], v[5], v[6], v[7]}; }
                            *(u32x4*)(T1 + (size_t)row * 256 + 128 + wc * 32 + fq * 8) = (u32x4){0u, 0u, 0u, 0u}; } }
                } else if (pn < 4) {
#pragma unroll
                    for (int bj = 0; bj < 2; ++bj) { EPI_GET8(v, ai, bj, m, rs); const int head = (pn - 2) * 4 + 2 * bj + (wc >> 1), off = 32 * (wc & 1) + 8 * fq;
                        if ((wc & 1) == 0 && fq < 2) rope4v(v, rc[m][0], rc[m][1]);
#pragma unroll
                        for (int i = 0; i < 8; ++i) v[i] *= QS_N;
                        *(u32x4*)(QN + (size_t)row * 512 + head * 64 + off) = pk8(v); }
                } else {
#pragma unroll
                    for (int bj = 0; bj < 2; ++bj) { EPI_GET8(v, ai, bj, m, rs); const int g = wc >> 1, d = 32 * (wc & 1) + 8 * fq;
                        if (pn > 4 && bj == 0 && (wc & 1) == 0 && fq < 2) rope4v(v, rc[m][0], rc[m][1]);
                        half_t* base = KVT + (size_t)((pn - 4) * 2 + bj) * KVT_STRIDE + (size_t)(b * 2 + g) * SEQ * 64;
                        *(u32x4*)(base + (pn == 4 ? (size_t)pos * 64 + d : (bj == 0 ? k_off(pos, d) : v_off(pos, d)))) = pk8(v); }
                }
            }
        }
    }
};

struct EpiUq {
    const float* SSQ; half_t* QM; const float2* ropeM;
    __device__ __forceinline__ void operator()(const AccT& acc, const pg8::Unit& u, int wr, int wc, int fr_, int fq_) const {
        EPI_IDS();
        const bool pe0 = ((8 * u.pn + wc) % 3 == 2), pe1 = ((8 * u.pn + 4 + wc) % 3 == 2);
#pragma unroll
        for (int ai = 0; ai < 2; ++ai) {
            f32x4 s4[4];
#pragma unroll
            for (int m = 0; m < 4; ++m) s4[m] = *(const f32x4*)(SSQ + (size_t)EPI_ROW(ai, m) * 4);
#pragma unroll
            for (int m = 0; m < 4; ++m) { const int row = EPI_ROW(ai, m);
                const float rs = __builtin_amdgcn_rsqf(sum4(s4[m]) * (1.f / 256.f) + NORM_EPS) * QS_M;
                float v[8];
#pragma unroll
                for (int bj = 0; bj < 2; ++bj) { EPI_GET8(v, ai, bj, m, rs); const int sidx = 8 * u.pn + 4 * bj + wc;
                    if (bj == 0 ? pe0 : pe1) { const f32x4* p = (const f32x4*)(ropeM + (size_t)(row & (SEQ - 1)) * 16 + fq * 4); rope4v(v, p[0], p[1]); }
                    *(u32x4*)(QM + (size_t)row * 768 + sidx * 32 + fq * 8) = pk8(v); }
            }
        }
    }
};
struct EpiUkv {
    const float* SSKV; half_t* KNM; half_t* VM;
    __device__ __forceinline__ void operator()(const AccT& acc, const pg8::Unit& u, int wr, int wc, int fr_, int fq_) const {
        EPI_IDS();
#pragma unroll
        for (int ai = 0; ai < 2; ++ai) {
            f32x4 s4[4];
#pragma unroll
            for (int m = 0; m < 4; ++m) s4[m] = *(const f32x4*)(SSKV + (size_t)EPI_ROW(ai, m) * 4);
#pragma unroll
            for (int m = 0; m < 4; ++m) { const int row = EPI_ROW(ai, m), pos = row & (SEQ - 1), b = row >> 12;
                const float rs = __builtin_amdgcn_rsqf(sum4(s4[m]) * (1.f / 128.f) + NORM_EPS);
                float v[8];
#pragma unroll
                for (int bj = 0; bj < 2; ++bj) { EPI_GET8(v, ai, bj, m, rs); const int c = (u.pn & 1) * 256 + bj * 128 + wc * 32 + fq * 8, head = c >> 6, d = c & 63;
                    half_t* base = ((u.pn < 2) ? KNM : VM) + (size_t)(b * 8 + head) * SEQ * 64;
                    *(u32x4*)(base + ((u.pn < 2) ? k_off(pos, d) : v_off(pos, d))) = pk8(v); }
            }
        }
    }
};
struct EpiC1 {
    float* HIDP;
    __device__ __forceinline__ void operator()(const AccT& acc, const pg8::Unit& u, int wr, int wc, int fr_, int fq_) const {
        EPI_IDS();
#pragma unroll
        for (int ai = 0; ai < 2; ++ai)
#pragma unroll
            for (int m = 0; m < 4; ++m) { const int rl = ai * 128 + wr * 64 + m * 16 + fr; float* p = HIDP + ((size_t)u.pm * 256 + rl) * 128 + wc * 32 + fq * 8;
                *(f32x4*)p = acc[ai][0][m][0]; *(f32x4*)(p + 4) = acc[ai][0][m][1]; }
    }
};
__device__ __forceinline__ float rstd8(const float* p, float inv_n) {
    const f32x4 a = *(const f32x4*)p, b = *(const f32x4*)(p + 4);
    return __builtin_amdgcn_rsqf((sum4(a) + sum4(b)) * inv_n + NORM_EPS);
}
struct EpiWo {
    const half_t* XH; half_t* H1; float* SS2; const float* SSM; const float* SSN; LAS float* red;
    __device__ __forceinline__ void midk(AccT& acc, const pg8::Unit& u, int wr) const {
        int t_ = threadIdx.x; asm volatile("" : "+v"(t_)); const int fr = t_ & 15;
#pragma unroll
        for (int ai = 0; ai < 2; ++ai) {
            f32x4 sm[4][2], sn[4][2];
#pragma unroll
            for (int m = 0; m < 4; ++m) { const int row = EPI_ROW(ai, m); sm[m][0] = *(const f32x4*)(SSM + (size_t)row * 8); sm[m][1] = *(const f32x4*)(SSM + (size_t)row * 8 + 4); sn[m][0] = *(const f32x4*)(SSN + (size_t)row * 8); sn[m][1] = *(const f32x4*)(SSN + (size_t)row * 8 + 4); }
#pragma unroll
            for (int m = 0; m < 4; ++m) {
                const float ratio = __builtin_amdgcn_rsqf((sum4(sm[m][0]) + sum4(sm[m][1])) * (1.f / 512.f) + NORM_EPS) / __builtin_amdgcn_rsqf((sum4(sn[m][0]) + sum4(sn[m][1])) * (1.f / 512.f) + NORM_EPS);
#pragma unroll
                for (int bj = 0; bj < 2; ++bj)
#pragma unroll
                    for (int n = 0; n < 2; ++n) acc[ai][bj][m][n] *= ratio; }
        }
    }
    __device__ __forceinline__ void operator()(const AccT& acc, const pg8::Unit& u, int wr, int wc, int fr_, int fq_) const {
        EPI_IDS();
#pragma unroll
        for (int ai = 0; ai < 2; ++ai) {
            f32x4 sn[4][2]; u32x4 xr[4][2];
#pragma unroll
            for (int m = 0; m < 4; ++m) { const int row = EPI_ROW(ai, m); sn[m][0] = *(const f32x4*)(SSN + (size_t)row * 8); sn[m][1] = *(const f32x4*)(SSN + (size_t)row * 8 + 4);
#pragma unroll
                for (int bj = 0; bj < 2; ++bj) xr[m][bj] = *(const u32x4*)(XH + (size_t)row * DM + u.pn * 256 + bj * 128 + wc * 32 + fq * 8); }
#pragma unroll
            for (int m = 0; m < 4; ++m) { const int row = EPI_ROW(ai, m);
                const float rn = __builtin_amdgcn_rsqf((sum4(sn[m][0]) + sum4(sn[m][1])) * (1.f / 512.f) + NORM_EPS);
                float v[8], x[8], ss = 0.f;
#pragma unroll
                for (int bj = 0; bj < 2; ++bj) { EPI_GET8(v, ai, bj, m, rn); unpk8(xr[m][bj], x);
#pragma unroll
                    for (int i = 0; i < 8; ++i) { v[i] += x[i]; ss += v[i] * v[i]; }
                    *(u32x4*)(H1 + (size_t)row * DM + u.pn * 256 + bj * 128 + wc * 32 + fq * 8) = pk8(v); }
                ss += __shfl_xor(ss, 16); ss += __shfl_xor(ss, 32);
                if (fq == 0) red[(ai * 128 + wr * 64 + m * 16 + fr) * 4 + wc] = ss;
            }
        }
        asm volatile("s_waitcnt lgkmcnt(0)" ::: "memory"); __builtin_amdgcn_s_barrier();
        if (t_ < 256) { const f32x4 r4 = *(const LAS f32x4*)(red + t_ * 4); SS2[(size_t)(u.pm * 256 + t_) * 4 + u.pn] = sum4(r4); }
    }
};
__device__ __forceinline__ float rstd16(const float* p, float inv_n) {
    const f32x4 a = *(const f32x4*)p, b = *(const f32x4*)(p + 4), c = *(const f32x4*)(p + 8), d = *(const f32x4*)(p + 12);
    return __builtin_amdgcn_rsqf(((sum4(a) + sum4(b)) + (sum4(c) + sum4(d))) * inv_n + NORM_EPS);
}
struct EpiUp {
    const float* SS2; half_t* A2;
    __device__ __forceinline__ void operator()(const AccT& acc, const pg8::Unit& u, int wr, int wc, int fr_, int fq_) const {
        EPI_IDS();
#pragma unroll
        for (int ai = 0; ai < 2; ++ai) {
            f32x4 s[4];
#pragma unroll
            for (int m = 0; m < 4; ++m) s[m] = *(const f32x4*)(SS2 + (size_t)EPI_ROW(ai, m) * 4);
#pragma unroll
            for (int m = 0; m < 4; ++m) { const int row = EPI_ROW(ai, m);
                const float rs = __builtin_amdgcn_rsqf(sum4(s[m]) * (1.f / 1024.f) + NORM_EPS);
                const float rs2 = rs * rs;
#pragma unroll
                for (int bj = 0; bj < 2; ++bj) { u32x4 w;
#pragma unroll
                    for (int n = 0; n < 2; ++n) { const f32x4 a = acc[ai][bj][m][n];
                        typedef float f32x2 __attribute__((ext_vector_type(2)));
                        f32x2 x0 = {relu_s(a[0]), relu_s(a[1])}, x1 = {relu_s(a[2]), relu_s(a[3])};
                        x0 = x0 * x0 * rs2; x1 = x1 * x1 * rs2;
                        w[2 * n] = pk_rne(x0[0], x0[1]); w[2 * n + 1] = pk_rne(x1[0], x1[1]); }
                    __builtin_nontemporal_store(w, (u32x4*)(A2 + (size_t)row * DFF + u.pn * 256 + bj * 128 + wc * 32 + fq * 8)); }
            }
        }
    }
};
struct EpiDn {
    const half_t* H1; half_t* H2; float* SS3; LAS float* red;
    __device__ __forceinline__ void operator()(const AccT& acc, const pg8::Unit& u, int wr, int wc, int fr_, int fq_) const {
        EPI_IDS();
#pragma unroll
        for (int ai = 0; ai < 2; ++ai) {
            u32x4 xr[4][2];
#pragma unroll
            for (int m = 0; m < 4; ++m)
#pragma unroll
                for (int bj = 0; bj < 2; ++bj) xr[m][bj] = *(const u32x4*)(H1 + (size_t)EPI_ROW(ai, m) * DM + u.pn * 256 + bj * 128 + wc * 32 + fq * 8);
#pragma unroll
            for (int m = 0; m < 4; ++m) { const int row = EPI_ROW(ai, m);
                float v[8], x[8], ss = 0.f;
#pragma unroll
                for (int bj = 0; bj < 2; ++bj) { EPI_GET8(v, ai, bj, m, 1.f); unpk8(xr[m][bj], x);
#pragma unroll
                    for (int i = 0; i < 8; ++i) { v[i] += x[i]; ss += v[i] * v[i]; }
                    *(u32x4*)(H2 + (size_t)row * DM + u.pn * 256 + bj * 128 + wc * 32 + fq * 8) = pk8(v); }
                ss += __shfl_xor(ss, 16); ss += __shfl_xor(ss, 32);
                if (fq == 0) red[(ai * 128 + wr * 64 + m * 16 + fr) * 4 + wc] = ss;
            }
        }
        asm volatile("s_waitcnt lgkmcnt(0)" ::: "memory"); __builtin_amdgcn_s_barrier();
        if (t_ < 256) { const f32x4 r4 = *(const LAS f32x4*)(red + t_ * 4); SS3[(size_t)(u.pm * 256 + t_) * 4 + u.pn] = sum4(r4); }
    }
};

constexpr int AT_KB = 0, AT_VB = 12288, AT_BUF = 20480;
constexpr int AT_SUB = 3;
constexpr int AT_STAGE = AT_SUB * AT_BUF;
constexpr int AT_IMP = 2 * AT_STAGE;
constexpr int AT_IMPW = 8 * 2 * 68 * 4;
constexpr int AT_SEL = AT_IMP + 8 * AT_IMPW;
constexpr int AT_QIDX = AT_SEL + 8 * 64;

struct TileRegs { u32x4 k, kp, v; };
__device__ __forceinline__ void tile_load(TileRegs& r, const half_t* Kt, const half_t* KPt, const half_t* Vt, int tid, int wid, int lane) {
    r.k = *(const u32x4*)(Kt + (size_t)(tid & 63) * 64 + wid * 8);
    if (KPt != nullptr && tid < 256) r.kp = *(const u32x4*)(KPt + (size_t)(tid & 63) * 32 + wid * 8);
    r.v = *(const u32x4*)(Vt + (size_t)(16 * (wid & 3) + (lane >> 2)) * 64 + (wid >> 2) * 32 + (lane & 3) * 8);
}
__device__ __forceinline__ void tile_store(const TileRegs& r, LAS unsigned char* buf, bool haspe, int tid, int wid, int lane) {
    *(LAS u32x4*)(buf + AT_KB + wid * 1024 + lane * 16) = r.k;
    if (haspe && tid < 256) *(LAS u32x4*)(buf + AT_KB + (8 + wid) * 1024 + lane * 16) = r.kp;
    *(LAS u32x4*)(buf + AT_VB + wid * 1024 + lane * 16) = r.v;
}
__device__ __forceinline__ float xhalf_max(float v) { const auto rr = __builtin_amdgcn_permlane32_swap(__float_as_uint(v), __float_as_uint(v), false, false); return fmaxf(__uint_as_float(rr[0]), __uint_as_float(rr[1])); }
__device__ __forceinline__ float xhalf_sum(float v) { const auto rr = __builtin_amdgcn_permlane32_swap(__float_as_uint(v), __float_as_uint(v), false, false); return __uint_as_float(rr[0]) + __uint_as_float(rr[1]); }
template <int NKS, int AB = 0>
__device__ __forceinline__ void tile_qk(const LAS unsigned char* kb, const half8 (&qf)[NKS], const f32x16& cinit, f32x16& p0, f32x16& p1) {
    if (AB & 1) { p0 = cinit; p1 = cinit; p0[0] += (float)qf[0][0]; p1[3] += (float)qf[1][1]; if (!(AB & 8)) { const half8 a = *(const LAS half8*)kb; p0[1] += (float)a[0]; } return; }
    half8 kf[2 * NKS];
#pragma unroll
    for (int ks = 0; ks < NKS; ++ks) { kf[2 * ks] = *(const LAS half8*)(kb + ks * 2048); kf[2 * ks + 1] = *(const LAS half8*)(kb + ks * 2048 + 512); }
    __builtin_amdgcn_sched_barrier(0);
    p0 = __builtin_amdgcn_mfma_f32_32x32x16_f16(kf[0], qf[0], cinit, 0, 0, 0);
    p1 = __builtin_amdgcn_mfma_f32_32x32x16_f16(kf[1], qf[0], cinit, 0, 0, 0);
#pragma unroll
    for (int ks = 1; ks < NKS; ++ks) {
        p0 = __builtin_amdgcn_mfma_f32_32x32x16_f16(kf[2 * ks], qf[ks], p0, 0, 0, 0);
        p1 = __builtin_amdgcn_mfma_f32_32x32x16_f16(kf[2 * ks + 1], qf[ks], p1, 0, 0, 0);
    }
}
__device__ __forceinline__ void tile_emask(f32x16& p0, f32x16& p1, int hiL, int loL) {
#pragma unroll
    for (int r = 0; r < 16; ++r) { const int c = (r & 3) + 8 * (r >> 2);
        if (!(c <= hiL && c >= loL)) p0[r] = -INFINITY;
        if (!(c + 32 <= hiL && c + 32 >= loL)) p1[r] = -INFINITY; }
}
__device__ __forceinline__ float tile_rowmax(const f32x16& p0, const f32x16& p1) {
    float a = fmaxf(fmaxf(p0[0], p0[1]), p0[2]), b = fmaxf(fmaxf(p1[0], p1[1]), p1[2]);
#pragma unroll
    for (int r = 3; r < 15; r += 2) { a = fmaxf(fmaxf(a, p0[r]), p0[r + 1]); b = fmaxf(fmaxf(b, p1[r]), p1[r + 1]); }
    a = fmaxf(fmaxf(a, p0[15]), fmaxf(b, p1[15]));
    return xhalf_max(a);
}
struct VFrags { v4i16 f[16]; };
__device__ __forceinline__ void vfrag_load(VFrags& V, const LAS unsigned char* vb) {
#pragma unroll
    for (int i = 0; i < 8; ++i) {
        V.f[2 * i]     = __builtin_amdgcn_ds_read_tr16_b64_v4i16((LAS v4i16*)(vb + (i >> 2) * 4096 + (i & 3) * 1024));
        V.f[2 * i + 1] = __builtin_amdgcn_ds_read_tr16_b64_v4i16((LAS v4i16*)(vb + (i >> 2) * 4096 + (i & 3) * 1024 + 512));
    }
}
__device__ __forceinline__ void tile_pv(const f32x16& p0, const f32x16& p1, const VFrags& V, f32x16 (&o)[2]) {
    u32x4 pw[4];
#pragma unroll
    for (int s = 0; s < 2; ++s) {
        pw[s]     = (u32x4){pk_rtz(p0[8 * s], p0[8 * s + 1]), pk_rtz(p0[8 * s + 2], p0[8 * s + 3]), pk_rtz(p0[8 * s + 4], p0[8 * s + 5]), pk_rtz(p0[8 * s + 6], p0[8 * s + 7])};
        pw[2 + s] = (u32x4){pk_rtz(p1[8 * s], p1[8 * s + 1]), pk_rtz(p1[8 * s + 2], p1[8 * s + 3]), pk_rtz(p1[8 * s + 4], p1[8 * s + 5]), pk_rtz(p1[8 * s + 6], p1[8 * s + 7])};
    }
    typedef short s8 __attribute__((ext_vector_type(8)));
#pragma unroll
    for (int db = 0; db < 2; ++db)
#pragma unroll
        for (int ks = 0; ks < 4; ++ks) {
            const v4i16 lo = V.f[2 * (db * 4 + ks)], hi = V.f[2 * (db * 4 + ks) + 1];
            const s8 t = {lo[0], lo[1], lo[2], lo[3], hi[0], hi[1], hi[2], hi[3]};
            o[db] = __builtin_amdgcn_mfma_f32_32x32x16_f16(__builtin_bit_cast(half8, t), __builtin_bit_cast(half8, pw[ks]), o[db], 0, 0, 0);
        }
}
constexpr float SM_THR = 6.f;
struct SmState { f32x16 negm; float mref, l; };
__device__ __forceinline__ void sm_reset(SmState& S) { S.negm = (f32x16){0.f}; S.mref = 0.f; S.l = 0.f; }
template <int AB = 0>
__device__ __forceinline__ void tile_softmax_pv(f32x16& p0, f32x16& p1, const LAS unsigned char* vb, f32x16 (&o)[2], SmState& S, bool first) {
    VFrags V; if (!(AB & 4)) vfrag_load(V, vb);
    if (!(AB & 2)) {
        const float tm = tile_rowmax(p0, p1);
        const bool need = first ? (tm > -INFINITY) : (tm > SM_THR);
        if (__any(need)) {
            const float delta = need ? tm : 0.f, alpha = __builtin_amdgcn_exp2f(-delta);
            S.mref += delta; S.l *= alpha;
#pragma unroll
            for (int r = 0; r < 16; ++r) { p0[r] -= delta; p1[r] -= delta; o[0][r] *= alpha; o[1][r] *= alpha; S.negm[r] = -S.mref; }
        }
        float s0 = 0.f, s1 = 0.f, s2 = 0.f, s3 = 0.f;
#pragma unroll
        for (int r = 0; r < 16; ++r) { p0[r] = __builtin_amdgcn_exp2f(p0[r]); p1[r] = __builtin_amdgcn_exp2f(p1[r]); }
#pragma unroll
        for (int r = 0; r < 16; r += 2) { s0 += p0[r]; s1 += p0[r + 1]; s2 += p1[r]; s3 += p1[r + 1]; }
        S.l += (s0 + s1) + (s2 + s3);
    }
    if (!(AB & 4)) tile_pv(p0, p1, V, o); else { _Pragma("unroll") for (int r = 0; r < 16; ++r) { o[0][r & 3] += p0[r]; o[1][r & 3] += p1[r]; } }
}

__device__ __forceinline__ void glds16(const void* gsrc, unsigned lds_dst) { unsigned keep;
    asm volatile("s_mov_b32 %0, m0\n\ts_mov_b32 m0, %2\n\ts_nop 0\n\tglobal_load_lds_dwordx4 %1, off\n\ts_mov_b32 m0, %0" : "=&s"(keep) : "v"(gsrc), "s"(lds_dst) : "memory"); }
__device__ __forceinline__ unsigned lds_addr(const LAS unsigned char* p) { return (unsigned)__builtin_amdgcn_readfirstlane((int)(unsigned)(size_t)p); }
__device__ __forceinline__ void tile_dma(const half_t* Kt, const half_t* KPt, const half_t* Vt, LAS unsigned char* sub, bool haspe, int wid, int lane) {
    const unsigned base = lds_addr(sub);
    glds16(Kt + wid * 512 + lane * 8, base + AT_KB + wid * 1024);
    if (haspe && wid < 4) glds16(KPt + wid * 512 + lane * 8, base + AT_KB + (8 + wid) * 1024);
    glds16(Vt + wid * 512 + lane * 8, base + AT_VB + wid * 1024);
}
#ifndef AT_STAGGER
#define AT_STAGGER 7
#endif
#ifndef AT_STAGGER_MASK
#define AT_STAGGER_MASK 4
#endif
#define AT_WAITBAR() do { asm volatile("s_waitcnt vmcnt(0) lgkmcnt(0)" ::: "memory"); __builtin_amdgcn_s_barrier(); } while (0)
#define KV_STREAM(NT, DMAT, COMPT) do { \
    const int nt__ = (NT), nst__ = (nt__ + AT_SUB - 1) / AT_SUB; \
    _Pragma("unroll") for (int j_ = 0; j_ < AT_SUB; ++j_) if (j_ < nt__) { DMAT(j_, lds + j_ * AT_BUF); } \
    AT_WAITBAR(); \
    for (int s_ = 0; s_ < nst__; ++s_) { \
        LAS unsigned char* cb_ = lds + (s_ & 1) * AT_STAGE; LAS unsigned char* nb_ = lds + ((s_ + 1) & 1) * AT_STAGE; \
        _Pragma("unroll") for (int j_ = 0; j_ < AT_SUB; ++j_) { const int tn_ = (s_ + 1) * AT_SUB + j_; if (tn_ < nt__) { DMAT(tn_, nb_ + j_ * AT_BUF); } } \
        _Pragma("unroll") for (int j_ = 0; j_ < AT_SUB; ++j_) { const int tc_ = s_ * AT_SUB + j_; if (tc_ < nt__) { COMPT(tc_, cb_ + j_ * AT_BUF); } } \
        AT_WAITBAR(); \
    } } while (0)

struct AttnPtrs {
    const half_t* QM; const half_t* KNM; const half_t* KPE; const half_t* VM;
    const half_t* QN; const half_t* KC; const half_t* VC; const half_t* KS; const half_t* VS; const half_t* KW; const half_t* VW; const float* GATE;
    half_t* Y; float* SSM; float* SSN;
};

template <int AB = 0>
__device__ __forceinline__ void mla_unit(const AttnPtrs& P, int bh, int qb, LAS unsigned char* lds, bool nostore = false) {
    int tid_ = threadIdx.x; asm volatile("" : "+v"(tid_));
    const int tid = tid_, lane = tid & 63, wid = __builtin_amdgcn_readfirstlane(tid >> 6), q = lane & 31, h = lane >> 5;
    const int b = bh >> 3, hd = bh & 7, q0 = qb * 256, qpos = q0 + wid * 32 + q;
    const size_t trow = (size_t)b * SEQ + qpos;
    half8 qf[6];
#pragma unroll
    for (int ks = 0; ks < 6; ++ks) qf[ks] = *(const half8*)(P.QM + trow * 768 + hd * 96 + ks * 16 + h * 8);
#pragma unroll
    for (int ks = 0; ks < 6; ++ks) asm volatile("" : "+v"(qf[ks]));
    const half_t* Kb = P.KNM + (size_t)bh * SEQ * 64; const half_t* Vb = P.VM + (size_t)bh * SEQ * 64; const half_t* KPb = P.KPE + (size_t)b * SEQ * 32;
    const int ntiles = 4 * qb + 4, my_last = 4 * qb + (wid >> 1);
    f32x16 o[2]; o[0] = (f32x16){0.f}; o[1] = (f32x16){0.f};
    SmState S; sm_reset(S);
    const int koff = h * 1024 + q * 16, voff = (4 * h + ((lane & 15) >> 2)) * 64 + ((lane >> 4) & 1) * 32 + (lane & 3) * 8;
#define MLA_LOAD(t, sub) if (!(AB & 16)) tile_dma(Kb + (size_t)(t) * 4096, KPb + (size_t)(t) * 2048, Vb + (size_t)(t) * 4096, sub, true, wid, lane)
#define MLA_COMP(t, buf) do { if ((t) <= my_last) { f32x16 p0, p1; \
        tile_qk<6, AB>((buf) + AT_KB + koff, qf, S.negm, p0, p1); \
        if ((t) == my_last) tile_emask(p0, p1, qpos - 64 * (t) - 4 * h, -1000); \
        tile_softmax_pv<AB>(p0, p1, (buf) + AT_VB + voff, o, S, (t) == 0); } } while (0)
    KV_STREAM(ntiles, MLA_LOAD, MLA_COMP);
#undef MLA_LOAD
#undef MLA_COMP
    const float l = xhalf_sum(S.l);
    const float inv = 1.f / l;
    if (nostore && !(l == 123.456f)) return;
    float ss = 0.f;
    half_t* yrow = P.Y + trow * DM + hd * 64;
#pragma unroll
    for (int db = 0; db < 2; ++db)
#pragma unroll
        for (int c = 0; c < 4; ++c) { const float a0 = o[db][4 * c] * inv, a1 = o[db][4 * c + 1] * inv, a2 = o[db][4 * c + 2] * inv, a3 = o[db][4 * c + 3] * inv;
            ss += (a0 * a0 + a1 * a1) + (a2 * a2 + a3 * a3);
            *(u32x2*)(yrow + db * 32 + 8 * c + 4 * h) = (u32x2){pk_rne(a0, a1), pk_rne(a2, a3)}; }
    ss = xhalf_sum(ss);
    if (h == 0) P.SSM[trow * 8 + hd] = ss;
}

template <int NKS_unused = 4>
__device__ __forceinline__ void nsa_stream_begin(TileRegs& tr, const half_t* Kt, const half_t* Vt, LAS unsigned char* lds, int tid, int wid, int lane) {
    tile_load(tr, Kt, nullptr, Vt, tid, wid, lane);
    tile_store(tr, lds, false, tid, wid, lane);
    __syncthreads();
}
__device__ __forceinline__ void nsa_unit(const AttnPtrs& P, int bg, int qb, LAS unsigned char* lds) {
    int tid_ = threadIdx.x; asm volatile("" : "+v"(tid_));
    const int tid = tid_, lane = tid & 63, wid = __builtin_amdgcn_readfirstlane(tid >> 6), j = lane & 31, h = lane >> 5;
    const int b = bg >> 1, g = bg & 1, q0 = qb * 64, cur = qb, qi = j >> 2, hh = j & 3, qrel = wid * 8 + qi, qpos = q0 + qrel, head = g * 4 + hh;
    const size_t trow = (size_t)b * SEQ + qpos;
    half8 qf[4];
#pragma unroll
    for (int ks = 0; ks < 4; ++ks) qf[ks] = *(const half8*)(P.QN + trow * 512 + head * 64 + ks * 16 + h * 8);
    float g0 = P.GATE[trow * 24 + head], g1 = P.GATE[trow * 24 + 8 + head], g2 = P.GATE[trow * 24 + 16 + head];
#pragma unroll
    for (int ks = 0; ks < 4; ++ks) asm volatile("" : "+v"(qf[ks]));
    asm volatile("" : "+v"(g0), "+v"(g1), "+v"(g2));
    const int koff = h * 1024 + j * 16, voff = (4 * h + ((lane & 15) >> 2)) * 64 + ((lane >> 4) & 1) * 32 + (lane & 3) * 8;
    f32x16 acc[2]; acc[0] = (f32x16){0.f}; acc[1] = (f32x16){0.f};
    f32x16 o[2];
    LAS float* impw = (LAS float*)(lds + AT_IMP + wid * AT_IMPW);
    unsigned long long selmask = (2ull << cur) - 1ull;

    const int ncmp = ((q0 + 32) >> 4) / 64 + 1;
    const half_t* Kc = P.KC + (size_t)bg * 256 * 64; const half_t* Vc = P.VC + (size_t)bg * 256 * 64;
    float m = -1e30f, l = 0.f; const f32x16 zero16 = (f32x16){0.f};
#define CMP_LOAD(t, sub) tile_dma(Kc + (size_t)(t) * 4096, nullptr, Vc + (size_t)(t) * 4096, sub, false, wid, lane)
#define CMP1_COMP(t, buf) do { f32x16 p0, p1; \
        tile_qk<4>((buf) + AT_KB + koff, qf, zero16, p0, p1); \
        tile_emask(p0, p1, ((qpos - 31 - 1024 * (t)) >> 4) - 4 * h, -1000); \
        const float tm = tile_rowmax(p0, p1), mn = fmaxf(m, tm), alpha = __builtin_amdgcn_exp2f(m - mn); \
        float sum = 0.f; \
        _Pragma("unroll") for (int r = 0; r < 16; ++r) sum += __builtin_amdgcn_exp2f(p0[r] - mn) + __builtin_amdgcn_exp2f(p1[r] - mn); \
        l = l * alpha + sum; m = mn; } while (0)
    KV_STREAM(ncmp, CMP_LOAD, CMP1_COMP);
    l = xhalf_sum(l);
    const float invl = (l > 0.f) ? 1.f / l : 0.f;
    o[0] = (f32x16){0.f}; o[1] = (f32x16){0.f};
#define CMP2_COMP(t, buf) do { f32x16 p0, p1; \
        VFrags V; vfrag_load(V, (buf) + AT_VB + voff); \
        tile_qk<4>((buf) + AT_KB + koff, qf, zero16, p0, p1); \
        tile_emask(p0, p1, ((qpos - 31 - 1024 * (t)) >> 4) - 4 * h, -1000); \
        _Pragma("unroll") for (int r = 0; r < 16; ++r) { p0[r] = __builtin_amdgcn_exp2f(p0[r] - m) * invl; p1[r] = __builtin_amdgcn_exp2f(p1[r] - m) * invl; } \
        if (cur >= 16) { \
            _Pragma("unroll") for (int kb = 0; kb < 2; ++kb) \
            _Pragma("unroll") for (int c = 0; c < 4; ++c) { \
                const f32x16& p = kb ? p1 : p0; \
                float C = (p[4 * c] + p[4 * c + 1]) + (p[4 * c + 2] + 0.5f * p[4 * c + 3]), D = 0.5f * p[4 * c + 3]; \
                C += __shfl_xor(C, 1); C += __shfl_xor(C, 2); D += __shfl_xor(D, 1); D += __shfl_xor(D, 2); \
                const int jb = 16 * (t) + 8 * kb + 2 * c + h; \
                if (hh == 0) { impw[qi * 136 + jb] = C; impw[qi * 136 + 68 + jb + 1] = D; } } } \
        tile_pv(p0, p1, V, o); } while (0)
    KV_STREAM(ncmp, CMP_LOAD, CMP2_COMP);
#undef CMP_LOAD
#undef CMP1_COMP
#undef CMP2_COMP
#pragma unroll
    for (int r = 0; r < 16; ++r) { acc[0][r] = g0 * o[0][r]; acc[1][r] = g0 * o[1][r]; }

    if (cur >= 16) {
        const int tq = lane >> 3, e = lane & 7;
        float v[8];
#pragma unroll
        for (int i = 0; i < 8; ++i) { const int jb = e + 8 * i; const float s = impw[tq * 136 + jb] + impw[tq * 136 + 68 + jb];
            v[i] = (jb >= 1 && jb <= cur - 2) ? s : -1.f; }
        unsigned selb = 0u;
        for (int it = 0; it < 13; ++it) {
            float lm = v[0];
#pragma unroll
            for (int i = 1; i < 8; ++i) lm = fmaxf(lm, v[i]);
            float gm = fmaxf(lm, __shfl_xor(lm, 1)); gm = fmaxf(gm, __shfl_xor(gm, 2)); gm = fmaxf(gm, __shfl_xor(gm, 4));
            int cj = 99;
#pragma unroll
            for (int i = 7; i >= 0; --i) cj = (v[i] == gm) ? (e + 8 * i) : cj;
            int gj = min(cj, __shfl_xor(cj, 1)); gj = min(gj, __shfl_xor(gj, 2)); gj = min(gj, __shfl_xor(gj, 4));
#pragma unroll
            for (int i = 0; i < 8; ++i) if (gj == e + 8 * i) { v[i] = -2.f; selb |= 1u << i; }
        }
        unsigned lo = 0u, hi = 0u;
#pragma unroll
        for (int i = 0; i < 4; ++i) { lo |= ((selb >> i) & 1u) << (e + 8 * i); hi |= ((selb >> (i + 4)) & 1u) << (e + 8 * i); }
        lo |= __shfl_xor(lo, 1); lo |= __shfl_xor(lo, 2); lo |= __shfl_xor(lo, 4);
        hi |= __shfl_xor(hi, 1); hi |= __shfl_xor(hi, 2); hi |= __shfl_xor(hi, 4);
        unsigned long long mk = ((unsigned long long)hi << 32) | lo;
        mk |= 1ull | (1ull << cur) | (1ull << (cur - 1));
        LAS unsigned long long* selw = (LAS unsigned long long*)(lds + AT_SEL + wid * 64);
        if (e == 0) selw[tq] = mk;
        selmask = selw[qi];
    }

    {
        const half_t* Ks = P.KS + (size_t)bg * SEQ * 64; const half_t* Vs = P.VS + (size_t)bg * SEQ * 64;
        SmState S; sm_reset(S); bool seen = false; o[0] = (f32x16){0.f}; o[1] = (f32x16){0.f};
#define SLC_LOAD(t, sub) tile_dma(Ks + (size_t)(t) * 4096, nullptr, Vs + (size_t)(t) * 4096, sub, false, wid, lane)
#define SLC_COMP(t, buf) do { const bool rowsel = (selmask >> (t)) & 1ull; \
            if (__any(rowsel)) { f32x16 p0, p1, ci; \
                _Pragma("unroll") for (int r = 0; r < 16; ++r) ci[r] = rowsel ? S.negm[r] : -INFINITY;     \
                tile_qk<4>((buf) + AT_KB + koff, qf, ci, p0, p1); \
                if ((t) == cur) tile_emask(p0, p1, qrel - 4 * h, -1000); \
                tile_softmax_pv(p0, p1, (buf) + AT_VB + voff, o, S, !seen); seen = seen || rowsel; } } while (0)
        KV_STREAM(cur + 1, SLC_LOAD, SLC_COMP);
#undef SLC_LOAD
#undef SLC_COMP
        const float sc = g1 / xhalf_sum(S.l);
#pragma unroll
        for (int r = 0; r < 16; ++r) { acc[0][r] += sc * o[0][r]; acc[1][r] += sc * o[1][r]; }
    }
    {
        const int t0 = (cur >= 8) ? cur - 8 : 0;
        const half_t* Kw = P.KW + ((size_t)bg * SEQ + (size_t)t0 * 64) * 64; const half_t* Vw = P.VW + ((size_t)bg * SEQ + (size_t)t0 * 64) * 64;
        SmState S; sm_reset(S); o[0] = (f32x16){0.f}; o[1] = (f32x16){0.f};
#define WIN_LOAD(i, sub) tile_dma(Kw + (size_t)(i) * 4096, nullptr, Vw + (size_t)(i) * 4096, sub, false, wid, lane)
#define WIN_COMP(i, buf) do { const int t = t0 + (i); f32x16 p0, p1; \
            tile_qk<4>((buf) + AT_KB + koff, qf, S.negm, p0, p1); \
            if (t == cur) tile_emask(p0, p1, qrel - 4 * h, -1000); \
            else if (t == cur - 8) tile_emask(p0, p1, 1000, qrel + 1 - 4 * h); \
            tile_softmax_pv(p0, p1, (buf) + AT_VB + voff, o, S, (i) == 0); } while (0)
        KV_STREAM(cur - t0 + 1, WIN_LOAD, WIN_COMP);
#undef WIN_LOAD
#undef WIN_COMP
        const float sc = g2 / xhalf_sum(S.l);
#pragma unroll
        for (int r = 0; r < 16; ++r) { acc[0][r] += sc * o[0][r]; acc[1][r] += sc * o[1][r]; }
    }
    float ss = 0.f;
    half_t* yrow = P.Y + trow * DM + 512 + head * 64;
#pragma unroll
    for (int db = 0; db < 2; ++db)
#pragma unroll
        for (int c = 0; c < 4; ++c) { const float a0 = acc[db][4 * c], a1 = acc[db][4 * c + 1], a2 = acc[db][4 * c + 2], a3 = acc[db][4 * c + 3];
            ss += (a0 * a0 + a1 * a1) + (a2 * a2 + a3 * a3);
            *(u32x2*)(yrow + db * 32 + 8 * c + 4 * h) = (u32x2){pk_rne(a0, a1), pk_rne(a2, a3)}; }
    ss = xhalf_sum(ss);
    if (h == 0) P.SSN[trow * 8 + head] = ss;
}

struct Args { const float* in[24]; float* out; unsigned char* ws; int ph_lo, ph_hi, li, pad; };

template <class SrcFn>
__device__ __forceinline__ void conv_wt(const float* W, int Ksrc, int Nsrc, const float* gain, const float* gain2, int ksplit, half_t* WT, int Ndst, int Kdst, SrcFn src, LAS float* scr, int gw, int ngw, int lane) {
    const int nblk = Ndst / 32, nitems = nblk * (Kdst / 64);
    for (int it = gw; it < nitems; it += ngw) {
        const int kb = it / nblk, nb = it % nblk, k0 = 64 * kb, n0 = 32 * nb;
        const int sc = src(n0 + (lane & 31));
#pragma unroll 8
        for (int i = 0; i < 32; ++i) { const int kk = 2 * i + (lane >> 5), k = k0 + kk;
            const int kc = k < Ksrc ? k : Ksrc - 1, scc = sc >= 0 ? sc : 0;
            float v = W[(size_t)kc * Nsrc + scc];
            if (gain) v *= (gain2 && kc >= ksplit) ? gain2[kc - ksplit] : gain[kc];
            scr[kk * 33 + (lane & 31)] = (sc >= 0 && k < Ksrc) ? v : 0.f; }
        asm volatile("s_waitcnt lgkmcnt(0)" ::: "memory");
        const int c = lane & 7;
#pragma unroll
        for (int jj = 0; jj < 4; ++jj) { const int n = (lane >> 3) + 8 * jj; const LAS float* s = scr + (8 * c) * 33 + n; float v[8];
#pragma unroll
            for (int e = 0; e < 8; ++e) v[e] = s[e * 33];
            *(u32x4*)(WT + (size_t)(n0 + n) * Kdst + k0 + 8 * c) = pk8(v); }
        asm volatile("s_waitcnt lgkmcnt(0)" ::: "memory");
    }
}
__device__ __forceinline__ int src_win(int n) {
    const int t = n >> 8, c = n & 255;
    if (t == 0) return c;
    if (t == 1) { if (c < 128) return 256 + c;
                  if (c < 160) { const int p = c - 128; return 384 + (p >> 1) + 16 * (p & 1); }
                  if (c < 184) return 1696 + (c - 160);
                  return -1; }
    if (t < 4) { const int hd = (t - 2) * 4 + (c >> 6), p = c & 63; const int d = (p < 16) ? (p >> 1) + 8 * (p & 1) : p; return 416 + hd * 64 + d; }
    const int br = (t - 4) * 2 + (c >> 7), g = (c >> 6) & 1, p = c & 63;
    const bool roped = (br == 2 || br == 4);
    const int d = (roped && p < 16) ? (p >> 1) + 8 * (p & 1) : p;
    return 928 + br * 128 + g * 64 + d;
}
__device__ __forceinline__ int src_wuq(int n) { const int hd = n / 96, p = n % 96; return (p < 64) ? hd * 96 + p : hd * 96 + 64 + ((p - 64) >> 1) + 16 * ((p - 64) & 1); }
__device__ __forceinline__ int src_wukv(int n) { return (n < 512) ? (n >> 6) * 128 + (n & 63) : ((n - 512) >> 6) * 128 + 64 + (n & 63); }

#define PH_IDS() int tid_ = threadIdx.x; asm volatile("" : "+v"(tid_)); const int tid = tid_, lane = tid & 63, wid = __builtin_amdgcn_readfirstlane(tid >> 6); \
    const int G = gridDim.x, gt = blockIdx.x * 512 + tid, ngt = G * 512, gw = blockIdx.x * 8 + wid, ngw = G * 8; (void)lane; (void)gt; (void)ngt; (void)gw; (void)ngw; (void)G
#define WSP(T, off) ((T*)(ws + (off)))


__global__ void __launch_bounds__(512, 2) hymba_fwd(Args args) {
    extern __shared__ __attribute__((aligned(16))) unsigned char lds_raw[];
    LAS unsigned char* lds = (LAS unsigned char*)lds_raw;
    unsigned char* ws = args.ws;
    volatile LAS unsigned* MISC = (volatile LAS unsigned*)(lds + LDS_MISC);
    if (threadIdx.x < 16) MISC[threadIdx.x] = 0u;
    __syncthreads();
    XcdBarrier bar = xcd_barrier_post(WSP(unsigned, WS_CTL) + CW_BAR + args.li * XCD_BAR_WORDS, MISC + 8);
#if defined(DBG_STAMP)
#define STAMP_FIRST() STAMP(0)
#define STAMP(k) do { if (blockIdx.x == 0 && threadIdx.x == 0) ((unsigned long long*)(WSP(unsigned, WS_CTL) + 160))[k] = __builtin_amdgcn_s_memrealtime(); } while (0)
#else
#define STAMP_FIRST() do { } while (0)
#define STAMP(k) do { } while (0)
#endif
    const int lo = args.ph_lo, hi = args.ph_hi;
    STAMP_FIRST();
#define IN(k) (lo <= (k) && (k) < hi)
#define REP_BEGIN(k) for (int rep_ = 0; rep_ < ((k) == REPEAT_PHASE ? 2 : 1); ++rep_) {
#define REP_END(k) if ((k) == REPEAT_PHASE && rep_ == 0) xcd_barrier(bar); }
#define SEAM(k) do { if (IN(k) && IN((k) + 1 + ((k) == 4))) xcd_barrier(bar); STAMP((k) + 1); } while (0)

    if (IN(0)) { REP_BEGIN(0)
        PH_IDS();
        LAS float* scr = (LAS float*)(lds + wid * 8448);
        const int BIG = 1 << 30;
        for (int step_ = 0; step_ < 2; ++step_) {
        if (((step_ ^ wid) & 1) == 0) {
        conv_wt(args.in[2], 1024, IN_COLS, args.in[1], nullptr, BIG, WSP(half_t, WS_WIN), NIN, 1024, [](int n) { return src_win(n); }, scr, (gw + ngw - 0 % ngw) % ngw, ngw, lane);
        conv_wt(args.in[4], 256, 768, args.in[3], nullptr, BIG, WSP(half_t, WS_WUQ), 768, 256, [](int n) { return src_wuq(n); }, scr, (gw + ngw - 896 % ngw) % ngw, ngw, lane);
        conv_wt(args.in[6], 128, 1024, args.in[5], nullptr, BIG, WSP(half_t, WS_WUKV), 1024, 256, [](int n) { return src_wukv(n); }, scr, (gw + ngw - 992 % ngw) % ngw, ngw, lane);
        conv_wt(args.in[8], 2048, 128, nullptr, nullptr, BIG, WSP(half_t, WS_WC1), 256, 2048, [](int n) { return n < 128 ? n : -1; }, scr, (gw + ngw - 1120 % ngw) % ngw, ngw, lane);
        conv_wt(args.in[13], 2048, 128, nullptr, nullptr, BIG, WSP(half_t, WS_WC1) + 256 * 2048, 256, 2048, [](int n) { return n < 128 ? n : -1; }, scr, (gw + ngw - 1376 % ngw) % ngw, ngw, lane);
        conv_wt(args.in[19], 1024, 1024, args.in[17], args.in[18], 512, WSP(half_t, WS_WO), 1024, 1024, [](int n) { return n; }, scr, (gw + ngw - 1632 % ngw) % ngw, ngw, lane);
        conv_wt(args.in[21], 1024, 4096, args.in[20], nullptr, BIG, WSP(half_t, WS_WUP), 4096, 1024, [](int n) { return n; }, scr, (gw + ngw - 2144 % ngw) % ngw, ngw, lane);
        conv_wt(args.in[22], 4096, 1024, nullptr, nullptr, BIG, WSP(half_t, WS_WDN), 1024, 4096, [](int n) { return n; }, scr, (gw + ngw - 4192 % ngw) % ngw, ngw, lane);
        { float2* ROPEM = WSP(float2, WS_ROPEM); float2* ROPEN = WSP(float2, WS_ROPEN);
          for (int it = gt; it < SEQ * 16; it += ngt) { const int pos = it >> 4, i = it & 15; const float inv = expf(-logf(500000.f) * (float)(2 * i) / 32.f), a = (float)pos * inv; ROPEM[it] = make_float2(cosf(a), sinf(a)); }
          for (int it = gt; it < SEQ * 8; it += ngt) { const int pos = it >> 3, i = it & 7; const float inv = expf(-logf(500000.f) * (float)(2 * i) / 16.f), a = (float)pos * inv; ROPEN[it] = make_float2(cosf(a), sinf(a)); } }
        for (int o = (gw & 7) == 0 ? (gw >> 3) : 256; o < 256; o += (ngw >> 3)) { const int kv = o >> 7, jj = o & 127; const float* pe = args.in[kv ? 12 : 7]; const float* w1 = args.in[kv ? 13 : 8]; const float* b1 = args.in[kv ? 14 : 9];
            float s = 0.f; for (int k = lane; k < 2048; k += 64) s += pe[k] * w1[(size_t)k * 128 + jj];
            s = wave_sum(s); if (lane == 0) WSP(float, WS_B1P)[o] = b1[jj] + s; }
        } else
        { const float* x = args.in[0]; half_t* XH = WSP(half_t, WS_XH); float* RS1 = WSP(float, WS_RS1);
          for (int r0 = gw * 4; r0 < MROWS; r0 += ngw * 4) {
            f32x4 v[4][4]; float s[4];
#pragma unroll
            for (int rr = 0; rr < 4; ++rr) { const f32x4* xr = (const f32x4*)(x + (size_t)(r0 + rr) * DM) + lane;
#pragma unroll
                for (int jv = 0; jv < 4; ++jv) v[rr][jv] = xr[64 * jv]; }
#pragma unroll
            for (int rr = 0; rr < 4; ++rr) { float t = 0.f;
#pragma unroll
                for (int jv = 0; jv < 4; ++jv) t += (v[rr][jv][0] * v[rr][jv][0] + v[rr][jv][1] * v[rr][jv][1]) + (v[rr][jv][2] * v[rr][jv][2] + v[rr][jv][3] * v[rr][jv][3]);
                s[rr] = t; }
#pragma unroll
            for (int o = 1; o < 64; o <<= 1) {
#pragma unroll
                for (int rr = 0; rr < 4; ++rr) s[rr] += __shfl_xor(s[rr], o); }
#pragma unroll
            for (int rr = 0; rr < 4; ++rr) { u32x2* o8 = (u32x2*)(XH + (size_t)(r0 + rr) * DM) + lane;
#pragma unroll
                for (int jv = 0; jv < 4; ++jv) o8[64 * jv] = (u32x2){pk_rne(v[rr][jv][0], v[rr][jv][1]), pk_rne(v[rr][jv][2], v[rr][jv][3])};
                if (lane == 0) RS1[r0 + rr] = __builtin_amdgcn_rsqf(s[rr] * (1.f / DM) + NORM_EPS); }
          } }
        }
    REP_END(0) }
    SEAM(0);
    if (IN(1)) { REP_BEGIN(1)
        pg8::Gemm g{WSP(half_t, WS_XH), WSP(half_t, WS_WIN), 1024, 1024, 1024}; pg8::StaticOrder S; S.init(MROWS, NIN, gridDim.x, (int)blockIdx.x, 1024, 1024);
        EpiIn E{WSP(float, WS_RS1), WSP(half_t, WS_CQ), WSP(half_t, WS_T1), WSP(half_t, WS_KPE), WSP(float, WS_GATE), WSP(float, WS_SSQ), WSP(float, WS_SSKV), WSP(half_t, WS_QN), WSP(half_t, WS_KVT), WSP(float2, WS_ROPEM), WSP(float2, WS_ROPEN)};
        pg8::gemm_phase(lds, g, S, E);
    REP_END(1) }
    SEAM(1);
    if (IN(2)) { REP_BEGIN(2)
        { pg8::Gemm g{WSP(half_t, WS_CQ), WSP(half_t, WS_WUQ), 256, 256, 256}; pg8::StaticOrder S; S.init(MROWS, 768, gridDim.x, (int)blockIdx.x, 256, 256); EpiUq E{WSP(float, WS_SSQ), WSP(half_t, WS_QM), WSP(float2, WS_ROPEM)}; pg8::gemm_phase(lds, g, S, E); }
        { pg8::Gemm g{WSP(half_t, WS_T1), WSP(half_t, WS_WUKV), 256, 256, 256}; pg8::StaticOrder S; S.init(MROWS, 1024, gridDim.x, (int)blockIdx.x, 256, 256); EpiUkv E{WSP(float, WS_SSKV), WSP(half_t, WS_KNM), WSP(half_t, WS_VM)}; pg8::gemm_phase(lds, g, S, E); }
        { pg8::Gemm g{WSP(half_t, WS_KVT), WSP(half_t, WS_WC1), 512, 1024, 2048}; pg8::Cmp1Order S{(int)gridDim.x, (int)blockIdx.x}; EpiC1 E{WSP(float, WS_HIDP)}; pg8::gemm_phase(lds, g, S, E); }
    REP_END(2) }
    SEAM(2);
    if (IN(3)) { REP_BEGIN(3)
        PH_IDS();
        const float* B1P = WSP(float, WS_B1P); const float* HIDP = WSP(float, WS_HIDP); const float2* ROPEN = WSP(float2, WS_ROPEN);
        LAS float* w2s = (LAS float*)lds;
        LAS float* hl = (LAS float*)(lds + 65536 + wid * 4096);
        for (int i = tid; i < 2 * 128 * 64; i += 512) { const int kv = i >> 13, k = (i >> 6) & 127, p = i & 63; const int dsrc = (kv == 0 && p < 16) ? (p >> 1) + 8 * (p & 1) : p;
            w2s[i] = args.in[kv ? 15 : 10][k * 64 + dsrc]; }
        __syncthreads();
        for (int it = gw; it < 2 * 32 * 32; it += ngw) {
            const int kv = it >> 10, slab = (it >> 5) & 31, n0 = (it & 31) * 8;
            const float* b2 = args.in[kv ? 16 : 11];
            float hv[8][2][4];
#pragma unroll
            for (int rr = 0; rr < 8; ++rr)
#pragma unroll
                for (int c = 0; c < 2; ++c)
#pragma unroll
                    for (int ch = 0; ch < 4; ++ch) hv[rr][c][ch] = HIDP[((size_t)((kv * 32 + slab) * 4 + ch) * 256 + n0 + rr) * 128 + lane + 64 * c];
#pragma unroll
            for (int rr = 0; rr < 8; ++rr)
#pragma unroll
                for (int c = 0; c < 2; ++c) { const int col = lane + 64 * c; const float s = B1P[kv * 128 + col] + ((hv[rr][c][0] + hv[rr][c][1]) + (hv[rr][c][2] + hv[rr][c][3]));
                    const float z = 0.7978845608028654f * (s + 0.044715f * s * s * s), th = 1.f - 2.f / (1.f + __expf(2.f * z));
                    hl[rr * 128 + col] = 0.5f * s * (1.f + th); }
            asm volatile("s_waitcnt lgkmcnt(0)" ::: "memory");
            const int dsrc = (kv == 0 && lane < 16) ? (lane >> 1) + 8 * (lane & 1) : lane;
            float a[8];
#pragma unroll
            for (int rr = 0; rr < 8; ++rr) a[rr] = b2[dsrc];
            const LAS float* wk = w2s + kv * 8192 + lane;
#pragma unroll 4
            for (int k = 0; k < 128; k += 4) {
                const float w0 = wk[k * 64], w1 = wk[(k + 1) * 64], w2v = wk[(k + 2) * 64], w3 = wk[(k + 3) * 64];
#pragma unroll
                for (int rr = 0; rr < 8; ++rr) { const f32x4 hh = *(const LAS f32x4*)(hl + rr * 128 + k); a[rr] += (hh[0] * w0 + hh[1] * w1) + (hh[2] * w2v + hh[3] * w3); }
            }
            half_t* dst = (kv ? WSP(half_t, WS_VC) : WSP(half_t, WS_KC)) + (size_t)slab * 256 * 64;
#pragma unroll
            for (int rr = 0; rr < 8; ++rr) { const int n = n0 + rr; float v = a[rr];
                if (kv == 0) { const float pp = __shfl_xor(v, 1);
                    if (lane < 16) { const int e1 = 16 * n + 31; const float2 cs = ROPEN[(size_t)(e1 > 4095 ? 4095 : e1) * 8 + (lane >> 1)];
                        v = (lane & 1) ? (v * cs.x + pp * cs.y) : (v * cs.x - pp * cs.y); } }
                if (n >= 255) v = 0.f;
                dst[kv ? v_off(n, lane) : k_off(n, lane)] = (half_t)v; }
            asm volatile("s_waitcnt lgkmcnt(0)" ::: "memory");
        }
    REP_END(3) }
    SEAM(3);
    if (IN(4)) {
        half_t* KVT = WSP(half_t, WS_KVT);
        const AttnPtrs P{WSP(half_t, WS_QM), WSP(half_t, WS_KNM), WSP(half_t, WS_KPE), WSP(half_t, WS_VM), WSP(half_t, WS_QN), WSP(half_t, WS_KC), WSP(half_t, WS_VC),
                         KVT + 2 * KVT_STRIDE, KVT + 3 * KVT_STRIDE, KVT + 4 * KVT_STRIDE, KVT + 5 * KVT_STRIDE, WSP(float, WS_GATE), WSP(half_t, WS_Y), WSP(float, WS_SSM), WSP(float, WS_SSN)};
        volatile LAS int* qw = (volatile LAS int*)(lds + AT_QIDX);
        REP_BEGIN(4)
        unsigned* qhead = WSP(unsigned, WS_CTL) + CW_QHEAD + 64 * rep_;
        for (;;) {
            if (threadIdx.x == 0) *qw = (int)__hip_atomic_fetch_add(qhead, 1u, __ATOMIC_RELAXED, __HIP_MEMORY_SCOPE_AGENT);
            __syncthreads();
            const int qi = __builtin_amdgcn_readfirstlane(*qw);
            __syncthreads();
            if (qi >= 4096) break;
            const int L = qi >> 8, r = qi & 255;
#ifdef REP_FILTER
            if (rep_ == 1 && ((REP_FILTER == 1) != (r < 128))) continue;
#endif
            if (r < 128) { if (rep_ == 1) mla_unit<ABL>(P, r, 15 - L, lds, true); else mla_unit<0>(P, r, 15 - L, lds); }
            else { const int r2 = r - 128; nsa_unit(P, r2 & 31, 63 - 4 * L - (r2 >> 5), lds); }
        }
        REP_END(4)
    }
    SEAM(4);
    if (IN(6)) { REP_BEGIN(6) pg8::Gemm g{WSP(half_t, WS_Y), WSP(half_t, WS_WO), 1024, 1024, 1024}; pg8::StaticOrder S; S.init(MROWS, 1024, gridDim.x, (int)blockIdx.x, 1024, 1024); EpiWo E{WSP(half_t, WS_XH), WSP(half_t, WS_H1), WSP(float, WS_SS2), WSP(float, WS_SSM), WSP(float, WS_SSN), (LAS float*)(lds + LDS_RED)}; pg8::gemm_phase<EpiWo, pg8::StaticOrder, true>(lds, g, S, E); REP_END(6) }
    SEAM(6);
    if (IN(7)) { REP_BEGIN(7) pg8::Gemm g{WSP(half_t, WS_H1), WSP(half_t, WS_WUP), 1024, 1024, 1024}; pg8::StaticOrder S; S.init(MROWS, DFF, gridDim.x, (int)blockIdx.x, 1024, 1024); EpiUp E{WSP(float, WS_SS2), WSP(half_t, WS_A2)}; pg8::gemm_phase(lds, g, S, E); REP_END(7) }
    SEAM(7);
    if (IN(8)) { REP_BEGIN(8) pg8::Gemm g{WSP(half_t, WS_A2), WSP(half_t, WS_WDN), 4096, 4096, 4096}; pg8::StaticOrder S; S.init(MROWS, 1024, gridDim.x, (int)blockIdx.x, 4096, 4096); EpiDn E{WSP(half_t, WS_H1), WSP(half_t, WS_H2), WSP(float, WS_SS3), (LAS float*)(lds + LDS_RED)}; pg8::gemm_phase(lds, g, S, E); REP_END(8) }
    SEAM(8);
    if (IN(9)) { REP_BEGIN(9)
        PH_IDS();
        const float* gf = args.in[23]; const float* SS3 = WSP(float, WS_SS3); const half_t* H2 = WSP(half_t, WS_H2);
        const f32x4 ga0 = *(const f32x4*)(gf + lane * 8), gb0 = *(const f32x4*)(gf + lane * 8 + 4), ga1 = *(const f32x4*)(gf + 512 + lane * 8), gb1 = *(const f32x4*)(gf + 512 + lane * 8 + 4);
        for (int r0 = gw * 4; r0 < MROWS; r0 += ngw * 4) {
            u32x4 hv[4][2]; float rs[4];
#pragma unroll
            for (int rr = 0; rr < 4; ++rr) { const u32x4* hr = (const u32x4*)(H2 + (size_t)(r0 + rr) * DM) + lane; hv[rr][0] = hr[0]; hv[rr][1] = hr[64]; rs[rr] = __builtin_amdgcn_rsqf(sum4(*(const f32x4*)(SS3 + (size_t)(r0 + rr) * 4)) * (1.f / 1024.f) + NORM_EPS); }
#pragma unroll
            for (int rr = 0; rr < 4; ++rr) { f32x4* orow = (f32x4*)(args.out + (size_t)(r0 + rr) * DM); float v[8];
                unpk8(hv[rr][0], v);
                orow[lane * 2] = (f32x4){v[0] * rs[rr] * ga0[0], v[1] * rs[rr] * ga0[1], v[2] * rs[rr] * ga0[2], v[3] * rs[rr] * ga0[3]};
                orow[lane * 2 + 1] = (f32x4){v[4] * rs[rr] * gb0[0], v[5] * rs[rr] * gb0[1], v[6] * rs[rr] * gb0[2], v[7] * rs[rr] * gb0[3]};
                unpk8(hv[rr][1], v);
                orow[128 + lane * 2] = (f32x4){v[0] * rs[rr] * ga1[0], v[1] * rs[rr] * ga1[1], v[2] * rs[rr] * ga1[2], v[3] * rs[rr] * ga1[3]};
                orow[128 + lane * 2 + 1] = (f32x4){v[4] * rs[rr] * gb1[0], v[5] * rs[rr] * gb1[1], v[6] * rs[rr] * gb1[2], v[7] * rs[rr] * gb1[3]}; }
        }
    REP_END(9) }
    STAMP(10);
#undef IN
#undef SEAM
}

#if DBG_CHECK
constexpr int CW_DBG = 96;
__device__ __forceinline__ void dbg_flag(unsigned* ctl, int id, float got, float ref) {
    const float d = fabsf(got - ref);
    if (!(d <= 0.03f + 0.03f * fabsf(ref))) atomicOr(ctl + CW_DBG, 1u << id);
}
__device__ __forceinline__ float h2f(const half_t* p) { return (float)(*p); }
__device__ float dbg_rope_cs(int pos, int i, int dim, bool want_sin) { const float inv = expf(-logf(500000.f) * (float)(2 * i) / (float)dim), a = (float)pos * inv; return want_sin ? sinf(a) : cosf(a); }
__device__ float dbg_u(const Args& args, int row, int co, int lane) {
    const float* x = args.in[0] + (size_t)row * DM; const float* g = args.in[1]; const float* w = args.in[2];
    float ss = 0.f, acc = 0.f;
    for (int k = lane; k < DM; k += 64) { const float xv = x[k]; ss += xv * xv; acc += xv * g[k] * w[(size_t)k * IN_COLS + co]; }
    ss = wave_sum(ss); acc = wave_sum(acc);
    return acc * (1.f / sqrtf(ss / DM + NORM_EPS));
}
__device__ const int dbgt_0_dbg_rows[4] = {0, 4096 + 6, 30000, 65535};
__device__ const int dbgt_1_cs[3] = {0, 77, 255};
__device__ const int dbgt_2_cs[2] = {5, 127};
__device__ const int dbgt_3_ps[4] = {0, 1, 14, 31};
__device__ const int dbgt_4_is[3] = {0, 13, 23};
__device__ const int dbgt_5_hs[4] = {0, 3, 5, 7};
__device__ const int dbgt_6_ps[4] = {0, 1, 14, 40};
__device__ const int dbgt_7_brs[7] = {0, 1, 2, 2, 3, 4, 5};
__device__ const int dbgt_8_gs[7] = {0, 1, 0, 1, 0, 1, 1};
__device__ const int dbgt_9_ps[7] = {3, 20, 1, 50, 9, 14, 63};
__device__ const int dbgt_10_hs[4] = {0, 2, 5, 7};
__device__ const int dbgt_11_ps[4] = {3, 64, 77, 95};
__device__ const int dbgt_12_slabs[3] = {0, 17, 31};
__device__ const int dbgt_13_ns[3] = {0, 100, 254};
__device__ const int dbgt_14_ps[4] = {0, 1, 15, 40};
__device__ const int dbgt_15_bs[5] = {0, 0, 5, 15, 9};
__device__ const int dbgt_16_hs[5] = {0, 3, 7, 2, 5};
__device__ const int dbgt_17_qs[5] = {0, 100, 2047, 4095, 1234};
__device__ const int dbgt_18_bs[6] = {0, 3, 7, 15, 11, 2};
__device__ const int dbgt_19_gs[6] = {0, 1, 0, 1, 1, 0};
__device__ const int dbgt_20_hhs[6] = {0, 2, 3, 1, 0, 2};
__device__ const int dbgt_21_qs[6] = {5, 700, 1030, 4095, 2500, 3071};
__device__ const int dbgt_22_dd[3] = {0, 33, 63};
__device__ const int dbgt_23_c4[4] = {0, 1300, 2777, 4095};
__device__ const int dbgt_24_cols[4] = {0, 300, 777, 1023};
__device__ const int dbgt_25_cc[6] = {768, 896, 800, 776, 775, 1023};
__global__ void __launch_bounds__(512) dbg_checks_a(Args args) {
    extern __shared__ __attribute__((aligned(16))) unsigned char lds_raw[]; LAS unsigned char* lds = (LAS unsigned char*)lds_raw;
    unsigned char* ws = args.ws; unsigned* ctl = WSP(unsigned, WS_CTL);
    const int lane = threadIdx.x & 63, wid = threadIdx.x >> 6;
    const int* rows = dbgt_0_dbg_rows;
    const half_t* XH = WSP(half_t, WS_XH);
    if (blockIdx.x == 0) {
        if (wid == 0) for (int s = 0; s < 4; ++s) { const int r = rows[s]; const float* x = args.in[0] + (size_t)r * DM; float ss = 0.f; for (int k = lane; k < DM; k += 64) ss += x[k] * x[k]; ss = wave_sum(ss);
            if (lane == 0) { dbg_flag(ctl, 1, WSP(float, WS_RS1)[r], 1.f / sqrtf(ss / DM + NORM_EPS)); dbg_flag(ctl, 1, h2f(XH + (size_t)r * DM + 517), x[517]); } }
        if (wid == 1) for (int s = 0; s < 4; ++s) { const int r = rows[s], pos = r & 4095, b = r >> 12;
            { const int* cs = dbgt_1_cs; for (int i = 0; i < 3; ++i) { const float u = dbg_u(args, r, cs[i], lane); if (lane == 0) dbg_flag(ctl, 2, h2f(WSP(half_t, WS_CQ) + (size_t)r * 256 + cs[i]), u); } }
            { const int* cs = dbgt_2_cs; for (int i = 0; i < 2; ++i) { const float u = dbg_u(args, r, 256 + cs[i], lane); if (lane == 0) dbg_flag(ctl, 3, h2f(WSP(half_t, WS_T1) + (size_t)r * 256 + cs[i]), u); } }
            { const int* ps = dbgt_3_ps; for (int i = 0; i < 4; ++i) { const int p = ps[i], pr = p >> 1; const float x1 = dbg_u(args, r, 384 + pr, lane), x2 = dbg_u(args, r, 384 + pr + 16, lane);
                const float c = dbg_rope_cs(pos, pr, 32, false), sn = dbg_rope_cs(pos, pr, 32, true); const float ref = (p & 1) ? (x2 * c + x1 * sn) : (x1 * c - x2 * sn);
                if (lane == 0) dbg_flag(ctl, 4, h2f(WSP(half_t, WS_KPE) + (size_t)b * SEQ * 32 + kpe_off(pos, p)), ref); } }
            { const int* is = dbgt_4_is; for (int i = 0; i < 3; ++i) { const float u = dbg_u(args, r, 1696 + is[i], lane); if (lane == 0) dbg_flag(ctl, 5, WSP(float, WS_GATE)[(size_t)r * 24 + is[i]], 1.f / (1.f + expf(-u))); } }
            { const int* hs = dbgt_5_hs; const int* ps = dbgt_6_ps; for (int i = 0; i < 4; ++i) { const int hd = hs[i], p = ps[i]; float ref;
                if (p < 16) { const int pr = p >> 1; const float x1 = dbg_u(args, r, 416 + hd * 64 + pr, lane), x2 = dbg_u(args, r, 416 + hd * 64 + pr + 8, lane);
                    const float c = dbg_rope_cs(pos, pr, 16, false), sn = dbg_rope_cs(pos, pr, 16, true); ref = (p & 1) ? (x2 * c + x1 * sn) : (x1 * c - x2 * sn); }
                else ref = dbg_u(args, r, 416 + hd * 64 + p, lane);
                if (lane == 0) dbg_flag(ctl, 6, h2f(WSP(half_t, WS_QN) + (size_t)r * 512 + hd * 64 + p), ref * QS_N); } }
            { const int* brs = dbgt_7_brs; const int* gs = dbgt_8_gs; const int* ps = dbgt_9_ps;
              for (int i = 0; i < 7; ++i) { const int br = brs[i], g = gs[i], p = ps[i]; const int base = 928 + br * 128 + g * 64; float ref;
                if ((br == 2 || br == 4) && p < 16) { const int pr = p >> 1; const float x1 = dbg_u(args, r, base + pr, lane), x2 = dbg_u(args, r, base + pr + 8, lane);
                    const float c = dbg_rope_cs(pos, pr, 16, false), sn = dbg_rope_cs(pos, pr, 16, true); ref = (p & 1) ? (x2 * c + x1 * sn) : (x1 * c - x2 * sn); }
                else ref = dbg_u(args, r, base + p, lane);
                if (lane == 0) dbg_flag(ctl, 7, h2f(WSP(half_t, WS_KVT) + (size_t)br * KVT_STRIDE + (size_t)(b * 2 + g) * SEQ * 64 + (br < 2 ? (size_t)pos * 64 + p : ((br & 1) ? v_off(pos, p) : k_off(pos, p)))), ref); } }
        }
        if (wid == 2) for (int s = 0; s < 4; ++s) { const int r = rows[s], pos = r & 4095, b = r >> 12;
            const half_t* cq = WSP(half_t, WS_CQ) + (size_t)r * 256; const half_t* t1 = WSP(half_t, WS_T1) + (size_t)r * 256;
            float sq = 0.f, skv = 0.f; for (int k = lane; k < 256; k += 64) { const float a = h2f(cq + k); sq += a * a; } for (int k = lane; k < 128; k += 64) { const float a = h2f(t1 + k); skv += a * a; }
            sq = wave_sum(sq); skv = wave_sum(skv); const float rq = 1.f / sqrtf(sq / 256.f + NORM_EPS), rkv = 1.f / sqrtf(skv / 128.f + NORM_EPS);
            const int* hs = dbgt_10_hs; const int* ps = dbgt_11_ps;
            for (int i = 0; i < 4; ++i) { const int hd = hs[i], p = ps[i]; float ref;
                auto qcol = [&](int col) { float a = 0.f; for (int k = lane; k < 256; k += 64) a += h2f(cq + k) * args.in[3][k] * args.in[4][(size_t)k * 768 + col]; return wave_sum(a) * rq; };
                if (p < 64) ref = qcol(hd * 96 + p);
                else { const int pp = p - 64, pr = pp >> 1; const float x1 = qcol(hd * 96 + 64 + pr), x2 = qcol(hd * 96 + 64 + pr + 16);
                    const float c = dbg_rope_cs(pos, pr, 32, false), sn = dbg_rope_cs(pos, pr, 32, true); ref = (pp & 1) ? (x2 * c + x1 * sn) : (x1 * c - x2 * sn); }
                if (lane == 0) dbg_flag(ctl, 8, h2f(WSP(half_t, WS_QM) + (size_t)r * 768 + hd * 96 + p), ref * QS_M); }
            for (int i = 0; i < 4; ++i) { const int hd = hs[i], d = ps[i] & 63;
                auto kvcol = [&](int col) { float a = 0.f; for (int k = lane; k < 128; k += 64) a += h2f(t1 + k) * args.in[5][k] * args.in[6][(size_t)k * 1024 + col]; return wave_sum(a) * rkv; };
                const float kr = kvcol(hd * 128 + d), vr = kvcol(hd * 128 + 64 + d);
                if (lane == 0) { dbg_flag(ctl, 9, h2f(WSP(half_t, WS_KNM) + (size_t)(b * 8 + hd) * SEQ * 64 + k_off(pos, d)), kr); dbg_flag(ctl, 10, h2f(WSP(half_t, WS_VM) + (size_t)(b * 8 + hd) * SEQ * 64 + v_off(pos, d)), vr); } }
        }
        if (wid == 3 || wid == 4) { const int kv = wid - 3; const int* slabs = dbgt_12_slabs; const int* ns = dbgt_13_ns;
            LAS float* hid = (LAS float*)(lds + 65536 + kv * 1024);
            const float* pe = args.in[kv ? 12 : 7]; const float* w1 = args.in[kv ? 13 : 8]; const float* b1 = args.in[kv ? 14 : 9]; const float* w2 = args.in[kv ? 15 : 10]; const float* b2 = args.in[kv ? 16 : 11];
            for (int s = 0; s < 3; ++s) { const int slab = slabs[s], n = ns[s]; const half_t* tok = WSP(half_t, WS_KVT) + (size_t)kv * KVT_STRIDE + ((size_t)slab * SEQ + 16 * n) * 64;
                for (int jj = 0; jj < 2; ++jj) { const int j = lane + 64 * jj; float a = b1[j]; for (int k = 0; k < 2048; ++k) a += (h2f(tok + k) + pe[k]) * w1[(size_t)k * 128 + j];
                    const float z = 0.7978845608028654f * (a + 0.044715f * a * a * a); hid[j] = 0.5f * a * (1.f + tanhf(z)); }
                asm volatile("s_waitcnt lgkmcnt(0)" ::: "memory");
                float o = b2[lane]; for (int j = 0; j < 128; ++j) o += hid[j] * w2[j * 64 + lane];
                const int* ps = dbgt_14_ps;
                for (int i = 0; i < 4; ++i) { const int p = ps[i]; float ref;
                    if (kv == 0 && p < 16) { const int pr = p >> 1; const float x1 = __shfl(o, pr), x2 = __shfl(o, pr + 8); const int pos = 16 * n + 31;
                        const float c = dbg_rope_cs(pos, pr, 16, false), sn = dbg_rope_cs(pos, pr, 16, true); ref = (p & 1) ? (x2 * c + x1 * sn) : (x1 * c - x2 * sn); }
                    else ref = __shfl(o, p);
                    if (lane == 0) dbg_flag(ctl, 11 + kv, h2f((kv ? WSP(half_t, WS_VC) : WSP(half_t, WS_KC)) + (size_t)slab * 256 * 64 + (kv ? v_off(n, p) : k_off(n, p))), ref); }
                asm volatile("s_waitcnt lgkmcnt(0)" ::: "memory"); }
        }
        if (wid == 5) { const int* bs = dbgt_15_bs; const int* hs = dbgt_16_hs; const int* qs = dbgt_17_qs;
            for (int s = 0; s < 5; ++s) { const int b = bs[s], hd = hs[s], q = qs[s]; const size_t r = (size_t)b * SEQ + q;
                const half_t* qv = WSP(half_t, WS_QM) + r * 768 + hd * 96; const half_t* Kn = WSP(half_t, WS_KNM) + (size_t)(b * 8 + hd) * SEQ * 64; const half_t* Kp = WSP(half_t, WS_KPE) + (size_t)b * SEQ * 32; const half_t* V = WSP(half_t, WS_VM) + (size_t)(b * 8 + hd) * SEQ * 64;
                float mx = -1e30f;
                for (int k = lane; k <= q; k += 64) { float sc = 0.f; for (int d = 0; d < 64; ++d) sc += h2f(qv + d) * h2f(Kn + k_off(k, d)); for (int d = 0; d < 32; ++d) sc += h2f(qv + 64 + d) * h2f(Kp + kpe_off(k, d)); mx = fmaxf(mx, sc); }
                for (int o = 1; o < 64; o <<= 1) mx = fmaxf(mx, __shfl_xor(mx, o));
                float l = 0.f, o0 = 0.f, o1 = 0.f, o2 = 0.f;
                for (int k = lane; k <= q; k += 64) { float sc = 0.f; for (int d = 0; d < 64; ++d) sc += h2f(qv + d) * h2f(Kn + k_off(k, d)); for (int d = 0; d < 32; ++d) sc += h2f(qv + 64 + d) * h2f(Kp + kpe_off(k, d));
                    const float p = exp2f(sc - mx); l += p; o0 += p * h2f(V + v_off(k, 0)); o1 += p * h2f(V + v_off(k, 33)); o2 += p * h2f(V + v_off(k, 63)); }
                l = wave_sum(l); o0 = wave_sum(o0); o1 = wave_sum(o1); o2 = wave_sum(o2);
                if (lane == 0) { const half_t* y = WSP(half_t, WS_Y) + r * DM + hd * 64; dbg_flag(ctl, 13, h2f(y + 0), o0 / l); dbg_flag(ctl, 13, h2f(y + 33), o1 / l); dbg_flag(ctl, 13, h2f(y + 63), o2 / l); } }
        }
        if (wid == 6 || wid == 7) { const int* bs = dbgt_18_bs; const int* gs = dbgt_19_gs; const int* hhs = dbgt_20_hhs; const int* qs = dbgt_21_qs;
            LAS float* pc = (LAS float*)(lds + 70000 + (wid - 6) * 8192);
            for (int s = wid - 6; s < 6; s += 2) { const int b = bs[s], g = gs[s], hh = hhs[s], q = qs[s], cur = q >> 6; const size_t r = (size_t)b * SEQ + q; const int bg = b * 2 + g;
                const half_t* Kc = WSP(half_t, WS_KC) + (size_t)bg * 256 * 64; const half_t* Vc = WSP(half_t, WS_VC) + (size_t)bg * 256 * 64;
                for (int h4 = 0; h4 < 4; ++h4) { const half_t* qv = WSP(half_t, WS_QN) + r * 512 + (g * 4 + h4) * 64;
                    float sc[4]; float mx = -1e30f;
                    for (int i = 0; i < 4; ++i) { const int n = lane + 64 * i; float a = -INFINITY; if (n < 255 && 16 * n + 31 <= q) { a = 0.f; for (int d = 0; d < 64; ++d) a += h2f(qv + d) * h2f(Kc + k_off(n, d)); } sc[i] = a; mx = fmaxf(mx, a); }
                    for (int o = 1; o < 64; o <<= 1) mx = fmaxf(mx, __shfl_xor(mx, o));
                    float l = 0.f; for (int i = 0; i < 4; ++i) { sc[i] = exp2f(sc[i] - mx); l += sc[i]; } l = wave_sum(l);
                    for (int i = 0; i < 4; ++i) pc[h4 * 256 + lane + 64 * i] = (l > 0.f) ? sc[i] / l : 0.f; }
                asm volatile("s_waitcnt lgkmcnt(0)" ::: "memory");
                { float imp = 0.f; const int jb = lane;
                  for (int n = 0; n < 255; ++n) { const int cs = 16 * n, ss0 = 64 * jb; const int lo2 = cs > ss0 ? cs : ss0, hi2 = (cs + 32 < ss0 + 64) ? cs + 32 : ss0 + 64; const int ov = hi2 - lo2; if (ov > 0) { const float w = (float)ov / 32.f; for (int h4 = 0; h4 < 4; ++h4) imp += pc[h4 * 256 + n] * w; } }
                  const bool forced = (jb == 0) || (jb == cur) || (jb == cur - 1), causal = jb * 64 <= q;
                  pc[1024 + jb] = forced ? 1e9f : (causal ? imp : -1e9f); }
                asm volatile("s_waitcnt lgkmcnt(0)" ::: "memory");
                if (lane == 0) { for (int jb = 0; jb < 64; ++jb) pc[1088 + jb] = 0.f; for (int it = 0; it < 16; ++it) { int best = -1; float bv = -INFINITY; for (int jb = 0; jb < 64; ++jb) if (pc[1088 + jb] == 0.f && pc[1024 + jb] > bv) { bv = pc[1024 + jb]; best = jb; } pc[1088 + best] = 1.f; } }
                asm volatile("s_waitcnt lgkmcnt(0)" ::: "memory");
                const half_t* qv = WSP(half_t, WS_QN) + r * 512 + (g * 4 + hh) * 64; const int* dd = dbgt_22_dd;
                float oc[3] = {0.f, 0.f, 0.f};
                for (int i = 0; i < 4; ++i) { const int n = lane + 64 * i; if (n < 255) { const float p = pc[hh * 256 + n]; for (int e = 0; e < 3; ++e) oc[e] += p * h2f(Vc + v_off(n, dd[e])); } }
                for (int e = 0; e < 3; ++e) oc[e] = wave_sum(oc[e]);
                float osw[2][3];
                for (int br = 0; br < 2; ++br) { const half_t* Kx = WSP(half_t, WS_KVT) + (size_t)(2 + 2 * br) * KVT_STRIDE + (size_t)bg * SEQ * 64; const half_t* Vx = WSP(half_t, WS_KVT) + (size_t)(3 + 2 * br) * KVT_STRIDE + (size_t)bg * SEQ * 64;
                    float mx = -1e30f;
                    for (int k = lane; k <= q; k += 64) { const bool ok = br ? (q - k < 512) : (pc[1088 + (k >> 6)] != 0.f); if (!ok) continue; float a = 0.f; for (int d = 0; d < 64; ++d) a += h2f(qv + d) * h2f(Kx + k_off(k, d)); mx = fmaxf(mx, a); }
                    for (int o = 1; o < 64; o <<= 1) mx = fmaxf(mx, __shfl_xor(mx, o));
                    float l = 0.f, a3[3] = {0.f, 0.f, 0.f};
                    for (int k = lane; k <= q; k += 64) { const bool ok = br ? (q - k < 512) : (pc[1088 + (k >> 6)] != 0.f); if (!ok) continue; float a = 0.f; for (int d = 0; d < 64; ++d) a += h2f(qv + d) * h2f(Kx + k_off(k, d));
                        const float p = exp2f(a - mx); l += p; for (int e = 0; e < 3; ++e) a3[e] += p * h2f(Vx + v_off(k, dd[e])); }
                    l = wave_sum(l); for (int e = 0; e < 3; ++e) osw[br][e] = wave_sum(a3[e]) / l; }
                if (lane == 0) { const float* gt = WSP(float, WS_GATE) + r * 24; const int head = g * 4 + hh; const float g0 = gt[head], g1 = gt[8 + head], g2 = gt[16 + head];
                    for (int e = 0; e < 3; ++e) dbg_flag(ctl, q < 1024 ? 14 : 15, h2f(WSP(half_t, WS_Y) + r * DM + 512 + head * 64 + dd[e]), g0 * oc[e] + g1 * osw[0][e] + g2 * osw[1][e]); }
                asm volatile("s_waitcnt lgkmcnt(0)" ::: "memory"); }
        }
    }
}
__global__ void __launch_bounds__(512) dbg_checks_b(Args args, int which) {
    unsigned char* ws = args.ws; unsigned* ctl = WSP(unsigned, WS_CTL);
    const int lane = threadIdx.x & 63, wid = threadIdx.x >> 6;
    const int* rows = dbgt_0_dbg_rows; const int* cols = dbgt_24_cols;
    if (blockIdx.x != 0 || wid >= 4) return;
    const int r = rows[wid];
    if (which == 6 && wid == 3) { const half_t* y = WSP(half_t, WS_Y) + (size_t)r * DM; const int* cc = dbgt_25_cc;
        for (int i = 0; i < 6; ++i) { const int c = cc[i]; float a = 0.f; for (int k = lane; k < DM; k += 64) a += h2f(y + k) * (k < 512 ? args.in[17][k] : args.in[18][k - 512]) * args.in[19][(size_t)k * DM + c];
            const float dot = wave_sum(a), xr = args.in[0][(size_t)r * DM + c], got = h2f(WSP(half_t, WS_H1) + (size_t)r * DM + c);
            if (lane == 0 && !(fabsf(got - (dot + xr)) <= 0.03f + 0.03f * fabsf(dot + xr))) atomicAdd(ctl + CW_DBG + 2, 1u << i); } }
    if (which == 6) { const half_t* y = WSP(half_t, WS_Y) + (size_t)r * DM;
        { float s0 = 0.f, s1 = 0.f; for (int k = lane; k < 512; k += 64) { const float a = h2f(y + k), b = h2f(y + 512 + k); s0 += a * a; s1 += b * b; } s0 = wave_sum(s0); s1 = wave_sum(s1);
          if (lane == 0) { dbg_flag(ctl, 20, s0 / 512.f, 1.f); dbg_flag(ctl, 21, s1 / 512.f, 1.f); } }
        { const int c = cols[wid], k = rows[wid] & 1023; if (lane == 0) dbg_flag(ctl, 22, 100.f * h2f(WSP(half_t, WS_WO) + (size_t)c * DM + k), 100.f * args.in[19][(size_t)k * DM + c] * (k < 512 ? args.in[17][k] : args.in[18][k - 512])); }
        for (int i = 0; i < 4; ++i) { const int c = cols[i]; float a = 0.f; for (int k = lane; k < DM; k += 64) a += h2f(y + k) * (k < 512 ? args.in[17][k] : args.in[18][k - 512]) * args.in[19][(size_t)k * DM + c];
            const float dot = wave_sum(a), xr = args.in[0][(size_t)r * DM + c], got = h2f(WSP(half_t, WS_H1) + (size_t)r * DM + c); a = dot + xr;
            if (lane == 0) { dbg_flag(ctl, 16, got, a);
                if ((wid == 0 && i == 0) || (wid == 3 && i == 3)) { int hcode = 9; auto near = [](float p, float q) { return fabsf(p - q) <= 0.03f + 0.03f * fabsf(q); };
                    if (near(got, dot + xr)) hcode = 1; else if (near(got, dot)) hcode = 2; else if (near(got, xr)) hcode = 3; else if (near(got, 2.f * xr + dot)) hcode = 4; else if (!(got == got)) hcode = 5; else if (near(got, 0.f)) hcode = 6;
                    atomicAdd(ctl + CW_DBG + 1, (unsigned)(wid == 0 ? 10 * hcode : hcode)); } } } }
    if (which == 7) { const half_t* h1 = WSP(half_t, WS_H1) + (size_t)r * DM; float ss = 0.f; for (int k = lane; k < DM; k += 64) { const float a = h2f(h1 + k); ss += a * a; } ss = wave_sum(ss); const float rs = 1.f / sqrtf(ss / DM + NORM_EPS);
        const int* c4 = dbgt_23_c4;
        for (int i = 0; i < 4; ++i) { const int c = c4[i]; float a = 0.f; for (int k = lane; k < DM; k += 64) a += h2f(h1 + k) * args.in[20][k] * args.in[21][(size_t)k * DFF + c];
            a = fmaxf(wave_sum(a) * rs, 0.f); if (lane == 0) dbg_flag(ctl, 17, h2f(WSP(half_t, WS_A2) + (size_t)r * DFF + c), a * a); } }
    if (which == 8) { const half_t* a2 = WSP(half_t, WS_A2) + (size_t)r * DFF;
        for (int i = 0; i < 4; ++i) { const int c = cols[i]; float a = 0.f; for (int k = lane; k < DFF; k += 64) a += h2f(a2 + k) * args.in[22][(size_t)k * DM + c];
            a = wave_sum(a) + h2f(WSP(half_t, WS_H1) + (size_t)r * DM + c); if (lane == 0) dbg_flag(ctl, 18, h2f(WSP(half_t, WS_H2) + (size_t)r * DM + c), a); } }
    if (which == 9) { const half_t* h2 = WSP(half_t, WS_H2) + (size_t)r * DM; float ss = 0.f; for (int k = lane; k < DM; k += 64) { const float a = h2f(h2 + k); ss += a * a; } ss = wave_sum(ss); const float rs = 1.f / sqrtf(ss / DM + NORM_EPS);
        for (int i = 0; i < 4; ++i) { const int c = cols[i]; if (lane == 0) dbg_flag(ctl, 19, args.out[(size_t)r * DM + c], h2f(h2 + c) * rs * args.in[23][c]); } }
}
__global__ void __launch_bounds__(512) dbg_fill(Args args) {
    unsigned char* ws = args.ws; unsigned* ctl = WSP(unsigned, WS_CTL);
#ifndef DBG_SKIP
#define DBG_SKIP 0
#endif
    const unsigned m = __hip_atomic_load(ctl + CW_DBG, __ATOMIC_RELAXED, __HIP_MEMORY_SCOPE_AGENT) & ~((1u << DBG_SKIP) - 1u);
#ifdef DBG_STAMP
    const unsigned long long* ts = (const unsigned long long*)(ctl + 160); (void)m;
    const int code = (int)((ts[DBG_T1B] - ts[DBG_T1A]) / 4000ull);
    const float vbig = (float)((ts[DBG_T2B] - ts[DBG_T2A]) / 100ull);
    if (blockIdx.x == 0 && threadIdx.x == 0) { args.out[(size_t)MROWS * DM - 1] = vbig; }
#elif defined(DBG_VALUE)
    const int code = (int)__hip_atomic_load(ctl + CW_DBG + 2, __ATOMIC_RELAXED, __HIP_MEMORY_SCOPE_AGENT); (void)m;
#else
    const int code = m ? __builtin_ctz(m) : 0;
#endif
    const float a = sqrtf((float)code);
#ifdef DBG_STAMP
    const size_t nfill = (size_t)MROWS * DM / 4 - 1;
    if (blockIdx.x == 0 && threadIdx.x == 1) { args.out[(size_t)MROWS * DM - 4] = a; args.out[(size_t)MROWS * DM - 3] = a; args.out[(size_t)MROWS * DM - 2] = a; }
#else
    const size_t nfill = (size_t)MROWS * DM / 4;
#endif
    for (size_t i = (size_t)blockIdx.x * 512 + threadIdx.x; i < nfill; i += (size_t)gridDim.x * 512) ((f32x4*)args.out)[i] = (f32x4){a, a, a, a};
}
#endif

extern "C" void kernel_launch(void* const* d_in, const int* in_sizes, int n_in, void* d_out, int out_size, void* d_ws, size_t ws_size, hipStream_t stream) {
    static int grid = 0;
    if (grid == 0) {
        if (n_in != 24 || out_size != MROWS * DM || ws_size < WS_END) { fprintf(stderr, "kernel_launch: unexpected problem (n_in %d, out %d, ws %zu)\n", n_in, out_size, ws_size); grid = -1; return; }
        int dev = 0, cus = 0, per_cu = 0;
        if (hipGetDevice(&dev) != hipSuccess || hipDeviceGetAttribute(&cus, hipDeviceAttributeMultiprocessorCount, dev) != hipSuccess) { grid = -1; return; }
        if (hipFuncSetAttribute((const void*)hymba_fwd, hipFuncAttributeMaxDynamicSharedMemorySize, LDS_BYTES) != hipSuccess) { fprintf(stderr, "kernel_launch: hipFuncSetAttribute failed\n"); grid = -1; return; }
        if (hipOccupancyMaxActiveBlocksPerMultiprocessor(&per_cu, (const void*)hymba_fwd, 512, LDS_BYTES) != hipSuccess || per_cu < 1) fprintf(stderr, "kernel_launch: occupancy query says %d\n", per_cu);
        (void)hipGetLastError();
        grid = cus;
#if DBG_CHECK
        (void)hipFuncSetAttribute((const void*)dbg_checks_a, hipFuncAttributeMaxDynamicSharedMemorySize, 98304);
#endif
    }
    if (grid < 0) return;
    (void)hipMemsetAsync((char*)d_ws + WS_CTL, 0, CTL_ZERO_BYTES, stream);
    Args a{};
    for (int i = 0; i < 24; ++i) a.in[i] = (const float*)d_in[i];
    a.out = (float*)d_out; a.ws = (unsigned char*)d_ws;
#if DBG_CHECK == 1
    a.ph_lo = 0; a.ph_hi = 5; a.li = 0; hipLaunchKernelGGL(hymba_fwd, dim3(grid), dim3(512), LDS_BYTES, stream, a);
    hipLaunchKernelGGL(dbg_checks_a, dim3(1), dim3(512), 98304, stream, a);
    hipLaunchKernelGGL(dbg_fill, dim3(1024), dim3(512), 0, stream, a);
#elif DBG_CHECK == 2
    a.ph_lo = 0; a.ph_hi = 7; a.li = 0; hipLaunchKernelGGL(hymba_fwd, dim3(grid), dim3(512), LDS_BYTES, stream, a);
    hipLaunchKernelGGL(dbg_checks_b, dim3(1), dim3(512), 0, stream, a, 6);
    a.ph_lo = 7; a.ph_hi = 8; a.li = 1; hipLaunchKernelGGL(hymba_fwd, dim3(grid), dim3(512), LDS_BYTES, stream, a);
    hipLaunchKernelGGL(dbg_checks_b, dim3(1), dim3(512), 0, stream, a, 7);
    a.ph_lo = 8; a.ph_hi = 9; a.li = 2; hipLaunchKernelGGL(hymba_fwd, dim3(grid), dim3(512), LDS_BYTES, stream, a);
    hipLaunchKernelGGL(dbg_checks_b, dim3(1), dim3(512), 0, stream, a, 8);
    a.ph_lo = 9; a.ph_hi = 10; a.li = 3; hipLaunchKernelGGL(hymba_fwd, dim3(grid), dim3(512), LDS_BYTES, stream, a);
    hipLaunchKernelGGL(dbg_checks_b, dim3(1), dim3(512), 0, stream, a, 9);
    hipLaunchKernelGGL(dbg_fill, dim3(1024), dim3(512), 0, stream, a);
#elif DBG_CHECK == 3
    a.ph_lo = 0; a.ph_hi = 10; a.li = 0; hipLaunchKernelGGL(hymba_fwd, dim3(grid), dim3(512), LDS_BYTES, stream, a);
    hipLaunchKernelGGL(dbg_fill, dim3(1024), dim3(512), 0, stream, a);
#elif MK_N_LAUNCHES == 1
    a.ph_lo = 0; a.ph_hi = 10; a.li = 0;
    hipLaunchKernelGGL(hymba_fwd, dim3(grid), dim3(512), LDS_BYTES, stream, a);
#else
    for (int p = 0; p < 10; ++p) { a.ph_lo = p; a.ph_hi = p + 1; a.li = p; hipLaunchKernelGGL(hymba_fwd, dim3(grid), dim3(512), LDS_BYTES, stream, a); }
#endif
}
```

```cpp
#include <hip/hip_runtime.h>
#include <cstdio>
#include <cstdint>

#ifndef DBG_CHECK
#define DBG_CHECK 0
#endif
#ifndef REPEAT_PHASE
#define REPEAT_PHASE -1
#endif
#ifndef ABL
#define ABL 0
#endif
#ifndef MK_N_LAUNCHES
#define MK_N_LAUNCHES 1
#endif

#define LAS __attribute__((address_space(3)))
typedef _Float16 half_t;
typedef _Float16 half8 __attribute__((ext_vector_type(8)));
typedef _Float16 half2v __attribute__((ext_vector_type(2)));
typedef float f32x4 __attribute__((ext_vector_type(4)));
typedef float f32x16 __attribute__((ext_vector_type(16)));
typedef unsigned u32x4 __attribute__((ext_vector_type(4)));
typedef unsigned u32x2 __attribute__((ext_vector_type(2)));
typedef short v4i16 __attribute__((ext_vector_type(4)));

constexpr int BATCH = 16, SEQ = 4096, DM = 1024, MROWS = BATCH * SEQ;
constexpr int IN_COLS = 1720, NIN = 1792;
constexpr int DFF = 4096;
constexpr float NORM_EPS = 1e-6f;
constexpr float LOG2E = 1.4426950408889634f;
constexpr float QS_N = 0.125f * LOG2E;
constexpr float QS_M = 0.10206207261596577f * LOG2E;

constexpr size_t MiB = 1u << 20;
constexpr size_t WS_CTL = 0, CTL_ZERO_BYTES = 1 * MiB;
constexpr size_t WS_WIN = 1 * MiB, WS_WUQ = 5 * MiB, WS_WUKV = 6 * MiB, WS_WC1 = 7 * MiB, WS_WO = 9 * MiB, WS_WUP = 11 * MiB, WS_WDN = 19 * MiB;
constexpr size_t WS_ROPEM = 27 * MiB, WS_ROPEN = 27 * MiB + 512 * 1024, WS_B1P = 27 * MiB + 768 * 1024;
constexpr size_t WS_KC = 28 * MiB, WS_VC = 29 * MiB;
constexpr size_t WS_RS1 = 32 * MiB, WS_SSQ = 33 * MiB, WS_SSKV = 34 * MiB, WS_SSM = 35 * MiB, WS_SSN = 37 * MiB, WS_SS2 = 39 * MiB, WS_SS3 = 43 * MiB;
constexpr size_t WS_GATE = 47 * MiB, WS_KPE = 53 * MiB;
constexpr size_t WS_CQ = 64 * MiB, WS_T1 = 96 * MiB, WS_QN = 128 * MiB, WS_KVT = 192 * MiB  ;
constexpr size_t WS_QM = 288 * MiB, WS_KNM = 384 * MiB, WS_VM = 448 * MiB, WS_HIDP = 512 * MiB;
constexpr size_t WS_A2 = 64 * MiB;
constexpr size_t WS_XH = 576 * MiB, WS_H2 = 576 * MiB, WS_Y = 704 * MiB, WS_H1 = 832 * MiB, WS_END = 960 * MiB;
constexpr size_t KVT_STRIDE = 16 * MiB / 2;

constexpr int CW_QHEAD = 64;
constexpr int CW_BAR = 4096;

constexpr int LDS_BYTES = 163840;
constexpr int LDS_MISC = 163840 - 256;

#define XB_TMO      128
#define XB_XCNT(j)  (256  + 64 * (j))
#define XB_XSUB(j)  (1280 + 64 * (j))
#define XB_XGEN(j)  (2304 + 64 * (j))
#define XB_TOP      3328
#define XB_TOPGEN   3392
#define XCD_BAR_WORDS 3456
#define XB_SPIN_CAP (1u << 22)

__device__ __forceinline__ unsigned xb_ld(unsigned* p)              { return __hip_atomic_load(p, __ATOMIC_RELAXED, __HIP_MEMORY_SCOPE_AGENT); }
__device__ __forceinline__ unsigned xb_add(unsigned* p, unsigned v) { return __hip_atomic_fetch_add(p, v, __ATOMIC_RELAXED, __HIP_MEMORY_SCOPE_AGENT); }
__device__ __forceinline__ unsigned xb_xcc_id() { return (unsigned)__builtin_amdgcn_s_getreg((3 << 11) | 20) & 0xFu; }
#define XB_SPIN(cond, bar) do { unsigned _sp = 0; while (cond) { __builtin_amdgcn_s_sleep(1); \
    if ((++_sp & 255u) == 0u) { if (xb_ld(&(bar)[XB_TMO])) break; if (_sp > XB_SPIN_CAP) { atomicAdd(&(bar)[XB_TMO], 1u); break; } } } } while (0)

struct XcdBarrier { unsigned* bar; unsigned x; volatile LAS unsigned* st; };

__device__ __forceinline__ XcdBarrier xcd_barrier_post(unsigned* bar, volatile LAS unsigned* st) {
    XcdBarrier b; b.bar = bar; b.x = xb_xcc_id(); b.st = st;
    if (threadIdx.x == 0) (void)xb_add(&bar[XB_XCNT(b.x)], 1u);
    return b;
}
__device__ __forceinline__ void xcd_barrier_complete(unsigned* bar, unsigned x, unsigned& nloc, unsigned& nx) {
    const unsigned G = gridDim.x * gridDim.y * gridDim.z;
    unsigned sum, cnt, mine, sp = 0u;
    for (;;) {
        sum = 0u; cnt = 0u; mine = 0u;
#pragma unroll
        for (unsigned j = 0; j < 16; ++j) { const unsigned c = xb_ld(&bar[XB_XCNT(j)]); sum += c; cnt += (c > 0u) ? 1u : 0u; mine = (j == x) ? c : mine; }
        if (sum == G) break;
        __builtin_amdgcn_s_sleep(1);
        if ((++sp & 255u) == 0u) { if (xb_ld(&bar[XB_TMO])) break; if (sp > XB_SPIN_CAP) { atomicAdd(&bar[XB_TMO], 1u); break; } }
    }
    nloc = mine > 0u ? mine : 1u; nx = cnt > 0u ? cnt : 1u;
}
__device__ __forceinline__ void xcd_barrier(const XcdBarrier& b) {
    asm volatile("s_waitcnt vmcnt(0)" ::: "memory");
    __syncthreads();
    if (threadIdx.x == 0) {
        unsigned* bar = b.bar;
        __builtin_amdgcn_s_waitcnt(0);
        unsigned nloc = b.st[0], nx = b.st[1];
        if (nloc == 0u) { xcd_barrier_complete(bar, b.x, nloc, nx); b.st[0] = nloc; b.st[1] = nx; }
        const unsigned old = xb_add(&bar[XB_XSUB(b.x)], 1u);
        const unsigned gen = old / nloc;
        if (old + 1u == (gen + 1u) * nloc) {
            __builtin_amdgcn_fence(__ATOMIC_RELEASE, "agent");
            asm volatile("s_waitcnt vmcnt(0)" ::: "memory");
            const unsigned og = xb_add(&bar[XB_TOP], 1u);
            const unsigned tg = og / nx;
            if (og + 1u == (tg + 1u) * nx) xb_add(&bar[XB_TOPGEN], 1u);
            else XB_SPIN(xb_ld(&bar[XB_TOPGEN]) == tg, bar);
            __builtin_amdgcn_fence(__ATOMIC_ACQUIRE, "agent");
            xb_add(&bar[XB_XGEN(b.x)], 1u);
            asm volatile("s_waitcnt vmcnt(0)" ::: "memory");
        } else {
            XB_SPIN(xb_ld(&bar[XB_XGEN(b.x)]) == gen, bar);
            __builtin_amdgcn_fence(__ATOMIC_ACQUIRE, "agent");
            asm volatile("s_waitcnt vmcnt(0)" ::: "memory");
        }
    }
    __syncthreads();
}

__device__ __forceinline__ unsigned pk_rne(float a, float b) { half2v v = {(_Float16)a, (_Float16)b}; return __builtin_bit_cast(unsigned, v); }
__device__ __forceinline__ unsigned pk_rtz(float a, float b) { auto v = __builtin_amdgcn_cvt_pkrtz(a, b); return __builtin_bit_cast(unsigned, v); }
__device__ __forceinline__ u32x4 pk8(const float* v) { u32x4 w; w.x = pk_rne(v[0], v[1]); w.y = pk_rne(v[2], v[3]); w.z = pk_rne(v[4], v[5]); w.w = pk_rne(v[6], v[7]); return w; }
__device__ __forceinline__ void unpk8(u32x4 w, float* v) {
    const half8 h = __builtin_bit_cast(half8, w);
#pragma unroll
    for (int i = 0; i < 8; ++i) v[i] = (float)h[i];
}
__device__ __forceinline__ float wave_sum(float v) {
#pragma unroll
    for (int o = 1; o < 64; o <<= 1) v += __shfl_xor(v, o);
    return v;
}
__device__ __forceinline__ void rope4(float* v, const float2* cs) {
#pragma unroll
    for (int p = 0; p < 4; ++p) { const float2 t = cs[p]; const float x1 = v[2 * p], x2 = v[2 * p + 1]; v[2 * p] = x1 * t.x - x2 * t.y; v[2 * p + 1] = x2 * t.x + x1 * t.y; }
}

__host__ __device__ __forceinline__ size_t k_off(int tok, int d)   { return (size_t)(((tok >> 6) * 8 + (d >> 3)) * 512 + (tok & 63) * 8 + (d & 7)); }
__host__ __device__ __forceinline__ size_t v_off(int tok, int d)   { return (size_t)((tok >> 6) * 4096 + ((d >> 5) * 8 + ((tok & 63) >> 3)) * 256 + (tok & 7) * 32 + (d & 31)); }
__host__ __device__ __forceinline__ size_t kpe_off(int tok, int p) { return (size_t)(((tok >> 6) * 4 + (p >> 3)) * 512 + (tok & 63) * 8 + (p & 7)); }

namespace pg8 {
constexpr int BM = 256, BK = 64, HALF = 128, HTB = HALF * BK * 2, NXCD = 8, WGM = 8;
__host__ __device__ __forceinline__ int lds_byte(int r, int c) { const int st = (r >> 4) * 2 + (c >> 5), rr = r & 15, cc = c & 31, ob = rr * 64 + cc * 2; return st * 1024 + (ob ^ (((ob >> 9) & 1) << 5)); }
__host__ __device__ __forceinline__ void stage_rc(int b, int& R, int& C) { const int st = b / 1024, sb = b % 1024, swz = sb ^ (((sb >> 9) & 1) << 5); R = (st >> 1) * 16 + swz / 64; C = (st & 1) * 32 + (swz % 64) / 2; }
__host__ __device__ __forceinline__ int perm32(int rho) { const int n = rho >> 4, i = rho & 15; return 8 * (i >> 2) + 4 * n + (i & 3); }

struct Unit { int pm, pn; size_t aoff, boff; };
struct Gemm { const half_t* A; const half_t* Bt; int K, lda, ldb; };

struct StaticOrder {
    int nM, nN, nwg, G, c; size_t tA, tB;
    __device__ void init(int M, int N, int G_, int c_, int lda, int ldb) { nM = M / BM; nN = N / BM; nwg = nM * nN; G = G_; c = c_; tA = (size_t)BM * lda * 2; tB = (size_t)BM * ldb * 2; }
    __device__ bool next(int i, Unit& u) const {
        const long L = (long)i * G + c; if (L >= nwg) return false;
        int wgid = (int)L; { const int q = nwg / NXCD, r = nwg % NXCD, xcd = wgid % NXCD, off = wgid / NXCD; wgid = (xcd < r ? xcd * (q + 1) : r * (q + 1) + (xcd - r) * q) + off; }
        const int nig = WGM * nN, gid = wgid / nig, fm = gid * WGM, gsz = (nM - fm) < WGM ? (nM - fm) : WGM;
        u.pm = fm + ((wgid % nig) % gsz); u.pn = (wgid % nig) / gsz; u.aoff = (size_t)u.pm * tA; u.boff = (size_t)u.pn * tB; return true;
    }
};
struct Cmp1Order {
    int G, c;
    __device__ bool next(int i, Unit& u) const {
        const int L = i * G + c; if (L >= 256) return false;
        const int kv = L >> 7, slab = (L >> 2) & 31, ch = L & 3;
        u.pm = L; u.pn = 0; u.aoff = (size_t)kv * (16 * MiB) + (size_t)slab * (512 * 1024) + (size_t)ch * 1024; u.boff = (size_t)kv * (256 * 2048 * 2) + (size_t)ch * 1024; return true;
    }
};

template <class Epi, class Sched, bool MIDK = false>
__device__ __forceinline__ void gemm_phase(LAS unsigned char* lds, const Gemm g, const Sched& S, const Epi& E) {
    int tid_ = threadIdx.x; asm volatile("" : "+v"(tid_));
    const int tid = tid_, wid = __builtin_amdgcn_readfirstlane(tid >> 6), lane = tid & 63, wr = wid >> 2, wc = wid & 3, fr = lane & 15, fq = lane >> 4;
    const int K = g.K, nt = K / BK;
    unsigned voffA[2], voffB[2];
#pragma unroll
    for (int i = 0; i < 2; ++i) { int R, C; stage_rc(tid * 16 + i * 8192, R, C); const int Rb = (R & ~31) + perm32(R & 31);
        voffA[i] = (unsigned)(R * g.lda + C) * 2u; voffB[i] = (unsigned)(Rb * g.ldb + C) * 2u; }
    const size_t kstep = (size_t)(BK * 2);
    const size_t hstepA = (size_t)HALF * g.lda * 2, hstepB = (size_t)HALF * g.ldb * 2;
    const unsigned ldsw = (unsigned)wid * 1024u;
    const int aoff = lds_byte(wr * 64 + fr, fq * 8), boff = lds_byte(wc * 32 + fr, fq * 8);
#define PG8_SA(b, h) (((b) * 2 + (h)) * HTB)
#define PG8_SB(b, h) ((4 + (b) * 2 + (h)) * HTB)
#define PG8_STAGE(bufoff, gbase, voff) do { _Pragma("unroll") for (int _i = 0; _i < 2; ++_i) \
        __builtin_amdgcn_global_load_lds((const unsigned*)((const char*)(gbase) + (voff)[_i]), (LAS unsigned*)(lds + (bufoff) + ldsw + _i * 8192), 16, 0, 0); } while (0)
#define PG8_LDA(dst, b, h) do { _Pragma("unroll") for (int m = 0; m < 4; ++m) _Pragma("unroll") for (int k = 0; k < 2; ++k) dst[m][k] = *(const LAS half8*)(lds + PG8_SA(b, h) + aoff + m * 2048 + k * 1024); } while (0)
#define PG8_LDB(dst, b, h) do { _Pragma("unroll") for (int n = 0; n < 2; ++n) _Pragma("unroll") for (int k = 0; k < 2; ++k) dst[n][k] = *(const LAS half8*)(lds + PG8_SB(b, h) + boff + n * 2048 + k * 1024); } while (0)
#define PG8_MMA(ai, bj, At, Bt) do { __builtin_amdgcn_s_setprio(1); _Pragma("unroll") for (int m = 0; m < 4; ++m) _Pragma("unroll") for (int n = 0; n < 2; ++n) _Pragma("unroll") for (int k = 0; k < 2; ++k) \
        acc[ai][bj][m][n] = __builtin_amdgcn_mfma_f32_16x16x32_f16(Bt[n][k], At[m][k], acc[ai][bj][m][n], 0, 0, 0); __builtin_amdgcn_s_setprio(0); } while (0)
#define PG8_WAIT_V(n) asm volatile("s_waitcnt vmcnt(" #n ")" ::: "memory")
#define PG8_WAIT_L(n) asm volatile("s_waitcnt lgkmcnt(" #n ")" ::: "memory")
#define PG8_BAR __builtin_amdgcn_s_barrier()
#define PG8_SCHED __builtin_amdgcn_sched_barrier(0)
    Unit cur, nxt; int ui = 0;
    if (!S.next(0, cur)) return;
    f32x4 acc[2][2][4][2];
#pragma unroll
    for (int a = 0; a < 2; ++a)
#pragma unroll
        for (int b = 0; b < 2; ++b)
#pragma unroll
            for (int m = 0; m < 4; ++m)
#pragma unroll
                for (int n = 0; n < 2; ++n) acc[a][b][m][n] = (f32x4){0.f, 0.f, 0.f, 0.f};
    half8 At[4][2], B0[2][2], B1[2][2];
    const char* cA = (const char*)g.A + cur.aoff; const char* cB = (const char*)g.Bt + cur.boff;
    PG8_STAGE(PG8_SB(0, 0), cB, voffB); PG8_STAGE(PG8_SB(0, 1), cB + hstepB, voffB); PG8_STAGE(PG8_SA(0, 0), cA, voffA); PG8_STAGE(PG8_SA(0, 1), cA + hstepA, voffA);
    if (wr == 1) PG8_BAR;
    PG8_WAIT_V(2); PG8_BAR;
    PG8_STAGE(PG8_SB(1, 0), cB + kstep, voffB); PG8_STAGE(PG8_SA(1, 0), cA + kstep, voffA); PG8_STAGE(PG8_SB(1, 1), cB + hstepB + kstep, voffB);
    PG8_WAIT_V(6); PG8_BAR;
    for (;;) {
        const bool has_next = S.next(ui + 1, nxt);
        const char* nA = has_next ? (const char*)g.A + nxt.aoff : cA; const char* nB = has_next ? (const char*)g.Bt + nxt.boff : cB;
        for (int t = 0; t < nt; t += 2) {
            if constexpr (MIDK) { if (t == nt / 2) E.midk(acc, cur, wr); }
            const bool last = (t == nt - 2);
            const char* a1 = cA + (size_t)(t + 1) * kstep;
            const char* a2 = last ? nA : cA + (size_t)(t + 2) * kstep; const char* b2 = last ? nB : cB + (size_t)(t + 2) * kstep;
            const char* a3 = a2 + kstep; const char* b3 = b2 + kstep;
            PG8_LDB(B0, 0, 0); PG8_LDB(B1, 0, 1); PG8_SCHED; PG8_LDA(At, 0, 0); PG8_STAGE(PG8_SA(1, 1), a1 + hstepA, voffA);
            PG8_WAIT_V(8); PG8_WAIT_L(0); PG8_BAR; PG8_MMA(0, 0, At, B0); PG8_MMA(0, 1, At, B1); PG8_BAR; PG8_SCHED;
            PG8_LDA(At, 0, 1); PG8_STAGE(PG8_SB(0, 0), b2, voffB); PG8_STAGE(PG8_SB(0, 1), b2 + hstepB, voffB); PG8_STAGE(PG8_SA(0, 0), a2, voffA);
            PG8_WAIT_V(8); PG8_WAIT_L(0); PG8_BAR; PG8_MMA(1, 0, At, B0); PG8_MMA(1, 1, At, B1); PG8_BAR; PG8_SCHED;
            PG8_LDB(B0, 1, 0); PG8_LDB(B1, 1, 1); PG8_SCHED; PG8_LDA(At, 1, 0); PG8_STAGE(PG8_SA(0, 1), a2 + hstepA, voffA);
            PG8_WAIT_V(8); PG8_WAIT_L(0); PG8_BAR; PG8_MMA(0, 0, At, B0); PG8_MMA(0, 1, At, B1); PG8_BAR; PG8_SCHED;
            PG8_LDA(At, 1, 1); PG8_STAGE(PG8_SB(1, 0), b3, voffB); PG8_STAGE(PG8_SB(1, 1), b3 + hstepB, voffB); PG8_STAGE(PG8_SA(1, 0), a3, voffA);
            PG8_WAIT_V(8); PG8_WAIT_L(0); PG8_BAR; PG8_MMA(1, 0, At, B0); PG8_MMA(1, 1, At, B1); PG8_BAR; PG8_SCHED;
        }
        if (wr == 0) PG8_BAR;
        E(acc, cur, wr, wc, fr, fq);
        if (!has_next) break;
#pragma unroll
        for (int a = 0; a < 2; ++a)
#pragma unroll
            for (int b = 0; b < 2; ++b)
#pragma unroll
                for (int m = 0; m < 4; ++m)
#pragma unroll
                    for (int n = 0; n < 2; ++n) acc[a][b][m][n] = (f32x4){0.f, 0.f, 0.f, 0.f};
        cur = nxt; cA = nA; cB = nB; ++ui;
        if (wr == 1) PG8_BAR;
    }
    PG8_WAIT_V(0);
    PG8_BAR;
#undef PG8_SA
#undef PG8_SB
#undef PG8_STAGE
#undef PG8_LDA
#undef PG8_LDB
#undef PG8_MMA
#undef PG8_WAIT_V
#undef PG8_WAIT_L
#undef PG8_BAR
#undef PG8_SCHED
}
}

typedef f32x4 AccT[2][2][4][2];
#define EPI_IDS() int t_ = threadIdx.x; asm volatile("" : "+v"(t_)); const int fr = t_ & 15, fq = (t_ >> 4) & 3; (void)fr_; (void)fq_
#define EPI_ROW(ai, m) (u.pm * 256 + (ai) * 128 + wr * 64 + (m) * 16 + fr)
#define EPI_GET8(v, ai, bj, m, s) do { const f32x4 _a = acc[ai][bj][m][0], _b = acc[ai][bj][m][1]; v[0] = _a[0] * (s); v[1] = _a[1] * (s); v[2] = _a[2] * (s); v[3] = _a[3] * (s); v[4] = _b[0] * (s); v[5] = _b[1] * (s); v[6] = _b[2] * (s); v[7] = _b[3] * (s); } while (0)
__device__ __forceinline__ void rope4v(float* v, const f32x4& c01, const f32x4& c23) {
    const float cs[8] = {c01[0], c01[1], c01[2], c01[3], c23[0], c23[1], c23[2], c23[3]};
#pragma unroll
    for (int p = 0; p < 4; ++p) { const float x1 = v[2 * p], x2 = v[2 * p + 1]; v[2 * p] = x1 * cs[2 * p] - x2 * cs[2 * p + 1]; v[2 * p + 1] = x2 * cs[2 * p] + x1 * cs[2 * p + 1]; }
}
__device__ __forceinline__ float sum4(const f32x4& a) { return (a[0] + a[1]) + (a[2] + a[3]); }
__device__ __forceinline__ float relu_s(float x) { float r; asm("v_max_f32_e32 %0, 0, %1" : "=v"(r) : "v"(x)); return r; }
constexpr int LDS_RED = 131072;

struct EpiIn {
    const float* rs1; half_t* CQ; half_t* T1; half_t* KPE; float* GATE; float* SSQ; float* SSKV; half_t* QN; half_t* KVT; const float2* ropeM; const float2* ropeN;
    __device__ __forceinline__ void operator()(const AccT& acc, const pg8::Unit& u, int wr, int wc, int fr_, int fq_) const {
        EPI_IDS();
        const int pn = u.pn;
        const bool ropem = (pn == 1 && wc == 0), ropen = (pn >= 2 && pn != 4 && (wc & 1) == 0);
#pragma unroll
        for (int ai = 0; ai < 2; ++ai) {
            float rsv[4]; f32x4 rc[4][2];
#pragma unroll
            for (int m = 0; m < 4; ++m) { const int row = EPI_ROW(ai, m), pos = row & (SEQ - 1); rsv[m] = rs1[row];
                if (ropem) { const f32x4* p = (const f32x4*)(ropeM + (size_t)pos * 16 + fq * 4); rc[m][0] = p[0]; rc[m][1] = p[1]; }
                else if (ropen) { const f32x4* p = (const f32x4*)(ropeN + (size_t)pos * 8 + (fq & 1) * 4); rc[m][0] = p[0]; rc[m][1] = p[1]; } }
#pragma unroll
            for (int m = 0; m < 4; ++m) { const int row = EPI_ROW(ai, m), pos = row & (SEQ - 1), b = row >> 12; const float rs = rsv[m];
                float v[8];
                if (pn == 0) {
                    float ss = 0.f;
#pragma unroll
                    for (int bj = 0; bj < 2; ++bj) { EPI_GET8(v, ai, bj, m, rs);
#pragma unroll
                        for (int i = 0; i < 8; ++i) ss += v[i] * v[i];
                        *(u32x4*)(CQ + (size_t)row * 256 + bj * 128 + wc * 32 + fq * 8) = pk8(v); }
                    ss += __shfl_xor(ss, 16); ss += __shfl_xor(ss, 32);
                    if (fq == 0) SSQ[(size_t)row * 4 + wc] = ss;
                } else if (pn == 1) {
                    { EPI_GET8(v, ai, 0, m, rs); float ss = 0.f;
#pragma unroll
                        for (int i = 0; i < 8; ++i) ss += v[i] * v[i];
                        *(u32x4*)(T1 + (size_t)row * 256 + wc * 32 + fq * 8) = pk8(v);
                        ss += __shfl_xor(ss, 16); ss += __shfl_xor(ss, 32);
                        if (fq == 0) SSKV[(size_t)row * 4 + wc] = ss; }
                    { EPI_GET8(v, ai, 1, m, rs);
                        if (wc == 0) { rope4v(v, rc[m][0], rc[m][1]); const u32x4 w = pk8(v);
                            *(u32x4*)(T1 + (size_t)row * 256 + 128 + fq * 8) = w; *(u32x4*)(KPE + (size_t)b * SEQ * 32 + kpe_off(pos, fq * 8)) = w; }
                        else { if (wc == 1 && fq < 3) { float* gp = GATE + (size_t)row * 24 + fq * 8;
#pragma unroll
                                for (int i = 0; i < 8; ++i) v[i] = 1.f / (1.f + __expf(-v[i]));
                                *(f32x4*)gp = (f32x4){v[0], v[1], v[2], v[3]}; *(f32x4*)(gp + 4) = (f32x4){v[4], v[5], v[6], v[7]}; }
                            *(u32x4*)(T1 + (size_t)row * 256 + 128 + wc * 32 + fq * 8) = (u32x4){0u, 0u, 0u, 0u}; } }
                } else if (pn < 4) {
#pragma unroll
                    for (int bj = 0; bj < 2; ++bj) { EPI_GET8(v, ai, bj, m, rs); const int head = (pn - 2) * 4 + 2 * bj + (wc >> 1), off = 32 * (wc & 1) + 8 * fq;
                        if ((wc & 1) == 0 && fq < 2) rope4v(v, rc[m][0], rc[m][1]);
#pragma unroll
                        for (int i = 0; i < 8; ++i) v[i] *= QS_N;
                        *(u32x4*)(QN + (size_t)row * 512 + head * 64 + off) = pk8(v); }
                } else {
#pragma unroll
                    for (int bj = 0; bj < 2; ++bj) { EPI_GET8(v, ai, bj, m, rs); const int g = wc >> 1, d = 32 * (wc & 1) + 8 * fq;
                        if (pn > 4 && bj == 0 && (wc & 1) == 0 && fq < 2) rope4v(v, rc[m][0], rc[m][1]);
                        half_t* base = KVT + (size_t)((pn - 4) * 2 + bj) * KVT_STRIDE + (size_t)(b * 2 + g) * SEQ * 64;
                        *(u32x4*)(base + (pn == 4 ? (size_t)pos * 64 + d : (bj == 0 ? k_off(pos, d) : v_off(pos, d)))) = pk8(v); }
                }
            }
        }
    }
};

struct EpiUq {
    const float* SSQ; half_t* QM; const float2* ropeM;
    __device__ __forceinline__ void operator()(const AccT& acc, const pg8::Unit& u, int wr, int wc, int fr_, int fq_) const {
        EPI_IDS();
        const bool pe0 = ((8 * u.pn + wc) % 3 == 2), pe1 = ((8 * u.pn + 4 + wc) % 3 == 2);
#pragma unroll
        for (int ai = 0; ai < 2; ++ai) {
            f32x4 s4[4];
#pragma unroll
            for (int m = 0; m < 4; ++m) s4[m] = *(const f32x4*)(SSQ + (size_t)EPI_ROW(ai, m) * 4);
#pragma unroll
            for (int m = 0; m < 4; ++m) { const int row = EPI_ROW(ai, m);
                const float rs = __builtin_amdgcn_rsqf(sum4(s4[m]) * (1.f / 256.f) + NORM_EPS) * QS_M;
                float v[8];
#pragma unroll
                for (int bj = 0; bj < 2; ++bj) { EPI_GET8(v, ai, bj, m, rs); const int sidx = 8 * u.pn + 4 * bj + wc;
                    if (bj == 0 ? pe0 : pe1) { const f32x4* p = (const f32x4*)(ropeM + (size_t)(row & (SEQ - 1)) * 16 + fq * 4); rope4v(v, p[0], p[1]); }
                    *(u32x4*)(QM + (size_t)row * 768 + sidx * 32 + fq * 8) = pk8(v); }
            }
        }
    }
};
struct EpiUkv {
    const float* SSKV; half_t* KNM; half_t* VM;
    __device__ __forceinline__ void operator()(const AccT& acc, const pg8::Unit& u, int wr, int wc, int fr_, int fq_) const {
        EPI_IDS();
#pragma unroll
        for (int ai = 0; ai < 2; ++ai) {
            f32x4 s4[4];
#pragma unroll
            for (int m = 0; m < 4; ++m) s4[m] = *(const f32x4*)(SSKV + (size_t)EPI_ROW(ai, m) * 4);
#pragma unroll
            for (int m = 0; m < 4; ++m) { const int row = EPI_ROW(ai, m), pos = row & (SEQ - 1), b = row >> 12;
                const float rs = __builtin_amdgcn_rsqf(sum4(s4[m]) * (1.f / 128.f) + NORM_EPS);
                float v[8];
#pragma unroll
                for (int bj = 0; bj < 2; ++bj) { EPI_GET8(v, ai, bj, m, rs); const int c = (u.pn & 1) * 256 + bj * 128 + wc * 32 + fq * 8, head = c >> 6, d = c & 63;
                    half_t* base = ((u.pn < 2) ? KNM : VM) + (size_t)(b * 8 + head) * SEQ * 64;
                    *(u32x4*)(base + ((u.pn < 2) ? k_off(pos, d) : v_off(pos, d))) = pk8(v); }
            }
        }
    }
};
struct EpiC1 {
    float* HIDP;
    __device__ __forceinline__ void operator()(const AccT& acc, const pg8::Unit& u, int wr, int wc, int fr_, int fq_) const {
        EPI_IDS();
#pragma unroll
        for (int ai = 0; ai < 2; ++ai)
#pragma unroll
            for (int m = 0; m < 4; ++m) { const int rl = ai * 128 + wr * 64 + m * 16 + fr; float* p = HIDP + ((size_t)u.pm * 256 + rl) * 128 + wc * 32 + fq * 8;
                *(f32x4*)p = acc[ai][0][m][0]; *(f32x4*)(p + 4) = acc[ai][0][m][1]; }
    }
};
__device__ __forceinline__ float rstd8(const float* p, float inv_n) {
    const f32x4 a = *(const f32x4*)p, b = *(const f32x4*)(p + 4);
    return __builtin_amdgcn_rsqf((sum4(a) + sum4(b)) * inv_n + NORM_EPS);
}
struct EpiWo {
    const half_t* XH; half_t* H1; float* SS2; const float* SSM; const float* SSN; LAS float* red;
    __device__ __forceinline__ void midk(AccT& acc, const pg8::Unit& u, int wr) const {
        int t_ = threadIdx.x; asm volatile("" : "+v"(t_)); const int fr = t_ & 15;
#pragma unroll
        for (int ai = 0; ai < 2; ++ai) {
            f32x4 sm[4][2], sn[4][2];
#pragma unroll
            for (int m = 0; m < 4; ++m) { const int row = EPI_ROW(ai, m); sm[m][0] = *(const f32x4*)(SSM + (size_t)row * 8); sm[m][1] = *(const f32x4*)(SSM + (size_t)row * 8 + 4); sn[m][0] = *(const f32x4*)(SSN + (size_t)row * 8); sn[m][1] = *(const f32x4*)(SSN + (size_t)row * 8 + 4); }
#pragma unroll
            for (int m = 0; m < 4; ++m) {
                const float ratio = __builtin_amdgcn_rsqf((sum4(sm[m][0]) + sum4(sm[m][1])) * (1.f / 512.f) + NORM_EPS) / __builtin_amdgcn_rsqf((sum4(sn[m][0]) + sum4(sn[m][1])) * (1.f / 512.f) + NORM_EPS);
#pragma unroll
                for (int bj = 0; bj < 2; ++bj)
#pragma unroll
                    for (int n = 0; n < 2; ++n) acc[ai][bj][m][n] *= ratio; }
        }
    }
    __device__ __forceinline__ void operator()(const AccT& acc, const pg8::Unit& u, int wr, int wc, int fr_, int fq_) const {
        EPI_IDS();
#pragma unroll
        for (int ai = 0; ai < 2; ++ai) {
            f32x4 sn[4][2]; u32x4 xr[4][2];
#pragma unroll
            for (int m = 0; m < 4; ++m) { const int row = EPI_ROW(ai, m); sn[m][0] = *(const f32x4*)(SSN + (size_t)row * 8); sn[m][1] = *(const f32x4*)(SSN + (size_t)row * 8 + 4);
#pragma unroll
                for (int bj = 0; bj < 2; ++bj) xr[m][bj] = *(const u32x4*)(XH + (size_t)row * DM + u.pn * 256 + bj * 128 + wc * 32 + fq * 8); }
#pragma unroll
            for (int m = 0; m < 4; ++m) { const int row = EPI_ROW(ai, m);
                const float rn = __builtin_amdgcn_rsqf((sum4(sn[m][0]) + sum4(sn[m][1])) * (1.f / 512.f) + NORM_EPS);
                float v[8], x[8], ss = 0.f;
#pragma unroll
                for (int bj = 0; bj < 2; ++bj) { EPI_GET8(v, ai, bj, m, rn); unpk8(xr[m][bj], x);
#pragma unroll
                    for (int i = 0; i < 8; ++i) { v[i] += x[i]; ss += v[i] * v[i]; }
                    *(u32x4*)(H1 + (size_t)row * DM + u.pn * 256 + bj * 128 + wc * 32 + fq * 8) = pk8(v); }
                ss += __shfl_xor(ss, 16); ss += __shfl_xor(ss, 32);
                if (fq == 0) red[(ai * 128 + wr * 64 + m * 16 + fr) * 4 + wc] = ss;
            }
        }
        asm volatile("s_waitcnt lgkmcnt(0)" ::: "memory"); __builtin_amdgcn_s_barrier();
        if (t_ < 256) { const f32x4 r4 = *(const LAS f32x4*)(red + t_ * 4); SS2[(size_t)(u.pm * 256 + t_) * 4 + u.pn] = sum4(r4); }
    }
};
__device__ __forceinline__ float rstd16(const float* p, float inv_n) {
    const f32x4 a = *(const f32x4*)p, b = *(const f32x4*)(p + 4), c = *(const f32x4*)(p + 8), d = *(const f32x4*)(p + 12);
    return __builtin_amdgcn_rsqf(((sum4(a) + sum4(b)) + (sum4(c) + sum4(d))) * inv_n + NORM_EPS);
}
struct EpiUp {
    const float* SS2; half_t* A2;
    __device__ __forceinline__ void operator()(const AccT& acc, const pg8::Unit& u, int wr, int wc, int fr_, int fq_) const {
        EPI_IDS();
#pragma unroll
        for (int ai = 0; ai < 2; ++ai) {
            f32x4 s[4];
#pragma unroll
            for (int m = 0; m < 4; ++m) s[m] = *(const f32x4*)(SS2 + (size_t)EPI_ROW(ai, m) * 4);
#pragma unroll
            for (int m = 0; m < 4; ++m) { const int row = EPI_ROW(ai, m);
                const float rs = __builtin_amdgcn_rsqf(sum4(s[m]) * (1.f / 1024.f) + NORM_EPS);
                const float rs2 = rs * rs;
#pragma unroll
                for (int bj = 0; bj < 2; ++bj) { u32x4 w;
#pragma unroll
                    for (int n = 0; n < 2; ++n) { const f32x4 a = acc[ai][bj][m][n];
                        typedef float f32x2 __attribute__((ext_vector_type(2)));
                        f32x2 x0 = {relu_s(a[0]), relu_s(a[1])}, x1 = {relu_s(a[2]), relu_s(a[3])};
                        x0 = x0 * x0 * rs2; x1 = x1 * x1 * rs2;
                        w[2 * n] = pk_rne(x0[0], x0[1]); w[2 * n + 1] = pk_rne(x1[0], x1[1]); }
                    __builtin_nontemporal_store(w, (u32x4*)(A2 + (size_t)row * DFF + u.pn * 256 + bj * 128 + wc * 32 + fq * 8)); }
            }
        }
    }
};
struct EpiDn {
    const half_t* H1; half_t* H2; float* SS3; LAS float* red;
    __device__ __forceinline__ void operator()(const AccT& acc, const pg8::Unit& u, int wr, int wc, int fr_, int fq_) const {
        EPI_IDS();
#pragma unroll
        for (int ai = 0; ai < 2; ++ai) {
            u32x4 xr[4][2];
#pragma unroll
            for (int m = 0; m < 4; ++m)
#pragma unroll
                for (int bj = 0; bj < 2; ++bj) xr[m][bj] = *(const u32x4*)(H1 + (size_t)EPI_ROW(ai, m) * DM + u.pn * 256 + bj * 128 + wc * 32 + fq * 8);
#pragma unroll
            for (int m = 0; m < 4; ++m) { const int row = EPI_ROW(ai, m);
                float v[8], x[8], ss = 0.f;
#pragma unroll
                for (int bj = 0; bj < 2; ++bj) { EPI_GET8(v, ai, bj, m, 1.f); unpk8(xr[m][bj], x);
#pragma unroll
                    for (int i = 0; i < 8; ++i) { v[i] += x[i]; ss += v[i] * v[i]; }
                    *(u32x4*)(H2 + (size_t)row * DM + u.pn * 256 + bj * 128 + wc * 32 + fq * 8) = pk8(v); }
                ss += __shfl_xor(ss, 16); ss += __shfl_xor(ss, 32);
                if (fq == 0) red[(ai * 128 + wr * 64 + m * 16 + fr) * 4 + wc] = ss;
            }
        }
        asm volatile("s_waitcnt lgkmcnt(0)" ::: "memory"); __builtin_amdgcn_s_barrier();
        if (t_ < 256) { const f32x4 r4 = *(const LAS f32x4*)(red + t_ * 4); SS3[(size_t)(u.pm * 256 + t_) * 4 + u.pn] = sum4(r4); }
    }
};

constexpr int AT_KB = 0, AT_VB = 12288, AT_BUF = 20480;
constexpr int AT_SUB = 3;
constexpr int AT_STAGE = AT_SUB * AT_BUF;
constexpr int AT_IMP = 2 * AT_STAGE;
constexpr int AT_IMPW = 8 * 2 * 68 * 4;
constexpr int AT_SEL = AT_IMP + 8 * AT_IMPW;
constexpr int AT_QIDX = AT_SEL + 8 * 64;

struct TileRegs { u32x4 k, kp, v; };
__device__ __forceinline__ void tile_load(TileRegs& r, const half_t* Kt, const half_t* KPt, const half_t* Vt, int tid, int wid, int lane) {
    r.k = *(const u32x4*)(Kt + (size_t)(tid & 63) * 64 + wid * 8);
    if (KPt != nullptr && tid < 256) r.kp = *(const u32x4*)(KPt + (size_t)(tid & 63) * 32 + wid * 8);
    r.v = *(const u32x4*)(Vt + (size_t)(16 * (wid & 3) + (lane >> 2)) * 64 + (wid >> 2) * 32 + (lane & 3) * 8);
}
__device__ __forceinline__ void tile_store(const TileRegs& r, LAS unsigned char* buf, bool haspe, int tid, int wid, int lane) {
    *(LAS u32x4*)(buf + AT_KB + wid * 1024 + lane * 16) = r.k;
    if (haspe && tid < 256) *(LAS u32x4*)(buf + AT_KB + (8 + wid) * 1024 + lane * 16) = r.kp;
    *(LAS u32x4*)(buf + AT_VB + wid * 1024 + lane * 16) = r.v;
}
__device__ __forceinline__ float xhalf_max(float v) { const auto rr = __builtin_amdgcn_permlane32_swap(__float_as_uint(v), __float_as_uint(v), false, false); return fmaxf(__uint_as_float(rr[0]), __uint_as_float(rr[1])); }
__device__ __forceinline__ float xhalf_sum(float v) { const auto rr = __builtin_amdgcn_permlane32_swap(__float_as_uint(v), __float_as_uint(v), false, false); return __uint_as_float(rr[0]) + __uint_as_float(rr[1]); }
template <int NKS, int AB = 0>
__device__ __forceinline__ void tile_qk(const LAS unsigned char* kb, const half8 (&qf)[NKS], const f32x16& cinit, f32x16& p0, f32x16& p1) {
    if (AB & 1) { p0 = cinit; p1 = cinit; p0[0] += (float)qf[0][0]; p1[3] += (float)qf[1][1]; if (!(AB & 8)) { const half8 a = *(const LAS half8*)kb; p0[1] += (float)a[0]; } return; }
    half8 kf[2 * NKS];
#pragma unroll
    for (int ks = 0; ks < NKS; ++ks) { kf[2 * ks] = *(const LAS half8*)(kb + ks * 2048); kf[2 * ks + 1] = *(const LAS half8*)(kb + ks * 2048 + 512); }
    __builtin_amdgcn_sched_barrier(0);
    p0 = __builtin_amdgcn_mfma_f32_32x32x16_f16(kf[0], qf[0], cinit, 0, 0, 0);
    p1 = __builtin_amdgcn_mfma_f32_32x32x16_f16(kf[1], qf[0], cinit, 0, 0, 0);
#pragma unroll
    for (int ks = 1; ks < NKS; ++ks) {
        p0 = __builtin_amdgcn_mfma_f32_32x32x16_f16(kf[2 * ks], qf[ks], p0, 0, 0, 0);
        p1 = __builtin_amdgcn_mfma_f32_32x32x16_f16(kf[2 * ks + 1], qf[ks], p1, 0, 0, 0);
    }
}
__device__ __forceinline__ void tile_emask(f32x16& p0, f32x16& p1, int hiL, int loL) {
#pragma unroll
    for (int r = 0; r < 16; ++r) { const int c = (r & 3) + 8 * (r >> 2);
        if (!(c <= hiL && c >= loL)) p0[r] = -INFINITY;
        if (!(c + 32 <= hiL && c + 32 >= loL)) p1[r] = -INFINITY; }
}
__device__ __forceinline__ float tile_rowmax(const f32x16& p0, const f32x16& p1) {
    float a = fmaxf(fmaxf(p0[0], p0[1]), p0[2]), b = fmaxf(fmaxf(p1[0], p1[1]), p1[2]);
#pragma unroll
    for (int r = 3; r < 15; r += 2) { a = fmaxf(fmaxf(a, p0[r]), p0[r + 1]); b = fmaxf(fmaxf(b, p1[r]), p1[r + 1]); }
    a = fmaxf(fmaxf(a, p0[15]), fmaxf(b, p1[15]));
    return xhalf_max(a);
}
struct VFrags { v4i16 f[16]; };
__device__ __forceinline__ void vfrag_load(VFrags& V, const LAS unsigned char* vb) {
#pragma unroll
    for (int i = 0; i < 8; ++i) {
        V.f[2 * i]     = __builtin_amdgcn_ds_read_tr16_b64_v4i16((LAS v4i16*)(vb + (i >> 2) * 4096 + (i & 3) * 1024));
        V.f[2 * i + 1] = __builtin_amdgcn_ds_read_tr16_b64_v4i16((LAS v4i16*)(vb + (i >> 2) * 4096 + (i & 3) * 1024 + 512));
    }
}
__device__ __forceinline__ void tile_pv(const f32x16& p0, const f32x16& p1, const VFrags& V, f32x16 (&o)[2]) {
    u32x4 pw[4];
#pragma unroll
    for (int s = 0; s < 2; ++s) {
        pw[s]     = (u32x4){pk_rtz(p0[8 * s], p0[8 * s + 1]), pk_rtz(p0[8 * s + 2], p0[8 * s + 3]), pk_rtz(p0[8 * s + 4], p0[8 * s + 5]), pk_rtz(p0[8 * s + 6], p0[8 * s + 7])};
        pw[2 + s] = (u32x4){pk_rtz(p1[8 * s], p1[8 * s + 1]), pk_rtz(p1[8 * s + 2], p1[8 * s + 3]), pk_rtz(p1[8 * s + 4], p1[8 * s + 5]), pk_rtz(p1[8 * s + 6], p1[8 * s + 7])};
    }
    typedef short s8 __attribute__((ext_vector_type(8)));
#pragma unroll
    for (int db = 0; db < 2; ++db)
#pragma unroll
        for (int ks = 0; ks < 4; ++ks) {
            const v4i16 lo = V.f[2 * (db * 4 + ks)], hi = V.f[2 * (db * 4 + ks) + 1];
            const s8 t = {lo[0], lo[1], lo[2], lo[3], hi[0], hi[1], hi[2], hi[3]};
            o[db] = __builtin_amdgcn_mfma_f32_32x32x16_f16(__builtin_bit_cast(half8, t), __builtin_bit_cast(half8, pw[ks]), o[db], 0, 0, 0);
        }
}
constexpr float SM_THR = 6.f;
struct SmState { f32x16 negm; float mref, l; };
__device__ __forceinline__ void sm_reset(SmState& S) { S.negm = (f32x16){0.f}; S.mref = 0.f; S.l = 0.f; }
template <int AB = 0>
__device__ __forceinline__ void tile_softmax_pv(f32x16& p0, f32x16& p1, const LAS unsigned char* vb, f32x16 (&o)[2], SmState& S, bool first) {
    VFrags V; if (!(AB & 4)) vfrag_load(V, vb);
    if (!(AB & 2)) {
        const float tm = tile_rowmax(p0, p1);
        const bool need = first ? (tm > -INFINITY) : (tm > SM_THR);
        if (__any(need)) {
            const float delta = need ? tm : 0.f, alpha = __builtin_amdgcn_exp2f(-delta);
            S.mref += delta; S.l *= alpha;
#pragma unroll
            for (int r = 0; r < 16; ++r) { p0[r] -= delta; p1[r] -= delta; o[0][r] *= alpha; o[1][r] *= alpha; S.negm[r] = -S.mref; }
        }
        float s0 = 0.f, s1 = 0.f, s2 = 0.f, s3 = 0.f;
#pragma unroll
        for (int r = 0; r < 16; ++r) { p0[r] = __builtin_amdgcn_exp2f(p0[r]); p1[r] = __builtin_amdgcn_exp2f(p1[r]); }
#pragma unroll
        for (int r = 0; r < 16; r += 2) { s0 += p0[r]; s1 += p0[r + 1]; s2 += p1[r]; s3 += p1[r + 1]; }
        S.l += (s0 + s1) + (s2 + s3);
    }
    if (!(AB & 4)) tile_pv(p0, p1, V, o); else { _Pragma("unroll") for (int r = 0; r < 16; ++r) { o[0][r & 3] += p0[r]; o[1][r & 3] += p1[r]; } }
}

__device__ __forceinline__ void glds16(const void* gsrc, unsigned lds_dst) { unsigned keep;
    asm volatile("s_mov_b32 %0, m0\n\ts_mov_b32 m0, %2\n\ts_nop 0\n\tglobal_load_lds_dwordx4 %1, off\n\ts_mov_b32 m0, %0" : "=&s"(keep) : "v"(gsrc), "s"(lds_dst) : "memory"); }
__device__ __forceinline__ unsigned lds_addr(const LAS unsigned char* p) { return (unsigned)__builtin_amdgcn_readfirstlane((int)(unsigned)(size_t)p); }
__device__ __forceinline__ void tile_dma(const half_t* Kt, const half_t* KPt, const half_t* Vt, LAS unsigned char* sub, bool haspe, int wid, int lane) {
    const unsigned base = lds_addr(sub);
    glds16(Kt + wid * 512 + lane * 8, base + AT_KB + wid * 1024);
    if (haspe && wid < 4) glds16(KPt + wid * 512 + lane * 8, base + AT_KB + (8 + wid) * 1024);
    glds16(Vt + wid * 512 + lane * 8, base + AT_VB + wid * 1024);
}
#ifndef AT_STAGGER
#define AT_STAGGER 7
#endif
#ifndef AT_STAGGER_MASK
#define AT_STAGGER_MASK 4
#endif
#define AT_WAITBAR() do { asm volatile("s_waitcnt vmcnt(0) lgkmcnt(0)" ::: "memory"); __builtin_amdgcn_s_barrier(); } while (0)
#define KV_STREAM(NT, DMAT, COMPT) do { \
    const int nt__ = (NT), nst__ = (nt__ + AT_SUB - 1) / AT_SUB; \
    _Pragma("unroll") for (int j_ = 0; j_ < AT_SUB; ++j_) if (j_ < nt__) { DMAT(j_, lds + j_ * AT_BUF); } \
    AT_WAITBAR(); \
    for (int s_ = 0; s_ < nst__; ++s_) { \
        LAS unsigned char* cb_ = lds + (s_ & 1) * AT_STAGE; LAS unsigned char* nb_ = lds + ((s_ + 1) & 1) * AT_STAGE; \
        _Pragma("unroll") for (int j_ = 0; j_ < AT_SUB; ++j_) { const int tn_ = (s_ + 1) * AT_SUB + j_; if (tn_ < nt__) { DMAT(tn_, nb_ + j_ * AT_BUF); } } \
        _Pragma("unroll") for (int j_ = 0; j_ < AT_SUB; ++j_) { const int tc_ = s_ * AT_SUB + j_; if (tc_ < nt__) { COMPT(tc_, cb_ + j_ * AT_BUF); } } \
        AT_WAITBAR(); \
    } } while (0)

struct AttnPtrs {
    const half_t* QM; const half_t* KNM; const half_t* KPE; const half_t* VM;
    const half_t* QN; const half_t* KC; const half_t* VC; const half_t* KS; const half_t* VS; const half_t* KW; const half_t* VW; const float* GATE;
    half_t* Y; float* SSM; float* SSN;
};

template <int AB = 0>
__device__ __forceinline__ void mla_unit(const AttnPtrs& P, int bh, int qb, LAS unsigned char* lds, bool nostore = false) {
    int tid_ = threadIdx.x; asm volatile("" : "+v"(tid_));
    const int tid = tid_, lane = tid & 63, wid = __builtin_amdgcn_readfirstlane(tid >> 6), q = lane & 31, h = lane >> 5;
    const int b = bh >> 3, hd = bh & 7, q0 = qb * 256, qpos = q0 + wid * 32 + q;
    const size_t trow = (size_t)b * SEQ + qpos;
    half8 qf[6];
#pragma unroll
    for (int ks = 0; ks < 6; ++ks) qf[ks] = *(const half8*)(P.QM + trow * 768 + hd * 96 + ks * 16 + h * 8);
#pragma unroll
    for (int ks = 0; ks < 6; ++ks) asm volatile("" : "+v"(qf[ks]));
    const half_t* Kb = P.KNM + (size_t)bh * SEQ * 64; const half_t* Vb = P.VM + (size_t)bh * SEQ * 64; const half_t* KPb = P.KPE + (size_t)b * SEQ * 32;
    const int ntiles = 4 * qb + 4, my_last = 4 * qb + (wid >> 1);
    f32x16 o[2]; o[0] = (f32x16){0.f}; o[1] = (f32x16){0.f};
    SmState S; sm_reset(S);
    const int koff = h * 1024 + q * 16, voff = (4 * h + ((lane & 15) >> 2)) * 64 + ((lane >> 4) & 1) * 32 + (lane & 3) * 8;
#define MLA_LOAD(t, sub) if (!(AB & 16)) tile_dma(Kb + (size_t)(t) * 4096, KPb + (size_t)(t) * 2048, Vb + (size_t)(t) * 4096, sub, true, wid, lane)
#define MLA_COMP(t, buf) do { if ((t) <= my_last) { f32x16 p0, p1; \
        tile_qk<6, AB>((buf) + AT_KB + koff, qf, S.negm, p0, p1); \
        if ((t) == my_last) tile_emask(p0, p1, qpos - 64 * (t) - 4 * h, -1000); \
        tile_softmax_pv<AB>(p0, p1, (buf) + AT_VB + voff, o, S, (t) == 0); } } while (0)
    KV_STREAM(ntiles, MLA_LOAD, MLA_COMP);
#undef MLA_LOAD
#undef MLA_COMP
    const float l = xhalf_sum(S.l);
    const float inv = 1.f / l;
    if (nostore && !(l == 123.456f)) return;
    float ss = 0.f;
    half_t* yrow = P.Y + trow * DM + hd * 64;
#pragma unroll
    for (int db = 0; db < 2; ++db)
#pragma unroll
        for (int c = 0; c < 4; ++c) { const float a0 = o[db][4 * c] * inv, a1 = o[db][4 * c + 1] * inv, a2 = o[db][4 * c + 2] * inv, a3 = o[db][4 * c + 3] * inv;
            ss += (a0 * a0 + a1 * a1) + (a2 * a2 + a3 * a3);
            *(u32x2*)(yrow + db * 32 + 8 * c + 4 * h) = (u32x2){pk_rne(a0, a1), pk_rne(a2, a3)}; }
    ss = xhalf_sum(ss);
    if (h == 0) P.SSM[trow * 8 + hd] = ss;
}

template <int NKS_unused = 4>
__device__ __forceinline__ void nsa_stream_begin(TileRegs& tr, const half_t* Kt, const half_t* Vt, LAS unsigned char* lds, int tid, int wid, int lane) {
    tile_load(tr, Kt, nullptr, Vt, tid, wid, lane);
    tile_store(tr, lds, false, tid, wid, lane);
    __syncthreads();
}
__device__ __forceinline__ void nsa_unit(const AttnPtrs& P, int bg, int qb, LAS unsigned char* lds) {
    int tid_ = threadIdx.x; asm volatile("" : "+v"(tid_));
    const int tid = tid_, lane = tid & 63, wid = __builtin_amdgcn_readfirstlane(tid >> 6), j = lane & 31, h = lane >> 5;
    const int b = bg >> 1, g = bg & 1, q0 = qb * 64, cur = qb, qi = j >> 2, hh = j & 3, qrel = wid * 8 + qi, qpos = q0 + qrel, head = g * 4 + hh;
    const size_t trow = (size_t)b * SEQ + qpos;
    half8 qf[4];
#pragma unroll
    for (int ks = 0; ks < 4; ++ks) qf[ks] = *(const half8*)(P.QN + trow * 512 + head * 64 + ks * 16 + h * 8);
    float g0 = P.GATE[trow * 24 + head], g1 = P.GATE[trow * 24 + 8 + head], g2 = P.GATE[trow * 24 + 16 + head];
#pragma unroll
    for (int ks = 0; ks < 4; ++ks) asm volatile("" : "+v"(qf[ks]));
    asm volatile("" : "+v"(g0), "+v"(g1), "+v"(g2));
    const int koff = h * 1024 + j * 16, voff = (4 * h + ((lane & 15) >> 2)) * 64 + ((lane >> 4) & 1) * 32 + (lane & 3) * 8;
    f32x16 acc[2]; acc[0] = (f32x16){0.f}; acc[1] = (f32x16){0.f};
    f32x16 o[2];
    LAS float* impw = (LAS float*)(lds + AT_IMP + wid * AT_IMPW);
    unsigned long long selmask = (2ull << cur) - 1ull;

    const int ncmp = ((q0 + 32) >> 4) / 64 + 1;
    const half_t* Kc = P.KC + (size_t)bg * 256 * 64; const half_t* Vc = P.VC + (size_t)bg * 256 * 64;
    float m = -1e30f, l = 0.f; const f32x16 zero16 = (f32x16){0.f};
#define CMP_LOAD(t, sub) tile_dma(Kc + (size_t)(t) * 4096, nullptr, Vc + (size_t)(t) * 4096, sub, false, wid, lane)
#define CMP1_COMP(t, buf) do { f32x16 p0, p1; \
        tile_qk<4>((buf) + AT_KB + koff, qf, zero16, p0, p1); \
        tile_emask(p0, p1, ((qpos - 31 - 1024 * (t)) >> 4) - 4 * h, -1000); \
        const float tm = tile_rowmax(p0, p1), mn = fmaxf(m, tm), alpha = __builtin_amdgcn_exp2f(m - mn); \
        float sum = 0.f; \
        _Pragma("unroll") for (int r = 0; r < 16; ++r) sum += __builtin_amdgcn_exp2f(p0[r] - mn) + __builtin_amdgcn_exp2f(p1[r] - mn); \
        l = l * alpha + sum; m = mn; } while (0)
    KV_STREAM(ncmp, CMP_LOAD, CMP1_COMP);
    l = xhalf_sum(l);
    const float invl = (l > 0.f) ? 1.f / l : 0.f;
    o[0] = (f32x16){0.f}; o[1] = (f32x16){0.f};
#define CMP2_COMP(t, buf) do { f32x16 p0, p1; \
        VFrags V; vfrag_load(V, (buf) + AT_VB + voff); \
        tile_qk<4>((buf) + AT_KB + koff, qf, zero16, p0, p1); \
        tile_emask(p0, p1, ((qpos - 31 - 1024 * (t)) >> 4) - 4 * h, -1000); \
        _Pragma("unroll") for (int r = 0; r < 16; ++r) { p0[r] = __builtin_amdgcn_exp2f(p0[r] - m) * invl; p1[r] = __builtin_amdgcn_exp2f(p1[r] - m) * invl; } \
        if (cur >= 16) { \
            _Pragma("unroll") for (int kb = 0; kb < 2; ++kb) \
            _Pragma("unroll") for (int c = 0; c < 4; ++c) { \
                const f32x16& p = kb ? p1 : p0; \
                float C = (p[4 * c] + p[4 * c + 1]) + (p[4 * c + 2] + 0.5f * p[4 * c + 3]), D = 0.5f * p[4 * c + 3]; \
                C += __shfl_xor(C, 1); C += __shfl_xor(C, 2); D += __shfl_xor(D, 1); D += __shfl_xor(D, 2); \
                const int jb = 16 * (t) + 8 * kb + 2 * c + h; \
                if (hh == 0) { impw[qi * 136 + jb] = C; impw[qi * 136 + 68 + jb + 1] = D; } } } \
        tile_pv(p0, p1, V, o); } while (0)
    KV_STREAM(ncmp, CMP_LOAD, CMP2_COMP);
#undef CMP_LOAD
#undef CMP1_COMP
#undef CMP2_COMP
#pragma unroll
    for (int r = 0; r < 16; ++r) { acc[0][r] = g0 * o[0][r]; acc[1][r] = g0 * o[1][r]; }

    if (cur >= 16) {
        const int tq = lane >> 3, e = lane & 7;
        float v[8];
#pragma unroll
        for (int i = 0; i < 8; ++i) { const int jb = e + 8 * i; const float s = impw[tq * 136 + jb] + impw[tq * 136 + 68 + jb];
            v[i] = (jb >= 1 && jb <= cur - 2) ? s : -1.f; }
        unsigned selb = 0u;
        for (int it = 0; it < 13; ++it) {
            float lm = v[0];
#pragma unroll
            for (int i = 1; i < 8; ++i) lm = fmaxf(lm, v[i]);
            float gm = fmaxf(lm, __shfl_xor(lm, 1)); gm = fmaxf(gm, __shfl_xor(gm, 2)); gm = fmaxf(gm, __shfl_xor(gm, 4));
            int cj = 99;
#pragma unroll
            for (int i = 7; i >= 0; --i) cj = (v[i] == gm) ? (e + 8 * i) : cj;
            int gj = min(cj, __shfl_xor(cj, 1)); gj = min(gj, __shfl_xor(gj, 2)); gj = min(gj, __shfl_xor(gj, 4));
#pragma unroll
            for (int i = 0; i < 8; ++i) if (gj == e + 8 * i) { v[i] = -2.f; selb |= 1u << i; }
        }
        unsigned lo = 0u, hi = 0u;
#pragma unroll
        for (int i = 0; i < 4; ++i) { lo |= ((selb >> i) & 1u) << (e + 8 * i); hi |= ((selb >> (i + 4)) & 1u) << (e + 8 * i); }
        lo |= __shfl_xor(lo, 1); lo |= __shfl_xor(lo, 2); lo |= __shfl_xor(lo, 4);
        hi |= __shfl_xor(hi, 1); hi |= __shfl_xor(hi, 2); hi |= __shfl_xor(hi, 4);
        unsigned long long mk = ((unsigned long long)hi << 32) | lo;
        mk |= 1ull | (1ull << cur) | (1ull << (cur - 1));
        LAS unsigned long long* selw = (LAS unsigned long long*)(lds + AT_SEL + wid * 64);
        if (e == 0) selw[tq] = mk;
        selmask = selw[qi];
    }

    {
        const half_t* Ks = P.KS + (size_t)bg * SEQ * 64; const half_t* Vs = P.VS + (size_t)bg * SEQ * 64;
        SmState S; sm_reset(S); bool seen = false; o[0] = (f32x16){0.f}; o[1] = (f32x16){0.f};
#define SLC_LOAD(t, sub) tile_dma(Ks + (size_t)(t) * 4096, nullptr, Vs + (size_t)(t) * 4096, sub, false, wid, lane)
#define SLC_COMP(t, buf) do { const bool rowsel = (selmask >> (t)) & 1ull; \
            if (__any(rowsel)) { f32x16 p0, p1, ci; \
                _Pragma("unroll") for (int r = 0; r < 16; ++r) ci[r] = rowsel ? S.negm[r] : -INFINITY;     \
                tile_qk<4>((buf) + AT_KB + koff, qf, ci, p0, p1); \
                if ((t) == cur) tile_emask(p0, p1, qrel - 4 * h, -1000); \
                tile_softmax_pv(p0, p1, (buf) + AT_VB + voff, o, S, !seen); seen = seen || rowsel; } } while (0)
        KV_STREAM(cur + 1, SLC_LOAD, SLC_COMP);
#undef SLC_LOAD
#undef SLC_COMP
        const float sc = g1 / xhalf_sum(S.l);
#pragma unroll
        for (int r = 0; r < 16; ++r) { acc[0][r] += sc * o[0][r]; acc[1][r] += sc * o[1][r]; }
    }
    {
        const int t0 = (cur >= 8) ? cur - 8 : 0;
        const half_t* Kw = P.KW + ((size_t)bg * SEQ + (size_t)t0 * 64) * 64; const half_t* Vw = P.VW + ((size_t)bg * SEQ + (size_t)t0 * 64) * 64;
        SmState S; sm_reset(S); o[0] = (f32x16){0.f}; o[1] = (f32x16){0.f};
#define WIN_LOAD(i, sub) tile_dma(Kw + (size_t)(i) * 4096, nullptr, Vw + (size_t)(i) * 4096, sub, false, wid, lane)
#define WIN_COMP(i, buf) do { const int t = t0 + (i); f32x16 p0, p1; \
            tile_qk<4>((buf) + AT_KB + koff, qf, S.negm, p0, p1); \
            if (t == cur) tile_emask(p0, p1, qrel - 4 * h, -1000); \
            else if (t == cur - 8) tile_emask(p0, p1, 1000, qrel + 1 - 4 * h); \
            tile_softmax_pv(p0, p1, (buf) + AT_VB + voff, o, S, (i) == 0); } while (0)
        KV_STREAM(cur - t0 + 1, WIN_LOAD, WIN_COMP);
#undef WIN_LOAD
#undef WIN_COMP
        const float sc = g2 / xhalf_sum(S.l);
#pragma unroll
        for (int r = 0; r < 16; ++r) { acc[0][r] += sc * o[0][r]; acc[1][r] += sc * o[1][r]; }
    }
    float ss = 0.f;
    half_t* yrow = P.Y + trow * DM + 512 + head * 64;
#pragma unroll
    for (int db = 0; db < 2; ++db)
#pragma unroll
        for (int c = 0; c < 4; ++c) { const float a0 = acc[db][4 * c], a1 = acc[db][4 * c + 1], a2 = acc[db][4 * c + 2], a3 = acc[db][4 * c + 3];
            ss += (a0 * a0 + a1 * a1) + (a2 * a2 + a3 * a3);
            *(u32x2*)(yrow + db * 32 + 8 * c + 4 * h) = (u32x2){pk_rne(a0, a1), pk_rne(a2, a3)}; }
    ss = xhalf_sum(ss);
    if (h == 0) P.SSN[trow * 8 + head] = ss;
}

struct Args { const float* in[24]; float* out; unsigned char* ws; int ph_lo, ph_hi, li, pad; };

template <bool GAIN, class SrcFn>
__device__ __forceinline__ void conv_wt(const float* W, int Ksrc, int Nsrc, const float* gain, const float* gain2, int ksplit, half_t* WT, int Ndst, int Kdst, SrcFn src, LAS float* scr, int gw, int ngw, int lane) {
    const int nblk = Ndst / 32, nitems = nblk * (Kdst / 64);
    for (int it = gw; it < nitems; it += ngw) {
        const int kb = it / nblk, nb = it % nblk, k0 = 64 * kb, n0 = 32 * nb;
        const int sc = src(n0 + (lane & 31)), scc = sc >= 0 ? sc : 0, c = lane & 7;
        float w[32];
#pragma unroll
        for (int i = 0; i < 32; ++i) { const int k = k0 + 2 * i + (lane >> 5), kc = k < Ksrc ? k : Ksrc - 1; w[i] = W[(size_t)kc * Nsrc + scc]; }
        f32x4 g0 = (f32x4){1.f, 1.f, 1.f, 1.f}, g1 = g0;
        if constexpr (GAIN) { int kq = k0 + 8 * c; kq = kq < Ksrc ? kq : Ksrc - 8; const float* gp = (k0 >= ksplit) ? gain2 + (kq - ksplit) : gain + kq; g0 = *(const f32x4*)gp; g1 = *(const f32x4*)(gp + 4); }
#pragma unroll
        for (int i = 0; i < 32; ++i) { const int kk = 2 * i + (lane >> 5); scr[kk * 33 + (lane & 31)] = (sc >= 0 && k0 + kk < Ksrc) ? w[i] : 0.f; }
        asm volatile("s_waitcnt lgkmcnt(0)" ::: "memory");
        const float gs[8] = {g0[0], g0[1], g0[2], g0[3], g1[0], g1[1], g1[2], g1[3]};
#pragma unroll
        for (int jj = 0; jj < 4; ++jj) { const int n = (lane >> 3) + 8 * jj; const LAS float* s = scr + (8 * c) * 33 + n; float v[8];
#pragma unroll
            for (int e = 0; e < 8; ++e) v[e] = s[e * 33] * gs[e];
            *(u32x4*)(WT + (size_t)(n0 + n) * Kdst + k0 + 8 * c) = pk8(v); }
        asm volatile("s_waitcnt lgkmcnt(0)" ::: "memory");
    }
}
__device__ __forceinline__ int src_win(int n) {
    const int t = n >> 8, c = n & 255;
    if (t == 0) return c;
    if (t == 1) { if (c < 128) return 256 + c;
                  if (c < 160) { const int p = c - 128; return 384 + (p >> 1) + 16 * (p & 1); }
                  if (c < 184) return 1696 + (c - 160);
                  return -1; }
    if (t < 4) { const int hd = (t - 2) * 4 + (c >> 6), p = c & 63; const int d = (p < 16) ? (p >> 1) + 8 * (p & 1) : p; return 416 + hd * 64 + d; }
    const int br = (t - 4) * 2 + (c >> 7), g = (c >> 6) & 1, p = c & 63;
    const bool roped = (br == 2 || br == 4);
    const int d = (roped && p < 16) ? (p >> 1) + 8 * (p & 1) : p;
    return 928 + br * 128 + g * 64 + d;
}
__device__ __forceinline__ int src_wuq(int n) { const int hd = n / 96, p = n % 96; return (p < 64) ? hd * 96 + p : hd * 96 + 64 + ((p - 64) >> 1) + 16 * ((p - 64) & 1); }
__device__ __forceinline__ int src_wukv(int n) { return (n < 512) ? (n >> 6) * 128 + (n & 63) : ((n - 512) >> 6) * 128 + 64 + (n & 63); }

#define PH_IDS() int tid_ = threadIdx.x; asm volatile("" : "+v"(tid_)); const int tid = tid_, lane = tid & 63, wid = __builtin_amdgcn_readfirstlane(tid >> 6); \
    const int G = gridDim.x, gt = blockIdx.x * 512 + tid, ngt = G * 512, gw = blockIdx.x * 8 + wid, ngw = G * 8; (void)lane; (void)gt; (void)ngt; (void)gw; (void)ngw; (void)G
#define WSP(T, off) ((T*)(ws + (off)))


__global__ void __launch_bounds__(512, 2) hymba_fwd(Args args) {
    extern __shared__ __attribute__((aligned(16))) unsigned char lds_raw[];
    LAS unsigned char* lds = (LAS unsigned char*)lds_raw;
    unsigned char* ws = args.ws;
    volatile LAS unsigned* MISC = (volatile LAS unsigned*)(lds + LDS_MISC);
    if (threadIdx.x < 16) MISC[threadIdx.x] = 0u;
    __syncthreads();
    XcdBarrier bar = xcd_barrier_post(WSP(unsigned, WS_CTL) + CW_BAR + args.li * XCD_BAR_WORDS, MISC + 8);
#if defined(DBG_STAMP)
#define STAMP_FIRST() STAMP(0)
#define STAMP(k) do { if (blockIdx.x == 0 && threadIdx.x == 0) ((unsigned long long*)(WSP(unsigned, WS_CTL) + 160))[k] = __builtin_amdgcn_s_memrealtime(); } while (0)
#else
#define STAMP_FIRST() do { } while (0)
#define STAMP(k) do { } while (0)
#endif
    const int lo = args.ph_lo, hi = args.ph_hi;
    STAMP_FIRST();
#define IN(k) (lo <= (k) && (k) < hi)
#define REP_BEGIN(k) for (int rep_ = 0; rep_ < ((k) == REPEAT_PHASE ? 2 : 1); ++rep_) {
#define REP_END(k) if ((k) == REPEAT_PHASE && rep_ == 0) xcd_barrier(bar); }
#define SEAM(k) do { if (IN(k) && IN((k) + 1 + ((k) == 4))) xcd_barrier(bar); STAMP((k) + 1); } while (0)

    if (IN(0)) { REP_BEGIN(0)
        PH_IDS();
        LAS float* scr = (LAS float*)(lds + wid * 8448);
        const int BIG = 1 << 30;
        for (int step_ = 0; step_ < 2; ++step_) {
        if (((step_ ^ wid) & 1) == 0) {
        conv_wt<true>(args.in[2], 1024, IN_COLS, args.in[1], nullptr, BIG, WSP(half_t, WS_WIN), NIN, 1024, [](int n) { return src_win(n); }, scr, (gw + ngw - 0 % ngw) % ngw, ngw, lane);
        conv_wt<true>(args.in[4], 256, 768, args.in[3], nullptr, BIG, WSP(half_t, WS_WUQ), 768, 256, [](int n) { return src_wuq(n); }, scr, (gw + ngw - 896 % ngw) % ngw, ngw, lane);
        conv_wt<true>(args.in[6], 128, 1024, args.in[5], nullptr, BIG, WSP(half_t, WS_WUKV), 1024, 256, [](int n) { return src_wukv(n); }, scr, (gw + ngw - 992 % ngw) % ngw, ngw, lane);
        conv_wt<false>(args.in[8], 2048, 128, nullptr, nullptr, BIG, WSP(half_t, WS_WC1), 256, 2048, [](int n) { return n < 128 ? n : -1; }, scr, (gw + ngw - 1120 % ngw) % ngw, ngw, lane);
        conv_wt<false>(args.in[13], 2048, 128, nullptr, nullptr, BIG, WSP(half_t, WS_WC1) + 256 * 2048, 256, 2048, [](int n) { return n < 128 ? n : -1; }, scr, (gw + ngw - 1376 % ngw) % ngw, ngw, lane);
        conv_wt<true>(args.in[19], 1024, 1024, args.in[17], args.in[18], 512, WSP(half_t, WS_WO), 1024, 1024, [](int n) { return n; }, scr, (gw + ngw - 1632 % ngw) % ngw, ngw, lane);
        conv_wt<true>(args.in[21], 1024, 4096, args.in[20], nullptr, BIG, WSP(half_t, WS_WUP), 4096, 1024, [](int n) { return n; }, scr, (gw + ngw - 2144 % ngw) % ngw, ngw, lane);
        conv_wt<false>(args.in[22], 4096, 1024, nullptr, nullptr, BIG, WSP(half_t, WS_WDN), 1024, 4096, [](int n) { return n; }, scr, (gw + ngw - 4192 % ngw) % ngw, ngw, lane);
        { float2* ROPEM = WSP(float2, WS_ROPEM); float2* ROPEN = WSP(float2, WS_ROPEN);
          for (int it = gt; it < SEQ * 16; it += ngt) { const int pos = it >> 4, i = it & 15; const float inv = expf(-logf(500000.f) * (float)(2 * i) / 32.f), a = (float)pos * inv; ROPEM[it] = make_float2(cosf(a), sinf(a)); }
          for (int it = gt; it < SEQ * 8; it += ngt) { const int pos = it >> 3, i = it & 7; const float inv = expf(-logf(500000.f) * (float)(2 * i) / 16.f), a = (float)pos * inv; ROPEN[it] = make_float2(cosf(a), sinf(a)); } }
        for (int o = (gw & 7) == 0 ? (gw >> 3) : 256; o < 256; o += (ngw >> 3)) { const int kv = o >> 7, jj = o & 127; const float* pe = args.in[kv ? 12 : 7]; const float* w1 = args.in[kv ? 13 : 8]; const float* b1 = args.in[kv ? 14 : 9];
            float s = 0.f; for (int k = lane; k < 2048; k += 64) s += pe[k] * w1[(size_t)k * 128 + jj];
            s = wave_sum(s); if (lane == 0) WSP(float, WS_B1P)[o] = b1[jj] + s; }
        } else
        { const float* x = args.in[0]; half_t* XH = WSP(half_t, WS_XH); float* RS1 = WSP(float, WS_RS1);
          for (int r0 = gw * 4; r0 < MROWS; r0 += ngw * 4) {
            f32x4 v[4][4]; float s[4];
#pragma unroll
            for (int rr = 0; rr < 4; ++rr) { const f32x4* xr = (const f32x4*)(x + (size_t)(r0 + rr) * DM) + lane;
#pragma unroll
                for (int jv = 0; jv < 4; ++jv) v[rr][jv] = xr[64 * jv]; }
#pragma unroll
            for (int rr = 0; rr < 4; ++rr) { float t = 0.f;
#pragma unroll
                for (int jv = 0; jv < 4; ++jv) t += (v[rr][jv][0] * v[rr][jv][0] + v[rr][jv][1] * v[rr][jv][1]) + (v[rr][jv][2] * v[rr][jv][2] + v[rr][jv][3] * v[rr][jv][3]);
                s[rr] = t; }
#pragma unroll
            for (int o = 1; o < 64; o <<= 1) {
#pragma unroll
                for (int rr = 0; rr < 4; ++rr) s[rr] += __shfl_xor(s[rr], o); }
#pragma unroll
            for (int rr = 0; rr < 4; ++rr) { u32x2* o8 = (u32x2*)(XH + (size_t)(r0 + rr) * DM) + lane;
#pragma unroll
                for (int jv = 0; jv < 4; ++jv) o8[64 * jv] = (u32x2){pk_rne(v[rr][jv][0], v[rr][jv][1]), pk_rne(v[rr][jv][2], v[rr][jv][3])};
                if (lane == 0) RS1[r0 + rr] = __builtin_amdgcn_rsqf(s[rr] * (1.f / DM) + NORM_EPS); }
          } }
        }
    REP_END(0) }
    SEAM(0);
    if (IN(1)) { REP_BEGIN(1)
        pg8::Gemm g{WSP(half_t, WS_XH), WSP(half_t, WS_WIN), 1024, 1024, 1024}; pg8::StaticOrder S; S.init(MROWS, NIN, gridDim.x, (int)blockIdx.x, 1024, 1024);
        EpiIn E{WSP(float, WS_RS1), WSP(half_t, WS_CQ), WSP(half_t, WS_T1), WSP(half_t, WS_KPE), WSP(float, WS_GATE), WSP(float, WS_SSQ), WSP(float, WS_SSKV), WSP(half_t, WS_QN), WSP(half_t, WS_KVT), WSP(float2, WS_ROPEM), WSP(float2, WS_ROPEN)};
        pg8::gemm_phase(lds, g, S, E);
    REP_END(1) }
    SEAM(1);
    if (IN(2)) { REP_BEGIN(2)
        { pg8::Gemm g{WSP(half_t, WS_CQ), WSP(half_t, WS_WUQ), 256, 256, 256}; pg8::StaticOrder S; S.init(MROWS, 768, gridDim.x, (int)blockIdx.x, 256, 256); EpiUq E{WSP(float, WS_SSQ), WSP(half_t, WS_QM), WSP(float2, WS_ROPEM)}; pg8::gemm_phase(lds, g, S, E); }
        { pg8::Gemm g{WSP(half_t, WS_T1), WSP(half_t, WS_WUKV), 256, 256, 256}; pg8::StaticOrder S; S.init(MROWS, 1024, gridDim.x, (int)blockIdx.x, 256, 256); EpiUkv E{WSP(float, WS_SSKV), WSP(half_t, WS_KNM), WSP(half_t, WS_VM)}; pg8::gemm_phase(lds, g, S, E); }
        { pg8::Gemm g{WSP(half_t, WS_KVT), WSP(half_t, WS_WC1), 512, 1024, 2048}; pg8::Cmp1Order S{(int)gridDim.x, (int)blockIdx.x}; EpiC1 E{WSP(float, WS_HIDP)}; pg8::gemm_phase(lds, g, S, E); }
    REP_END(2) }
    SEAM(2);
    if (IN(3)) { REP_BEGIN(3)
        PH_IDS();
        const float* B1P = WSP(float, WS_B1P); const float* HIDP = WSP(float, WS_HIDP); const float2* ROPEN = WSP(float2, WS_ROPEN);
        LAS float* w2s = (LAS float*)lds;
        LAS float* hl = (LAS float*)(lds + 65536 + wid * 4096);
        for (int i = tid; i < 2 * 128 * 64; i += 512) { const int kv = i >> 13, k = (i >> 6) & 127, p = i & 63; const int dsrc = (kv == 0 && p < 16) ? (p >> 1) + 8 * (p & 1) : p;
            w2s[i] = args.in[kv ? 15 : 10][k * 64 + dsrc]; }
        __syncthreads();
        for (int it = gw; it < 2 * 32 * 32; it += ngw) {
            const int kv = it >> 10, slab = (it >> 5) & 31, n0 = (it & 31) * 8;
            const float* b2 = args.in[kv ? 16 : 11];
            float hv[8][2][4];
#pragma unroll
            for (int rr = 0; rr < 8; ++rr)
#pragma unroll
                for (int c = 0; c < 2; ++c)
#pragma unroll
                    for (int ch = 0; ch < 4; ++ch) hv[rr][c][ch] = HIDP[((size_t)((kv * 32 + slab) * 4 + ch) * 256 + n0 + rr) * 128 + lane + 64 * c];
#pragma unroll
            for (int rr = 0; rr < 8; ++rr)
#pragma unroll
                for (int c = 0; c < 2; ++c) { const int col = lane + 64 * c; const float s = B1P[kv * 128 + col] + ((hv[rr][c][0] + hv[rr][c][1]) + (hv[rr][c][2] + hv[rr][c][3]));
                    const float z = 0.7978845608028654f * (s + 0.044715f * s * s * s), th = 1.f - 2.f / (1.f + __expf(2.f * z));
                    hl[rr * 128 + col] = 0.5f * s * (1.f + th); }
            asm volatile("s_waitcnt lgkmcnt(0)" ::: "memory");
            const int dsrc = (kv == 0 && lane < 16) ? (lane >> 1) + 8 * (lane & 1) : lane;
            float a[8];
#pragma unroll
            for (int rr = 0; rr < 8; ++rr) a[rr] = b2[dsrc];
            const LAS float* wk = w2s + kv * 8192 + lane;
#pragma unroll 4
            for (int k = 0; k < 128; k += 4) {
                const float w0 = wk[k * 64], w1 = wk[(k + 1) * 64], w2v = wk[(k + 2) * 64], w3 = wk[(k + 3) * 64];
#pragma unroll
                for (int rr = 0; rr < 8; ++rr) { const f32x4 hh = *(const LAS f32x4*)(hl + rr * 128 + k); a[rr] += (hh[0] * w0 + hh[1] * w1) + (hh[2] * w2v + hh[3] * w3); }
            }
            half_t* dst = (kv ? WSP(half_t, WS_VC) : WSP(half_t, WS_KC)) + (size_t)slab * 256 * 64;
#pragma unroll
            for (int rr = 0; rr < 8; ++rr) { const int n = n0 + rr; float v = a[rr];
                if (kv == 0) { const float pp = __shfl_xor(v, 1);
                    if (lane < 16) { const int e1 = 16 * n + 31; const float2 cs = ROPEN[(size_t)(e1 > 4095 ? 4095 : e1) * 8 + (lane >> 1)];
                        v = (lane & 1) ? (v * cs.x + pp * cs.y) : (v * cs.x - pp * cs.y); } }
                if (n >= 255) v = 0.f;
                dst[kv ? v_off(n, lane) : k_off(n, lane)] = (half_t)v; }
            asm volatile("s_waitcnt lgkmcnt(0)" ::: "memory");
        }
    REP_END(3) }
    SEAM(3);
    if (IN(4)) {
        half_t* KVT = WSP(half_t, WS_KVT);
        const AttnPtrs P{WSP(half_t, WS_QM), WSP(half_t, WS_KNM), WSP(half_t, WS_KPE), WSP(half_t, WS_VM), WSP(half_t, WS_QN), WSP(half_t, WS_KC), WSP(half_t, WS_VC),
                         KVT + 2 * KVT_STRIDE, KVT + 3 * KVT_STRIDE, KVT + 4 * KVT_STRIDE, KVT + 5 * KVT_STRIDE, WSP(float, WS_GATE), WSP(half_t, WS_Y), WSP(float, WS_SSM), WSP(float, WS_SSN)};
        volatile LAS int* qw = (volatile LAS int*)(lds + AT_QIDX);
        REP_BEGIN(4)
        unsigned* qhead = WSP(unsigned, WS_CTL) + CW_QHEAD + 64 * rep_;
        for (;;) {
            if (threadIdx.x == 0) *qw = (int)__hip_atomic_fetch_add(qhead, 1u, __ATOMIC_RELAXED, __HIP_MEMORY_SCOPE_AGENT);
            __syncthreads();
            const int qi = __builtin_amdgcn_readfirstlane(*qw);
            __syncthreads();
            if (qi >= 4096) break;
            const int L = qi >> 8, r = qi & 255;
#ifdef REP_FILTER
            if (rep_ == 1 && ((REP_FILTER == 1) != (r < 128))) continue;
#endif
            if (r < 128) { if (rep_ == 1) mla_unit<ABL>(P, r, 15 - L, lds, true); else mla_unit<0>(P, r, 15 - L, lds); }
            else { const int r2 = r - 128; nsa_unit(P, r2 & 31, 63 - 4 * L - (r2 >> 5), lds); }
        }
        REP_END(4)
    }
    SEAM(4);
    if (IN(6)) { REP_BEGIN(6) pg8::Gemm g{WSP(half_t, WS_Y), WSP(half_t, WS_WO), 1024, 1024, 1024}; pg8::StaticOrder S; S.init(MROWS, 1024, gridDim.x, (int)blockIdx.x, 1024, 1024); EpiWo E{WSP(half_t, WS_XH), WSP(half_t, WS_H1), WSP(float, WS_SS2), WSP(float, WS_SSM), WSP(float, WS_SSN), (LAS float*)(lds + LDS_RED)}; pg8::gemm_phase<EpiWo, pg8::StaticOrder, true>(lds, g, S, E); REP_END(6) }
    SEAM(6);
    if (IN(7)) { REP_BEGIN(7) pg8::Gemm g{WSP(half_t, WS_H1), WSP(half_t, WS_WUP), 1024, 1024, 1024}; pg8::StaticOrder S; S.init(MROWS, DFF, gridDim.x, (int)blockIdx.x, 1024, 1024); EpiUp E{WSP(float, WS_SS2), WSP(half_t, WS_A2)}; pg8::gemm_phase(lds, g, S, E); REP_END(7) }
    SEAM(7);
    if (IN(8)) { REP_BEGIN(8) pg8::Gemm g{WSP(half_t, WS_A2), WSP(half_t, WS_WDN), 4096, 4096, 4096}; pg8::StaticOrder S; S.init(MROWS, 1024, gridDim.x, (int)blockIdx.x, 4096, 4096); EpiDn E{WSP(half_t, WS_H1), WSP(half_t, WS_H2), WSP(float, WS_SS3), (LAS float*)(lds + LDS_RED)}; pg8::gemm_phase(lds, g, S, E); REP_END(8) }
    SEAM(8);
    if (IN(9)) { REP_BEGIN(9)
        PH_IDS();
        const float* gf = args.in[23]; const float* SS3 = WSP(float, WS_SS3); const half_t* H2 = WSP(half_t, WS_H2);
        const f32x4 ga0 = *(const f32x4*)(gf + lane * 8), gb0 = *(const f32x4*)(gf + lane * 8 + 4), ga1 = *(const f32x4*)(gf + 512 + lane * 8), gb1 = *(const f32x4*)(gf + 512 + lane * 8 + 4);
        for (int r0 = gw * 4; r0 < MROWS; r0 += ngw * 4) {
            u32x4 hv[4][2]; float rs[4];
#pragma unroll
            for (int rr = 0; rr < 4; ++rr) { const u32x4* hr = (const u32x4*)(H2 + (size_t)(r0 + rr) * DM) + lane; hv[rr][0] = hr[0]; hv[rr][1] = hr[64]; rs[rr] = __builtin_amdgcn_rsqf(sum4(*(const f32x4*)(SS3 + (size_t)(r0 + rr) * 4)) * (1.f / 1024.f) + NORM_EPS); }
#pragma unroll
            for (int rr = 0; rr < 4; ++rr) { f32x4* orow = (f32x4*)(args.out + (size_t)(r0 + rr) * DM); float v[8];
                unpk8(hv[rr][0], v);
                orow[lane * 2] = (f32x4){v[0] * rs[rr] * ga0[0], v[1] * rs[rr] * ga0[1], v[2] * rs[rr] * ga0[2], v[3] * rs[rr] * ga0[3]};
                orow[lane * 2 + 1] = (f32x4){v[4] * rs[rr] * gb0[0], v[5] * rs[rr] * gb0[1], v[6] * rs[rr] * gb0[2], v[7] * rs[rr] * gb0[3]};
                unpk8(hv[rr][1], v);
                orow[128 + lane * 2] = (f32x4){v[0] * rs[rr] * ga1[0], v[1] * rs[rr] * ga1[1], v[2] * rs[rr] * ga1[2], v[3] * rs[rr] * ga1[3]};
                orow[128 + lane * 2 + 1] = (f32x4){v[4] * rs[rr] * gb1[0], v[5] * rs[rr] * gb1[1], v[6] * rs[rr] * gb1[2], v[7] * rs[rr] * gb1[3]}; }
        }
    REP_END(9) }
    STAMP(10);
#undef IN
#undef SEAM
}

#if DBG_CHECK
constexpr int CW_DBG = 96;
__device__ __forceinline__ void dbg_flag(unsigned* ctl, int id, float got, float ref) {
    const float d = fabsf(got - ref);
    if (!(d <= 0.03f + 0.03f * fabsf(ref))) atomicOr(ctl + CW_DBG, 1u << id);
}
__device__ __forceinline__ float h2f(const half_t* p) { return (float)(*p); }
__device__ float dbg_rope_cs(int pos, int i, int dim, bool want_sin) { const float inv = expf(-logf(500000.f) * (float)(2 * i) / (float)dim), a = (float)pos * inv; return want_sin ? sinf(a) : cosf(a); }
__device__ float dbg_u(const Args& args, int row, int co, int lane) {
    const float* x = args.in[0] + (size_t)row * DM; const float* g = args.in[1]; const float* w = args.in[2];
    float ss = 0.f, acc = 0.f;
    for (int k = lane; k < DM; k += 64) { const float xv = x[k]; ss += xv * xv; acc += xv * g[k] * w[(size_t)k * IN_COLS + co]; }
    ss = wave_sum(ss); acc = wave_sum(acc);
    return acc * (1.f / sqrtf(ss / DM + NORM_EPS));
}
__device__ const int dbgt_0_dbg_rows[4] = {0, 4096 + 6, 30000, 65535};
__device__ const int dbgt_1_cs[3] = {0, 77, 255};
__device__ const int dbgt_2_cs[2] = {5, 127};
__device__ const int dbgt_3_ps[4] = {0, 1, 14, 31};
__device__ const int dbgt_4_is[3] = {0, 13, 23};
__device__ const int dbgt_5_hs[4] = {0, 3, 5, 7};
__device__ const int dbgt_6_ps[4] = {0, 1, 14, 40};
__device__ const int dbgt_7_brs[7] = {0, 1, 2, 2, 3, 4, 5};
__device__ const int dbgt_8_gs[7] = {0, 1, 0, 1, 0, 1, 1};
__device__ const int dbgt_9_ps[7] = {3, 20, 1, 50, 9, 14, 63};
__device__ const int dbgt_10_hs[4] = {0, 2, 5, 7};
__device__ const int dbgt_11_ps[4] = {3, 64, 77, 95};
__device__ const int dbgt_12_slabs[3] = {0, 17, 31};
__device__ const int dbgt_13_ns[3] = {0, 100, 254};
__device__ const int dbgt_14_ps[4] = {0, 1, 15, 40};
__device__ const int dbgt_15_bs[5] = {0, 0, 5, 15, 9};
__device__ const int dbgt_16_hs[5] = {0, 3, 7, 2, 5};
__device__ const int dbgt_17_qs[5] = {0, 100, 2047, 4095, 1234};
__device__ const int dbgt_18_bs[6] = {0, 3, 7, 15, 11, 2};
__device__ const int dbgt_19_gs[6] = {0, 1, 0, 1, 1, 0};
__device__ const int dbgt_20_hhs[6] = {0, 2, 3, 1, 0, 2};
__device__ const int dbgt_21_qs[6] = {5, 700, 1030, 4095, 2500, 3071};
__device__ const int dbgt_22_dd[3] = {0, 33, 63};
__device__ const int dbgt_23_c4[4] = {0, 1300, 2777, 4095};
__device__ const int dbgt_24_cols[4] = {0, 300, 777, 1023};
__device__ const int dbgt_25_cc[6] = {768, 896, 800, 776, 775, 1023};
__global__ void __launch_bounds__(512) dbg_checks_a(Args args) {
    extern __shared__ __attribute__((aligned(16))) unsigned char lds_raw[]; LAS unsigned char* lds = (LAS unsigned char*)lds_raw;
    unsigned char* ws = args.ws; unsigned* ctl = WSP(unsigned, WS_CTL);
    const int lane = threadIdx.x & 63, wid = threadIdx.x >> 6;
    const int* rows = dbgt_0_dbg_rows;
    const half_t* XH = WSP(half_t, WS_XH);
    if (blockIdx.x == 0) {
        if (wid == 0) for (int s = 0; s < 4; ++s) { const int r = rows[s]; const float* x = args.in[0] + (size_t)r * DM; float ss = 0.f; for (int k = lane; k < DM; k += 64) ss += x[k] * x[k]; ss = wave_sum(ss);
            if (lane == 0) { dbg_flag(ctl, 1, WSP(float, WS_RS1)[r], 1.f / sqrtf(ss / DM + NORM_EPS)); dbg_flag(ctl, 1, h2f(XH + (size_t)r * DM + 517), x[517]); } }
        if (wid == 1) for (int s = 0; s < 4; ++s) { const int r = rows[s], pos = r & 4095, b = r >> 12;
            { const int* cs = dbgt_1_cs; for (int i = 0; i < 3; ++i) { const float u = dbg_u(args, r, cs[i], lane); if (lane == 0) dbg_flag(ctl, 2, h2f(WSP(half_t, WS_CQ) + (size_t)r * 256 + cs[i]), u); } }
            { const int* cs = dbgt_2_cs; for (int i = 0; i < 2; ++i) { const float u = dbg_u(args, r, 256 + cs[i], lane); if (lane == 0) dbg_flag(ctl, 3, h2f(WSP(half_t, WS_T1) + (size_t)r * 256 + cs[i]), u); } }
            { const int* ps = dbgt_3_ps; for (int i = 0; i < 4; ++i) { const int p = ps[i], pr = p >> 1; const float x1 = dbg_u(args, r, 384 + pr, lane), x2 = dbg_u(args, r, 384 + pr + 16, lane);
                const float c = dbg_rope_cs(pos, pr, 32, false), sn = dbg_rope_cs(pos, pr, 32, true); const float ref = (p & 1) ? (x2 * c + x1 * sn) : (x1 * c - x2 * sn);
                if (lane == 0) dbg_flag(ctl, 4, h2f(WSP(half_t, WS_KPE) + (size_t)b * SEQ * 32 + kpe_off(pos, p)), ref); } }
            { const int* is = dbgt_4_is; for (int i = 0; i < 3; ++i) { const float u = dbg_u(args, r, 1696 + is[i], lane); if (lane == 0) dbg_flag(ctl, 5, WSP(float, WS_GATE)[(size_t)r * 24 + is[i]], 1.f / (1.f + expf(-u))); } }
            { const int* hs = dbgt_5_hs; const int* ps = dbgt_6_ps; for (int i = 0; i < 4; ++i) { const int hd = hs[i], p = ps[i]; float ref;
                if (p < 16) { const int pr = p >> 1; const float x1 = dbg_u(args, r, 416 + hd * 64 + pr, lane), x2 = dbg_u(args, r, 416 + hd * 64 + pr + 8, lane);
                    const float c = dbg_rope_cs(pos, pr, 16, false), sn = dbg_rope_cs(pos, pr, 16, true); ref = (p & 1) ? (x2 * c + x1 * sn) : (x1 * c - x2 * sn); }
                else ref = dbg_u(args, r, 416 + hd * 64 + p, lane);
                if (lane == 0) dbg_flag(ctl, 6, h2f(WSP(half_t, WS_QN) + (size_t)r * 512 + hd * 64 + p), ref * QS_N); } }
            { const int* brs = dbgt_7_brs; const int* gs = dbgt_8_gs; const int* ps = dbgt_9_ps;
              for (int i = 0; i < 7; ++i) { const int br = brs[i], g = gs[i], p = ps[i]; const int base = 928 + br * 128 + g * 64; float ref;
                if ((br == 2 || br == 4) && p < 16) { const int pr = p >> 1; const float x1 = dbg_u(args, r, base + pr, lane), x2 = dbg_u(args, r, base + pr + 8, lane);
                    const float c = dbg_rope_cs(pos, pr, 16, false), sn = dbg_rope_cs(pos, pr, 16, true); ref = (p & 1) ? (x2 * c + x1 * sn) : (x1 * c - x2 * sn); }
                else ref = dbg_u(args, r, base + p, lane);
                if (lane == 0) dbg_flag(ctl, 7, h2f(WSP(half_t, WS_KVT) + (size_t)br * KVT_STRIDE + (size_t)(b * 2 + g) * SEQ * 64 + (br < 2 ? (size_t)pos * 64 + p : ((br & 1) ? v_off(pos, p) : k_off(pos, p)))), ref); } }
        }
        if (wid == 2) for (int s = 0; s < 4; ++s) { const int r = rows[s], pos = r & 4095, b = r >> 12;
            const half_t* cq = WSP(half_t, WS_CQ) + (size_t)r * 256; const half_t* t1 = WSP(half_t, WS_T1) + (size_t)r * 256;
            float sq = 0.f, skv = 0.f; for (int k = lane; k < 256; k += 64) { const float a = h2f(cq + k); sq += a * a; } for (int k = lane; k < 128; k += 64) { const float a = h2f(t1 + k); skv += a * a; }
            sq = wave_sum(sq); skv = wave_sum(skv); const float rq = 1.f / sqrtf(sq / 256.f + NORM_EPS), rkv = 1.f / sqrtf(skv / 128.f + NORM_EPS);
            const int* hs = dbgt_10_hs; const int* ps = dbgt_11_ps;
            for (int i = 0; i < 4; ++i) { const int hd = hs[i], p = ps[i]; float ref;
                auto qcol = [&](int col) { float a = 0.f; for (int k = lane; k < 256; k += 64) a += h2f(cq + k) * args.in[3][k] * args.in[4][(size_t)k * 768 + col]; return wave_sum(a) * rq; };
                if (p < 64) ref = qcol(hd * 96 + p);
                else { const int pp = p - 64, pr = pp >> 1; const float x1 = qcol(hd * 96 + 64 + pr), x2 = qcol(hd * 96 + 64 + pr + 16);
                    const float c = dbg_rope_cs(pos, pr, 32, false), sn = dbg_rope_cs(pos, pr, 32, true); ref = (pp & 1) ? (x2 * c + x1 * sn) : (x1 * c - x2 * sn); }
                if (lane == 0) dbg_flag(ctl, 8, h2f(WSP(half_t, WS_QM) + (size_t)r * 768 + hd * 96 + p), ref * QS_M); }
            for (int i = 0; i < 4; ++i) { const int hd = hs[i], d = ps[i] & 63;
                auto kvcol = [&](int col) { float a = 0.f; for (int k = lane; k < 128; k += 64) a += h2f(t1 + k) * args.in[5][k] * args.in[6][(size_t)k * 1024 + col]; return wave_sum(a) * rkv; };
                const float kr = kvcol(hd * 128 + d), vr = kvcol(hd * 128 + 64 + d);
                if (lane == 0) { dbg_flag(ctl, 9, h2f(WSP(half_t, WS_KNM) + (size_t)(b * 8 + hd) * SEQ * 64 + k_off(pos, d)), kr); dbg_flag(ctl, 10, h2f(WSP(half_t, WS_VM) + (size_t)(b * 8 + hd) * SEQ * 64 + v_off(pos, d)), vr); } }
        }
        if (wid == 3 || wid == 4) { const int kv = wid - 3; const int* slabs = dbgt_12_slabs; const int* ns = dbgt_13_ns;
            LAS float* hid = (LAS float*)(lds + 65536 + kv * 1024);
            const float* pe = args.in[kv ? 12 : 7]; const float* w1 = args.in[kv ? 13 : 8]; const float* b1 = args.in[kv ? 14 : 9]; const float* w2 = args.in[kv ? 15 : 10]; const float* b2 = args.in[kv ? 16 : 11];
            for (int s = 0; s < 3; ++s) { const int slab = slabs[s], n = ns[s]; const half_t* tok = WSP(half_t, WS_KVT) + (size_t)kv * KVT_STRIDE + ((size_t)slab * SEQ + 16 * n) * 64;
                for (int jj = 0; jj < 2; ++jj) { const int j = lane + 64 * jj; float a = b1[j]; for (int k = 0; k < 2048; ++k) a += (h2f(tok + k) + pe[k]) * w1[(size_t)k * 128 + j];
                    const float z = 0.7978845608028654f * (a + 0.044715f * a * a * a); hid[j] = 0.5f * a * (1.f + tanhf(z)); }
                asm volatile("s_waitcnt lgkmcnt(0)" ::: "memory");
                float o = b2[lane]; for (int j = 0; j < 128; ++j) o += hid[j] * w2[j * 64 + lane];
                const int* ps = dbgt_14_ps;
                for (int i = 0; i < 4; ++i) { const int p = ps[i]; float ref;
                    if (kv == 0 && p < 16) { const int pr = p >> 1; const float x1 = __shfl(o, pr), x2 = __shfl(o, pr + 8); const int pos = 16 * n + 31;
                        const float c = dbg_rope_cs(pos, pr, 16, false), sn = dbg_rope_cs(pos, pr, 16, true); ref = (p & 1) ? (x2 * c + x1 * sn) : (x1 * c - x2 * sn); }
                    else ref = __shfl(o, p);
                    if (lane == 0) dbg_flag(ctl, 11 + kv, h2f((kv ? WSP(half_t, WS_VC) : WSP(half_t, WS_KC)) + (size_t)slab * 256 * 64 + (kv ? v_off(n, p) : k_off(n, p))), ref); }
                asm volatile("s_waitcnt lgkmcnt(0)" ::: "memory"); }
        }
        if (wid == 5) { const int* bs = dbgt_15_bs; const int* hs = dbgt_16_hs; const int* qs = dbgt_17_qs;
            for (int s = 0; s < 5; ++s) { const int b = bs[s], hd = hs[s], q = qs[s]; const size_t r = (size_t)b * SEQ + q;
                const half_t* qv = WSP(half_t, WS_QM) + r * 768 + hd * 96; const half_t* Kn = WSP(half_t, WS_KNM) + (size_t)(b * 8 + hd) * SEQ * 64; const half_t* Kp = WSP(half_t, WS_KPE) + (size_t)b * SEQ * 32; const half_t* V = WSP(half_t, WS_VM) + (size_t)(b * 8 + hd) * SEQ * 64;
                float mx = -1e30f;
                for (int k = lane; k <= q; k += 64) { float sc = 0.f; for (int d = 0; d < 64; ++d) sc += h2f(qv + d) * h2f(Kn + k_off(k, d)); for (int d = 0; d < 32; ++d) sc += h2f(qv + 64 + d) * h2f(Kp + kpe_off(k, d)); mx = fmaxf(mx, sc); }
                for (int o = 1; o < 64; o <<= 1) mx = fmaxf(mx, __shfl_xor(mx, o));
                float l = 0.f, o0 = 0.f, o1 = 0.f, o2 = 0.f;
                for (int k = lane; k <= q; k += 64) { float sc = 0.f; for (int d = 0; d < 64; ++d) sc += h2f(qv + d) * h2f(Kn + k_off(k, d)); for (int d = 0; d < 32; ++d) sc += h2f(qv + 64 + d) * h2f(Kp + kpe_off(k, d));
                    const float p = exp2f(sc - mx); l += p; o0 += p * h2f(V + v_off(k, 0)); o1 += p * h2f(V + v_off(k, 33)); o2 += p * h2f(V + v_off(k, 63)); }
                l = wave_sum(l); o0 = wave_sum(o0); o1 = wave_sum(o1); o2 = wave_sum(o2);
                if (lane == 0) { const half_t* y = WSP(half_t, WS_Y) + r * DM + hd * 64; dbg_flag(ctl, 13, h2f(y + 0), o0 / l); dbg_flag(ctl, 13, h2f(y + 33), o1 / l); dbg_flag(ctl, 13, h2f(y + 63), o2 / l); } }
        }
        if (wid == 6 || wid == 7) { const int* bs = dbgt_18_bs; const int* gs = dbgt_19_gs; const int* hhs = dbgt_20_hhs; const int* qs = dbgt_21_qs;
            LAS float* pc = (LAS float*)(lds + 70000 + (wid - 6) * 8192);
            for (int s = wid - 6; s < 6; s += 2) { const int b = bs[s], g = gs[s], hh = hhs[s], q = qs[s], cur = q >> 6; const size_t r = (size_t)b * SEQ + q; const int bg = b * 2 + g;
                const half_t* Kc = WSP(half_t, WS_KC) + (size_t)bg * 256 * 64; const half_t* Vc = WSP(half_t, WS_VC) + (size_t)bg * 256 * 64;
                for (int h4 = 0; h4 < 4; ++h4) { const half_t* qv = WSP(half_t, WS_QN) + r * 512 + (g * 4 + h4) * 64;
                    float sc[4]; float mx = -1e30f;
                    for (int i = 0; i < 4; ++i) { const int n = lane + 64 * i; float a = -INFINITY; if (n < 255 && 16 * n + 31 <= q) { a = 0.f; for (int d = 0; d < 64; ++d) a += h2f(qv + d) * h2f(Kc + k_off(n, d)); } sc[i] = a; mx = fmaxf(mx, a); }
                    for (int o = 1; o < 64; o <<= 1) mx = fmaxf(mx, __shfl_xor(mx, o));
                    float l = 0.f; for (int i = 0; i < 4; ++i) { sc[i] = exp2f(sc[i] - mx); l += sc[i]; } l = wave_sum(l);
                    for (int i = 0; i < 4; ++i) pc[h4 * 256 + lane + 64 * i] = (l > 0.f) ? sc[i] / l : 0.f; }
                asm volatile("s_waitcnt lgkmcnt(0)" ::: "memory");
                { float imp = 0.f; const int jb = lane;
                  for (int n = 0; n < 255; ++n) { const int cs = 16 * n, ss0 = 64 * jb; const int lo2 = cs > ss0 ? cs : ss0, hi2 = (cs + 32 < ss0 + 64) ? cs + 32 : ss0 + 64; const int ov = hi2 - lo2; if (ov > 0) { const float w = (float)ov / 32.f; for (int h4 = 0; h4 < 4; ++h4) imp += pc[h4 * 256 + n] * w; } }
                  const bool forced = (jb == 0) || (jb == cur) || (jb == cur - 1), causal = jb * 64 <= q;
                  pc[1024 + jb] = forced ? 1e9f : (causal ? imp : -1e9f); }
                asm volatile("s_waitcnt lgkmcnt(0)" ::: "memory");
                if (lane == 0) { for (int jb = 0; jb < 64; ++jb) pc[1088 + jb] = 0.f; for (int it = 0; it < 16; ++it) { int best = -1; float bv = -INFINITY; for (int jb = 0; jb < 64; ++jb) if (pc[1088 + jb] == 0.f && pc[1024 + jb] > bv) { bv = pc[1024 + jb]; best = jb; } pc[1088 + best] = 1.f; } }
                asm volatile("s_waitcnt lgkmcnt(0)" ::: "memory");
                const half_t* qv = WSP(half_t, WS_QN) + r * 512 + (g * 4 + hh) * 64; const int* dd = dbgt_22_dd;
                float oc[3] = {0.f, 0.f, 0.f};
                for (int i = 0; i < 4; ++i) { const int n = lane + 64 * i; if (n < 255) { const float p = pc[hh * 256 + n]; for (int e = 0; e < 3; ++e) oc[e] += p * h2f(Vc + v_off(n, dd[e])); } }
                for (int e = 0; e < 3; ++e) oc[e] = wave_sum(oc[e]);
                float osw[2][3];
                for (int br = 0; br < 2; ++br) { const half_t* Kx = WSP(half_t, WS_KVT) + (size_t)(2 + 2 * br) * KVT_STRIDE + (size_t)bg * SEQ * 64; const half_t* Vx = WSP(half_t, WS_KVT) + (size_t)(3 + 2 * br) * KVT_STRIDE + (size_t)bg * SEQ * 64;
                    float mx = -1e30f;
                    for (int k = lane; k <= q; k += 64) { const bool ok = br ? (q - k < 512) : (pc[1088 + (k >> 6)] != 0.f); if (!ok) continue; float a = 0.f; for (int d = 0; d < 64; ++d) a += h2f(qv + d) * h2f(Kx + k_off(k, d)); mx = fmaxf(mx, a); }
                    for (int o = 1; o < 64; o <<= 1) mx = fmaxf(mx, __shfl_xor(mx, o));
                    float l = 0.f, a3[3] = {0.f, 0.f, 0.f};
                    for (int k = lane; k <= q; k += 64) { const bool ok = br ? (q - k < 512) : (pc[1088 + (k >> 6)] != 0.f); if (!ok) continue; float a = 0.f; for (int d = 0; d < 64; ++d) a += h2f(qv + d) * h2f(Kx + k_off(k, d));
                        const float p = exp2f(a - mx); l += p; for (int e = 0; e < 3; ++e) a3[e] += p * h2f(Vx + v_off(k, dd[e])); }
                    l = wave_sum(l); for (int e = 0; e < 3; ++e) osw[br][e] = wave_sum(a3[e]) / l; }
                if (lane == 0) { const float* gt = WSP(float, WS_GATE) + r * 24; const int head = g * 4 + hh; const float g0 = gt[head], g1 = gt[8 + head], g2 = gt[16 + head];
                    for (int e = 0; e < 3; ++e) dbg_flag(ctl, q < 1024 ? 14 : 15, h2f(WSP(half_t, WS_Y) + r * DM + 512 + head * 64 + dd[e]), g0 * oc[e] + g1 * osw[0][e] + g2 * osw[1][e]); }
                asm volatile("s_waitcnt lgkmcnt(0)" ::: "memory"); }
        }
    }
}
__global__ void __launch_bounds__(512) dbg_checks_b(Args args, int which) {
    unsigned char* ws = args.ws; unsigned* ctl = WSP(unsigned, WS_CTL);
    const int lane = threadIdx.x & 63, wid = threadIdx.x >> 6;
    const int* rows = dbgt_0_dbg_rows; const int* cols = dbgt_24_cols;
    if (blockIdx.x != 0 || wid >= 4) return;
    const int r = rows[wid];
    if (which == 6 && wid == 3) { const half_t* y = WSP(half_t, WS_Y) + (size_t)r * DM; const int* cc = dbgt_25_cc;
        for (int i = 0; i < 6; ++i) { const int c = cc[i]; float a = 0.f; for (int k = lane; k < DM; k += 64) a += h2f(y + k) * (k < 512 ? args.in[17][k] : args.in[18][k - 512]) * args.in[19][(size_t)k * DM + c];
            const float dot = wave_sum(a), xr = args.in[0][(size_t)r * DM + c], got = h2f(WSP(half_t, WS_H1) + (size_t)r * DM + c);
            if (lane == 0 && !(fabsf(got - (dot + xr)) <= 0.03f + 0.03f * fabsf(dot + xr))) atomicAdd(ctl + CW_DBG + 2, 1u << i); } }
    if (which == 6) { const half_t* y = WSP(half_t, WS_Y) + (size_t)r * DM;
        { float s0 = 0.f, s1 = 0.f; for (int k = lane; k < 512; k += 64) { const float a = h2f(y + k), b = h2f(y + 512 + k); s0 += a * a; s1 += b * b; } s0 = wave_sum(s0); s1 = wave_sum(s1);
          if (lane == 0) { dbg_flag(ctl, 20, s0 / 512.f, 1.f); dbg_flag(ctl, 21, s1 / 512.f, 1.f); } }
        { const int c = cols[wid], k = rows[wid] & 1023; if (lane == 0) dbg_flag(ctl, 22, 100.f * h2f(WSP(half_t, WS_WO) + (size_t)c * DM + k), 100.f * args.in[19][(size_t)k * DM + c] * (k < 512 ? args.in[17][k] : args.in[18][k - 512])); }
        for (int i = 0; i < 4; ++i) { const int c = cols[i]; float a = 0.f; for (int k = lane; k < DM; k += 64) a += h2f(y + k) * (k < 512 ? args.in[17][k] : args.in[18][k - 512]) * args.in[19][(size_t)k * DM + c];
            const float dot = wave_sum(a), xr = args.in[0][(size_t)r * DM + c], got = h2f(WSP(half_t, WS_H1) + (size_t)r * DM + c); a = dot + xr;
            if (lane == 0) { dbg_flag(ctl, 16, got, a);
                if ((wid == 0 && i == 0) || (wid == 3 && i == 3)) { int hcode = 9; auto near = [](float p, float q) { return fabsf(p - q) <= 0.03f + 0.03f * fabsf(q); };
                    if (near(got, dot + xr)) hcode = 1; else if (near(got, dot)) hcode = 2; else if (near(got, xr)) hcode = 3; else if (near(got, 2.f * xr + dot)) hcode = 4; else if (!(got == got)) hcode = 5; else if (near(got, 0.f)) hcode = 6;
                    atomicAdd(ctl + CW_DBG + 1, (unsigned)(wid == 0 ? 10 * hcode : hcode)); } } } }
    if (which == 7) { const half_t* h1 = WSP(half_t, WS_H1) + (size_t)r * DM; float ss = 0.f; for (int k = lane; k < DM; k += 64) { const float a = h2f(h1 + k); ss += a * a; } ss = wave_sum(ss); const float rs = 1.f / sqrtf(ss / DM + NORM_EPS);
        const int* c4 = dbgt_23_c4;
        for (int i = 0; i < 4; ++i) { const int c = c4[i]; float a = 0.f; for (int k = lane; k < DM; k += 64) a += h2f(h1 + k) * args.in[20][k] * args.in[21][(size_t)k * DFF + c];
            a = fmaxf(wave_sum(a) * rs, 0.f); if (lane == 0) dbg_flag(ctl, 17, h2f(WSP(half_t, WS_A2) + (size_t)r * DFF + c), a * a); } }
    if (which == 8) { const half_t* a2 = WSP(half_t, WS_A2) + (size_t)r * DFF;
        for (int i = 0; i < 4; ++i) { const int c = cols[i]; float a = 0.f; for (int k = lane; k < DFF; k += 64) a += h2f(a2 + k) * args.in[22][(size_t)k * DM + c];
            a = wave_sum(a) + h2f(WSP(half_t, WS_H1) + (size_t)r * DM + c); if (lane == 0) dbg_flag(ctl, 18, h2f(WSP(half_t, WS_H2) + (size_t)r * DM + c), a); } }
    if (which == 9) { const half_t* h2 = WSP(half_t, WS_H2) + (size_t)r * DM; float ss = 0.f; for (int k = lane; k < DM; k += 64) { const float a = h2f(h2 + k); ss += a * a; } ss = wave_sum(ss); const float rs = 1.f / sqrtf(ss / DM + NORM_EPS);
        for (int i = 0; i < 4; ++i) { const int c = cols[i]; if (lane == 0) dbg_flag(ctl, 19, args.out[(size_t)r * DM + c], h2f(h2 + c) * rs * args.in[23][c]); } }
}
__global__ void __launch_bounds__(512) dbg_fill(Args args) {
    unsigned char* ws = args.ws; unsigned* ctl = WSP(unsigned, WS_CTL);
#ifndef DBG_SKIP
#define DBG_SKIP 0
#endif
    const unsigned m = __hip_atomic_load(ctl + CW_DBG, __ATOMIC_RELAXED, __HIP_MEMORY_SCOPE_AGENT) & ~((1u << DBG_SKIP) - 1u);
#ifdef DBG_STAMP
    const unsigned long long* ts = (const unsigned long long*)(ctl + 160); (void)m;
    const int code = (int)((ts[DBG_T1B] - ts[DBG_T1A]) / 4000ull);
    const float vbig = (float)((ts[DBG_T2B] - ts[DBG_T2A]) / 100ull);
    if (blockIdx.x == 0 && threadIdx.x == 0) { args.out[(size_t)MROWS * DM - 1] = vbig; }
#elif defined(DBG_VALUE)
    const int code = (int)__hip_atomic_load(ctl + CW_DBG + 2, __ATOMIC_RELAXED, __HIP_MEMORY_SCOPE_AGENT); (void)m;
#else
    const int code = m ? __builtin_ctz(m) : 0;
#endif
    const float a = sqrtf((float)code);
#ifdef DBG_STAMP
    const size_t nfill = (size_t)MROWS * DM / 4 - 1;
    if (blockIdx.x == 0 && threadIdx.x == 1) { args.out[(size_t)MROWS * DM - 4] = a; args.out[(size_t)MROWS * DM - 3] = a; args.out[(size_t)MROWS * DM - 2] = a; }
#else
    const size_t nfill = (size_t)MROWS * DM / 4;
#endif
    for (size_t i = (size_t)blockIdx.x * 512 + threadIdx.x; i < nfill; i += (size_t)gridDim.x * 512) ((f32x4*)args.out)[i] = (f32x4){a, a, a, a};
}
#endif

extern "C" void kernel_launch(void* const* d_in, const int* in_sizes, int n_in, void* d_out, int out_size, void* d_ws, size_t ws_size, hipStream_t stream) {
    static int grid = 0;
    if (grid == 0) {
        if (n_in != 24 || out_size != MROWS * DM || ws_size < WS_END) { fprintf(stderr, "kernel_launch: unexpected problem (n_in %d, out %d, ws %zu)\n", n_in, out_size, ws_size); grid = -1; return; }
        int dev = 0, cus = 0, per_cu = 0;
        if (hipGetDevice(&dev) != hipSuccess || hipDeviceGetAttribute(&cus, hipDeviceAttributeMultiprocessorCount, dev) != hipSuccess) { grid = -1; return; }
        if (hipFuncSetAttribute((const void*)hymba_fwd, hipFuncAttributeMaxDynamicSharedMemorySize, LDS_BYTES) != hipSuccess) { fprintf(stderr, "kernel_launch: hipFuncSetAttribute failed\n"); grid = -1; return; }
        if (hipOccupancyMaxActiveBlocksPerMultiprocessor(&per_cu, (const void*)hymba_fwd, 512, LDS_BYTES) != hipSuccess || per_cu < 1) fprintf(stderr, "kernel_launch: occupancy query says %d\n", per_cu);
        (void)hipGetLastError();
        grid = cus;
#if DBG_CHECK
        (void)hipFuncSetAttribute((const void*)dbg_checks_a, hipFuncAttributeMaxDynamicSharedMemorySize, 98304);
#endif
    }
    if (grid < 0) return;
    (void)hipMemsetAsync((char*)d_ws + WS_CTL, 0, CTL_ZERO_BYTES, stream);
    Args a{};
    for (int i = 0; i < 24; ++i) a.in[i] = (const float*)d_in[i];
    a.out = (float*)d_out; a.ws = (unsigned char*)d_ws;
#if DBG_CHECK == 1
    a.ph_lo = 0; a.ph_hi = 5; a.li = 0; hipLaunchKernelGGL(hymba_fwd, dim3(grid), dim3(512), LDS_BYTES, stream, a);
    hipLaunchKernelGGL(dbg_checks_a, dim3(1), dim3(512), 98304, stream, a);
    hipLaunchKernelGGL(dbg_fill, dim3(1024), dim3(512), 0, stream, a);
#elif DBG_CHECK == 2
    a.ph_lo = 0; a.ph_hi = 7; a.li = 0; hipLaunchKernelGGL(hymba_fwd, dim3(grid), dim3(512), LDS_BYTES, stream, a);
    hipLaunchKernelGGL(dbg_checks_b, dim3(1), dim3(512), 0, stream, a, 6);
    a.ph_lo = 7; a.ph_hi = 8; a.li = 1; hipLaunchKernelGGL(hymba_fwd, dim3(grid), dim3(512), LDS_BYTES, stream, a);
    hipLaunchKernelGGL(dbg_checks_b, dim3(1), dim3(512), 0, stream, a, 7);
    a.ph_lo = 8; a.ph_hi = 9; a.li = 2; hipLaunchKernelGGL(hymba_fwd, dim3(grid), dim3(512), LDS_BYTES, stream, a);
    hipLaunchKernelGGL(dbg_checks_b, dim3(1), dim3(512), 0, stream, a, 8);
    a.ph_lo = 9; a.ph_hi = 10; a.li = 3; hipLaunchKernelGGL(hymba_fwd, dim3(grid), dim3(512), LDS_BYTES, stream, a);
    hipLaunchKernelGGL(dbg_checks_b, dim3(1), dim3(512), 0, stream, a, 9);
    hipLaunchKernelGGL(dbg_fill, dim3(1024), dim3(512), 0, stream, a);
#elif DBG_CHECK == 3
    a.ph_lo = 0; a.ph_hi = 10; a.li = 0; hipLaunchKernelGGL(hymba_fwd, dim3(grid), dim3(512), LDS_BYTES, stream, a);
    hipLaunchKernelGGL(dbg_fill, dim3(1024), dim3(512), 0, stream, a);
#elif MK_N_LAUNCHES == 1
    a.ph_lo = 0; a.ph_hi = 10; a.li = 0;
    hipLaunchKernelGGL(hymba_fwd, dim3(grid), dim3(512), LDS_BYTES, stream, a);
#else
    for (int p = 0; p < 10; ++p) { a.ph_lo = p; a.ph_hi = p + 1; a.li = p; hipLaunchKernelGGL(hymba_fwd, dim3(grid), dim3(512), LDS_BYTES, stream, a); }
#endif
}
```

```cpp
#include <hip/hip_runtime.h>
#include <cstdio>
#include <cstdint>

#ifndef DBG_CHECK
#define DBG_CHECK 0
#endif
#ifndef REPEAT_PHASE
#define REPEAT_PHASE -1
#endif
#ifndef ABL
#define ABL 0
#endif
#ifndef MK_N_LAUNCHES
#define MK_N_LAUNCHES 1
#endif

#define LAS __attribute__((address_space(3)))
typedef _Float16 half_t;
typedef _Float16 half8 __attribute__((ext_vector_type(8)));
typedef _Float16 half2v __attribute__((ext_vector_type(2)));
typedef float f32x4 __attribute__((ext_vector_type(4)));
typedef float f32x16 __attribute__((ext_vector_type(16)));
typedef unsigned u32x4 __attribute__((ext_vector_type(4)));
typedef unsigned u32x2 __attribute__((ext_vector_type(2)));
typedef short v4i16 __attribute__((ext_vector_type(4)));

constexpr int BATCH = 16, SEQ = 4096, DM = 1024, MROWS = BATCH * SEQ;
constexpr int IN_COLS = 1720, NIN = 1792;
constexpr int DFF = 4096;
constexpr float NORM_EPS = 1e-6f;
constexpr float LOG2E = 1.4426950408889634f;
constexpr float QS_N = 0.125f * LOG2E;
constexpr float QS_M = 0.10206207261596577f * LOG2E;

constexpr size_t MiB = 1u << 20;
constexpr size_t WS_CTL = 0, CTL_ZERO_BYTES = 1 * MiB;
constexpr size_t WS_WIN = 1 * MiB, WS_WUQ = 5 * MiB, WS_WUKV = 6 * MiB, WS_WC1 = 7 * MiB, WS_WO = 9 * MiB, WS_WUP = 11 * MiB, WS_WDN = 19 * MiB;
constexpr size_t WS_ROPEM = 27 * MiB, WS_ROPEN = 27 * MiB + 512 * 1024, WS_B1P = 27 * MiB + 768 * 1024;
constexpr size_t WS_KC = 28 * MiB, WS_VC = 29 * MiB;
constexpr size_t WS_RS1 = 32 * MiB, WS_SSQ = 33 * MiB, WS_SSKV = 34 * MiB, WS_SSM = 35 * MiB, WS_SSN = 37 * MiB, WS_SS2 = 39 * MiB, WS_SS3 = 43 * MiB;
constexpr size_t WS_GATE = 47 * MiB, WS_KPE = 53 * MiB;
constexpr size_t WS_CQ = 64 * MiB, WS_T1 = 96 * MiB, WS_QN = 128 * MiB, WS_KVT = 192 * MiB  ;
constexpr size_t WS_QM = 288 * MiB, WS_KNM = 384 * MiB, WS_VM = 448 * MiB, WS_HIDP = 512 * MiB;
constexpr size_t WS_A2 = 64 * MiB;
constexpr size_t WS_XH = 576 * MiB, WS_H2 = 576 * MiB, WS_Y = 704 * MiB, WS_H1 = 832 * MiB, WS_END = 960 * MiB;
constexpr size_t KVT_STRIDE = 16 * MiB / 2;

constexpr int CW_QHEAD = 64;
constexpr int CW_BAR = 4096;

constexpr int LDS_BYTES = 163840;
constexpr int LDS_MISC = 163840 - 256;

#define XB_TMO      128
#define XB_XCNT(j)  (256  + 64 * (j))
#define XB_XSUB(j)  (1280 + 64 * (j))
#define XB_XGEN(j)  (2304 + 64 * (j))
#define XB_TOP      3328
#define XB_TOPGEN   3392
#define XCD_BAR_WORDS 3456
#define XB_SPIN_CAP (1u << 22)

__device__ __forceinline__ unsigned xb_ld(unsigned* p)              { return __hip_atomic_load(p, __ATOMIC_RELAXED, __HIP_MEMORY_SCOPE_AGENT); }
__device__ __forceinline__ unsigned xb_add(unsigned* p, unsigned v) { return __hip_atomic_fetch_add(p, v, __ATOMIC_RELAXED, __HIP_MEMORY_SCOPE_AGENT); }
__device__ __forceinline__ unsigned xb_xcc_id() { return (unsigned)__builtin_amdgcn_s_getreg((3 << 11) | 20) & 0xFu; }
#define XB_SPIN(cond, bar) do { unsigned _sp = 0; while (cond) { __builtin_amdgcn_s_sleep(1); \
    if ((++_sp & 255u) == 0u) { if (xb_ld(&(bar)[XB_TMO])) break; if (_sp > XB_SPIN_CAP) { atomicAdd(&(bar)[XB_TMO], 1u); break; } } } } while (0)

struct XcdBarrier { unsigned* bar; unsigned x; volatile LAS unsigned* st; };

__device__ __forceinline__ XcdBarrier xcd_barrier_post(unsigned* bar, volatile LAS unsigned* st) {
    XcdBarrier b; b.bar = bar; b.x = xb_xcc_id(); b.st = st;
    if (threadIdx.x == 0) (void)xb_add(&bar[XB_XCNT(b.x)], 1u);
    return b;
}
__device__ __forceinline__ void xcd_barrier_complete(unsigned* bar, unsigned x, unsigned& nloc, unsigned& nx) {
    const unsigned G = gridDim.x * gridDim.y * gridDim.z;
    unsigned sum, cnt, mine, sp = 0u;
    for (;;) {
        sum = 0u; cnt = 0u; mine = 0u;
#pragma unroll
        for (unsigned j = 0; j < 16; ++j) { const unsigned c = xb_ld(&bar[XB_XCNT(j)]); sum += c; cnt += (c > 0u) ? 1u : 0u; mine = (j == x) ? c : mine; }
        if (sum == G) break;
        __builtin_amdgcn_s_sleep(1);
        if ((++sp & 255u) == 0u) { if (xb_ld(&bar[XB_TMO])) break; if (sp > XB_SPIN_CAP) { atomicAdd(&bar[XB_TMO], 1u); break; } }
    }
    nloc = mine > 0u ? mine : 1u; nx = cnt > 0u ? cnt : 1u;
}
__device__ __forceinline__ void xcd_barrier(const XcdBarrier& b) {
    asm volatile("s_waitcnt vmcnt(0)" ::: "memory");
    __syncthreads();
    if (threadIdx.x == 0) {
        unsigned* bar = b.bar;
        __builtin_amdgcn_s_waitcnt(0);
        unsigned nloc = b.st[0], nx = b.st[1];
        if (nloc == 0u) { xcd_barrier_complete(bar, b.x, nloc, nx); b.st[0] = nloc; b.st[1] = nx; }
        const unsigned old = xb_add(&bar[XB_XSUB(b.x)], 1u);
        const unsigned gen = old / nloc;
        if (old + 1u == (gen + 1u) * nloc) {
            __builtin_amdgcn_fence(__ATOMIC_RELEASE, "agent");
            asm volatile("s_waitcnt vmcnt(0)" ::: "memory");
            const unsigned og = xb_add(&bar[XB_TOP], 1u);
            const unsigned tg = og / nx;
            if (og + 1u == (tg + 1u) * nx) xb_add(&bar[XB_TOPGEN], 1u);
            else XB_SPIN(xb_ld(&bar[XB_TOPGEN]) == tg, bar);
            __builtin_amdgcn_fence(__ATOMIC_ACQUIRE, "agent");
            xb_add(&bar[XB_XGEN(b.x)], 1u);
            asm volatile("s_waitcnt vmcnt(0)" ::: "memory");
        } else {
            XB_SPIN(xb_ld(&bar[XB_XGEN(b.x)]) == gen, bar);
            __builtin_amdgcn_fence(__ATOMIC_ACQUIRE, "agent");
            asm volatile("s_waitcnt vmcnt(0)" ::: "memory");
        }
    }
    __syncthreads();
}

__device__ __forceinline__ unsigned pk_rne(float a, float b) { half2v v = {(_Float16)a, (_Float16)b}; return __builtin_bit_cast(unsigned, v); }
__device__ __forceinline__ unsigned pk_rtz(float a, float b) { auto v = __builtin_amdgcn_cvt_pkrtz(a, b); return __builtin_bit_cast(unsigned, v); }
__device__ __forceinline__ u32x4 pk8(const float* v) { u32x4 w; w.x = pk_rne(v[0], v[1]); w.y = pk_rne(v[2], v[3]); w.z = pk_rne(v[4], v[5]); w.w = pk_rne(v[6], v[7]); return w; }
__device__ __forceinline__ void unpk8(u32x4 w, float* v) {
    const half8 h = __builtin_bit_cast(half8, w);
#pragma unroll
    for (int i = 0; i < 8; ++i) v[i] = (float)h[i];
}
__device__ __forceinline__ float wave_sum(float v) {
#pragma unroll
    for (int o = 1; o < 64; o <<= 1) v += __shfl_xor(v, o);
    return v;
}
__device__ __forceinline__ void rope4(float* v, const float2* cs) {
#pragma unroll
    for (int p = 0; p < 4; ++p) { const float2 t = cs[p]; const float x1 = v[2 * p], x2 = v[2 * p + 1]; v[2 * p] = x1 * t.x - x2 * t.y; v[2 * p + 1] = x2 * t.x + x1 * t.y; }
}

__host__ __device__ __forceinline__ size_t k_off(int tok, int d)   { return (size_t)(((tok >> 6) * 8 + (d >> 3)) * 512 + (tok & 63) * 8 + (d & 7)); }
__host__ __device__ __forceinline__ size_t v_off(int tok, int d)   { return (size_t)((tok >> 6) * 4096 + ((d >> 5) * 8 + ((tok & 63) >> 3)) * 256 + (tok & 7) * 32 + (d & 31)); }
__host__ __device__ __forceinline__ size_t kpe_off(int tok, int p) { return (size_t)(((tok >> 6) * 4 + (p >> 3)) * 512 + (tok & 63) * 8 + (p & 7)); }

namespace pg8 {
constexpr int BM = 256, BK = 64, HALF = 128, HTB = HALF * BK * 2, NXCD = 8, WGM = 8;
__host__ __device__ __forceinline__ int lds_byte(int r, int c) { const int st = (r >> 4) * 2 + (c >> 5), rr = r & 15, cc = c & 31, ob = rr * 64 + cc * 2; return st * 1024 + (ob ^ (((ob >> 9) & 1) << 5)); }
__host__ __device__ __forceinline__ void stage_rc(int b, int& R, int& C) { const int st = b / 1024, sb = b % 1024, swz = sb ^ (((sb >> 9) & 1) << 5); R = (st >> 1) * 16 + swz / 64; C = (st & 1) * 32 + (swz % 64) / 2; }
__host__ __device__ __forceinline__ int perm32(int rho) { const int n = rho >> 4, i = rho & 15; return 8 * (i >> 2) + 4 * n + (i & 3); }

struct Unit { int pm, pn; size_t aoff, boff; };
struct Gemm { const half_t* A; const half_t* Bt; int K, lda, ldb; };

struct StaticOrder {
    int nM, nN, nwg, G, c; size_t tA, tB;
    __device__ void init(int M, int N, int G_, int c_, int lda, int ldb) { nM = M / BM; nN = N / BM; nwg = nM * nN; G = G_; c = c_; tA = (size_t)BM * lda * 2; tB = (size_t)BM * ldb * 2; }
    __device__ bool next(int i, Unit& u) const {
        const long L = (long)i * G + c; if (L >= nwg) return false;
        int wgid = (int)L; { const int q = nwg / NXCD, r = nwg % NXCD, xcd = wgid % NXCD, off = wgid / NXCD; wgid = (xcd < r ? xcd * (q + 1) : r * (q + 1) + (xcd - r) * q) + off; }
        const int nig = WGM * nN, gid = wgid / nig, fm = gid * WGM, gsz = (nM - fm) < WGM ? (nM - fm) : WGM;
        u.pm = fm + ((wgid % nig) % gsz); u.pn = (wgid % nig) / gsz; u.aoff = (size_t)u.pm * tA; u.boff = (size_t)u.pn * tB; return true;
    }
};
struct Cmp1Order {
    int G, c;
    __device__ bool next(int i, Unit& u) const {
        const int L = i * G + c; if (L >= 256) return false;
        const int kv = L >> 7, slab = (L >> 2) & 31, ch = L & 3;
        u.pm = L; u.pn = 0; u.aoff = (size_t)kv * (16 * MiB) + (size_t)slab * (512 * 1024) + (size_t)ch * 1024; u.boff = (size_t)kv * (256 * 2048 * 2) + (size_t)ch * 1024; return true;
    }
};

template <class Epi, class Sched, bool MIDK = false>
__device__ __forceinline__ void gemm_phase(LAS unsigned char* lds, const Gemm g, const Sched& S, const Epi& E) {
    int tid_ = threadIdx.x; asm volatile("" : "+v"(tid_));
    const int tid = tid_, wid = __builtin_amdgcn_readfirstlane(tid >> 6), lane = tid & 63, wr = wid >> 2, wc = wid & 3, fr = lane & 15, fq = lane >> 4;
    const int K = g.K, nt = K / BK;
    unsigned voffA[2], voffB[2];
#pragma unroll
    for (int i = 0; i < 2; ++i) { int R, C; stage_rc(tid * 16 + i * 8192, R, C); const int Rb = (R & ~31) + perm32(R & 31);
        voffA[i] = (unsigned)(R * g.lda + C) * 2u; voffB[i] = (unsigned)(Rb * g.ldb + C) * 2u; }
    const size_t kstep = (size_t)(BK * 2);
    const size_t hstepA = (size_t)HALF * g.lda * 2, hstepB = (size_t)HALF * g.ldb * 2;
    const unsigned ldsw = (unsigned)wid * 1024u;
    const int aoff = lds_byte(wr * 64 + fr, fq * 8), boff = lds_byte(wc * 32 + fr, fq * 8);
#define PG8_SA(b, h) (((b) * 2 + (h)) * HTB)
#define PG8_SB(b, h) ((4 + (b) * 2 + (h)) * HTB)
#define PG8_STAGE(bufoff, gbase, voff) do { _Pragma("unroll") for (int _i = 0; _i < 2; ++_i) \
        __builtin_amdgcn_global_load_lds((const unsigned*)((const char*)(gbase) + (voff)[_i]), (LAS unsigned*)(lds + (bufoff) + ldsw + _i * 8192), 16, 0, 0); } while (0)
#define PG8_LDA(dst, b, h) do { _Pragma("unroll") for (int m = 0; m < 4; ++m) _Pragma("unroll") for (int k = 0; k < 2; ++k) dst[m][k] = *(const LAS half8*)(lds + PG8_SA(b, h) + aoff + m * 2048 + k * 1024); } while (0)
#define PG8_LDB(dst, b, h) do { _Pragma("unroll") for (int n = 0; n < 2; ++n) _Pragma("unroll") for (int k = 0; k < 2; ++k) dst[n][k] = *(const LAS half8*)(lds + PG8_SB(b, h) + boff + n * 2048 + k * 1024); } while (0)
#define PG8_MMA(ai, bj, At, Bt) do { __builtin_amdgcn_s_setprio(1); _Pragma("unroll") for (int m = 0; m < 4; ++m) _Pragma("unroll") for (int n = 0; n < 2; ++n) _Pragma("unroll") for (int k = 0; k < 2; ++k) \
        acc[ai][bj][m][n] = __builtin_amdgcn_mfma_f32_16x16x32_f16(Bt[n][k], At[m][k], acc[ai][bj][m][n], 0, 0, 0); __builtin_amdgcn_s_setprio(0); } while (0)
#define PG8_WAIT_V(n) asm volatile("s_waitcnt vmcnt(" #n ")" ::: "memory")
#define PG8_WAIT_L(n) asm volatile("s_waitcnt lgkmcnt(" #n ")" ::: "memory")
#define PG8_BAR __builtin_amdgcn_s_barrier()
#define PG8_SCHED __builtin_amdgcn_sched_barrier(0)
    Unit cur, nxt; int ui = 0;
    if (!S.next(0, cur)) return;
    f32x4 acc[2][2][4][2];
#pragma unroll
    for (int a = 0; a < 2; ++a)
#pragma unroll
        for (int b = 0; b < 2; ++b)
#pragma unroll
            for (int m = 0; m < 4; ++m)
#pragma unroll
                for (int n = 0; n < 2; ++n) acc[a][b][m][n] = (f32x4){0.f, 0.f, 0.f, 0.f};
    half8 At[4][2], B0[2][2], B1[2][2];
    const char* cA = (const char*)g.A + cur.aoff; const char* cB = (const char*)g.Bt + cur.boff;
    PG8_STAGE(PG8_SB(0, 0), cB, voffB); PG8_STAGE(PG8_SB(0, 1), cB + hstepB, voffB); PG8_STAGE(PG8_SA(0, 0), cA, voffA); PG8_STAGE(PG8_SA(0, 1), cA + hstepA, voffA);
    if (wr == 1) PG8_BAR;
    PG8_WAIT_V(2); PG8_BAR;
    PG8_STAGE(PG8_SB(1, 0), cB + kstep, voffB); PG8_STAGE(PG8_SA(1, 0), cA + kstep, voffA); PG8_STAGE(PG8_SB(1, 1), cB + hstepB + kstep, voffB);
    PG8_WAIT_V(6); PG8_BAR;
    for (;;) {
        const bool has_next = S.next(ui + 1, nxt);
        const char* nA = has_next ? (const char*)g.A + nxt.aoff : cA; const char* nB = has_next ? (const char*)g.Bt + nxt.boff : cB;
        for (int t = 0; t < nt; t += 2) {
            if constexpr (MIDK) { if (t == nt / 2) E.midk(acc, cur, wr); }
            const bool last = (t == nt - 2);
            const char* a1 = cA + (size_t)(t + 1) * kstep;
            const char* a2 = last ? nA : cA + (size_t)(t + 2) * kstep; const char* b2 = last ? nB : cB + (size_t)(t + 2) * kstep;
            const char* a3 = a2 + kstep; const char* b3 = b2 + kstep;
            PG8_LDB(B0, 0, 0); PG8_LDB(B1, 0, 1); PG8_SCHED; PG8_LDA(At, 0, 0); PG8_STAGE(PG8_SA(1, 1), a1 + hstepA, voffA);
            PG8_WAIT_V(8); PG8_WAIT_L(0); PG8_BAR; PG8_MMA(0, 0, At, B0); PG8_MMA(0, 1, At, B1); PG8_BAR; PG8_SCHED;
            PG8_LDA(At, 0, 1); PG8_STAGE(PG8_SB(0, 0), b2, voffB); PG8_STAGE(PG8_SB(0, 1), b2 + hstepB, voffB); PG8_STAGE(PG8_SA(0, 0), a2, voffA);
            PG8_WAIT_V(8); PG8_WAIT_L(0); PG8_BAR; PG8_MMA(1, 0, At, B0); PG8_MMA(1, 1, At, B1); PG8_BAR; PG8_SCHED;
            PG8_LDB(B0, 1, 0); PG8_LDB(B1, 1, 1); PG8_SCHED; PG8_LDA(At, 1, 0); PG8_STAGE(PG8_SA(0, 1), a2 + hstepA, voffA);
            PG8_WAIT_V(8); PG8_WAIT_L(0); PG8_BAR; PG8_MMA(0, 0, At, B0); PG8_MMA(0, 1, At, B1); PG8_BAR; PG8_SCHED;
            PG8_LDA(At, 1, 1); PG8_STAGE(PG8_SB(1, 0), b3, voffB); PG8_STAGE(PG8_SB(1, 1), b3 + hstepB, voffB); PG8_STAGE(PG8_SA(1, 0), a3, voffA);
            PG8_WAIT_V(8); PG8_WAIT_L(0); PG8_BAR; PG8_MMA(1, 0, At, B0); PG8_MMA(1, 1, At, B1); PG8_BAR; PG8_SCHED;
        }
        if (wr == 0) PG8_BAR;
        E(acc, cur, wr, wc, fr, fq);
        if (!has_next) break;
#pragma unroll
        for (int a = 0; a < 2; ++a)
#pragma unroll
            for (int b = 0; b < 2; ++b)
#pragma unroll
                for (int m = 0; m < 4; ++m)
#pragma unroll
                    for (int n = 0; n < 2; ++n) acc[a][b][m][n] = (f32x4){0.f, 0.f, 0.f, 0.f};
        cur = nxt; cA = nA; cB = nB; ++ui;
        if (wr == 1) PG8_BAR;
    }
    PG8_WAIT_V(0);
    PG8_BAR;
#undef PG8_SA
#undef PG8_SB
#undef PG8_STAGE
#undef PG8_LDA
#undef PG8_LDB
#undef PG8_MMA
#undef PG8_WAIT_V
#undef PG8_WAIT_L
#undef PG8_BAR
#undef PG8_SCHED
}
}

typedef f32x4 AccT[2][2][4][2];
#define EPI_IDS() int t_ = threadIdx.x; asm volatile("" : "+v"(t_)); const int fr = t_ & 15, fq = (t_ >> 4) & 3; (void)fr_; (void)fq_
#define EPI_ROW(ai, m) (u.pm * 256 + (ai) * 128 + wr * 64 + (m) * 16 + fr)
#define EPI_GET8(v, ai, bj, m, s) do { const f32x4 _a = acc[ai][bj][m][0], _b = acc[ai][bj][m][1]; v[0] = _a[0] * (s); v[1] = _a[1] * (s); v[2] = _a[2] * (s); v[3] = _a[3] * (s); v[4] = _b[0] * (s); v[5] = _b[1] * (s); v[6] = _b[2] * (s); v[7] = _b[3] * (s); } while (0)
__device__ __forceinline__ void rope4v(float* v, const f32x4& c01, const f32x4& c23) {
    const float cs[8] = {c01[0], c01[1], c01[2], c01[3], c23[0], c23[1], c23[2], c23[3]};
#pragma unroll
    for (int p = 0; p < 4; ++p) { const float x1 = v[2 * p], x2 = v[2 * p + 1]; v[2 * p] = x1 * cs[2 * p] - x2 * cs[2 * p + 1]; v[2 * p + 1] = x2 * cs[2 * p] + x1 * cs[2 * p + 1]; }
}
__device__ __forceinline__ float sum4(const f32x4& a) { return (a[0] + a[1]) + (a[2] + a[3]); }
__device__ __forceinline__ float relu_s(float x) { float r; asm("v_max_f32_e32 %0, 0, %1" : "=v"(r) : "v"(x)); return r; }
constexpr int LDS_RED = 131072;

struct EpiIn {
    const float* rs1; half_t* CQ; half_t* T1; half_t* KPE; float* GATE; float* SSQ; float* SSKV; half_t* QN; half_t* KVT; const float2* ropeM; const float2* ropeN;
    __device__ __forceinline__ void operator()(const AccT& acc, const pg8::Unit& u, int wr, int wc, int fr_, int fq_) const {
        EPI_IDS();
        const int pn = u.pn;
        const bool ropem = (pn == 1 && wc == 0), ropen = (pn >= 2 && pn != 4 && (wc & 1) == 0);
#pragma unroll
        for (int ai = 0; ai < 2; ++ai) {
            float rsv[4]; f32x4 rc[4][2];
#pragma unroll
            for (int m = 0; m < 4; ++m) { const int row = EPI_ROW(ai, m), pos = row & (SEQ - 1); rsv[m] = rs1[row];
                if (ropem) { const f32x4* p = (const f32x4*)(ropeM + (size_t)pos * 16 + fq * 4); rc[m][0] = p[0]; rc[m][1] = p[1]; }
                else if (ropen) { const f32x4* p = (const f32x4*)(ropeN + (size_t)pos * 8 + (fq & 1) * 4); rc[m][0] = p[0]; rc[m][1] = p[1]; } }
#pragma unroll
            for (int m = 0; m < 4; ++m) { const int row = EPI_ROW(ai, m), pos = row & (SEQ - 1), b = row >> 12; const float rs = rsv[m];
                float v[8];
                if (pn == 0) {
                    float ss = 0.f;
#pragma unroll
                    for (int bj = 0; bj < 2; ++bj) { EPI_GET8(v, ai, bj, m, rs);
#pragma unroll
                        for (int i = 0; i < 8; ++i) ss += v[i] * v[i];
                        *(u32x4*)(CQ + (size_t)row * 256 + bj * 128 + wc * 32 + fq * 8) = pk8(v); }
                    ss += __shfl_xor(ss, 16); ss += __shfl_xor(ss, 32);
                    if (fq == 0) SSQ[(size_t)row * 4 + wc] = ss;
                } else if (pn == 1) {
                    { EPI_GET8(v, ai, 0, m, rs); float ss = 0.f;
#pragma unroll
                        for (int i = 0; i < 8; ++i) ss += v[i] * v[i];
                        *(u32x4*)(T1 + (size_t)row * 256 + wc * 32 + fq * 8) = pk8(v);
                        ss += __shfl_xor(ss, 16); ss += __shfl_xor(ss, 32);
                        if (fq == 0) SSKV[(size_t)row * 4 + wc] = ss; }
                    { EPI_GET8(v, ai, 1, m, rs);
                        if (wc == 0) { rope4v(v, rc[m][0], rc[m][1]); const u32x4 w = pk8(v);
                            *(u32x4*)(T1 + (size_t)row * 256 + 128 + fq * 8) = w; *(u32x4*)(KPE + (size_t)b * SEQ * 32 + kpe_off(pos, fq * 8)) = w; }
                        else { if (wc == 1 && fq < 3) { float* gp = GATE + (size_t)row * 24 + fq * 8;
#pragma unroll
                                for (int i = 0; i < 8; ++i) v[i] = 1.f / (1.f + __expf(-v[i]));
                                *(f32x4*)gp = (f32x4){v[0], v[1], v[2], v[3]}; *(f32x4*)(gp + 4) = (f32x4){v[4], v[5], v[6], v[7]}; }
                            *(u32x4*)(T1 + (size_t)row * 256 + 128 + wc * 32 + fq * 8) = (u32x4){0u, 0u, 0u, 0u}; } }
                } else if (pn < 4) {
#pragma unroll
                    for (int bj = 0; bj < 2; ++bj) { EPI_GET8(v, ai, bj, m, rs); const int head = (pn - 2) * 4 + 2 * bj + (wc >> 1), off = 32 * (wc & 1) + 8 * fq;
                        if ((wc & 1) == 0 && fq < 2) rope4v(v, rc[m][0], rc[m][1]);
#pragma unroll
                        for (int i = 0; i < 8; ++i) v[i] *= QS_N;
                        *(u32x4*)(QN + (size_t)row * 512 + head * 64 + off) = pk8(v); }
                } else {
#pragma unroll
                    for (int bj = 0; bj < 2; ++bj) { EPI_GET8(v, ai, bj, m, rs); const int g = wc >> 1, d = 32 * (wc & 1) + 8 * fq;
                        if (pn > 4 && bj == 0 && (wc & 1) == 0 && fq < 2) rope4v(v, rc[m][0], rc[m][1]);
                        half_t* base = KVT + (size_t)((pn - 4) * 2 + bj) * KVT_STRIDE + (size_t)(b * 2 + g) * SEQ * 64;
                        *(u32x4*)(base + (pn == 4 ? (size_t)pos * 64 + d : (bj == 0 ? k_off(pos, d) : v_off(pos, d)))) = pk8(v); }
                }
            }
        }
    }
};

struct EpiUq {
    const float* SSQ; half_t* QM; const float2* ropeM;
    __device__ __forceinline__ void operator()(const AccT& acc, const pg8::Unit& u, int wr, int wc, int fr_, int fq_) const {
        EPI_IDS();
        const bool pe0 = ((8 * u.pn + wc) % 3 == 2), pe1 = ((8 * u.pn + 4 + wc) % 3 == 2);
#pragma unroll
        for (int ai = 0; ai < 2; ++ai) {
            f32x4 s4[4];
#pragma unroll
            for (int m = 0; m < 4; ++m) s4[m] = *(const f32x4*)(SSQ + (size_t)EPI_ROW(ai, m) * 4);
#pragma unroll
            for (int m = 0; m < 4; ++m) { const int row = EPI_ROW(ai, m);
                const float rs = __builtin_amdgcn_rsqf(sum4(s4[m]) * (1.f / 256.f) + NORM_EPS) * QS_M;
                float v[8];
#pragma unroll
                for (int bj = 0; bj < 2; ++bj) { EPI_GET8(v, ai, bj, m, rs); const int sidx = 8 * u.pn + 4 * bj + wc;
                    if (bj == 0 ? pe0 : pe1) { const f32x4* p = (const f32x4*)(ropeM + (size_t)(row & (SEQ - 1)) * 16 + fq * 4); rope4v(v, p[0], p[1]); }
                    *(u32x4*)(QM + (size_t)row * 768 + sidx * 32 + fq * 8) = pk8(v); }
            }
        }
    }
};
struct EpiUkv {
    const float* SSKV; half_t* KNM; half_t* VM;
    __device__ __forceinline__ void operator()(const AccT& acc, const pg8::Unit& u, int wr, int wc, int fr_, int fq_) const {
        EPI_IDS();
#pragma unroll
        for (int ai = 0; ai < 2; ++ai) {
            f32x4 s4[4];
#pragma unroll
            for (int m = 0; m < 4; ++m) s4[m] = *(const f32x4*)(SSKV + (size_t)EPI_ROW(ai, m) * 4);
#pragma unroll
            for (int m = 0; m < 4; ++m) { const int row = EPI_ROW(ai, m), pos = row & (SEQ - 1), b = row >> 12;
                const float rs = __builtin_amdgcn_rsqf(sum4(s4[m]) * (1.f / 128.f) + NORM_EPS);
                float v[8];
#pragma unroll
                for (int bj = 0; bj < 2; ++bj) { EPI_GET8(v, ai, bj, m, rs); const int c = (u.pn & 1) * 256 + bj * 128 + wc * 32 + fq * 8, head = c >> 6, d = c & 63;
                    half_t* base = ((u.pn < 2) ? KNM : VM) + (size_t)(b * 8 + head) * SEQ * 64;
                    *(u32x4*)(base + ((u.pn < 2) ? k_off(pos, d) : v_off(pos, d))) = pk8(v); }
            }
        }
    }
};
struct EpiC1 {
    float* HIDP;
    __device__ __forceinline__ void operator()(const AccT& acc, const pg8::Unit& u, int wr, int wc, int fr_, int fq_) const {
        EPI_IDS();
#pragma unroll
        for (int ai = 0; ai < 2; ++ai)
#pragma unroll
            for (int m = 0; m < 4; ++m) { const int rl = ai * 128 + wr * 64 + m * 16 + fr; float* p = HIDP + ((size_t)u.pm * 256 + rl) * 128 + wc * 32 + fq * 8;
                *(f32x4*)p = acc[ai][0][m][0]; *(f32x4*)(p + 4) = acc[ai][0][m][1]; }
    }
};
__device__ __forceinline__ float rstd8(const float* p, float inv_n) {
    const f32x4 a = *(const f32x4*)p, b = *(const f32x4*)(p + 4);
    return __builtin_amdgcn_rsqf((sum4(a) + sum4(b)) * inv_n + NORM_EPS);
}
struct EpiWo {
    const half_t* XH; half_t* H1; float* SS2; const float* SSM; const float* SSN; LAS float* red;
    __device__ __forceinline__ void midk(AccT& acc, const pg8::Unit& u, int wr) const {
        int t_ = threadIdx.x; asm volatile("" : "+v"(t_)); const int fr = t_ & 15;
#pragma unroll
        for (int ai = 0; ai < 2; ++ai) {
            f32x4 sm[4][2], sn[4][2];
#pragma unroll
            for (int m = 0; m < 4; ++m) { const int row = EPI_ROW(ai, m); sm[m][0] = *(const f32x4*)(SSM + (size_t)row * 8); sm[m][1] = *(const f32x4*)(SSM + (size_t)row * 8 + 4); sn[m][0] = *(const f32x4*)(SSN + (size_t)row * 8); sn[m][1] = *(const f32x4*)(SSN + (size_t)row * 8 + 4); }
#pragma unroll
            for (int m = 0; m < 4; ++m) {
                const float ratio = __builtin_amdgcn_rsqf((sum4(sm[m][0]) + sum4(sm[m][1])) * (1.f / 512.f) + NORM_EPS) / __builtin_amdgcn_rsqf((sum4(sn[m][0]) + sum4(sn[m][1])) * (1.f / 512.f) + NORM_EPS);
#pragma unroll
                for (int bj = 0; bj < 2; ++bj)
#pragma unroll
                    for (int n = 0; n < 2; ++n) acc[ai][bj][m][n] *= ratio; }
        }
    }
    __device__ __forceinline__ void operator()(const AccT& acc, const pg8::Unit& u, int wr, int wc, int fr_, int fq_) const {
        EPI_IDS();
#pragma unroll
        for (int ai = 0; ai < 2; ++ai) {
            f32x4 sn[4][2]; u32x4 xr[4][2];
#pragma unroll
            for (int m = 0; m < 4; ++m) { const int row = EPI_ROW(ai, m); sn[m][0] = *(const f32x4*)(SSN + (size_t)row * 8); sn[m][1] = *(const f32x4*)(SSN + (size_t)row * 8 + 4);
#pragma unroll
                for (int bj = 0; bj < 2; ++bj) xr[m][bj] = *(const u32x4*)(XH + (size_t)row * DM + u.pn * 256 + bj * 128 + wc * 32 + fq * 8); }
#pragma unroll
            for (int m = 0; m < 4; ++m) { const int row = EPI_ROW(ai, m);
                const float rn = __builtin_amdgcn_rsqf((sum4(sn[m][0]) + sum4(sn[m][1])) * (1.f / 512.f) + NORM_EPS);
                float v[8], x[8], ss = 0.f;
#pragma unroll
                for (int bj = 0; bj < 2; ++bj) { EPI_GET8(v, ai, bj, m, rn); unpk8(xr[m][bj], x);
#pragma unroll
                    for (int i = 0; i < 8; ++i) { v[i] += x[i]; ss += v[i] * v[i]; }
                    *(u32x4*)(H1 + (size_t)row * DM + u.pn * 256 + bj * 128 + wc * 32 + fq * 8) = pk8(v); }
                ss += __shfl_xor(ss, 16); ss += __shfl_xor(ss, 32);
                if (fq == 0) red[(ai * 128 + wr * 64 + m * 16 + fr) * 4 + wc] = ss;
            }
        }
        asm volatile("s_waitcnt lgkmcnt(0)" ::: "memory"); __builtin_amdgcn_s_barrier();
        if (t_ < 256) { const f32x4 r4 = *(const LAS f32x4*)(red + t_ * 4); SS2[(size_t)(u.pm * 256 + t_) * 4 + u.pn] = sum4(r4); }
    }
};
__device__ __forceinline__ float rstd16(const float* p, float inv_n) {
    const f32x4 a = *(const f32x4*)p, b = *(const f32x4*)(p + 4), c = *(const f32x4*)(p + 8), d = *(const f32x4*)(p + 12);
    return __builtin_amdgcn_rsqf(((sum4(a) + sum4(b)) + (sum4(c) + sum4(d))) * inv_n + NORM_EPS);
}
struct EpiUp {
    const float* SS2; half_t* A2;
    __device__ __forceinline__ void operator()(const AccT& acc, const pg8::Unit& u, int wr, int wc, int fr_, int fq_) const {
        EPI_IDS();
#pragma unroll
        for (int ai = 0; ai < 2; ++ai) {
            f32x4 s[4];
#pragma unroll
            for (int m = 0; m < 4; ++m) s[m] = *(const f32x4*)(SS2 + (size_t)EPI_ROW(ai, m) * 4);
#pragma unroll
            for (int m = 0; m < 4; ++m) { const int row = EPI_ROW(ai, m);
                const float rs = __builtin_amdgcn_rsqf(sum4(s[m]) * (1.f / 1024.f) + NORM_EPS);
                const float rs2 = rs * rs;
#pragma unroll
                for (int bj = 0; bj < 2; ++bj) { u32x4 w;
#pragma unroll
                    for (int n = 0; n < 2; ++n) { const f32x4 a = acc[ai][bj][m][n];
                        typedef float f32x2 __attribute__((ext_vector_type(2)));
                        f32x2 x0 = {relu_s(a[0]), relu_s(a[1])}, x1 = {relu_s(a[2]), relu_s(a[3])};
                        x0 = x0 * x0 * rs2; x1 = x1 * x1 * rs2;
                        w[2 * n] = pk_rne(x0[0], x0[1]); w[2 * n + 1] = pk_rne(x1[0], x1[1]); }
                    __builtin_nontemporal_store(w, (u32x4*)(A2 + (size_t)row * DFF + u.pn * 256 + bj * 128 + wc * 32 + fq * 8)); }
            }
        }
    }
};
struct EpiDn {
    const half_t* H1; half_t* H2; float* SS3; LAS float* red;
    __device__ __forceinline__ void operator()(const AccT& acc, const pg8::Unit& u, int wr, int wc, int fr_, int fq_) const {
        EPI_IDS();
#pragma unroll
        for (int ai = 0; ai < 2; ++ai) {
            u32x4 xr[4][2];
#pragma unroll
            for (int m = 0; m < 4; ++m)
#pragma unroll
                for (int bj = 0; bj < 2; ++bj) xr[m][bj] = *(const u32x4*)(H1 + (size_t)EPI_ROW(ai, m) * DM + u.pn * 256 + bj * 128 + wc * 32 + fq * 8);
#pragma unroll
            for (int m = 0; m < 4; ++m) { const int row = EPI_ROW(ai, m);
                float v[8], x[8], ss = 0.f;
#pragma unroll
                for (int bj = 0; bj < 2; ++bj) { EPI_GET8(v, ai, bj, m, 1.f); unpk8(xr[m][bj], x);
#pragma unroll
                    for (int i = 0; i < 8; ++i) { v[i] += x[i]; ss += v[i] * v[i]; }
                    *(u32x4*)(H2 + (size_t)row * DM + u.pn * 256 + bj * 128 + wc * 32 + fq * 8) = pk8(v); }
                ss += __shfl_xor(ss, 16); ss += __shfl_xor(ss, 32);
                if (fq == 0) red[(ai * 128 + wr * 64 + m * 16 + fr) * 4 + wc] = ss;
            }
        }
        asm volatile("s_waitcnt lgkmcnt(0)" ::: "memory"); __builtin_amdgcn_s_barrier();
        if (t_ < 256) { const f32x4 r4 = *(const LAS f32x4*)(red + t_ * 4); SS3[(size_t)(u.pm * 256 + t_) * 4 + u.pn] = sum4(r4); }
    }
};

constexpr int AT_KB = 0, AT_VB = 12288, AT_BUF = 20480;
constexpr int AT_SUB = 3;
constexpr int AT_STAGE = AT_SUB * AT_BUF;
constexpr int AT_IMP = 2 * AT_STAGE;
constexpr int AT_IMPW = 8 * 2 * 68 * 4;
constexpr int AT_SEL = AT_IMP + 8 * AT_IMPW;
constexpr int AT_QIDX = AT_SEL + 8 * 64;

struct TileRegs { u32x4 k, kp, v; };
__device__ __forceinline__ void tile_load(TileRegs& r, const half_t* Kt, const half_t* KPt, const half_t* Vt, int tid, int wid, int lane) {
    r.k = *(const u32x4*)(Kt + (size_t)(tid & 63) * 64 + wid * 8);
    if (KPt != nullptr && tid < 256) r.kp = *(const u32x4*)(KPt + (size_t)(tid & 63) * 32 + wid * 8);
    r.v = *(const u32x4*)(Vt + (size_t)(16 * (wid & 3) + (lane >> 2)) * 64 + (wid >> 2) * 32 + (lane & 3) * 8);
}
__device__ __forceinline__ void tile_store(const TileRegs& r, LAS unsigned char* buf, bool haspe, int tid, int wid, int lane) {
    *(LAS u32x4*)(buf + AT_KB + wid * 1024 + lane * 16) = r.k;
    if (haspe && tid < 256) *(LAS u32x4*)(buf + AT_KB + (8 + wid) * 1024 + lane * 16) = r.kp;
    *(LAS u32x4*)(buf + AT_VB + wid * 1024 + lane * 16) = r.v;
}
__device__ __forceinline__ float xhalf_max(float v) { const auto rr = __builtin_amdgcn_permlane32_swap(__float_as_uint(v), __float_as_uint(v), false, false); return fmaxf(__uint_as_float(rr[0]), __uint_as_float(rr[1])); }
__device__ __forceinline__ float xhalf_sum(float v) { const auto rr = __builtin_amdgcn_permlane32_swap(__float_as_uint(v), __float_as_uint(v), false, false); return __uint_as_float(rr[0]) + __uint_as_float(rr[1]); }
template <int NKS, int AB = 0>
__device__ __forceinline__ void tile_qk(const LAS unsigned char* kb, const half8 (&qf)[NKS], const f32x16& cinit, f32x16& p0, f32x16& p1) {
    if (AB & 1) { p0 = cinit; p1 = cinit; p0[0] += (float)qf[0][0]; p1[3] += (float)qf[1][1]; if (!(AB & 8)) { const half8 a = *(const LAS half8*)kb; p0[1] += (float)a[0]; } return; }
    half8 kf[2 * NKS];
#pragma unroll
    for (int ks = 0; ks < NKS; ++ks) { kf[2 * ks] = *(const LAS half8*)(kb + ks * 2048); kf[2 * ks + 1] = *(const LAS half8*)(kb + ks * 2048 + 512); }
    __builtin_amdgcn_sched_barrier(0);
    p0 = __builtin_amdgcn_mfma_f32_32x32x16_f16(kf[0], qf[0], cinit, 0, 0, 0);
    p1 = __builtin_amdgcn_mfma_f32_32x32x16_f16(kf[1], qf[0], cinit, 0, 0, 0);
#pragma unroll
    for (int ks = 1; ks < NKS; ++ks) {
        p0 = __builtin_amdgcn_mfma_f32_32x32x16_f16(kf[2 * ks], qf[ks], p0, 0, 0, 0);
        p1 = __builtin_amdgcn_mfma_f32_32x32x16_f16(kf[2 * ks + 1], qf[ks], p1, 0, 0, 0);
    }
}
__device__ __forceinline__ void tile_emask(f32x16& p0, f32x16& p1, int hiL, int loL) {
#pragma unroll
    for (int r = 0; r < 16; ++r) { const int c = (r & 3) + 8 * (r >> 2);
        if (!(c <= hiL && c >= loL)) p0[r] = -INFINITY;
        if (!(c + 32 <= hiL && c + 32 >= loL)) p1[r] = -INFINITY; }
}
__device__ __forceinline__ float tile_rowmax(const f32x16& p0, const f32x16& p1) {
    float a = fmaxf(fmaxf(p0[0], p0[1]), p0[2]), b = fmaxf(fmaxf(p1[0], p1[1]), p1[2]);
#pragma unroll
    for (int r = 3; r < 15; r += 2) { a = fmaxf(fmaxf(a, p0[r]), p0[r + 1]); b = fmaxf(fmaxf(b, p1[r]), p1[r + 1]); }
    a = fmaxf(fmaxf(a, p0[15]), fmaxf(b, p1[15]));
    return xhalf_max(a);
}
struct VFrags { v4i16 f[16]; };
__device__ __forceinline__ void vfrag_load(VFrags& V, const LAS unsigned char* vb) {
#pragma unroll
    for (int i = 0; i < 8; ++i) {
        V.f[2 * i]     = __builtin_amdgcn_ds_read_tr16_b64_v4i16((LAS v4i16*)(vb + (i >> 2) * 4096 + (i & 3) * 1024));
        V.f[2 * i + 1] = __builtin_amdgcn_ds_read_tr16_b64_v4i16((LAS v4i16*)(vb + (i >> 2) * 4096 + (i & 3) * 1024 + 512));
    }
}
__device__ __forceinline__ void tile_pv(const f32x16& p0, const f32x16& p1, const VFrags& V, f32x16 (&o)[2]) {
    u32x4 pw[4];
#pragma unroll
    for (int s = 0; s < 2; ++s) {
        pw[s]     = (u32x4){pk_rtz(p0[8 * s], p0[8 * s + 1]), pk_rtz(p0[8 * s + 2], p0[8 * s + 3]), pk_rtz(p0[8 * s + 4], p0[8 * s + 5]), pk_rtz(p0[8 * s + 6], p0[8 * s + 7])};
        pw[2 + s] = (u32x4){pk_rtz(p1[8 * s], p1[8 * s + 1]), pk_rtz(p1[8 * s + 2], p1[8 * s + 3]), pk_rtz(p1[8 * s + 4], p1[8 * s + 5]), pk_rtz(p1[8 * s + 6], p1[8 * s + 7])};
    }
    typedef short s8 __attribute__((ext_vector_type(8)));
#pragma unroll
    for (int db = 0; db < 2; ++db)
#pragma unroll
        for (int ks = 0; ks < 4; ++ks) {
            const v4i16 lo = V.f[2 * (db * 4 + ks)], hi = V.f[2 * (db * 4 + ks) + 1];
            const s8 t = {lo[0], lo[1], lo[2], lo[3], hi[0], hi[1], hi[2], hi[3]};
            o[db] = __builtin_amdgcn_mfma_f32_32x32x16_f16(__builtin_bit_cast(half8, t), __builtin_bit_cast(half8, pw[ks]), o[db], 0, 0, 0);
        }
}
constexpr float SM_THR = 6.f;
struct SmState { f32x16 negm; float mref, l; };
__device__ __forceinline__ void sm_reset(SmState& S) { S.negm = (f32x16){0.f}; S.mref = 0.f; S.l = 0.f; }
template <int AB = 0>
__device__ __forceinline__ void tile_softmax_pv(f32x16& p0, f32x16& p1, const LAS unsigned char* vb, f32x16 (&o)[2], SmState& S, bool first) {
    VFrags V; if (!(AB & 4)) vfrag_load(V, vb);
    if (!(AB & 2)) {
        const float tm = tile_rowmax(p0, p1);
        const bool need = first ? (tm > -INFINITY) : (tm > SM_THR);
        if (__any(need)) {
            const float delta = need ? tm : 0.f, alpha = __builtin_amdgcn_exp2f(-delta);
            S.mref += delta; S.l *= alpha;
#pragma unroll
            for (int r = 0; r < 16; ++r) { p0[r] -= delta; p1[r] -= delta; o[0][r] *= alpha; o[1][r] *= alpha; S.negm[r] = -S.mref; }
        }
        float s0 = 0.f, s1 = 0.f, s2 = 0.f, s3 = 0.f;
#pragma unroll
        for (int r = 0; r < 16; ++r) { p0[r] = __builtin_amdgcn_exp2f(p0[r]); p1[r] = __builtin_amdgcn_exp2f(p1[r]); }
#pragma unroll
        for (int r = 0; r < 16; r += 2) { s0 += p0[r]; s1 += p0[r + 1]; s2 += p1[r]; s3 += p1[r + 1]; }
        S.l += (s0 + s1) + (s2 + s3);
    }
    if (!(AB & 4)) tile_pv(p0, p1, V, o); else { _Pragma("unroll") for (int r = 0; r < 16; ++r) { o[0][r & 3] += p0[r]; o[1][r & 3] += p1[r]; } }
}

__device__ __forceinline__ void glds16(const void* gsrc, unsigned lds_dst) { unsigned keep;
    asm volatile("s_mov_b32 %0, m0\n\ts_mov_b32 m0, %2\n\ts_nop 0\n\tglobal_load_lds_dwordx4 %1, off\n\ts_mov_b32 m0, %0" : "=&s"(keep) : "v"(gsrc), "s"(lds_dst) : "memory"); }
__device__ __forceinline__ unsigned lds_addr(const LAS unsigned char* p) { return (unsigned)__builtin_amdgcn_readfirstlane((int)(unsigned)(size_t)p); }
__device__ __forceinline__ void tile_dma(const half_t* Kt, const half_t* KPt, const half_t* Vt, LAS unsigned char* sub, bool haspe, int wid, int lane) {
    const unsigned base = lds_addr(sub);
    glds16(Kt + wid * 512 + lane * 8, base + AT_KB + wid * 1024);
    if (haspe && wid < 4) glds16(KPt + wid * 512 + lane * 8, base + AT_KB + (8 + wid) * 1024);
    glds16(Vt + wid * 512 + lane * 8, base + AT_VB + wid * 1024);
}
#ifndef AT_STAGGER
#define AT_STAGGER 7
#endif
#ifndef AT_STAGGER_MASK
#define AT_STAGGER_MASK 4
#endif
#define AT_WAITBAR() do { asm volatile("s_waitcnt vmcnt(0) lgkmcnt(0)" ::: "memory"); __builtin_amdgcn_s_barrier(); } while (0)
#define KV_STREAM(NT, DMAT, COMPT) do { \
    const int nt__ = (NT), nst__ = (nt__ + AT_SUB - 1) / AT_SUB; \
    _Pragma("unroll") for (int j_ = 0; j_ < AT_SUB; ++j_) if (j_ < nt__) { DMAT(j_, lds + j_ * AT_BUF); } \
    AT_WAITBAR(); \
    for (int s_ = 0; s_ < nst__; ++s_) { \
        LAS unsigned char* cb_ = lds + (s_ & 1) * AT_STAGE; LAS unsigned char* nb_ = lds + ((s_ + 1) & 1) * AT_STAGE; \
        _Pragma("unroll") for (int j_ = 0; j_ < AT_SUB; ++j_) { const int tn_ = (s_ + 1) * AT_SUB + j_; if (tn_ < nt__) { DMAT(tn_, nb_ + j_ * AT_BUF); } } \
        _Pragma("unroll") for (int j_ = 0; j_ < AT_SUB; ++j_) { const int tc_ = s_ * AT_SUB + j_; if (tc_ < nt__) { COMPT(tc_, cb_ + j_ * AT_BUF); } } \
        AT_WAITBAR(); \
    } } while (0)

struct AttnPtrs {
    const half_t* QM; const half_t* KNM; const half_t* KPE; const half_t* VM;
    const half_t* QN; const half_t* KC; const half_t* VC; const half_t* KS; const half_t* VS; const half_t* KW; const half_t* VW; const float* GATE;
    half_t* Y; float* SSM; float* SSN;
};

template <int AB = 0>
__device__ __forceinline__ void mla_unit(const AttnPtrs& P, int bh, int qb, LAS unsigned char* lds, bool nostore = false) {
    int tid_ = threadIdx.x; asm volatile("" : "+v"(tid_));
    const int tid = tid_, lane = tid & 63, wid = __builtin_amdgcn_readfirstlane(tid >> 6), q = lane & 31, h = lane >> 5;
    const int b = bh >> 3, hd = bh & 7, q0 = qb * 256, qpos = q0 + wid * 32 + q;
    const size_t trow = (size_t)b * SEQ + qpos;
    half8 qf[6];
#pragma unroll
    for (int ks = 0; ks < 6; ++ks) qf[ks] = *(const half8*)(P.QM + trow * 768 + hd * 96 + ks * 16 + h * 8);
#pragma unroll
    for (int ks = 0; ks < 6; ++ks) asm volatile("" : "+v"(qf[ks]));
    const half_t* Kb = P.KNM + (size_t)bh * SEQ * 64; const half_t* Vb = P.VM + (size_t)bh * SEQ * 64; const half_t* KPb = P.KPE + (size_t)b * SEQ * 32;
    const int ntiles = 4 * qb + 4, my_last = 4 * qb + (wid >> 1);
    f32x16 o[2]; o[0] = (f32x16){0.f}; o[1] = (f32x16){0.f};
    SmState S; sm_reset(S);
    const int koff = h * 1024 + q * 16, voff = (4 * h + ((lane & 15) >> 2)) * 64 + ((lane >> 4) & 1) * 32 + (lane & 3) * 8;
#define MLA_LOAD(t, sub) if (!(AB & 16)) tile_dma(Kb + (size_t)(t) * 4096, KPb + (size_t)(t) * 2048, Vb + (size_t)(t) * 4096, sub, true, wid, lane)
#define MLA_COMP(t, buf) do { if ((t) <= my_last) { f32x16 p0, p1; \
        tile_qk<6, AB>((buf) + AT_KB + koff, qf, S.negm, p0, p1); \
        if ((t) == my_last) tile_emask(p0, p1, qpos - 64 * (t) - 4 * h, -1000); \
        tile_softmax_pv<AB>(p0, p1, (buf) + AT_VB + voff, o, S, (t) == 0); } } while (0)
    KV_STREAM(ntiles, MLA_LOAD, MLA_COMP);
#undef MLA_LOAD
#undef MLA_COMP
    const float l = xhalf_sum(S.l);
    const float inv = 1.f / l;
    if (nostore && !(l == 123.456f)) return;
    float ss = 0.f;
    half_t* yrow = P.Y + trow * DM + hd * 64;
#pragma unroll
    for (int db = 0; db < 2; ++db)
#pragma unroll
        for (int c = 0; c < 4; ++c) { const float a0 = o[db][4 * c] * inv, a1 = o[db][4 * c + 1] * inv, a2 = o[db][4 * c + 2] * inv, a3 = o[db][4 * c + 3] * inv;
            ss += (a0 * a0 + a1 * a1) + (a2 * a2 + a3 * a3);
            *(u32x2*)(yrow + db * 32 + 8 * c + 4 * h) = (u32x2){pk_rne(a0, a1), pk_rne(a2, a3)}; }
    ss = xhalf_sum(ss);
    if (h == 0) P.SSM[trow * 8 + hd] = ss;
}

template <int NKS_unused = 4>
__device__ __forceinline__ void nsa_stream_begin(TileRegs& tr, const half_t* Kt, const half_t* Vt, LAS unsigned char* lds, int tid, int wid, int lane) {
    tile_load(tr, Kt, nullptr, Vt, tid, wid, lane);
    tile_store(tr, lds, false, tid, wid, lane);
    __syncthreads();
}
__device__ __forceinline__ void nsa_unit(const AttnPtrs& P, int bg, int qb, LAS unsigned char* lds) {
    int tid_ = threadIdx.x; asm volatile("" : "+v"(tid_));
    const int tid = tid_, lane = tid & 63, wid = __builtin_amdgcn_readfirstlane(tid >> 6), j = lane & 31, h = lane >> 5;
    const int b = bg >> 1, g = bg & 1, q0 = qb * 64, cur = qb, qi = j >> 2, hh = j & 3, qrel = wid * 8 + qi, qpos = q0 + qrel, head = g * 4 + hh;
    const size_t trow = (size_t)b * SEQ + qpos;
    half8 qf[4];
#pragma unroll
    for (int ks = 0; ks < 4; ++ks) qf[ks] = *(const half8*)(P.QN + trow * 512 + head * 64 + ks * 16 + h * 8);
    float g0 = P.GATE[trow * 24 + head], g1 = P.GATE[trow * 24 + 8 + head], g2 = P.GATE[trow * 24 + 16 + head];
#pragma unroll
    for (int ks = 0; ks < 4; ++ks) asm volatile("" : "+v"(qf[ks]));
    asm volatile("" : "+v"(g0), "+v"(g1), "+v"(g2));
    const int koff = h * 1024 + j * 16, voff = (4 * h + ((lane & 15) >> 2)) * 64 + ((lane >> 4) & 1) * 32 + (lane & 3) * 8;
    f32x16 acc[2]; acc[0] = (f32x16){0.f}; acc[1] = (f32x16){0.f};
    f32x16 o[2];
    LAS float* impw = (LAS float*)(lds + AT_IMP + wid * AT_IMPW);
    unsigned long long selmask = (2ull << cur) - 1ull;

    const int ncmp = ((q0 + 32) >> 4) / 64 + 1;
    const half_t* Kc = P.KC + (size_t)bg * 256 * 64; const half_t* Vc = P.VC + (size_t)bg * 256 * 64;
    float m = -1e30f, l = 0.f; const f32x16 zero16 = (f32x16){0.f};
#define CMP_LOAD(t, sub) tile_dma(Kc + (size_t)(t) * 4096, nullptr, Vc + (size_t)(t) * 4096, sub, false, wid, lane)
#define CMP1_COMP(t, buf) do { f32x16 p0, p1; \
        tile_qk<4>((buf) + AT_KB + koff, qf, zero16, p0, p1); \
        tile_emask(p0, p1, ((qpos - 31 - 1024 * (t)) >> 4) - 4 * h, -1000); \
        const float tm = tile_rowmax(p0, p1), mn = fmaxf(m, tm), alpha = __builtin_amdgcn_exp2f(m - mn); \
        float sum = 0.f; \
        _Pragma("unroll") for (int r = 0; r < 16; ++r) sum += __builtin_amdgcn_exp2f(p0[r] - mn) + __builtin_amdgcn_exp2f(p1[r] - mn); \
        l = l * alpha + sum; m = mn; } while (0)
    KV_STREAM(ncmp, CMP_LOAD, CMP1_COMP);
    l = xhalf_sum(l);
    const float invl = (l > 0.f) ? 1.f / l : 0.f;
    o[0] = (f32x16){0.f}; o[1] = (f32x16){0.f};
#define CMP2_COMP(t, buf) do { f32x16 p0, p1; \
        VFrags V; vfrag_load(V, (buf) + AT_VB + voff); \
        tile_qk<4>((buf) + AT_KB + koff, qf, zero16, p0, p1); \
        tile_emask(p0, p1, ((qpos - 31 - 1024 * (t)) >> 4) - 4 * h, -1000); \
        _Pragma("unroll") for (int r = 0; r < 16; ++r) { p0[r] = __builtin_amdgcn_exp2f(p0[r] - m) * invl; p1[r] = __builtin_amdgcn_exp2f(p1[r] - m) * invl; } \
        if (cur >= 16) { \
            _Pragma("unroll") for (int kb = 0; kb < 2; ++kb) \
            _Pragma("unroll") for (int c = 0; c < 4; ++c) { \
                const f32x16& p = kb ? p1 : p0; \
                float C = (p[4 * c] + p[4 * c + 1]) + (p[4 * c + 2] + 0.5f * p[4 * c + 3]), D = 0.5f * p[4 * c + 3]; \
                C += __shfl_xor(C, 1); C += __shfl_xor(C, 2); D += __shfl_xor(D, 1); D += __shfl_xor(D, 2); \
                const int jb = 16 * (t) + 8 * kb + 2 * c + h; \
                if (hh == 0) { impw[qi * 136 + jb] = C; impw[qi * 136 + 68 + jb + 1] = D; } } } \
        tile_pv(p0, p1, V, o); } while (0)
    KV_STREAM(ncmp, CMP_LOAD, CMP2_COMP);
#undef CMP_LOAD
#undef CMP1_COMP
#undef CMP2_COMP
#pragma unroll
    for (int r = 0; r < 16; ++r) { acc[0][r] = g0 * o[0][r]; acc[1][r] = g0 * o[1][r]; }

    if (cur >= 16) {
        const int tq = lane >> 3, e = lane & 7;
        float v[8];
#pragma unroll
        for (int i = 0; i < 8; ++i) { const int jb = e + 8 * i; const float s = impw[tq * 136 + jb] + impw[tq * 136 + 68 + jb];
            v[i] = (jb >= 1 && jb <= cur - 2) ? s : -1.f; }
        unsigned selb = 0u;
        for (int it = 0; it < 13; ++it) {
            float lm = v[0];
#pragma unroll
            for (int i = 1; i < 8; ++i) lm = fmaxf(lm, v[i]);
            float gm = fmaxf(lm, __shfl_xor(lm, 1)); gm = fmaxf(gm, __shfl_xor(gm, 2)); gm = fmaxf(gm, __shfl_xor(gm, 4));
            int cj = 99;
#pragma unroll
            for (int i = 7; i >= 0; --i) cj = (v[i] == gm) ? (e + 8 * i) : cj;
            int gj = min(cj, __shfl_xor(cj, 1)); gj = min(gj, __shfl_xor(gj, 2)); gj = min(gj, __shfl_xor(gj, 4));
#pragma unroll
            for (int i = 0; i < 8; ++i) if (gj == e + 8 * i) { v[i] = -2.f; selb |= 1u << i; }
        }
        unsigned lo = 0u, hi = 0u;
#pragma unroll
        for (int i = 0; i < 4; ++i) { lo |= ((selb >> i) & 1u) << (e + 8 * i); hi |= ((selb >> (i + 4)) & 1u) << (e + 8 * i); }
        lo |= __shfl_xor(lo, 1); lo |= __shfl_xor(lo, 2); lo |= __shfl_xor(lo, 4);
        hi |= __shfl_xor(hi, 1); hi |= __shfl_xor(hi, 2); hi |= __shfl_xor(hi, 4);
        unsigned long long mk = ((unsigned long long)hi << 32) | lo;
        mk |= 1ull | (1ull << cur) | (1ull << (cur - 1));
        LAS unsigned long long* selw = (LAS unsigned long long*)(lds + AT_SEL + wid * 64);
        if (e == 0) selw[tq] = mk;
        selmask = selw[qi];
    }

    {
        const half_t* Ks = P.KS + (size_t)bg * SEQ * 64; const half_t* Vs = P.VS + (size_t)bg * SEQ * 64;
        SmState S; sm_reset(S); bool seen = false; o[0] = (f32x16){0.f}; o[1] = (f32x16){0.f};
#define SLC_LOAD(t, sub) tile_dma(Ks + (size_t)(t) * 4096, nullptr, Vs + (size_t)(t) * 4096, sub, false, wid, lane)
#define SLC_COMP(t, buf) do { const bool rowsel = (selmask >> (t)) & 1ull; \
            if (__any(rowsel)) { f32x16 p0, p1, ci; \
                _Pragma("unroll") for (int r = 0; r < 16; ++r) ci[r] = rowsel ? S.negm[r] : -INFINITY;     \
                tile_qk<4>((buf) + AT_KB + koff, qf, ci, p0, p1); \
                if ((t) == cur) tile_emask(p0, p1, qrel - 4 * h, -1000); \
                tile_softmax_pv(p0, p1, (buf) + AT_VB + voff, o, S, !seen); seen = seen || rowsel; } } while (0)
        KV_STREAM(cur + 1, SLC_LOAD, SLC_COMP);
#undef SLC_LOAD
#undef SLC_COMP
        const float sc = g1 / xhalf_sum(S.l);
#pragma unroll
        for (int r = 0; r < 16; ++r) { acc[0][r] += sc * o[0][r]; acc[1][r] += sc * o[1][r]; }
    }
    {
        const int t0 = (cur >= 8) ? cur - 8 : 0;
        const half_t* Kw = P.KW + ((size_t)bg * SEQ + (size_t)t0 * 64) * 64; const half_t* Vw = P.VW + ((size_t)bg * SEQ + (size_t)t0 * 64) * 64;
        SmState S; sm_reset(S); o[0] = (f32x16){0.f}; o[1] = (f32x16){0.f};
#define WIN_LOAD(i, sub) tile_dma(Kw + (size_t)(i) * 4096, nullptr, Vw + (size_t)(i) * 4096, sub, false, wid, lane)
#define WIN_COMP(i, buf) do { const int t = t0 + (i); f32x16 p0, p1; \
            tile_qk<4>((buf) + AT_KB + koff, qf, S.negm, p0, p1); \
            if (t == cur) tile_emask(p0, p1, qrel - 4 * h, -1000); \
            else if (t == cur - 8) tile_emask(p0, p1, 1000, qrel + 1 - 4 * h); \
            tile_softmax_pv(p0, p1, (buf) + AT_VB + voff, o, S, (i) == 0); } while (0)
        KV_STREAM(cur - t0 + 1, WIN_LOAD, WIN_COMP);
#undef WIN_LOAD
#undef WIN_COMP
        const float sc = g2 / xhalf_sum(S.l);
#pragma unroll
        for (int r = 0; r < 16; ++r) { acc[0][r] += sc * o[0][r]; acc[1][r] += sc * o[1][r]; }
    }
    float ss = 0.f;
    half_t* yrow = P.Y + trow * DM + 512 + head * 64;
#pragma unroll
    for (int db = 0; db < 2; ++db)
#pragma unroll
        for (int c = 0; c < 4; ++c) { const float a0 = acc[db][4 * c], a1 = acc[db][4 * c + 1], a2 = acc[db][4 * c + 2], a3 = acc[db][4 * c + 3];
            ss += (a0 * a0 + a1 * a1) + (a2 * a2 + a3 * a3);
            *(u32x2*)(yrow + db * 32 + 8 * c + 4 * h) = (u32x2){pk_rne(a0, a1), pk_rne(a2, a3)}; }
    ss = xhalf_sum(ss);
    if (h == 0) P.SSN[trow * 8 + head] = ss;
}

struct Args { const float* in[24]; float* out; unsigned char* ws; int ph_lo, ph_hi, li, pad; };

template <bool GAIN, class SrcFn>
__device__ __forceinline__ void conv_wt(const float* W, int Ksrc, int Nsrc, const float* gain, const float* gain2, int ksplit, half_t* WT, int Ndst, int Kdst, SrcFn src, LAS float* scr, int gw, int ngw, int lane) {
    const int nblk = Ndst / 32, nitems = nblk * (Kdst / 64);
    for (int it = gw; it < nitems; it += ngw) {
        const int kb = it / nblk, nb = it % nblk, k0 = 64 * kb, n0 = 32 * nb;
        const int sc = src(n0 + (lane & 31)), scc = sc >= 0 ? sc : 0, c = lane & 7;
        float w[32];
#pragma unroll
        for (int i = 0; i < 32; ++i) { const int k = k0 + 2 * i + (lane >> 5), kc = k < Ksrc ? k : Ksrc - 1; w[i] = W[(size_t)kc * Nsrc + scc]; }
        f32x4 g0 = (f32x4){1.f, 1.f, 1.f, 1.f}, g1 = g0;
        if constexpr (GAIN) { int kq = k0 + 8 * c; kq = kq < Ksrc ? kq : Ksrc - 8; const float* gp = (k0 >= ksplit) ? gain2 + (kq - ksplit) : gain + kq; g0 = *(const f32x4*)gp; g1 = *(const f32x4*)(gp + 4); }
#pragma unroll
        for (int i = 0; i < 32; ++i) { const int kk = 2 * i + (lane >> 5); scr[kk * 33 + (lane & 31)] = (sc >= 0 && k0 + kk < Ksrc) ? w[i] : 0.f; }
        asm volatile("s_waitcnt lgkmcnt(0)" ::: "memory");
        const float gs[8] = {g0[0], g0[1], g0[2], g0[3], g1[0], g1[1], g1[2], g1[3]};
#pragma unroll
        for (int jj = 0; jj < 4; ++jj) { const int n = (lane >> 3) + 8 * jj; const LAS float* s = scr + (8 * c) * 33 + n; float v[8];
#pragma unroll
            for (int e = 0; e < 8; ++e) v[e] = s[e * 33] * gs[e];
            *(u32x4*)(WT + (size_t)(n0 + n) * Kdst + k0 + 8 * c) = pk8(v); }
        asm volatile("s_waitcnt lgkmcnt(0)" ::: "memory");
    }
}
__device__ __forceinline__ int src_win(int n) {
    const int t = n >> 8, c = n & 255;
    if (t == 0) return c;
    if (t == 1) { if (c < 128) return 256 + c;
                  if (c < 160) { const int p = c - 128; return 384 + (p >> 1) + 16 * (p & 1); }
                  if (c < 184) return 1696 + (c - 160);
                  return -1; }
    if (t < 4) { const int hd = (t - 2) * 4 + (c >> 6), p = c & 63; const int d = (p < 16) ? (p >> 1) + 8 * (p & 1) : p; return 416 + hd * 64 + d; }
    const int br = (t - 4) * 2 + (c >> 7), g = (c >> 6) & 1, p = c & 63;
    const bool roped = (br == 2 || br == 4);
    const int d = (roped && p < 16) ? (p >> 1) + 8 * (p & 1) : p;
    return 928 + br * 128 + g * 64 + d;
}
__device__ __forceinline__ int src_wuq(int n) { const int hd = n / 96, p = n % 96; return (p < 64) ? hd * 96 + p : hd * 96 + 64 + ((p - 64) >> 1) + 16 * ((p - 64) & 1); }
__device__ __forceinline__ int src_wukv(int n) { return (n < 512) ? (n >> 6) * 128 + (n & 63) : ((n - 512) >> 6) * 128 + 64 + (n & 63); }

#define PH_IDS() int tid_ = threadIdx.x; asm volatile("" : "+v"(tid_)); const int tid = tid_, lane = tid & 63, wid = __builtin_amdgcn_readfirstlane(tid >> 6); \
    const int G = gridDim.x, gt = blockIdx.x * 512 + tid, ngt = G * 512, gw = blockIdx.x * 8 + wid, ngw = G * 8; (void)lane; (void)gt; (void)ngt; (void)gw; (void)ngw; (void)G
#define WSP(T, off) ((T*)(ws + (off)))


__global__ void __launch_bounds__(512, 2) hymba_fwd(Args args) {
    extern __shared__ __attribute__((aligned(16))) unsigned char lds_raw[];
    LAS unsigned char* lds = (LAS unsigned char*)lds_raw;
    unsigned char* ws = args.ws;
    volatile LAS unsigned* MISC = (volatile LAS unsigned*)(lds + LDS_MISC);
    if (threadIdx.x < 16) MISC[threadIdx.x] = 0u;
    __syncthreads();
    XcdBarrier bar = xcd_barrier_post(WSP(unsigned, WS_CTL) + CW_BAR + args.li * XCD_BAR_WORDS, MISC + 8);
#if defined(DBG_STAMP)
#define STAMP_FIRST() STAMP(0)
#define STAMP(k) do { if (blockIdx.x == 0 && threadIdx.x == 0) ((unsigned long long*)(WSP(unsigned, WS_CTL) + 160))[k] = __builtin_amdgcn_s_memrealtime(); } while (0)
#else
#define STAMP_FIRST() do { } while (0)
#define STAMP(k) do { } while (0)
#endif
    const int lo = args.ph_lo, hi = args.ph_hi;
    STAMP_FIRST();
#define IN(k) (lo <= (k) && (k) < hi)
#define REP_BEGIN(k) for (int rep_ = 0; rep_ < ((k) == REPEAT_PHASE ? 2 : 1); ++rep_) {
#define REP_END(k) if ((k) == REPEAT_PHASE && rep_ == 0) xcd_barrier(bar); }
#define SEAM(k) do { if (IN(k) && IN((k) + 1 + ((k) == 4))) xcd_barrier(bar); STAMP((k) + 1); } while (0)

    if (IN(0)) { REP_BEGIN(0)
        PH_IDS();
        LAS float* scr = (LAS float*)(lds + wid * 8448);
        const int BIG = 1 << 30;
        for (int step_ = 0; step_ < 2; ++step_) {
        if (((step_ ^ wid) & 1) == 0) {
        conv_wt<true>(args.in[2], 1024, IN_COLS, args.in[1], nullptr, BIG, WSP(half_t, WS_WIN), NIN, 1024, [](int n) { return src_win(n); }, scr, (gw + ngw - 0 % ngw) % ngw, ngw, lane);
        conv_wt<true>(args.in[4], 256, 768, args.in[3], nullptr, BIG, WSP(half_t, WS_WUQ), 768, 256, [](int n) { return src_wuq(n); }, scr, (gw + ngw - 896 % ngw) % ngw, ngw, lane);
        conv_wt<true>(args.in[6], 128, 1024, args.in[5], nullptr, BIG, WSP(half_t, WS_WUKV), 1024, 256, [](int n) { return src_wukv(n); }, scr, (gw + ngw - 992 % ngw) % ngw, ngw, lane);
        conv_wt<false>(args.in[8], 2048, 128, nullptr, nullptr, BIG, WSP(half_t, WS_WC1), 256, 2048, [](int n) { return n < 128 ? n : -1; }, scr, (gw + ngw - 1120 % ngw) % ngw, ngw, lane);
        conv_wt<false>(args.in[13], 2048, 128, nullptr, nullptr, BIG, WSP(half_t, WS_WC1) + 256 * 2048, 256, 2048, [](int n) { return n < 128 ? n : -1; }, scr, (gw + ngw - 1376 % ngw) % ngw, ngw, lane);
        conv_wt<true>(args.in[19], 1024, 1024, args.in[17], args.in[18], 512, WSP(half_t, WS_WO), 1024, 1024, [](int n) { return n; }, scr, (gw + ngw - 1632 % ngw) % ngw, ngw, lane);
        conv_wt<true>(args.in[21], 1024, 4096, args.in[20], nullptr, BIG, WSP(half_t, WS_WUP), 4096, 1024, [](int n) { return n; }, scr, (gw + ngw - 2144 % ngw) % ngw, ngw, lane);
        conv_wt<false>(args.in[22], 4096, 1024, nullptr, nullptr, BIG, WSP(half_t, WS_WDN), 1024, 4096, [](int n) { return n; }, scr, (gw + ngw - 4192 % ngw) % ngw, ngw, lane);
        { float2* ROPEM = WSP(float2, WS_ROPEM); float2* ROPEN = WSP(float2, WS_ROPEN);
          for (int it = gt; it < SEQ * 16; it += ngt) { const int pos = it >> 4, i = it & 15; const float inv = expf(-logf(500000.f) * (float)(2 * i) / 32.f), a = (float)pos * inv; ROPEM[it] = make_float2(cosf(a), sinf(a)); }
          for (int it = gt; it < SEQ * 8; it += ngt) { const int pos = it >> 3, i = it & 7; const float inv = expf(-logf(500000.f) * (float)(2 * i) / 16.f), a = (float)pos * inv; ROPEN[it] = make_float2(cosf(a), sinf(a)); } }
        for (int o = (gw & 7) == 0 ? (gw >> 3) : 256; o < 256; o += (ngw >> 3)) { const int kv = o >> 7, jj = o & 127; const float* pe = args.in[kv ? 12 : 7]; const float* w1 = args.in[kv ? 13 : 8]; const float* b1 = args.in[kv ? 14 : 9];
            float s = 0.f; for (int k = lane; k < 2048; k += 64) s += pe[k] * w1[(size_t)k * 128 + jj];
            s = wave_sum(s); if (lane == 0) WSP(float, WS_B1P)[o] = b1[jj] + s; }
        } else
        { const float* x = args.in[0]; half_t* XH = WSP(half_t, WS_XH); float* RS1 = WSP(float, WS_RS1); constexpr int XR = 8;
          for (int r0 = gw * XR; r0 < MROWS; r0 += ngw * XR) {
            f32x4 v[XR][4]; float s[XR];
#pragma unroll
            for (int rr = 0; rr < XR; ++rr) { const f32x4* xr = (const f32x4*)(x + (size_t)(r0 + rr) * DM) + lane;
#pragma unroll
                for (int jv = 0; jv < 4; ++jv) v[rr][jv] = __builtin_nontemporal_load(xr + 64 * jv); }
#pragma unroll
            for (int rr = 0; rr < XR; ++rr) { float t = 0.f;
#pragma unroll
                for (int jv = 0; jv < 4; ++jv) t += (v[rr][jv][0] * v[rr][jv][0] + v[rr][jv][1] * v[rr][jv][1]) + (v[rr][jv][2] * v[rr][jv][2] + v[rr][jv][3] * v[rr][jv][3]);
                s[rr] = t; }
#pragma unroll
            for (int o = 1; o < 64; o <<= 1) {
#pragma unroll
                for (int rr = 0; rr < XR; ++rr) s[rr] += __shfl_xor(s[rr], o); }
#pragma unroll
            for (int rr = 0; rr < XR; ++rr) { u32x2* o8 = (u32x2*)(XH + (size_t)(r0 + rr) * DM) + lane;
#pragma unroll
                for (int jv = 0; jv < 4; ++jv) o8[64 * jv] = (u32x2){pk_rne(v[rr][jv][0], v[rr][jv][1]), pk_rne(v[rr][jv][2], v[rr][jv][3])};
                if (lane == 0) RS1[r0 + rr] = __builtin_amdgcn_rsqf(s[rr] * (1.f / DM) + NORM_EPS); }
          } }
        }
    REP_END(0) }
    SEAM(0);
    if (IN(1)) { REP_BEGIN(1)
        pg8::Gemm g{WSP(half_t, WS_XH), WSP(half_t, WS_WIN), 1024, 1024, 1024}; pg8::StaticOrder S; S.init(MROWS, NIN, gridDim.x, (int)blockIdx.x, 1024, 1024);
        EpiIn E{WSP(float, WS_RS1), WSP(half_t, WS_CQ), WSP(half_t, WS_T1), WSP(half_t, WS_KPE), WSP(float, WS_GATE), WSP(float, WS_SSQ), WSP(float, WS_SSKV), WSP(half_t, WS_QN), WSP(half_t, WS_KVT), WSP(float2, WS_ROPEM), WSP(float2, WS_ROPEN)};
        pg8::gemm_phase(lds, g, S, E);
    REP_END(1) }
    SEAM(1);
    if (IN(2)) { REP_BEGIN(2)
        { pg8::Gemm g{WSP(half_t, WS_CQ), WSP(half_t, WS_WUQ), 256, 256, 256}; pg8::StaticOrder S; S.init(MROWS, 768, gridDim.x, (int)blockIdx.x, 256, 256); EpiUq E{WSP(float, WS_SSQ), WSP(half_t, WS_QM), WSP(float2, WS_ROPEM)}; pg8::gemm_phase(lds, g, S, E); }
        { pg8::Gemm g{WSP(half_t, WS_T1), WSP(half_t, WS_WUKV), 256, 256, 256}; pg8::StaticOrder S; S.init(MROWS, 1024, gridDim.x, (int)blockIdx.x, 256, 256); EpiUkv E{WSP(float, WS_SSKV), WSP(half_t, WS_KNM), WSP(half_t, WS_VM)}; pg8::gemm_phase(lds, g, S, E); }
        { pg8::Gemm g{WSP(half_t, WS_KVT), WSP(half_t, WS_WC1), 512, 1024, 2048}; pg8::Cmp1Order S{(int)gridDim.x, (int)blockIdx.x}; EpiC1 E{WSP(float, WS_HIDP)}; pg8::gemm_phase(lds, g, S, E); }
    REP_END(2) }
    SEAM(2);
    if (IN(3)) { REP_BEGIN(3)
        PH_IDS();
        const float* B1P = WSP(float, WS_B1P); const float* HIDP = WSP(float, WS_HIDP); const float2* ROPEN = WSP(float2, WS_ROPEN);
        LAS float* w2s = (LAS float*)lds;
        LAS float* hl = (LAS float*)(lds + 65536 + wid * 4096);
        for (int i = tid; i < 2 * 128 * 64; i += 512) { const int kv = i >> 13, k = (i >> 6) & 127, p = i & 63; const int dsrc = (kv == 0 && p < 16) ? (p >> 1) + 8 * (p & 1) : p;
            w2s[i] = args.in[kv ? 15 : 10][k * 64 + dsrc]; }
        __syncthreads();
        for (int it = gw; it < 2 * 32 * 32; it += ngw) {
            const int kv = it >> 10, slab = (it >> 5) & 31, n0 = (it & 31) * 8;
            const float* b2 = args.in[kv ? 16 : 11];
            float hv[8][2][4];
#pragma unroll
            for (int rr = 0; rr < 8; ++rr)
#pragma unroll
                for (int c = 0; c < 2; ++c)
#pragma unroll
                    for (int ch = 0; ch < 4; ++ch) hv[rr][c][ch] = HIDP[((size_t)((kv * 32 + slab) * 4 + ch) * 256 + n0 + rr) * 128 + lane + 64 * c];
#pragma unroll
            for (int rr = 0; rr < 8; ++rr)
#pragma unroll
                for (int c = 0; c < 2; ++c) { const int col = lane + 64 * c; const float s = B1P[kv * 128 + col] + ((hv[rr][c][0] + hv[rr][c][1]) + (hv[rr][c][2] + hv[rr][c][3]));
                    const float z = 0.7978845608028654f * (s + 0.044715f * s * s * s), th = 1.f - 2.f / (1.f + __expf(2.f * z));
                    hl[rr * 128 + col] = 0.5f * s * (1.f + th); }
            asm volatile("s_waitcnt lgkmcnt(0)" ::: "memory");
            const int dsrc = (kv == 0 && lane < 16) ? (lane >> 1) + 8 * (lane & 1) : lane;
            float a[8];
#pragma unroll
            for (int rr = 0; rr < 8; ++rr) a[rr] = b2[dsrc];
            const LAS float* wk = w2s + kv * 8192 + lane;
#pragma unroll 4
            for (int k = 0; k < 128; k += 4) {
                const float w0 = wk[k * 64], w1 = wk[(k + 1) * 64], w2v = wk[(k + 2) * 64], w3 = wk[(k + 3) * 64];
#pragma unroll
                for (int rr = 0; rr < 8; ++rr) { const f32x4 hh = *(const LAS f32x4*)(hl + rr * 128 + k); a[rr] += (hh[0] * w0 + hh[1] * w1) + (hh[2] * w2v + hh[3] * w3); }
            }
            half_t* dst = (kv ? WSP(half_t, WS_VC) : WSP(half_t, WS_KC)) + (size_t)slab * 256 * 64;
#pragma unroll
            for (int rr = 0; rr < 8; ++rr) { const int n = n0 + rr; float v = a[rr];
                if (kv == 0) { const float pp = __shfl_xor(v, 1);
                    if (lane < 16) { const int e1 = 16 * n + 31; const float2 cs = ROPEN[(size_t)(e1 > 4095 ? 4095 : e1) * 8 + (lane >> 1)];
                        v = (lane & 1) ? (v * cs.x + pp * cs.y) : (v * cs.x - pp * cs.y); } }
                if (n >= 255) v = 0.f;
                dst[kv ? v_off(n, lane) : k_off(n, lane)] = (half_t)v; }
            asm volatile("s_waitcnt lgkmcnt(0)" ::: "memory");
        }
    REP_END(3) }
    SEAM(3);
    if (IN(4)) {
        half_t* KVT = WSP(half_t, WS_KVT);
        const AttnPtrs P{WSP(half_t, WS_QM), WSP(half_t, WS_KNM), WSP(half_t, WS_KPE), WSP(half_t, WS_VM), WSP(half_t, WS_QN), WSP(half_t, WS_KC), WSP(half_t, WS_VC),
                         KVT + 2 * KVT_STRIDE, KVT + 3 * KVT_STRIDE, KVT + 4 * KVT_STRIDE, KVT + 5 * KVT_STRIDE, WSP(float, WS_GATE), WSP(half_t, WS_Y), WSP(float, WS_SSM), WSP(float, WS_SSN)};
        volatile LAS int* qw = (volatile LAS int*)(lds + AT_QIDX);
        REP_BEGIN(4)
        unsigned* qhead = WSP(unsigned, WS_CTL) + CW_QHEAD + 64 * rep_;
        for (;;) {
            if (threadIdx.x == 0) *qw = (int)__hip_atomic_fetch_add(qhead, 1u, __ATOMIC_RELAXED, __HIP_MEMORY_SCOPE_AGENT);
            __syncthreads();
            const int qi = __builtin_amdgcn_readfirstlane(*qw);
            __syncthreads();
            if (qi >= 4096) break;
            const int L = qi >> 8, r = qi & 255;
#ifdef REP_FILTER
            if (rep_ == 1 && ((REP_FILTER == 1) != (r < 128))) continue;
#endif
            if (r < 128) { if (rep_ == 1) mla_unit<ABL>(P, r, 15 - L, lds, true); else mla_unit<0>(P, r, 15 - L, lds); }
            else { const int r2 = r - 128; nsa_unit(P, r2 & 31, 63 - 4 * L - (r2 >> 5), lds); }
        }
        REP_END(4)
    }
    SEAM(4);
    if (IN(6)) { REP_BEGIN(6) pg8::Gemm g{WSP(half_t, WS_Y), WSP(half_t, WS_WO), 1024, 1024, 1024}; pg8::StaticOrder S; S.init(MROWS, 1024, gridDim.x, (int)blockIdx.x, 1024, 1024); EpiWo E{WSP(half_t, WS_XH), WSP(half_t, WS_H1), WSP(float, WS_SS2), WSP(float, WS_SSM), WSP(float, WS_SSN), (LAS float*)(lds + LDS_RED)}; pg8::gemm_phase<EpiWo, pg8::StaticOrder, true>(lds, g, S, E); REP_END(6) }
    SEAM(6);
    if (IN(7)) { REP_BEGIN(7) pg8::Gemm g{WSP(half_t, WS_H1), WSP(half_t, WS_WUP), 1024, 1024, 1024}; pg8::StaticOrder S; S.init(MROWS, DFF, gridDim.x, (int)blockIdx.x, 1024, 1024); EpiUp E{WSP(float, WS_SS2), WSP(half_t, WS_A2)}; pg8::gemm_phase(lds, g, S, E); REP_END(7) }
    SEAM(7);
    if (IN(8)) { REP_BEGIN(8) pg8::Gemm g{WSP(half_t, WS_A2), WSP(half_t, WS_WDN), 4096, 4096, 4096}; pg8::StaticOrder S; S.init(MROWS, 1024, gridDim.x, (int)blockIdx.x, 4096, 4096); EpiDn E{WSP(half_t, WS_H1), WSP(half_t, WS_H2), WSP(float, WS_SS3), (LAS float*)(lds + LDS_RED)}; pg8::gemm_phase(lds, g, S, E); REP_END(8) }
    SEAM(8);
    if (IN(9)) { REP_BEGIN(9)
        PH_IDS();
        const float* gf = args.in[23]; const float* SS3 = WSP(float, WS_SS3); const half_t* H2 = WSP(half_t, WS_H2);
        const f32x4 ga0 = *(const f32x4*)(gf + lane * 8), gb0 = *(const f32x4*)(gf + lane * 8 + 4), ga1 = *(const f32x4*)(gf + 512 + lane * 8), gb1 = *(const f32x4*)(gf + 512 + lane * 8 + 4);
        for (int r0 = gw * 4; r0 < MROWS; r0 += ngw * 4) {
            u32x4 hv[4][2]; float rs[4];
#pragma unroll
            for (int rr = 0; rr < 4; ++rr) { const u32x4* hr = (const u32x4*)(H2 + (size_t)(r0 + rr) * DM) + lane; hv[rr][0] = hr[0]; hv[rr][1] = hr[64]; rs[rr] = __builtin_amdgcn_rsqf(sum4(*(const f32x4*)(SS3 + (size_t)(r0 + rr) * 4)) * (1.f / 1024.f) + NORM_EPS); }
#pragma unroll
            for (int rr = 0; rr < 4; ++rr) { f32x4* orow = (f32x4*)(args.out + (size_t)(r0 + rr) * DM); float v[8];
                unpk8(hv[rr][0], v);
                orow[lane * 2] = (f32x4){v[0] * rs[rr] * ga0[0], v[1] * rs[rr] * ga0[1], v[2] * rs[rr] * ga0[2], v[3] * rs[rr] * ga0[3]};
                orow[lane * 2 + 1] = (f32x4){v[4] * rs[rr] * gb0[0], v[5] * rs[rr] * gb0[1], v[6] * rs[rr] * gb0[2], v[7] * rs[rr] * gb0[3]};
                unpk8(hv[rr][1], v);
                orow[128 + lane * 2] = (f32x4){v[0] * rs[rr] * ga1[0], v[1] * rs[rr] * ga1[1], v[2] * rs[rr] * ga1[2], v[3] * rs[rr] * ga1[3]};
                orow[128 + lane * 2 + 1] = (f32x4){v[4] * rs[rr] * gb1[0], v[5] * rs[rr] * gb1[1], v[6] * rs[rr] * gb1[2], v[7] * rs[rr] * gb1[3]}; }
        }
    REP_END(9) }
    STAMP(10);
#undef IN
#undef SEAM
}

#if DBG_CHECK
constexpr int CW_DBG = 96;
__device__ __forceinline__ void dbg_flag(unsigned* ctl, int id, float got, float ref) {
    const float d = fabsf(got - ref);
    if (!(d <= 0.03f + 0.03f * fabsf(ref))) atomicOr(ctl + CW_DBG, 1u << id);
}
__device__ __forceinline__ float h2f(const half_t* p) { return (float)(*p); }
__device__ float dbg_rope_cs(int pos, int i, int dim, bool want_sin) { const float inv = expf(-logf(500000.f) * (float)(2 * i) / (float)dim), a = (float)pos * inv; return want_sin ? sinf(a) : cosf(a); }
__device__ float dbg_u(const Args& args, int row, int co, int lane) {
    const float* x = args.in[0] + (size_t)row * DM; const float* g = args.in[1]; const float* w = args.in[2];
    float ss = 0.f, acc = 0.f;
    for (int k = lane; k < DM; k += 64) { const float xv = x[k]; ss += xv * xv; acc += xv * g[k] * w[(size_t)k * IN_COLS + co]; }
    ss = wave_sum(ss); acc = wave_sum(acc);
    return acc * (1.f / sqrtf(ss / DM + NORM_EPS));
}
__device__ const int dbgt_0_dbg_rows[4] = {0, 4096 + 6, 30000, 65535};
__device__ const int dbgt_1_cs[3] = {0, 77, 255};
__device__ const int dbgt_2_cs[2] = {5, 127};
__device__ const int dbgt_3_ps[4] = {0, 1, 14, 31};
__device__ const int dbgt_4_is[3] = {0, 13, 23};
__device__ const int dbgt_5_hs[4] = {0, 3, 5, 7};
__device__ const int dbgt_6_ps[4] = {0, 1, 14, 40};
__device__ const int dbgt_7_brs[7] = {0, 1, 2, 2, 3, 4, 5};
__device__ const int dbgt_8_gs[7] = {0, 1, 0, 1, 0, 1, 1};
__device__ const int dbgt_9_ps[7] = {3, 20, 1, 50, 9, 14, 63};
__device__ const int dbgt_10_hs[4] = {0, 2, 5, 7};
__device__ const int dbgt_11_ps[4] = {3, 64, 77, 95};
__device__ const int dbgt_12_slabs[3] = {0, 17, 31};
__device__ const int dbgt_13_ns[3] = {0, 100, 254};
__device__ const int dbgt_14_ps[4] = {0, 1, 15, 40};
__device__ const int dbgt_15_bs[5] = {0, 0, 5, 15, 9};
__device__ const int dbgt_16_hs[5] = {0, 3, 7, 2, 5};
__device__ const int dbgt_17_qs[5] = {0, 100, 2047, 4095, 1234};
__device__ const int dbgt_18_bs[6] = {0, 3, 7, 15, 11, 2};
__device__ const int dbgt_19_gs[6] = {0, 1, 0, 1, 1, 0};
__device__ const int dbgt_20_hhs[6] = {0, 2, 3, 1, 0, 2};
__device__ const int dbgt_21_qs[6] = {5, 700, 1030, 4095, 2500, 3071};
__device__ const int dbgt_22_dd[3] = {0, 33, 63};
__device__ const int dbgt_23_c4[4] = {0, 1300, 2777, 4095};
__device__ const int dbgt_24_cols[4] = {0, 300, 777, 1023};
__device__ const int dbgt_25_cc[6] = {768, 896, 800, 776, 775, 1023};
__global__ void __launch_bounds__(512) dbg_checks_a(Args args) {
    extern __shared__ __attribute__((aligned(16))) unsigned char lds_raw[]; LAS unsigned char* lds = (LAS unsigned char*)lds_raw;
    unsigned char* ws = args.ws; unsigned* ctl = WSP(unsigned, WS_CTL);
    const int lane = threadIdx.x & 63, wid = threadIdx.x >> 6;
    const int* rows = dbgt_0_dbg_rows;
    const half_t* XH = WSP(half_t, WS_XH);
    if (blockIdx.x == 0) {
        if (wid == 0) for (int s = 0; s < 4; ++s) { const int r = rows[s]; const float* x = args.in[0] + (size_t)r * DM; float ss = 0.f; for (int k = lane; k < DM; k += 64) ss += x[k] * x[k]; ss = wave_sum(ss);
            if (lane == 0) { dbg_flag(ctl, 1, WSP(float, WS_RS1)[r], 1.f / sqrtf(ss / DM + NORM_EPS)); dbg_flag(ctl, 1, h2f(XH + (size_t)r * DM + 517), x[517]); } }
        if (wid == 1) for (int s = 0; s < 4; ++s) { const int r = rows[s], pos = r & 4095, b = r >> 12;
            { const int* cs = dbgt_1_cs; for (int i = 0; i < 3; ++i) { const float u = dbg_u(args, r, cs[i], lane); if (lane == 0) dbg_flag(ctl, 2, h2f(WSP(half_t, WS_CQ) + (size_t)r * 256 + cs[i]), u); } }
            { const int* cs = dbgt_2_cs; for (int i = 0; i < 2; ++i) { const float u = dbg_u(args, r, 256 + cs[i], lane); if (lane == 0) dbg_flag(ctl, 3, h2f(WSP(half_t, WS_T1) + (size_t)r * 256 + cs[i]), u); } }
            { const int* ps = dbgt_3_ps; for (int i = 0; i < 4; ++i) { const int p = ps[i], pr = p >> 1; const float x1 = dbg_u(args, r, 384 + pr, lane), x2 = dbg_u(args, r, 384 + pr + 16, lane);
                const float c = dbg_rope_cs(pos, pr, 32, false), sn = dbg_rope_cs(pos, pr, 32, true); const float ref = (p & 1) ? (x2 * c + x1 * sn) : (x1 * c - x2 * sn);
                if (lane == 0) dbg_flag(ctl, 4, h2f(WSP(half_t, WS_KPE) + (size_t)b * SEQ * 32 + kpe_off(pos, p)), ref); } }
            { const int* is = dbgt_4_is; for (int i = 0; i < 3; ++i) { const float u = dbg_u(args, r, 1696 + is[i], lane); if (lane == 0) dbg_flag(ctl, 5, WSP(float, WS_GATE)[(size_t)r * 24 + is[i]], 1.f / (1.f + expf(-u))); } }
            { const int* hs = dbgt_5_hs; const int* ps = dbgt_6_ps; for (int i = 0; i < 4; ++i) { const int hd = hs[i], p = ps[i]; float ref;
                if (p < 16) { const int pr = p >> 1; const float x1 = dbg_u(args, r, 416 + hd * 64 + pr, lane), x2 = dbg_u(args, r, 416 + hd * 64 + pr + 8, lane);
                    const float c = dbg_rope_cs(pos, pr, 16, false), sn = dbg_rope_cs(pos, pr, 16, true); ref = (p & 1) ? (x2 * c + x1 * sn) : (x1 * c - x2 * sn); }
                else ref = dbg_u(args, r, 416 + hd * 64 + p, lane);
                if (lane == 0) dbg_flag(ctl, 6, h2f(WSP(half_t, WS_QN) + (size_t)r * 512 + hd * 64 + p), ref * QS_N); } }
            { const int* brs = dbgt_7_brs; const int* gs = dbgt_8_gs; const int* ps = dbgt_9_ps;
              for (int i = 0; i < 7; ++i) { const int br = brs[i], g = gs[i], p = ps[i]; const int base = 928 + br * 128 + g * 64; float ref;
                if ((br == 2 || br == 4) && p < 16) { const int pr = p >> 1; const float x1 = dbg_u(args, r, base + pr, lane), x2 = dbg_u(args, r, base + pr + 8, lane);
                    const float c = dbg_rope_cs(pos, pr, 16, false), sn = dbg_rope_cs(pos, pr, 16, true); ref = (p & 1) ? (x2 * c + x1 * sn) : (x1 * c - x2 * sn); }
                else ref = dbg_u(args, r, base + p, lane);
                if (lane == 0) dbg_flag(ctl, 7, h2f(WSP(half_t, WS_KVT) + (size_t)br * KVT_STRIDE + (size_t)(b * 2 + g) * SEQ * 64 + (br < 2 ? (size_t)pos * 64 + p : ((br & 1) ? v_off(pos, p) : k_off(pos, p)))), ref); } }
        }
        if (wid == 2) for (int s = 0; s < 4; ++s) { const int r = rows[s], pos = r & 4095, b = r >> 12;
            const half_t* cq = WSP(half_t, WS_CQ) + (size_t)r * 256; const half_t* t1 = WSP(half_t, WS_T1) + (size_t)r * 256;
            float sq = 0.f, skv = 0.f; for (int k = lane; k < 256; k += 64) { const float a = h2f(cq + k); sq += a * a; } for (int k = lane; k < 128; k += 64) { const float a = h2f(t1 + k); skv += a * a; }
            sq = wave_sum(sq); skv = wave_sum(skv); const float rq = 1.f / sqrtf(sq / 256.f + NORM_EPS), rkv = 1.f / sqrtf(skv / 128.f + NORM_EPS);
            const int* hs = dbgt_10_hs; const int* ps = dbgt_11_ps;
            for (int i = 0; i < 4; ++i) { const int hd = hs[i], p = ps[i]; float ref;
                auto qcol = [&](int col) { float a = 0.f; for (int k = lane; k < 256; k += 64) a += h2f(cq + k) * args.in[3][k] * args.in[4][(size_t)k * 768 + col]; return wave_sum(a) * rq; };
                if (p < 64) ref = qcol(hd * 96 + p);
                else { const int pp = p - 64, pr = pp >> 1; const float x1 = qcol(hd * 96 + 64 + pr), x2 = qcol(hd * 96 + 64 + pr + 16);
                    const float c = dbg_rope_cs(pos, pr, 32, false), sn = dbg_rope_cs(pos, pr, 32, true); ref = (pp & 1) ? (x2 * c + x1 * sn) : (x1 * c - x2 * sn); }
                if (lane == 0) dbg_flag(ctl, 8, h2f(WSP(half_t, WS_QM) + (size_t)r * 768 + hd * 96 + p), ref * QS_M); }
            for (int i = 0; i < 4; ++i) { const int hd = hs[i], d = ps[i] & 63;
                auto kvcol = [&](int col) { float a = 0.f; for (int k = lane; k < 128; k += 64) a += h2f(t1 + k) * args.in[5][k] * args.in[6][(size_t)k * 1024 + col]; return wave_sum(a) * rkv; };
                const float kr = kvcol(hd * 128 + d), vr = kvcol(hd * 128 + 64 + d);
                if (lane == 0) { dbg_flag(ctl, 9, h2f(WSP(half_t, WS_KNM) + (size_t)(b * 8 + hd) * SEQ * 64 + k_off(pos, d)), kr); dbg_flag(ctl, 10, h2f(WSP(half_t, WS_VM) + (size_t)(b * 8 + hd) * SEQ * 64 + v_off(pos, d)), vr); } }
        }
        if (wid == 3 || wid == 4) { const int kv = wid - 3; const int* slabs = dbgt_12_slabs; const int* ns = dbgt_13_ns;
            LAS float* hid = (LAS float*)(lds + 65536 + kv * 1024);
            const float* pe = args.in[kv ? 12 : 7]; const float* w1 = args.in[kv ? 13 : 8]; const float* b1 = args.in[kv ? 14 : 9]; const float* w2 = args.in[kv ? 15 : 10]; const float* b2 = args.in[kv ? 16 : 11];
            for (int s = 0; s < 3; ++s) { const int slab = slabs[s], n = ns[s]; const half_t* tok = WSP(half_t, WS_KVT) + (size_t)kv * KVT_STRIDE + ((size_t)slab * SEQ + 16 * n) * 64;
                for (int jj = 0; jj < 2; ++jj) { const int j = lane + 64 * jj; float a = b1[j]; for (int k = 0; k < 2048; ++k) a += (h2f(tok + k) + pe[k]) * w1[(size_t)k * 128 + j];
                    const float z = 0.7978845608028654f * (a + 0.044715f * a * a * a); hid[j] = 0.5f * a * (1.f + tanhf(z)); }
                asm volatile("s_waitcnt lgkmcnt(0)" ::: "memory");
                float o = b2[lane]; for (int j = 0; j < 128; ++j) o += hid[j] * w2[j * 64 + lane];
                const int* ps = dbgt_14_ps;
                for (int i = 0; i < 4; ++i) { const int p = ps[i]; float ref;
                    if (kv == 0 && p < 16) { const int pr = p >> 1; const float x1 = __shfl(o, pr), x2 = __shfl(o, pr + 8); const int pos = 16 * n + 31;
                        const float c = dbg_rope_cs(pos, pr, 16, false), sn = dbg_rope_cs(pos, pr, 16, true); ref = (p & 1) ? (x2 * c + x1 * sn) : (x1 * c - x2 * sn); }
                    else ref = __shfl(o, p);
                    if (lane == 0) dbg_flag(ctl, 11 + kv, h2f((kv ? WSP(half_t, WS_VC) : WSP(half_t, WS_KC)) + (size_t)slab * 256 * 64 + (kv ? v_off(n, p) : k_off(n, p))), ref); }
                asm volatile("s_waitcnt lgkmcnt(0)" ::: "memory"); }
        }
        if (wid == 5) { const int* bs = dbgt_15_bs; const int* hs = dbgt_16_hs; const int* qs = dbgt_17_qs;
            for (int s = 0; s < 5; ++s) { const int b = bs[s], hd = hs[s], q = qs[s]; const size_t r = (size_t)b * SEQ + q;
                const half_t* qv = WSP(half_t, WS_QM) + r * 768 + hd * 96; const half_t* Kn = WSP(half_t, WS_KNM) + (size_t)(b * 8 + hd) * SEQ * 64; const half_t* Kp = WSP(half_t, WS_KPE) + (size_t)b * SEQ * 32; const half_t* V = WSP(half_t, WS_VM) + (size_t)(b * 8 + hd) * SEQ * 64;
                float mx = -1e30f;
                for (int k = lane; k <= q; k += 64) { float sc = 0.f; for (int d = 0; d < 64; ++d) sc += h2f(qv + d) * h2f(Kn + k_off(k, d)); for (int d = 0; d < 32; ++d) sc += h2f(qv + 64 + d) * h2f(Kp + kpe_off(k, d)); mx = fmaxf(mx, sc); }
                for (int o = 1; o < 64; o <<= 1) mx = fmaxf(mx, __shfl_xor(mx, o));
                float l = 0.f, o0 = 0.f, o1 = 0.f, o2 = 0.f;
                for (int k = lane; k <= q; k += 64) { float sc = 0.f; for (int d = 0; d < 64; ++d) sc += h2f(qv + d) * h2f(Kn + k_off(k, d)); for (int d = 0; d < 32; ++d) sc += h2f(qv + 64 + d) * h2f(Kp + kpe_off(k, d));
                    const float p = exp2f(sc - mx); l += p; o0 += p * h2f(V + v_off(k, 0)); o1 += p * h2f(V + v_off(k, 33)); o2 += p * h2f(V + v_off(k, 63)); }
                l = wave_sum(l); o0 = wave_sum(o0); o1 = wave_sum(o1); o2 = wave_sum(o2);
                if (lane == 0) { const half_t* y = WSP(half_t, WS_Y) + r * DM + hd * 64; dbg_flag(ctl, 13, h2f(y + 0), o0 / l); dbg_flag(ctl, 13, h2f(y + 33), o1 / l); dbg_flag(ctl, 13, h2f(y + 63), o2 / l); } }
        }
        if (wid == 6 || wid == 7) { const int* bs = dbgt_18_bs; const int* gs = dbgt_19_gs; const int* hhs = dbgt_20_hhs; const int* qs = dbgt_21_qs;
            LAS float* pc = (LAS float*)(lds + 70000 + (wid - 6) * 8192);
            for (int s = wid - 6; s < 6; s += 2) { const int b = bs[s], g = gs[s], hh = hhs[s], q = qs[s], cur = q >> 6; const size_t r = (size_t)b * SEQ + q; const int bg = b * 2 + g;
                const half_t* Kc = WSP(half_t, WS_KC) + (size_t)bg * 256 * 64; const half_t* Vc = WSP(half_t, WS_VC) + (size_t)bg * 256 * 64;
                for (int h4 = 0; h4 < 4; ++h4) { const half_t* qv = WSP(half_t, WS_QN) + r * 512 + (g * 4 + h4) * 64;
                    float sc[4]; float mx = -1e30f;
                    for (int i = 0; i < 4; ++i) { const int n = lane + 64 * i; float a = -INFINITY; if (n < 255 && 16 * n + 31 <= q) { a = 0.f; for (int d = 0; d < 64; ++d) a += h2f(qv + d) * h2f(Kc + k_off(n, d)); } sc[i] = a; mx = fmaxf(mx, a); }
                    for (int o = 1; o < 64; o <<= 1) mx = fmaxf(mx, __shfl_xor(mx, o));
                    float l = 0.f; for (int i = 0; i < 4; ++i) { sc[i] = exp2f(sc[i] - mx); l += sc[i]; } l = wave_sum(l);
                    for (int i = 0; i < 4; ++i) pc[h4 * 256 + lane + 64 * i] = (l > 0.f) ? sc[i] / l : 0.f; }
                asm volatile("s_waitcnt lgkmcnt(0)" ::: "memory");
                { float imp = 0.f; const int jb = lane;
                  for (int n = 0; n < 255; ++n) { const int cs = 16 * n, ss0 = 64 * jb; const int lo2 = cs > ss0 ? cs : ss0, hi2 = (cs + 32 < ss0 + 64) ? cs + 32 : ss0 + 64; const int ov = hi2 - lo2; if (ov > 0) { const float w = (float)ov / 32.f; for (int h4 = 0; h4 < 4; ++h4) imp += pc[h4 * 256 + n] * w; } }
                  const bool forced = (jb == 0) || (jb == cur) || (jb == cur - 1), causal = jb * 64 <= q;
                  pc[1024 + jb] = forced ? 1e9f : (causal ? imp : -1e9f); }
                asm volatile("s_waitcnt lgkmcnt(0)" ::: "memory");
                if (lane == 0) { for (int jb = 0; jb < 64; ++jb) pc[1088 + jb] = 0.f; for (int it = 0; it < 16; ++it) { int best = -1; float bv = -INFINITY; for (int jb = 0; jb < 64; ++jb) if (pc[1088 + jb] == 0.f && pc[1024 + jb] > bv) { bv = pc[1024 + jb]; best = jb; } pc[1088 + best] = 1.f; } }
                asm volatile("s_waitcnt lgkmcnt(0)" ::: "memory");
                const half_t* qv = WSP(half_t, WS_QN) + r * 512 + (g * 4 + hh) * 64; const int* dd = dbgt_22_dd;
                float oc[3] = {0.f, 0.f, 0.f};
                for (int i = 0; i < 4; ++i) { const int n = lane + 64 * i; if (n < 255) { const float p = pc[hh * 256 + n]; for (int e = 0; e < 3; ++e) oc[e] += p * h2f(Vc + v_off(n, dd[e])); } }
                for (int e = 0; e < 3; ++e) oc[e] = wave_sum(oc[e]);
                float osw[2][3];
                for (int br = 0; br < 2; ++br) { const half_t* Kx = WSP(half_t, WS_KVT) + (size_t)(2 + 2 * br) * KVT_STRIDE + (size_t)bg * SEQ * 64; const half_t* Vx = WSP(half_t, WS_KVT) + (size_t)(3 + 2 * br) * KVT_STRIDE + (size_t)bg * SEQ * 64;
                    float mx = -1e30f;
                    for (int k = lane; k <= q; k += 64) { const bool ok = br ? (q - k < 512) : (pc[1088 + (k >> 6)] != 0.f); if (!ok) continue; float a = 0.f; for (int d = 0; d < 64; ++d) a += h2f(qv + d) * h2f(Kx + k_off(k, d)); mx = fmaxf(mx, a); }
                    for (int o = 1; o < 64; o <<= 1) mx = fmaxf(mx, __shfl_xor(mx, o));
                    float l = 0.f, a3[3] = {0.f, 0.f, 0.f};
                    for (int k = lane; k <= q; k += 64) { const bool ok = br ? (q - k < 512) : (pc[1088 + (k >> 6)] != 0.f); if (!ok) continue; float a = 0.f; for (int d = 0; d < 64; ++d) a += h2f(qv + d) * h2f(Kx + k_off(k, d));
                        const float p = exp2f(a - mx); l += p; for (int e = 0; e < 3; ++e) a3[e] += p * h2f(Vx + v_off(k, dd[e])); }
                    l = wave_sum(l); for (int e = 0; e < 3; ++e) osw[br][e] = wave_sum(a3[e]) / l; }
                if (lane == 0) { const float* gt = WSP(float, WS_GATE) + r * 24; const int head = g * 4 + hh; const float g0 = gt[head], g1 = gt[8 + head], g2 = gt[16 + head];
                    for (int e = 0; e < 3; ++e) dbg_flag(ctl, q < 1024 ? 14 : 15, h2f(WSP(half_t, WS_Y) + r * DM + 512 + head * 64 + dd[e]), g0 * oc[e] + g1 * osw[0][e] + g2 * osw[1][e]); }
                asm volatile("s_waitcnt lgkmcnt(0)" ::: "memory"); }
        }
    }
}
__global__ void __launch_bounds__(512) dbg_checks_b(Args args, int which) {
    unsigned char* ws = args.ws; unsigned* ctl = WSP(unsigned, WS_CTL);
    const int lane = threadIdx.x & 63, wid = threadIdx.x >> 6;
    const int* rows = dbgt_0_dbg_rows; const int* cols = dbgt_24_cols;
    if (blockIdx.x != 0 || wid >= 4) return;
    const int r = rows[wid];
    if (which == 6 && wid == 3) { const half_t* y = WSP(half_t, WS_Y) + (size_t)r * DM; const int* cc = dbgt_25_cc;
        for (int i = 0; i < 6; ++i) { const int c = cc[i]; float a = 0.f; for (int k = lane; k < DM; k += 64) a += h2f(y + k) * (k < 512 ? args.in[17][k] : args.in[18][k - 512]) * args.in[19][(size_t)k * DM + c];
            const float dot = wave_sum(a), xr = args.in[0][(size_t)r * DM + c], got = h2f(WSP(half_t, WS_H1) + (size_t)r * DM + c);
            if (lane == 0 && !(fabsf(got - (dot + xr)) <= 0.03f + 0.03f * fabsf(dot + xr))) atomicAdd(ctl + CW_DBG + 2, 1u << i); } }
    if (which == 6) { const half_t* y = WSP(half_t, WS_Y) + (size_t)r * DM;
        { float s0 = 0.f, s1 = 0.f; for (int k = lane; k < 512; k += 64) { const float a = h2f(y + k), b = h2f(y + 512 + k); s0 += a * a; s1 += b * b; } s0 = wave_sum(s0); s1 = wave_sum(s1);
          if (lane == 0) { dbg_flag(ctl, 20, s0 / 512.f, 1.f); dbg_flag(ctl, 21, s1 / 512.f, 1.f); } }
        { const int c = cols[wid], k = rows[wid] & 1023; if (lane == 0) dbg_flag(ctl, 22, 100.f * h2f(WSP(half_t, WS_WO) + (size_t)c * DM + k), 100.f * args.in[19][(size_t)k * DM + c] * (k < 512 ? args.in[17][k] : args.in[18][k - 512])); }
        for (int i = 0; i < 4; ++i) { const int c = cols[i]; float a = 0.f; for (int k = lane; k < DM; k += 64) a += h2f(y + k) * (k < 512 ? args.in[17][k] : args.in[18][k - 512]) * args.in[19][(size_t)k * DM + c];
            const float dot = wave_sum(a), xr = args.in[0][(size_t)r * DM + c], got = h2f(WSP(half_t, WS_H1) + (size_t)r * DM + c); a = dot + xr;
            if (lane == 0) { dbg_flag(ctl, 16, got, a);
                if ((wid == 0 && i == 0) || (wid == 3 && i == 3)) { int hcode = 9; auto near = [](float p, float q) { return fabsf(p - q) <= 0.03f + 0.03f * fabsf(q); };
                    if (near(got, dot + xr)) hcode = 1; else if (near(got, dot)) hcode = 2; else if (near(got, xr)) hcode = 3; else if (near(got, 2.f * xr + dot)) hcode = 4; else if (!(got == got)) hcode = 5; else if (near(got, 0.f)) hcode = 6;
                    atomicAdd(ctl + CW_DBG + 1, (unsigned)(wid == 0 ? 10 * hcode : hcode)); } } } }
    if (which == 7) { const half_t* h1 = WSP(half_t, WS_H1) + (size_t)r * DM; float ss = 0.f; for (int k = lane; k < DM; k += 64) { const float a = h2f(h1 + k); ss += a * a; } ss = wave_sum(ss); const float rs = 1.f / sqrtf(ss / DM + NORM_EPS);
        const int* c4 = dbgt_23_c4;
        for (int i = 0; i < 4; ++i) { const int c = c4[i]; float a = 0.f; for (int k = lane; k < DM; k += 64) a += h2f(h1 + k) * args.in[20][k] * args.in[21][(size_t)k * DFF + c];
            a = fmaxf(wave_sum(a) * rs, 0.f); if (lane == 0) dbg_flag(ctl, 17, h2f(WSP(half_t, WS_A2) + (size_t)r * DFF + c), a * a); } }
    if (which == 8) { const half_t* a2 = WSP(half_t, WS_A2) + (size_t)r * DFF;
        for (int i = 0; i < 4; ++i) { const int c = cols[i]; float a = 0.f; for (int k = lane; k < DFF; k += 64) a += h2f(a2 + k) * args.in[22][(size_t)k * DM + c];
            a = wave_sum(a) + h2f(WSP(half_t, WS_H1) + (size_t)r * DM + c); if (lane == 0) dbg_flag(ctl, 18, h2f(WSP(half_t, WS_H2) + (size_t)r * DM + c), a); } }
    if (which == 9) { const half_t* h2 = WSP(half_t, WS_H2) + (size_t)r * DM; float ss = 0.f; for (int k = lane; k < DM; k += 64) { const float a = h2f(h2 + k); ss += a * a; } ss = wave_sum(ss); const float rs = 1.f / sqrtf(ss / DM + NORM_EPS);
        for (int i = 0; i < 4; ++i) { const int c = cols[i]; if (lane == 0) dbg_flag(ctl, 19, args.out[(size_t)r * DM + c], h2f(h2 + c) * rs * args.in[23][c]); } }
}
__global__ void __launch_bounds__(512) dbg_fill(Args args) {
    unsigned char* ws = args.ws; unsigned* ctl = WSP(unsigned, WS_CTL);
#ifndef DBG_SKIP
#define DBG_SKIP 0
#endif
    const unsigned m = __hip_atomic_load(ctl + CW_DBG, __ATOMIC_RELAXED, __HIP_MEMORY_SCOPE_AGENT) & ~((1u << DBG_SKIP) - 1u);
#ifdef DBG_STAMP
    const unsigned long long* ts = (const unsigned long long*)(ctl + 160); (void)m;
    const int code = (int)((ts[DBG_T1B] - ts[DBG_T1A]) / 4000ull);
    const float vbig = (float)((ts[DBG_T2B] - ts[DBG_T2A]) / 100ull);
    if (blockIdx.x == 0 && threadIdx.x == 0) { args.out[(size_t)MROWS * DM - 1] = vbig; }
#elif defined(DBG_VALUE)
    const int code = (int)__hip_atomic_load(ctl + CW_DBG + 2, __ATOMIC_RELAXED, __HIP_MEMORY_SCOPE_AGENT); (void)m;
#else
    const int code = m ? __builtin_ctz(m) : 0;
#endif
    const float a = sqrtf((float)code);
#ifdef DBG_STAMP
    const size_t nfill = (size_t)MROWS * DM / 4 - 1;
    if (blockIdx.x == 0 && threadIdx.x == 1) { args.out[(size_t)MROWS * DM - 4] = a; args.out[(size_t)MROWS * DM - 3] = a; args.out[(size_t)MROWS * DM - 2] = a; }
#else
    const size_t nfill = (size_t)MROWS * DM / 4;
#endif
    for (size_t i = (size_t)blockIdx.x * 512 + threadIdx.x; i < nfill; i += (size_t)gridDim.x * 512) ((f32x4*)args.out)[i] = (f32x4){a, a, a, a};
}
#endif

extern "C" void kernel_launch(void* const* d_in, const int* in_sizes, int n_in, void* d_out, int out_size, void* d_ws, size_t ws_size, hipStream_t stream) {
    static int grid = 0;
    if (grid == 0) {
        if (n_in != 24 || out_size != MROWS * DM || ws_size < WS_END) { fprintf(stderr, "kernel_launch: unexpected problem (n_in %d, out %d, ws %zu)\n", n_in, out_size, ws_size); grid = -1; return; }
        int dev = 0, cus = 0, per_cu = 0;
        if (hipGetDevice(&dev) != hipSuccess || hipDeviceGetAttribute(&cus, hipDeviceAttributeMultiprocessorCount, dev) != hipSuccess) { grid = -1; return; }
        if (hipFuncSetAttribute((const void*)hymba_fwd, hipFuncAttributeMaxDynamicSharedMemorySize, LDS_BYTES) != hipSuccess) { fprintf(stderr, "kernel_launch: hipFuncSetAttribute failed\n"); grid = -1; return; }
        if (hipOccupancyMaxActiveBlocksPerMultiprocessor(&per_cu, (const void*)hymba_fwd, 512, LDS_BYTES) != hipSuccess || per_cu < 1) fprintf(stderr, "kernel_launch: occupancy query says %d\n", per_cu);
        (void)hipGetLastError();
        grid = cus;
#if DBG_CHECK
        (void)hipFuncSetAttribute((const void*)dbg_checks_a, hipFuncAttributeMaxDynamicSharedMemorySize, 98304);
#endif
    }
    if (grid < 0) return;
    (void)hipMemsetAsync((char*)d_ws + WS_CTL, 0, CTL_ZERO_BYTES, stream);
    Args a{};
    for (int i = 0; i < 24; ++i) a.in[i] = (const float*)d_in[i];
    a.out = (float*)d_out; a.ws = (unsigned char*)d_ws;
#if DBG_CHECK == 1
    a.ph_lo = 0; a.ph_hi = 5; a.li = 0; hipLaunchKernelGGL(hymba_fwd, dim3(grid), dim3(512), LDS_BYTES, stream, a);
    hipLaunchKernelGGL(dbg_checks_a, dim3(1), dim3(512), 98304, stream, a);
    hipLaunchKernelGGL(dbg_fill, dim3(1024), dim3(512), 0, stream, a);
#elif DBG_CHECK == 2
    a.ph_lo = 0; a.ph_hi = 7; a.li = 0; hipLaunchKernelGGL(hymba_fwd, dim3(grid), dim3(512), LDS_BYTES, stream, a);
    hipLaunchKernelGGL(dbg_checks_b, dim3(1), dim3(512), 0, stream, a, 6);
    a.ph_lo = 7; a.ph_hi = 8; a.li = 1; hipLaunchKernelGGL(hymba_fwd, dim3(grid), dim3(512), LDS_BYTES, stream, a);
    hipLaunchKernelGGL(dbg_checks_b, dim3(1), dim3(512), 0, stream, a, 7);
    a.ph_lo = 8; a.ph_hi = 9; a.li = 2; hipLaunchKernelGGL(hymba_fwd, dim3(grid), dim3(512), LDS_BYTES, stream, a);
    hipLaunchKernelGGL(dbg_checks_b, dim3(1), dim3(512), 0, stream, a, 8);
    a.ph_lo = 9; a.ph_hi = 10; a.li = 3; hipLaunchKernelGGL(hymba_fwd, dim3(grid), dim3(512), LDS_BYTES, stream, a);
    hipLaunchKernelGGL(dbg_checks_b, dim3(1), dim3(512), 0, stream, a, 9);
    hipLaunchKernelGGL(dbg_fill, dim3(1024), dim3(512), 0, stream, a);
#elif DBG_CHECK == 3
    a.ph_lo = 0; a.ph_hi = 10; a.li = 0; hipLaunchKernelGGL(hymba_fwd, dim3(grid), dim3(512), LDS_BYTES, stream, a);
    hipLaunchKernelGGL(dbg_fill, dim3(1024), dim3(512), 0, stream, a);
#elif MK_N_LAUNCHES == 1
    a.ph_lo = 0; a.ph_hi = 10; a.li = 0;
    hipLaunchKernelGGL(hymba_fwd, dim3(grid), dim3(512), LDS_BYTES, stream, a);
#else
    for (int p = 0; p < 10; ++p) { a.ph_lo = p; a.ph_hi = p + 1; a.li = p; hipLaunchKernelGGL(hymba_fwd, dim3(grid), dim3(512), LDS_BYTES, stream, a); }
#endif
}
```

```cpp
#include <hip/hip_runtime.h>
#include <cstdio>
#include <cstdint>

#ifndef DBG_CHECK
#define DBG_CHECK 0
#endif
#ifndef REPEAT_PHASE
#define REPEAT_PHASE -1
#endif
#ifndef ABL
#define ABL 0
#endif
#ifndef MK_N_LAUNCHES
#define MK_N_LAUNCHES 1
#endif

#define LAS __attribute__((address_space(3)))
typedef _Float16 half_t;
typedef _Float16 half8 __attribute__((ext_vector_type(8)));
typedef _Float16 half2v __attribute__((ext_vector_type(2)));
typedef float f32x4 __attribute__((ext_vector_type(4)));
typedef float f32x16 __attribute__((ext_vector_type(16)));
typedef unsigned u32x4 __attribute__((ext_vector_type(4)));
typedef unsigned u32x2 __attribute__((ext_vector_type(2)));
typedef int i32x4 __attribute__((ext_vector_type(4)));
typedef short v4i16 __attribute__((ext_vector_type(4)));

constexpr int BATCH = 16, SEQ = 4096, DM = 1024, MROWS = BATCH * SEQ;
constexpr int IN_COLS = 1720, NIN = 1792;
constexpr int DFF = 4096;
constexpr float NORM_EPS = 1e-6f;
constexpr float LOG2E = 1.4426950408889634f;
constexpr float QS_N = 0.125f * LOG2E;
constexpr float QS_M = 0.10206207261596577f * LOG2E;

constexpr size_t MiB = 1u << 20;
constexpr size_t WS_CTL = 0, CTL_ZERO_BYTES = 1 * MiB;
constexpr size_t WS_WUPQ = 23 * MiB;
constexpr size_t WS_WIN = 1 * MiB, WS_WUQ = 5 * MiB, WS_WUKV = 6 * MiB, WS_WC1 = 7 * MiB, WS_WO = 9 * MiB, WS_WUP = 11 * MiB, WS_WDN = 19 * MiB;
constexpr size_t WS_ROPEM = 27 * MiB, WS_ROPEN = 27 * MiB + 512 * 1024, WS_B1P = 27 * MiB + 768 * 1024;
constexpr size_t WS_KC = 28 * MiB, WS_VC = 29 * MiB;
constexpr size_t WS_PMAX = 30 * MiB, WS_COLS = 31 * MiB, WS_SCAL = 31 * MiB + 16384, WS_PSQO = 31 * MiB + 32768, WS_PSQU = 31 * MiB + 65536;
constexpr size_t WS_PMAXD = 30 * MiB + 512 * 1024, WS_DCOLS = 31 * MiB + 24576;
constexpr float H1Q_SIGMAS = 6.f;
constexpr size_t WS_RS1 = 32 * MiB, WS_SSQ = 33 * MiB, WS_SSKV = 34 * MiB, WS_SSM = 35 * MiB, WS_SSN = 37 * MiB, WS_SS2 = 39 * MiB, WS_SS3 = 43 * MiB;
constexpr size_t WS_GATE = 47 * MiB, WS_KPE = 53 * MiB;
constexpr size_t WS_CQ = 64 * MiB, WS_T1 = 96 * MiB, WS_QN = 128 * MiB, WS_KVT = 192 * MiB  ;
constexpr size_t WS_QM = 288 * MiB, WS_KNM = 384 * MiB, WS_VM = 448 * MiB, WS_HIDP = 512 * MiB;
constexpr size_t WS_A2 = 64 * MiB;
constexpr size_t WS_EX = 43 * MiB, EX_BYTES = 1 * MiB;
constexpr size_t WS_XH = 576 * MiB, WS_H2 = 576 * MiB, WS_Y = 704 * MiB, WS_H1 = 832 * MiB, WS_H1Q = 960 * MiB, WS_END = 1024 * MiB;
constexpr size_t KVT_STRIDE = 16 * MiB / 2;

constexpr int CW_QHEAD = 64;
constexpr int CW_BAR = 4096;

constexpr int LDS_BYTES = 163840;
constexpr int LDS_MISC = 163840 - 256;

#define XB_TMO      128
#define XB_XCNT(j)  (256  + 64 * (j))
#define XB_XSUB(j)  (1280 + 64 * (j))
#define XB_XGEN(j)  (2304 + 64 * (j))
#define XB_TOP      3328
#define XB_TOPGEN   3392
#define XCD_BAR_WORDS 3456
#define XB_SPIN_CAP (1u << 22)

__device__ __forceinline__ unsigned xb_ld(unsigned* p)              { return __hip_atomic_load(p, __ATOMIC_RELAXED, __HIP_MEMORY_SCOPE_AGENT); }
__device__ __forceinline__ unsigned xb_add(unsigned* p, unsigned v) { return __hip_atomic_fetch_add(p, v, __ATOMIC_RELAXED, __HIP_MEMORY_SCOPE_AGENT); }
__device__ __forceinline__ unsigned xb_xcc_id() { return (unsigned)__builtin_amdgcn_s_getreg((3 << 11) | 20) & 0xFu; }
#define XB_SPIN(cond, bar) do { unsigned _sp = 0; while (cond) { __builtin_amdgcn_s_sleep(1); \
    if ((++_sp & 255u) == 0u) { if (xb_ld(&(bar)[XB_TMO])) break; if (_sp > XB_SPIN_CAP) { atomicAdd(&(bar)[XB_TMO], 1u); break; } } } } while (0)

struct XcdBarrier { unsigned* bar; unsigned x; volatile LAS unsigned* st; };

__device__ __forceinline__ XcdBarrier xcd_barrier_post(unsigned* bar, volatile LAS unsigned* st) {
    XcdBarrier b; b.bar = bar; b.x = xb_xcc_id(); b.st = st;
    if (threadIdx.x == 0) (void)xb_add(&bar[XB_XCNT(b.x)], 1u);
    return b;
}
__device__ __forceinline__ void xcd_barrier_complete(unsigned* bar, unsigned x, unsigned& nloc, unsigned& nx) {
    const unsigned G = gridDim.x * gridDim.y * gridDim.z;
    unsigned sum, cnt, mine, sp = 0u;
    for (;;) {
        sum = 0u; cnt = 0u; mine = 0u;
#pragma unroll
        for (unsigned j = 0; j < 16; ++j) { const unsigned c = xb_ld(&bar[XB_XCNT(j)]); sum += c; cnt += (c > 0u) ? 1u : 0u; mine = (j == x) ? c : mine; }
        if (sum == G) break;
        __builtin_amdgcn_s_sleep(1);
        if ((++sp & 255u) == 0u) { if (xb_ld(&bar[XB_TMO])) break; if (sp > XB_SPIN_CAP) { atomicAdd(&bar[XB_TMO], 1u); break; } }
    }
    nloc = mine > 0u ? mine : 1u; nx = cnt > 0u ? cnt : 1u;
}
__device__ __forceinline__ void xcd_barrier(const XcdBarrier& b) {
    asm volatile("s_waitcnt vmcnt(0)" ::: "memory");
    __syncthreads();
    if (threadIdx.x == 0) {
        unsigned* bar = b.bar;
        __builtin_amdgcn_s_waitcnt(0);
        unsigned nloc = b.st[0], nx = b.st[1];
        if (nloc == 0u) { xcd_barrier_complete(bar, b.x, nloc, nx); b.st[0] = nloc; b.st[1] = nx; }
        const unsigned old = xb_add(&bar[XB_XSUB(b.x)], 1u);
        const unsigned gen = old / nloc;
        if (old + 1u == (gen + 1u) * nloc) {
            __builtin_amdgcn_fence(__ATOMIC_RELEASE, "agent");
            asm volatile("s_waitcnt vmcnt(0)" ::: "memory");
            const unsigned og = xb_add(&bar[XB_TOP], 1u);
            const unsigned tg = og / nx;
            if (og + 1u == (tg + 1u) * nx) xb_add(&bar[XB_TOPGEN], 1u);
            else XB_SPIN(xb_ld(&bar[XB_TOPGEN]) == tg, bar);
            __builtin_amdgcn_fence(__ATOMIC_ACQUIRE, "agent");
            xb_add(&bar[XB_XGEN(b.x)], 1u);
            asm volatile("s_waitcnt vmcnt(0)" ::: "memory");
        } else {
            XB_SPIN(xb_ld(&bar[XB_XGEN(b.x)]) == gen, bar);
            __builtin_amdgcn_fence(__ATOMIC_ACQUIRE, "agent");
            asm volatile("s_waitcnt vmcnt(0)" ::: "memory");
        }
    }
    __syncthreads();
}

__device__ __forceinline__ unsigned pk_rne(float a, float b) { half2v v = {(_Float16)a, (_Float16)b}; return __builtin_bit_cast(unsigned, v); }
__device__ __forceinline__ unsigned pk_rtz(float a, float b) { auto v = __builtin_amdgcn_cvt_pkrtz(a, b); return __builtin_bit_cast(unsigned, v); }
constexpr float F8_MAX = 448.f;
constexpr float A2_SCALE = 8.f, WDN_TOP = 256.f;
__device__ __forceinline__ unsigned pk4_f8(float a, float b, float c, float d) { int r = __builtin_amdgcn_cvt_pk_fp8_f32(a, b, 0, false); r = __builtin_amdgcn_cvt_pk_fp8_f32(c, d, r, true); return (unsigned)r; }
__device__ __forceinline__ unsigned pk4_i8(float a, float b, float c, float d) {
    const unsigned ua = __builtin_bit_cast(unsigned, a + 12582912.f), ub = __builtin_bit_cast(unsigned, b + 12582912.f), uc = __builtin_bit_cast(unsigned, c + 12582912.f), ud = __builtin_bit_cast(unsigned, d + 12582912.f);
    return __builtin_amdgcn_perm(ub, ua, 0x0c0c0400u) | __builtin_amdgcn_perm(ud, uc, 0x04000c0cu);
}
__device__ __forceinline__ float clamp_i8(float x) { return __builtin_amdgcn_fmed3f(x, -127.f, 127.f); }
__device__ __forceinline__ float clamp_f8(float x) { return __builtin_amdgcn_fmed3f(x, -F8_MAX, F8_MAX); }
__device__ __forceinline__ u32x4 pk8(const float* v) { u32x4 w; w.x = pk_rne(v[0], v[1]); w.y = pk_rne(v[2], v[3]); w.z = pk_rne(v[4], v[5]); w.w = pk_rne(v[6], v[7]); return w; }
__device__ __forceinline__ void unpk8(u32x4 w, float* v) {
    const half8 h = __builtin_bit_cast(half8, w);
#pragma unroll
    for (int i = 0; i < 8; ++i) v[i] = (float)h[i];
}
template <int CTRL> __device__ __forceinline__ unsigned dpp_u(unsigned v) { return (unsigned)__builtin_amdgcn_mov_dpp((int)v, CTRL, 0xf, 0xf, true); }
template <int CTRL> __device__ __forceinline__ float dpp_f(float v) { return __uint_as_float(dpp_u<CTRL>(__float_as_uint(v))); }
constexpr int DPP_X1 = 0xB1, DPP_X2 = 0x4E, DPP_HM = 0x141, DPP_RM = 0x140;
__device__ __forceinline__ float quad_sum(float v) { v += dpp_f<DPP_X1>(v); v += dpp_f<DPP_X2>(v); return v; }
__device__ __forceinline__ float oct_max(float v) { v = fmaxf(v, dpp_f<DPP_X1>(v)); v = fmaxf(v, dpp_f<DPP_X2>(v)); return fmaxf(v, dpp_f<DPP_HM>(v)); }
__device__ __forceinline__ int oct_min(int v) { v = min(v, (int)dpp_u<DPP_X1>((unsigned)v)); v = min(v, (int)dpp_u<DPP_X2>((unsigned)v)); return min(v, (int)dpp_u<DPP_HM>((unsigned)v)); }
__device__ __forceinline__ unsigned oct_or(unsigned v) { v |= dpp_u<DPP_X1>(v); v |= dpp_u<DPP_X2>(v); return v | dpp_u<DPP_HM>(v); }
__device__ __forceinline__ float x16_sum(float v) { const auto rr = __builtin_amdgcn_permlane16_swap(__float_as_uint(v), __float_as_uint(v), false, false); return __uint_as_float(rr[0]) + __uint_as_float(rr[1]); }
__device__ __forceinline__ float x32_sum(float v) { const auto rr = __builtin_amdgcn_permlane32_swap(__float_as_uint(v), __float_as_uint(v), false, false); return __uint_as_float(rr[0]) + __uint_as_float(rr[1]); }
__device__ __forceinline__ float x32_max(float v) { const auto rr = __builtin_amdgcn_permlane32_swap(__float_as_uint(v), __float_as_uint(v), false, false); return fmaxf(__uint_as_float(rr[0]), __uint_as_float(rr[1])); }
__device__ __forceinline__ float wave_sum(float v) {
    v += dpp_f<DPP_X1>(v); v += dpp_f<DPP_X2>(v); v += dpp_f<DPP_HM>(v); v += dpp_f<DPP_RM>(v);
    return x32_sum(x16_sum(v));
}
__device__ __forceinline__ void rope4(float* v, const float2* cs) {
#pragma unroll
    for (int p = 0; p < 4; ++p) { const float2 t = cs[p]; const float x1 = v[2 * p], x2 = v[2 * p + 1]; v[2 * p] = x1 * t.x - x2 * t.y; v[2 * p + 1] = x2 * t.x + x1 * t.y; }
}

__host__ __device__ __forceinline__ size_t k_off(int tok, int d)   { return (size_t)(((tok >> 6) * 8 + (d >> 3)) * 512 + (tok & 63) * 8 + (d & 7)); }
__host__ __device__ __forceinline__ size_t v_off(int tok, int d)   { return (size_t)((tok >> 6) * 4096 + ((d >> 5) * 8 + ((tok & 63) >> 3)) * 256 + (tok & 7) * 32 + (d & 31)); }
__host__ __device__ __forceinline__ size_t kpe_off(int tok, int p) { return (size_t)(((tok >> 6) * 4 + (p >> 3)) * 512 + (tok & 63) * 8 + (p & 7)); }

namespace pg8 {
constexpr int BM = 256, BK = 64, HALF = 128, HTB = HALF * BK * 2, NXCD = 8, WGM = 8;
__host__ __device__ __forceinline__ int lds_byte(int r, int c) { const int st = (r >> 4) * 2 + (c >> 5), rr = r & 15, cc = c & 31, ob = rr * 64 + cc * 2; return st * 1024 + (ob ^ (((ob >> 9) & 1) << 5)); }
__host__ __device__ __forceinline__ void stage_rc(int b, int& R, int& C) { const int st = b / 1024, sb = b % 1024, swz = sb ^ (((sb >> 9) & 1) << 5); R = (st >> 1) * 16 + swz / 64; C = (st & 1) * 32 + (swz % 64) / 2; }
__host__ __device__ __forceinline__ int perm32(int rho) { const int n = rho >> 4, i = rho & 15; return 8 * (i >> 2) + 4 * n + (i & 3); }

struct Unit { int pm, pn; size_t aoff, boff; };
struct Gemm { const half_t* A; const half_t* Bt; int K, lda, ldb; };

struct StaticOrder {
    int nM, nN, nwg, G, c; size_t tA, tB;
    __device__ __forceinline__ void init(int M, int N, int G_, int c_, int lda, int ldb) { nM = M / BM; nN = N / BM; nwg = nM * nN; G = G_; c = c_; tA = (size_t)BM * lda * 2; tB = (size_t)BM * ldb * 2; }
    __device__ __forceinline__ bool next(int i, Unit& u) const {
        const long L = (long)i * G + c; if (L >= nwg) return false;
        int wgid = (int)L; { const int q = nwg / NXCD, r = nwg % NXCD, xcd = wgid % NXCD, off = wgid / NXCD; wgid = (xcd < r ? xcd * (q + 1) : r * (q + 1) + (xcd - r) * q) + off; }
        const int nig = WGM * nN, gid = wgid / nig, fm = gid * WGM, gsz = (nM - fm) < WGM ? (nM - fm) : WGM;
        u.pm = fm + ((wgid % nig) % gsz); u.pn = (wgid % nig) / gsz; u.aoff = (size_t)u.pm * tA; u.boff = (size_t)u.pn * tB; return true;
    }
};
struct Cmp1Order {
    int G, c;
    __device__ __forceinline__ bool next(int i, Unit& u) const {
        const int L = i * G + c; if (L >= 256) return false;
        const int kv = L >> 7, slab = (L >> 2) & 31, ch = L & 3;
        u.pm = L; u.pn = 0; u.aoff = (size_t)kv * (16 * MiB) + (size_t)slab * (512 * 1024) + (size_t)ch * 1024; u.boff = (size_t)kv * (256 * 2048 * 2) + (size_t)ch * 1024; return true;
    }
};

template <class Epi, class Sched, bool MIDK = false, bool FP8 = false, bool WIDE = false, bool I8 = false>
__device__ __forceinline__ void gemm_phase(LAS unsigned char* lds, const Gemm g, const Sched& S, const Epi& E) {
    int tid_ = threadIdx.x; asm volatile("" : "+v"(tid_));
    const int tid = tid_, wid = __builtin_amdgcn_readfirstlane(tid >> 6), lane = tid & 63, wr = wid >> 2, wc = wid & 3, fr = lane & 15, fq = lane >> 4;
    const int K = g.K, nt = K / BK;
    unsigned voffA[2], voffB[2];
#pragma unroll
    for (int i = 0; i < 2; ++i) { int R, C; stage_rc(tid * 16 + i * 8192, R, C); const int Rb = WIDE ? 64 * (R >> 5) + 16 * ((R & 15) >> 2) + 4 * ((R >> 4) & 1) + (R & 3) : (R & ~31) + perm32(R & 31);
        voffA[i] = (unsigned)(R * g.lda + C) * 2u; voffB[i] = (unsigned)(Rb * g.ldb + C) * 2u; }
    const size_t kstep = (size_t)(BK * 2);
    const size_t hstepA = (size_t)HALF * g.lda * 2, hstepB = (size_t)(WIDE ? 8 : HALF) * g.ldb * 2;
    const unsigned ldsw = (unsigned)wid * 1024u;
    const int aoff = lds_byte(wr * 64 + fr, fq * 8), boff = lds_byte(wc * 32 + fr, fq * 8);
#define PG8_SA(b, h) (((b) * 2 + (h)) * HTB)
#define PG8_SB(b, h) ((4 + (b) * 2 + (h)) * HTB)
#define PG8_STAGE(bufoff, gbase, voff) do { _Pragma("unroll") for (int _i = 0; _i < 2; ++_i) \
        __builtin_amdgcn_global_load_lds((const unsigned*)((const char*)(gbase) + (voff)[_i]), (LAS unsigned*)(lds + (bufoff) + ldsw + _i * 8192), 16, 0, 0); } while (0)
#define PG8_LDA(dst, b, h) do { _Pragma("unroll") for (int m = 0; m < 4; ++m) _Pragma("unroll") for (int k = 0; k < 2; ++k) dst[m][k] = *(const LAS half8*)(lds + PG8_SA(b, h) + aoff + m * 2048 + k * 1024); } while (0)
#define PG8_LDB(dst, b, h) do { _Pragma("unroll") for (int n = 0; n < 2; ++n) _Pragma("unroll") for (int k = 0; k < 2; ++k) dst[n][k] = *(const LAS half8*)(lds + PG8_SB(b, h) + boff + n * 2048 + k * 1024); } while (0)
#define PG8_CAT(x) __builtin_shufflevector(__builtin_bit_cast(i32x4, x[0]), __builtin_bit_cast(i32x4, x[1]), 0, 1, 2, 3, 4, 5, 6, 7)
#define PG8_MMA(ai, bj, At, Bt) do { __builtin_amdgcn_s_setprio(1); \
        if constexpr (FP8) { _Pragma("unroll") for (int m = 0; m < 4; ++m) _Pragma("unroll") for (int n = 0; n < 2; ++n) \
            asm volatile("v_mfma_f32_16x16x128_f8f6f4 %0, %1, %2, %0" : "+v"(acc[ai][bj][m][n]) : "v"(PG8_CAT(Bt[n])), "v"(PG8_CAT(At[m]))); }   \
        else if constexpr (I8) { _Pragma("unroll") for (int m = 0; m < 4; ++m) _Pragma("unroll") for (int n = 0; n < 2; ++n) _Pragma("unroll") for (int k = 0; k < 2; ++k)   \
            acc[ai][bj][m][n] = __builtin_bit_cast(f32x4, __builtin_amdgcn_mfma_i32_16x16x64_i8(__builtin_bit_cast(i32x4, Bt[n][k]), __builtin_bit_cast(i32x4, At[m][k]), __builtin_bit_cast(i32x4, acc[ai][bj][m][n]), 0, 0, 0)); } \
        else { _Pragma("unroll") for (int m = 0; m < 4; ++m) _Pragma("unroll") for (int n = 0; n < 2; ++n) _Pragma("unroll") for (int k = 0; k < 2; ++k) \
            acc[ai][bj][m][n] = __builtin_amdgcn_mfma_f32_16x16x32_f16(Bt[n][k], At[m][k], acc[ai][bj][m][n], 0, 0, 0); } \
        __builtin_amdgcn_s_setprio(0); } while (0)
#define PG8_WAIT_V(n) asm volatile("s_waitcnt vmcnt(" #n ")" ::: "memory")
#define PG8_WAIT_L(n) asm volatile("s_waitcnt lgkmcnt(" #n ")" ::: "memory")
#define PG8_BAR __builtin_amdgcn_s_barrier()
#define PG8_SCHED __builtin_amdgcn_sched_barrier(0)
    Unit cur, nxt; int ui = 0;
    if (!S.next(0, cur)) return;
    f32x4 acc[2][2][4][2];
#pragma unroll
    for (int a = 0; a < 2; ++a)
#pragma unroll
        for (int b = 0; b < 2; ++b)
#pragma unroll
            for (int m = 0; m < 4; ++m)
#pragma unroll
                for (int n = 0; n < 2; ++n) acc[a][b][m][n] = (f32x4){0.f, 0.f, 0.f, 0.f};
    half8 At[4][2], B0[2][2], B1[2][2];
    const char* cA = (const char*)g.A + cur.aoff; const char* cB = (const char*)g.Bt + cur.boff;
    PG8_STAGE(PG8_SB(0, 0), cB, voffB); PG8_STAGE(PG8_SB(0, 1), cB + hstepB, voffB); PG8_STAGE(PG8_SA(0, 0), cA, voffA); PG8_STAGE(PG8_SA(0, 1), cA + hstepA, voffA);
    if (wr == 1) PG8_BAR;
    PG8_WAIT_V(2); PG8_BAR;
    PG8_STAGE(PG8_SB(1, 0), cB + kstep, voffB); PG8_STAGE(PG8_SA(1, 0), cA + kstep, voffA); PG8_STAGE(PG8_SB(1, 1), cB + hstepB + kstep, voffB);
    PG8_WAIT_V(6); PG8_BAR;
    for (;;) {
        const bool has_next = S.next(ui + 1, nxt);
        const char* nA = has_next ? (const char*)g.A + nxt.aoff : cA; const char* nB = has_next ? (const char*)g.Bt + nxt.boff : cB;
        for (int t = 0; t < nt; t += 2) {
            if constexpr (MIDK) { if (t == nt / 2) E.midk(acc, cur, wr); }
            const bool last = (t == nt - 2);
            const char* a1 = cA + (size_t)(t + 1) * kstep;
            const char* a2 = last ? nA : cA + (size_t)(t + 2) * kstep; const char* b2 = last ? nB : cB + (size_t)(t + 2) * kstep;
            const char* a3 = a2 + kstep; const char* b3 = b2 + kstep;
            PG8_LDB(B0, 0, 0); PG8_LDB(B1, 0, 1); PG8_SCHED; PG8_LDA(At, 0, 0); PG8_STAGE(PG8_SA(1, 1), a1 + hstepA, voffA);
            PG8_WAIT_V(8); PG8_WAIT_L(0); PG8_BAR; PG8_MMA(0, 0, At, B0); PG8_MMA(0, 1, At, B1); PG8_BAR; PG8_SCHED;
            PG8_LDA(At, 0, 1); PG8_STAGE(PG8_SB(0, 0), b2, voffB); PG8_STAGE(PG8_SB(0, 1), b2 + hstepB, voffB); PG8_STAGE(PG8_SA(0, 0), a2, voffA);
            PG8_WAIT_V(8); PG8_WAIT_L(0); PG8_BAR; PG8_MMA(1, 0, At, B0); PG8_MMA(1, 1, At, B1); PG8_BAR; PG8_SCHED;
            PG8_LDB(B0, 1, 0); PG8_LDB(B1, 1, 1); PG8_SCHED; PG8_LDA(At, 1, 0); PG8_STAGE(PG8_SA(0, 1), a2 + hstepA, voffA);
            PG8_WAIT_V(8); PG8_WAIT_L(0); PG8_BAR; PG8_MMA(0, 0, At, B0); PG8_MMA(0, 1, At, B1); PG8_BAR; PG8_SCHED;
            PG8_LDA(At, 1, 1); PG8_STAGE(PG8_SB(1, 0), b3, voffB); PG8_STAGE(PG8_SB(1, 1), b3 + hstepB, voffB); PG8_STAGE(PG8_SA(1, 0), a3, voffA);
            PG8_WAIT_V(8); PG8_WAIT_L(0); PG8_BAR; PG8_MMA(1, 0, At, B0); PG8_MMA(1, 1, At, B1); PG8_BAR; PG8_SCHED;
        }
        if constexpr (FP8) asm volatile("s_nop 15\n\ts_nop 15" ::: "memory");
        if (wr == 0) PG8_BAR;
        E(acc, cur, wr, wc, fr, fq);
        if (!has_next) break;
#pragma unroll
        for (int a = 0; a < 2; ++a)
#pragma unroll
            for (int b = 0; b < 2; ++b)
#pragma unroll
                for (int m = 0; m < 4; ++m)
#pragma unroll
                    for (int n = 0; n < 2; ++n) acc[a][b][m][n] = (f32x4){0.f, 0.f, 0.f, 0.f};
        cur = nxt; cA = nA; cB = nB; ++ui;
        if (wr == 1) PG8_BAR;
    }
    PG8_WAIT_V(0);
    PG8_BAR;
#undef PG8_SA
#undef PG8_SB
#undef PG8_STAGE
#undef PG8_LDA
#undef PG8_LDB
#undef PG8_MMA
#undef PG8_CAT
#undef PG8_WAIT_V
#undef PG8_WAIT_L
#undef PG8_BAR
#undef PG8_SCHED
}
}

typedef f32x4 AccT[2][2][4][2];
#define EPI_IDS() int t_ = threadIdx.x; asm volatile("" : "+v"(t_)); const int fr = t_ & 15, fq = (t_ >> 4) & 3; (void)fr_; (void)fq_
#define EPI_ROW(ai, m) (u.pm * 256 + (ai) * 128 + wr * 64 + (m) * 16 + fr)
#define EPI_GET8(v, ai, bj, m, s) do { const f32x4 _a = acc[ai][bj][m][0], _b = acc[ai][bj][m][1]; v[0] = _a[0] * (s); v[1] = _a[1] * (s); v[2] = _a[2] * (s); v[3] = _a[3] * (s); v[4] = _b[0] * (s); v[5] = _b[1] * (s); v[6] = _b[2] * (s); v[7] = _b[3] * (s); } while (0)
__device__ __forceinline__ void rope4v(float* v, const f32x4& c01, const f32x4& c23) {
    const float cs[8] = {c01[0], c01[1], c01[2], c01[3], c23[0], c23[1], c23[2], c23[3]};
#pragma unroll
    for (int p = 0; p < 4; ++p) { const float x1 = v[2 * p], x2 = v[2 * p + 1]; v[2 * p] = x1 * cs[2 * p] - x2 * cs[2 * p + 1]; v[2 * p + 1] = x2 * cs[2 * p] + x1 * cs[2 * p + 1]; }
}
__device__ __forceinline__ float sum4(const f32x4& a) { return (a[0] + a[1]) + (a[2] + a[3]); }
__device__ __forceinline__ float relu_s(float x) { float r; asm("v_max_f32_e32 %0, 0, %1" : "=v"(r) : "v"(x)); return r; }
constexpr int LDS_ROWC = 135168;
constexpr int LDS_ROWT = LDS_ROWC + 12288;
constexpr int LDS_RED = 131072;

struct EpiIn {
    const float* rs1; half_t* CQ; half_t* T1; half_t* KPE; float* GATE; float* SSQ; float* SSKV; half_t* QN; half_t* KVT; const float2* ropeM; const float2* ropeN;
    __device__ __forceinline__ void operator()(const AccT& acc, const pg8::Unit& u, int wr, int wc, int fr_, int fq_) const {
        EPI_IDS();
        const int pn = u.pn;
        const bool ropem = (pn == 1 && wc == 0), ropen = (pn >= 2 && pn != 4 && (wc & 1) == 0);
#pragma unroll
        for (int ai = 0; ai < 2; ++ai) {
            float rsv[4]; f32x4 rc[4][2];
#pragma unroll
            for (int m = 0; m < 4; ++m) { const int row = EPI_ROW(ai, m), pos = row & (SEQ - 1); rsv[m] = rs1[row];
                const f32x4* p = ropem ? (const f32x4*)(ropeM + (size_t)pos * 16 + fq * 4) : (const f32x4*)(ropeN + (size_t)pos * 8 + (fq & 1) * 4);
                rc[m][0] = p[0]; rc[m][1] = p[1]; }
#pragma unroll
            for (int m = 0; m < 4; ++m) { const int row = EPI_ROW(ai, m), pos = row & (SEQ - 1), b = row >> 12; const float rs = rsv[m];
                float v[8];
                if (pn == 0) {
                    float ss = 0.f;
#pragma unroll
                    for (int bj = 0; bj < 2; ++bj) { EPI_GET8(v, ai, bj, m, rs);
#pragma unroll
                        for (int i = 0; i < 8; ++i) ss += v[i] * v[i];
                        *(u32x4*)(CQ + (size_t)row * 256 + bj * 128 + wc * 32 + fq * 8) = pk8(v); }
                    ss = x32_sum(x16_sum(ss));
                    if (fq == 0) SSQ[(size_t)row * 4 + wc] = ss;
                } else if (pn == 1) {
                    { EPI_GET8(v, ai, 0, m, rs); float ss = 0.f;
#pragma unroll
                        for (int i = 0; i < 8; ++i) ss += v[i] * v[i];
                        *(u32x4*)(T1 + (size_t)row * 256 + wc * 32 + fq * 8) = pk8(v);
                        ss = x32_sum(x16_sum(ss));
                        if (fq == 0) SSKV[(size_t)row * 4 + wc] = ss; }
                    { EPI_GET8(v, ai, 1, m, rs);
                        if (wc == 0) { rope4v(v, rc[m][0], rc[m][1]); const u32x4 w = pk8(v);
                            *(u32x4*)(T1 + (size_t)row * 256 + 128 + fq * 8) = w; *(u32x4*)(KPE + (size_t)b * SEQ * 32 + kpe_off(pos, fq * 8)) = w; }
                        else { if (wc == 1 && fq < 3) { float* gp = GATE + (size_t)row * 24 + fq * 8;
#pragma unroll
                                for (int i = 0; i < 8; ++i) v[i] = 1.f / (1.f + __expf(-v[i]));
                                *(f32x4*)gp = (f32x4){v[0], v[1], v[2], v[3]}; *(f32x4*)(gp + 4) = (f32x4){v[4], v[5], v[6], v[7]}; }
                            *(u32x4*)(T1 + (size_t)row * 256 + 128 + wc * 32 + fq * 8) = (u32x4){0u, 0u, 0u, 0u}; } }
                } else if (pn < 4) {
#pragma unroll
                    for (int bj = 0; bj < 2; ++bj) { EPI_GET8(v, ai, bj, m, rs); const int head = (pn - 2) * 4 + 2 * bj + (wc >> 1), off = 32 * (wc & 1) + 8 * fq;
                        if ((wc & 1) == 0 && fq < 2) rope4v(v, rc[m][0], rc[m][1]);
#pragma unroll
                        for (int i = 0; i < 8; ++i) v[i] *= QS_N;
                        *(u32x4*)(QN + (size_t)row * 512 + head * 64 + off) = pk8(v); }
                } else {
#pragma unroll
                    for (int bj = 0; bj < 2; ++bj) { EPI_GET8(v, ai, bj, m, rs); const int g = wc >> 1, d = 32 * (wc & 1) + 8 * fq;
                        if (pn > 4 && bj == 0 && (wc & 1) == 0 && fq < 2) rope4v(v, rc[m][0], rc[m][1]);
                        half_t* base = KVT + (size_t)((pn - 4) * 2 + bj) * KVT_STRIDE + (size_t)(b * 2 + g) * SEQ * 64;
                        *(u32x4*)(base + (pn == 4 ? (size_t)pos * 64 + d : (bj == 0 ? k_off(pos, d) : v_off(pos, d)))) = pk8(v); }
                }
            }
        }
    }
};

struct EpiUq {
    const float* SSQ; half_t* QM; const float2* ropeM;
    __device__ __forceinline__ void operator()(const AccT& acc, const pg8::Unit& u, int wr, int wc, int fr_, int fq_) const {
        EPI_IDS();
        const bool pe0 = ((8 * u.pn + wc) % 3 == 2), pe1 = ((8 * u.pn + 4 + wc) % 3 == 2);
#pragma unroll
        for (int ai = 0; ai < 2; ++ai) {
            f32x4 s4[4], rp[4][2];
#pragma unroll
            for (int m = 0; m < 4; ++m) { const int row = EPI_ROW(ai, m); s4[m] = *(const f32x4*)(SSQ + (size_t)row * 4);
                const f32x4* p = (const f32x4*)(ropeM + (size_t)(row & (SEQ - 1)) * 16 + fq * 4); rp[m][0] = p[0]; rp[m][1] = p[1]; }
#pragma unroll
            for (int m = 0; m < 4; ++m) { const int row = EPI_ROW(ai, m);
                const float rs = __builtin_amdgcn_rsqf(sum4(s4[m]) * (1.f / 256.f) + NORM_EPS) * QS_M;
                float v[8];
#pragma unroll
                for (int bj = 0; bj < 2; ++bj) { EPI_GET8(v, ai, bj, m, rs); const int sidx = 8 * u.pn + 4 * bj + wc;
                    if (bj == 0 ? pe0 : pe1) rope4v(v, rp[m][0], rp[m][1]);
                    *(u32x4*)(QM + (size_t)row * 768 + sidx * 32 + fq * 8) = pk8(v); }
            }
        }
    }
};
struct EpiUkv {
    const float* SSKV; half_t* KNM; half_t* VM;
    __device__ __forceinline__ void operator()(const AccT& acc, const pg8::Unit& u, int wr, int wc, int fr_, int fq_) const {
        EPI_IDS();
        f32x4 s4[2][4];
#pragma unroll
        for (int ai = 0; ai < 2; ++ai)
#pragma unroll
            for (int m = 0; m < 4; ++m) s4[ai][m] = *(const f32x4*)(SSKV + (size_t)EPI_ROW(ai, m) * 4);
#pragma unroll
        for (int ai = 0; ai < 2; ++ai) {
#pragma unroll
            for (int m = 0; m < 4; ++m) { const int row = EPI_ROW(ai, m), pos = row & (SEQ - 1), b = row >> 12;
                const float rs = __builtin_amdgcn_rsqf(sum4(s4[ai][m]) * (1.f / 128.f) + NORM_EPS);
                float v[8];
#pragma unroll
                for (int bj = 0; bj < 2; ++bj) { EPI_GET8(v, ai, bj, m, rs); const int c = (u.pn & 1) * 256 + bj * 128 + wc * 32 + fq * 8, head = c >> 6, d = c & 63;
                    half_t* base = ((u.pn < 2) ? KNM : VM) + (size_t)(b * 8 + head) * SEQ * 64;
                    *(u32x4*)(base + ((u.pn < 2) ? k_off(pos, d) : v_off(pos, d))) = pk8(v); }
            }
        }
    }
};
struct EpiC1 {
    float* HIDP;
    __device__ __forceinline__ void operator()(const AccT& acc, const pg8::Unit& u, int wr, int wc, int fr_, int fq_) const {
        EPI_IDS();
#pragma unroll
        for (int ai = 0; ai < 2; ++ai)
#pragma unroll
            for (int m = 0; m < 4; ++m) { const int rl = ai * 128 + wr * 64 + m * 16 + fr; float* p = HIDP + ((size_t)u.pm * 256 + rl) * 128 + wc * 32 + fq * 8;
                *(f32x4*)p = acc[ai][0][m][0]; *(f32x4*)(p + 4) = acc[ai][0][m][1]; }
    }
};
__device__ __forceinline__ float rstd8(const float* p, float inv_n) {
    const f32x4 a = *(const f32x4*)p, b = *(const f32x4*)(p + 4);
    return __builtin_amdgcn_rsqf((sum4(a) + sum4(b)) * inv_n + NORM_EPS);
}
__device__ __forceinline__ float h1q_scale(float rs1, float wo2) { return (127.f / H1Q_SIGMAS) * __builtin_amdgcn_rsqf(1.f / (rs1 * rs1) + wo2); }
struct EpiWo {
    const half_t* XH; half_t* H1; float* SS2; const float* SSM; const float* SSN; LAS float* red; unsigned char* H1Q; const float* RS1; const float* SCAL; LAS const float* rowc;
    __device__ __forceinline__ void midk(AccT& acc, const pg8::Unit& u, int wr) const {
        int t_ = threadIdx.x; asm volatile("" : "+v"(t_)); const int fr = t_ & 15;
        const int slot = (u.pm >> 3) & 3; const bool hit = *(const LAS int*)(rowc + 3072 + slot) == u.pm;
#pragma unroll
        for (int ai = 0; ai < 2; ++ai)
#pragma unroll
            for (int m = 0; m < 4; ++m) { float ratio;
                if (hit) ratio = rowc[(slot * 256 + ai * 128 + wr * 64 + m * 16 + fr) * 3];
                else { const int row = EPI_ROW(ai, m); const f32x4 m0 = *(const f32x4*)(SSM + (size_t)row * 8), m1 = *(const f32x4*)(SSM + (size_t)row * 8 + 4), n0 = *(const f32x4*)(SSN + (size_t)row * 8), n1 = *(const f32x4*)(SSN + (size_t)row * 8 + 4);
                    ratio = __builtin_amdgcn_rsqf((sum4(m0) + sum4(m1)) * (1.f / 512.f) + NORM_EPS) / __builtin_amdgcn_rsqf((sum4(n0) + sum4(n1)) * (1.f / 512.f) + NORM_EPS); }
#pragma unroll
                for (int bj = 0; bj < 2; ++bj)
#pragma unroll
                    for (int n = 0; n < 2; ++n) acc[ai][bj][m][n] *= ratio; }
    }
    __device__ __forceinline__ void operator()(const AccT& acc, const pg8::Unit& u, int wr, int wc, int fr_, int fq_) const {
        EPI_IDS();
        const int slot = (u.pm >> 3) & 3; const bool hit = *(const LAS int*)(rowc + 3072 + slot) == u.pm;
        const unsigned eoff = (unsigned)((u.pm * 256 + wr * 64 + fr) * DM + u.pn * 256 + wc * 64 + fq * 16);
#define EPI_OFF(ai, m) (eoff + (unsigned)(((ai) * 128 + (m) * 16) * DM))
#pragma unroll
        for (int ai = 0; ai < 2; ++ai) {
            u32x4 xr[4][2];
#pragma unroll
            for (int m = 0; m < 4; ++m)
#pragma unroll
                for (int bj = 0; bj < 2; ++bj) xr[m][bj] = *(const u32x4*)((const char*)XH + (EPI_OFF(ai, m) + bj * 8u) * 2u);
#pragma unroll
            for (int m = 0; m < 4; ++m) { const int row = EPI_ROW(ai, m);
                float rn, qs;
                if (hit) { const LAS float* rc = rowc + (slot * 256 + ai * 128 + wr * 64 + m * 16 + fr) * 3; rn = rc[1]; qs = rc[2]; }
                else { const f32x4 n0 = *(const f32x4*)(SSN + (size_t)row * 8), n1 = *(const f32x4*)(SSN + (size_t)row * 8 + 4); rn = __builtin_amdgcn_rsqf((sum4(n0) + sum4(n1)) * (1.f / 512.f) + NORM_EPS); qs = h1q_scale(RS1[row], SCAL[0]); }
                float v[8], x[8], ss = 0.f; u32x4 q;
#pragma unroll
                for (int bj = 0; bj < 2; ++bj) { EPI_GET8(v, ai, bj, m, rn); unpk8(xr[m][bj], x);
#pragma unroll
                    for (int i = 0; i < 8; ++i) { v[i] += x[i]; ss += v[i] * v[i]; }
                    *(u32x4*)((char*)H1 + (EPI_OFF(ai, m) + bj * 8u) * 2u) = pk8(v);
                    q[2 * bj] = pk4_i8(clamp_i8(v[0] * qs), clamp_i8(v[1] * qs), clamp_i8(v[2] * qs), clamp_i8(v[3] * qs));
                    q[2 * bj + 1] = pk4_i8(clamp_i8(v[4] * qs), clamp_i8(v[5] * qs), clamp_i8(v[6] * qs), clamp_i8(v[7] * qs)); }
                *(u32x4*)(H1Q + EPI_OFF(ai, m)) = q;
                ss = x32_sum(x16_sum(ss));
                if (fq == 0) red[(ai * 128 + wr * 64 + m * 16 + fr) * 4 + wc] = ss;
            }
        }
#undef EPI_OFF
        asm volatile("s_waitcnt lgkmcnt(0)" ::: "memory"); __builtin_amdgcn_s_barrier();
        if (t_ < 256) { const f32x4 r4 = *(const LAS f32x4*)(red + t_ * 4); SS2[(size_t)(u.pm * 256 + t_) * 4 + u.pn] = sum4(r4); }
    }
};
__device__ __forceinline__ float rstd16(const float* p, float inv_n) {
    const f32x4 a = *(const f32x4*)p, b = *(const f32x4*)(p + 4), c = *(const f32x4*)(p + 8), d = *(const f32x4*)(p + 12);
    return __builtin_amdgcn_rsqf(((sum4(a) + sum4(b)) + (sum4(c) + sum4(d))) * inv_n + NORM_EPS);
}
__device__ __forceinline__ float up_row_factor(float ss2, float rs1, const float* SCAL) {
    const float rs = __builtin_amdgcn_rsqf(ss2 * (1.f / 1024.f) + NORM_EPS), iq = 1.f / h1q_scale(rs1, SCAL[0]);
    return rs * rs * iq * iq * (A2_SCALE / SCAL[1]);
}
struct EpiUp {
    const float* SS2; unsigned char* A2; LAS const float* rowc; const float* cols; const float* RS1; const float* SCAL;
    __device__ __forceinline__ void operator()(const AccT& acc, const pg8::Unit& u, int wr, int wc, int fr_, int fq_) const {
        EPI_IDS();
        const int slot = (u.pm >> 3) & 3;
        const bool hit = *(const LAS int*)(rowc + 3072 + slot) == u.pm;
        float rsq[2][4];
        if (hit) {
#pragma unroll
            for (int ai = 0; ai < 2; ++ai)
#pragma unroll
                for (int m = 0; m < 4; ++m) rsq[ai][m] = rowc[slot * 256 + ai * 128 + wr * 64 + m * 16 + fr];
        } else {
            f32x4 s[2][4];
#pragma unroll
            for (int ai = 0; ai < 2; ++ai)
#pragma unroll
                for (int m = 0; m < 4; ++m) s[ai][m] = *(const f32x4*)(SS2 + (size_t)EPI_ROW(ai, m) * 4);
#pragma unroll
            for (int ai = 0; ai < 2; ++ai)
#pragma unroll
                for (int m = 0; m < 4; ++m) rsq[ai][m] = up_row_factor(sum4(s[ai][m]), RS1[EPI_ROW(ai, m)], SCAL);
        }
        f32x4 cs[2][2];
#pragma unroll
        for (int bj = 0; bj < 2; ++bj)
#pragma unroll
            for (int n = 0; n < 2; ++n) cs[bj][n] = *(const f32x4*)(cols + u.pn * 256 + wc * 64 + fq * 16 + bj * 8 + n * 4) * (1.f / 127.f);
#pragma unroll
        for (int ai = 0; ai < 2; ++ai) {
#pragma unroll
            for (int m = 0; m < 4; ++m) { const int row = EPI_ROW(ai, m);
                const float rs2 = rsq[ai][m];
                const float capr = __builtin_amdgcn_sqrtf(F8_MAX * __builtin_amdgcn_rcpf(rs2));
                u32x4 w;
#pragma unroll
                for (int bj = 0; bj < 2; ++bj)
#pragma unroll
                    for (int n = 0; n < 2; ++n) {
                        const i32x4 ai4 = __builtin_bit_cast(i32x4, acc[ai][bj][m][n]); const f32x4 a = {(float)ai4[0], (float)ai4[1], (float)ai4[2], (float)ai4[3]};
                        typedef float f32x2 __attribute__((ext_vector_type(2)));
                        const f32x4 c1 = cs[bj][n];
                        f32x2 t0 = (f32x2){a[0], a[1]} * (f32x2){c1[0], c1[1]}, t1 = (f32x2){a[2], a[3]} * (f32x2){c1[2], c1[3]};
                        t0 = (f32x2){__builtin_amdgcn_fmed3f(t0[0], 0.f, capr), __builtin_amdgcn_fmed3f(t0[1], 0.f, capr)}; t1 = (f32x2){__builtin_amdgcn_fmed3f(t1[0], 0.f, capr), __builtin_amdgcn_fmed3f(t1[1], 0.f, capr)};
                        const f32x2 x0 = t0 * t0 * rs2, x1 = t1 * t1 * rs2;
                        w[2 * bj + n] = pk4_f8(x0[0], x0[1], x1[0], x1[1]); }
                __builtin_nontemporal_store(w, (u32x4*)(A2 + (size_t)row * DFF + u.pn * 256 + wc * 64 + fq * 16));
            }
        }
    }
};
struct EpiDn {
    const half_t* H1; float* OUT; const float* G3; unsigned* EX; LAS float* red; const float* SCAL; const float* DCOLS;
    __device__ __forceinline__ void operator()(AccT& acc, const pg8::Unit& u, int wr, int wc, int fr_, int fq_) const {
        EPI_IDS();
        const int c0 = u.pn * 256 + wc * 64 + fq * 16;
        const float dsc = SCAL[1] * (1.f / (A2_SCALE * WDN_TOP));
        f32x4 dc[2][2];
#pragma unroll
        for (int bj = 0; bj < 2; ++bj)
#pragma unroll
            for (int n = 0; n < 2; ++n) dc[bj][n] = *(const f32x4*)(DCOLS + c0 + bj * 8 + n * 4) * dsc;
        u32x4 xr[2][4][2];
        const unsigned eoff = (unsigned)((u.pm * 256 + wr * 64 + fr) * DM + c0);
#pragma unroll
        for (int ai = 0; ai < 2; ++ai)
#pragma unroll
            for (int m = 0; m < 4; ++m)
#pragma unroll
                for (int bj = 0; bj < 2; ++bj) xr[ai][m][bj] = *(const u32x4*)((const char*)H1 + (eoff + (unsigned)((ai * 128 + m * 16) * DM) + bj * 8u) * 2u);
#pragma unroll
        for (int ai = 0; ai < 2; ++ai) {
#pragma unroll
            for (int m = 0; m < 4; ++m) {
                float x[8], ss = 0.f;
#pragma unroll
                for (int bj = 0; bj < 2; ++bj) { unpk8(xr[ai][m][bj], x);
#pragma unroll
                    for (int n = 0; n < 2; ++n)
#pragma unroll
                        for (int i = 0; i < 4; ++i) { const float v = acc[ai][bj][m][n][i] * dc[bj][n][i] + x[4 * n + i]; acc[ai][bj][m][n][i] = v; ss += v * v; } }
                ss = x32_sum(x16_sum(ss));
                if (fq == 0) red[(ai * 128 + wr * 64 + m * 16 + fr) * 4 + wc] = ss;
            }
        }
        asm volatile("s_waitcnt lgkmcnt(0)" ::: "memory"); __builtin_amdgcn_s_barrier();
        if (t_ < 256) {
            unsigned* ex = EX + (size_t)u.pm * 1024 + t_;
            const f32x4 r4 = *(const LAS f32x4*)(red + t_ * 4); const float mine = sum4(r4);
            __hip_atomic_store(ex + u.pn * 256, __builtin_bit_cast(unsigned, mine) | 0x80000000u, __ATOMIC_RELAXED, __HIP_MEMORY_SCOPE_AGENT);
            unsigned g[4]; int spins = 0;
            for (;;) {
#pragma unroll
                for (int p = 0; p < 4; ++p) g[p] = __hip_atomic_load(ex + p * 256, __ATOMIC_RELAXED, __HIP_MEMORY_SCOPE_AGENT);
                if ((g[0] & g[1] & g[2] & g[3] & 0x80000000u) || ++spins >= (1 << 20)) break;
                __builtin_amdgcn_s_sleep(1); }
            float part[4];
#pragma unroll
            for (int p = 0; p < 4; ++p) part[p] = __builtin_bit_cast(float, g[p] & 0x7fffffffu);
            red[t_ * 4] = __builtin_amdgcn_rsqf(((part[0] + part[1]) + (part[2] + part[3])) * (1.f / 1024.f) + NORM_EPS);
        }
        asm volatile("s_waitcnt lgkmcnt(0)" ::: "memory"); __builtin_amdgcn_s_barrier();
        f32x4 gg[2][2];
#pragma unroll
        for (int bj = 0; bj < 2; ++bj) { gg[bj][0] = *(const f32x4*)(G3 + c0 + bj * 8); gg[bj][1] = *(const f32x4*)(G3 + c0 + bj * 8 + 4); }
#pragma unroll
        for (int ai = 0; ai < 2; ++ai)
#pragma unroll
            for (int m = 0; m < 4; ++m) { const int row = EPI_ROW(ai, m); const float rs = red[(ai * 128 + wr * 64 + m * 16 + fr) * 4];
                f32x4* o = (f32x4*)(OUT + (size_t)row * DM + c0);
#pragma unroll
                for (int bj = 0; bj < 2; ++bj)
#pragma unroll
                    for (int n = 0; n < 2; ++n) o[2 * bj + n] = acc[ai][bj][m][n] * rs * gg[bj][n]; }
    }
};

constexpr int AT_KB = 0, AT_VB = 12288, AT_BUF = 20480;
constexpr int AT_SUB = 3;
constexpr int AT_STAGE = AT_SUB * AT_BUF;
constexpr int AT_IMP = 2 * AT_STAGE;
constexpr int AT_IMPW = 8 * 2 * 68 * 4;
constexpr int AT_SEL = AT_IMP + 8 * AT_IMPW;
constexpr int AT_QIDX = AT_SEL + 8 * 64;

struct TileRegs { u32x4 k, kp, v; };
__device__ __forceinline__ void tile_load(TileRegs& r, const half_t* Kt, const half_t* KPt, const half_t* Vt, int tid, int wid, int lane) {
    r.k = *(const u32x4*)(Kt + (size_t)(tid & 63) * 64 + wid * 8);
    if (KPt != nullptr && tid < 256) r.kp = *(const u32x4*)(KPt + (size_t)(tid & 63) * 32 + wid * 8);
    r.v = *(const u32x4*)(Vt + (size_t)(16 * (wid & 3) + (lane >> 2)) * 64 + (wid >> 2) * 32 + (lane & 3) * 8);
}
__device__ __forceinline__ void tile_store(const TileRegs& r, LAS unsigned char* buf, bool haspe, int tid, int wid, int lane) {
    *(LAS u32x4*)(buf + AT_KB + wid * 1024 + lane * 16) = r.k;
    if (haspe && tid < 256) *(LAS u32x4*)(buf + AT_KB + (8 + wid) * 1024 + lane * 16) = r.kp;
    *(LAS u32x4*)(buf + AT_VB + wid * 1024 + lane * 16) = r.v;
}
__device__ __forceinline__ float xhalf_max(float v) { const auto rr = __builtin_amdgcn_permlane32_swap(__float_as_uint(v), __float_as_uint(v), false, false); float r; asm("v_max_f32_e32 %0, %1, %2" : "=v"(r) : "v"(rr[0]), "v"(rr[1])); return r; }
__device__ __forceinline__ float xhalf_sum(float v) { const auto rr = __builtin_amdgcn_permlane32_swap(__float_as_uint(v), __float_as_uint(v), false, false); return __uint_as_float(rr[0]) + __uint_as_float(rr[1]); }
template <int NKS, int AB = 0>
__device__ __forceinline__ void tile_qk(const LAS unsigned char* kb, const half8 (&qf)[NKS], const f32x16& cinit, f32x16& p0, f32x16& p1) {
    if (AB & 1) { p0 = cinit; p1 = cinit; p0[0] += (float)qf[0][0]; p1[3] += (float)qf[1][1]; if (!(AB & 8)) { const half8 a = *(const LAS half8*)kb; p0[1] += (float)a[0]; } return; }
    half8 kf[2 * NKS];
#pragma unroll
    for (int ks = 0; ks < NKS; ++ks) { kf[2 * ks] = *(const LAS half8*)(kb + ks * 2048); kf[2 * ks + 1] = *(const LAS half8*)(kb + ks * 2048 + 512); }
    __builtin_amdgcn_sched_barrier(0);
    p0 = __builtin_amdgcn_mfma_f32_32x32x16_f16(kf[0], qf[0], cinit, 0, 0, 0);
    p1 = __builtin_amdgcn_mfma_f32_32x32x16_f16(kf[1], qf[0], cinit, 0, 0, 0);
#pragma unroll
    for (int ks = 1; ks < NKS; ++ks) {
        p0 = __builtin_amdgcn_mfma_f32_32x32x16_f16(kf[2 * ks], qf[ks], p0, 0, 0, 0);
        p1 = __builtin_amdgcn_mfma_f32_32x32x16_f16(kf[2 * ks + 1], qf[ks], p1, 0, 0, 0);
    }
}
__device__ __forceinline__ void tile_emask(f32x16& p0, f32x16& p1, int hiL, int loL) {
#pragma unroll
    for (int r = 0; r < 16; ++r) { const int c = (r & 3) + 8 * (r >> 2);
        if (!(c <= hiL && c >= loL)) p0[r] = -INFINITY;
        if (!(c + 32 <= hiL && c + 32 >= loL)) p1[r] = -INFINITY; }
}
__device__ __forceinline__ void tile_cmask(const f32x16& base, int hiL, int loL, f32x16& c0, f32x16& c1) {
#pragma unroll
    for (int r = 0; r < 16; ++r) { const int c = (r & 3) + 8 * (r >> 2);
        c0[r] = (c <= hiL && c >= loL) ? base[r] : -INFINITY;
        c1[r] = (c + 32 <= hiL && c + 32 >= loL) ? base[r] : -INFINITY; }
}
template <int NKS>
__device__ __forceinline__ void tile_qk2(const LAS unsigned char* kb, const half8 (&qf)[NKS], const f32x16& c0, const f32x16& c1, f32x16& p0, f32x16& p1) {
    half8 kf[2 * NKS];
#pragma unroll
    for (int ks = 0; ks < NKS; ++ks) { kf[2 * ks] = *(const LAS half8*)(kb + ks * 2048); kf[2 * ks + 1] = *(const LAS half8*)(kb + ks * 2048 + 512); }
    __builtin_amdgcn_sched_barrier(0);
    p0 = __builtin_amdgcn_mfma_f32_32x32x16_f16(kf[0], qf[0], c0, 0, 0, 0);
    p1 = __builtin_amdgcn_mfma_f32_32x32x16_f16(kf[1], qf[0], c1, 0, 0, 0);
#pragma unroll
    for (int ks = 1; ks < NKS; ++ks) {
        p0 = __builtin_amdgcn_mfma_f32_32x32x16_f16(kf[2 * ks], qf[ks], p0, 0, 0, 0);
        p1 = __builtin_amdgcn_mfma_f32_32x32x16_f16(kf[2 * ks + 1], qf[ks], p1, 0, 0, 0);
    }
}
__device__ __forceinline__ float tile_rowmax(const f32x16& p0, const f32x16& p1) {
    float a = fmaxf(fmaxf(p0[0], p0[1]), p0[2]), b = fmaxf(fmaxf(p1[0], p1[1]), p1[2]);
#pragma unroll
    for (int r = 3; r < 15; r += 2) { a = fmaxf(fmaxf(a, p0[r]), p0[r + 1]); b = fmaxf(fmaxf(b, p1[r]), p1[r + 1]); }
    a = fmaxf(fmaxf(a, p0[15]), fmaxf(b, p1[15]));
    return xhalf_max(a);
}
struct VFrags { v4i16 f[16]; };
__device__ __forceinline__ void vfrag_load(VFrags& V, const LAS unsigned char* vb) {
#pragma unroll
    for (int i = 0; i < 8; ++i) {
        V.f[2 * i]     = __builtin_amdgcn_ds_read_tr16_b64_v4i16((LAS v4i16*)(vb + (i >> 2) * 4096 + (i & 3) * 1024));
        V.f[2 * i + 1] = __builtin_amdgcn_ds_read_tr16_b64_v4i16((LAS v4i16*)(vb + (i >> 2) * 4096 + (i & 3) * 1024 + 512));
    }
}
__device__ __forceinline__ void tile_pv(const f32x16& p0, const f32x16& p1, const VFrags& V, f32x16 (&o)[2], float* lsum = nullptr) {
    u32x4 pw[4];
#pragma unroll
    for (int s = 0; s < 2; ++s) {
        pw[s]     = (u32x4){pk_rtz(p0[8 * s], p0[8 * s + 1]), pk_rtz(p0[8 * s + 2], p0[8 * s + 3]), pk_rtz(p0[8 * s + 4], p0[8 * s + 5]), pk_rtz(p0[8 * s + 6], p0[8 * s + 7])};
        pw[2 + s] = (u32x4){pk_rtz(p1[8 * s], p1[8 * s + 1]), pk_rtz(p1[8 * s + 2], p1[8 * s + 3]), pk_rtz(p1[8 * s + 4], p1[8 * s + 5]), pk_rtz(p1[8 * s + 6], p1[8 * s + 7])};
    }
    if (lsum != nullptr) {
        const half8 t = (__builtin_bit_cast(half8, pw[0]) + __builtin_bit_cast(half8, pw[1])) + (__builtin_bit_cast(half8, pw[2]) + __builtin_bit_cast(half8, pw[3]));
        const half2v u = ((half2v){t[0], t[1]} + (half2v){t[2], t[3]}) + ((half2v){t[4], t[5]} + (half2v){t[6], t[7]});
        *lsum += (float)u[0] + (float)u[1];
    }
    typedef short s8 __attribute__((ext_vector_type(8)));
#pragma unroll
    for (int db = 0; db < 2; ++db)
#pragma unroll
        for (int ks = 0; ks < 4; ++ks) {
            const v4i16 lo = V.f[2 * (db * 4 + ks)], hi = V.f[2 * (db * 4 + ks) + 1];
            const s8 t = {lo[0], lo[1], lo[2], lo[3], hi[0], hi[1], hi[2], hi[3]};
            o[db] = __builtin_amdgcn_mfma_f32_32x32x16_f16(__builtin_bit_cast(half8, t), __builtin_bit_cast(half8, pw[ks]), o[db], 0, 0, 0);
        }
}
constexpr float SM_THR = 6.f;
struct SmState { f32x16 negm; float mref, l; };
__device__ __forceinline__ void sm_reset(SmState& S) { S.negm = (f32x16){0.f}; S.mref = 0.f; S.l = 0.f; }
template <int AB = 0>
__device__ __forceinline__ void tile_softmax_pv(f32x16& p0, f32x16& p1, const LAS unsigned char* vb, f32x16 (&o)[2], SmState& S, bool first) {
    VFrags V; if (!(AB & 4)) vfrag_load(V, vb);
    if (!(AB & 2)) {
        const float tm = tile_rowmax(p0, p1);
        const bool need = tm > (first ? -INFINITY : SM_THR);
        if (__any(need)) {
            const float delta = need ? tm : 0.f, alpha = __builtin_amdgcn_exp2f(-delta);
            S.mref += delta; S.l *= alpha;
#pragma unroll
            for (int r = 0; r < 16; ++r) { p0[r] -= delta; p1[r] -= delta; o[0][r] *= alpha; o[1][r] *= alpha; S.negm[r] = -S.mref; }
        }
#pragma unroll
        for (int r = 0; r < 16; ++r) { p0[r] = __builtin_amdgcn_exp2f(p0[r]); p1[r] = __builtin_amdgcn_exp2f(p1[r]); }
    }
    if (!(AB & 4)) tile_pv(p0, p1, V, o, &S.l); else { _Pragma("unroll") for (int r = 0; r < 16; ++r) { o[0][r & 3] += p0[r]; o[1][r & 3] += p1[r]; } }
}

__device__ __forceinline__ void glds16(const void* gsrc, unsigned lds_dst) { unsigned keep;
    asm volatile("s_mov_b32 %0, m0\n\ts_mov_b32 m0, %2\n\ts_nop 0\n\tglobal_load_lds_dwordx4 %1, off\n\ts_mov_b32 m0, %0" : "=&s"(keep) : "v"(gsrc), "s"(lds_dst) : "memory"); }
__device__ __forceinline__ unsigned lds_addr(const LAS unsigned char* p) { return (unsigned)__builtin_amdgcn_readfirstlane((int)(unsigned)(size_t)p); }
__device__ __forceinline__ void tile_dma(const half_t* Kt, const half_t* KPt, const half_t* Vt, LAS unsigned char* sub, bool haspe, int wid, int lane) {
    const unsigned base = lds_addr(sub);
    glds16(Kt + wid * 512 + lane * 8, base + AT_KB + wid * 1024);
    if (haspe && wid < 4) glds16(KPt + wid * 512 + lane * 8, base + AT_KB + (8 + wid) * 1024);
    glds16(Vt + wid * 512 + lane * 8, base + AT_VB + wid * 1024);
}
#ifndef AT_STAGGER
#define AT_STAGGER 7
#endif
#ifndef AT_STAGGER_MASK
#define AT_STAGGER_MASK 4
#endif
#define AT_WAITBAR() do { asm volatile("s_waitcnt vmcnt(0) lgkmcnt(0)" ::: "memory"); __builtin_amdgcn_s_barrier(); } while (0)
#define KV_STREAM(NT, DMAT, COMPT) do { \
    const int nt__ = (NT), nst__ = (nt__ + AT_SUB - 1) / AT_SUB; \
    _Pragma("unroll") for (int j_ = 0; j_ < AT_SUB; ++j_) if (j_ < nt__) { DMAT(j_, lds + j_ * AT_BUF); } \
    AT_WAITBAR(); \
    for (int s_ = 0; s_ < nst__; ++s_) { \
        LAS unsigned char* cb_ = lds + (s_ & 1) * AT_STAGE; LAS unsigned char* nb_ = lds + ((s_ + 1) & 1) * AT_STAGE; \
        _Pragma("unroll") for (int j_ = 0; j_ < AT_SUB; ++j_) { const int tn_ = (s_ + 1) * AT_SUB + j_; if (tn_ < nt__) { DMAT(tn_, nb_ + j_ * AT_BUF); } } \
        _Pragma("unroll") for (int j_ = 0; j_ < AT_SUB; ++j_) { const int tc_ = s_ * AT_SUB + j_; if (tc_ < nt__) { COMPT(tc_, cb_ + j_ * AT_BUF); } } \
        AT_WAITBAR(); \
    } } while (0)

#define KV_STREAM_X(NT, DMAT, COMPT, PAR, PRE, NDMAT, NNT) do { \
    const int nt__ = (NT), nst__ = (nt__ + AT_SUB - 1) / AT_SUB, par__ = (PAR); \
    if (!(PRE)) { _Pragma("unroll") for (int j_ = 0; j_ < AT_SUB; ++j_) if (j_ < nt__) { DMAT(j_, lds + par__ * AT_STAGE + j_ * AT_BUF); } AT_WAITBAR(); } \
    for (int s_ = 0; s_ < nst__; ++s_) { \
        LAS unsigned char* cb_ = lds + ((s_ + par__) & 1) * AT_STAGE; LAS unsigned char* nb_ = lds + ((s_ + 1 + par__) & 1) * AT_STAGE; \
        if (s_ + 1 < nst__) { _Pragma("unroll") for (int j_ = 0; j_ < AT_SUB; ++j_) { const int tn_ = (s_ + 1) * AT_SUB + j_; if (tn_ < nt__) { DMAT(tn_, nb_ + j_ * AT_BUF); } } } \
        else { const int nnt__ = (NNT); _Pragma("unroll") for (int j_ = 0; j_ < AT_SUB; ++j_) if (j_ < nnt__) { NDMAT(j_, nb_ + j_ * AT_BUF); } } \
        _Pragma("unroll") for (int j_ = 0; j_ < AT_SUB; ++j_) { const int tc_ = s_ * AT_SUB + j_; if (tc_ < nt__) { COMPT(tc_, cb_ + j_ * AT_BUF); } } \
        AT_WAITBAR(); \
    } } while (0)
#define KV_NONE(t, sub) do { } while (0)

struct AttnPtrs {
    const half_t* QM; const half_t* KNM; const half_t* KPE; const half_t* VM;
    const half_t* QN; const half_t* KC; const half_t* VC; const half_t* KS; const half_t* VS; const half_t* KW; const half_t* VW; const float* GATE;
    half_t* Y; float* SSM; float* SSN;
};

__device__ __forceinline__ void store_pair16(half_t* p16, unsigned k0, unsigned k1, unsigned n0, unsigned n1) {
    const auto s0 = __builtin_amdgcn_permlane32_swap(k0, n0, false, false), s1 = __builtin_amdgcn_permlane32_swap(k1, n1, false, false);
    *(u32x4*)p16 = (u32x4){(unsigned)s0[0], (unsigned)s1[0], (unsigned)s0[1], (unsigned)s1[1]};
}
template <int AB = 0>
__device__ __forceinline__ void mla_unit(const AttnPtrs& P, int bh, int qb, LAS unsigned char* lds, bool nostore = false) {
    int tid_ = threadIdx.x; asm volatile("" : "+v"(tid_));
    const int tid = tid_, lane = tid & 63, wid = __builtin_amdgcn_readfirstlane(tid >> 6), q = lane & 31, h = lane >> 5;
    const int b = bh >> 3, hd = bh & 7, q0 = qb * 256, qpos = q0 + wid * 32 + q;
    const size_t trow = (size_t)b * SEQ + qpos;
    half8 qf[6];
#pragma unroll
    for (int ks = 0; ks < 6; ++ks) qf[ks] = *(const half8*)(P.QM + trow * 768 + hd * 96 + ks * 16 + h * 8);
#pragma unroll
    for (int ks = 0; ks < 6; ++ks) asm volatile("" : "+v"(qf[ks]));
    const half_t* Kb = P.KNM + (size_t)bh * SEQ * 64; const half_t* Vb = P.VM + (size_t)bh * SEQ * 64; const half_t* KPb = P.KPE + (size_t)b * SEQ * 32;
    const int ntiles = 4 * qb + 4, my_last = 4 * qb + (wid >> 1);
    f32x16 o[2]; o[0] = (f32x16){0.f}; o[1] = (f32x16){0.f};
    SmState S; sm_reset(S);
    const int koff = h * 1024 + q * 16, voff = (4 * h + ((lane & 15) >> 2)) * 64 + ((lane >> 4) & 1) * 32 + (lane & 3) * 8;
#define MLA_LOAD(t, sub) if (!(AB & 16)) tile_dma(Kb + (size_t)(t) * 4096, KPb + (size_t)(t) * 2048, Vb + (size_t)(t) * 4096, sub, true, wid, lane)
#define MLA_COMP(t, buf) do { if ((t) <= my_last) { f32x16 p0, p1; \
        tile_qk<6, AB>((buf) + AT_KB + koff, qf, S.negm, p0, p1); \
        if ((t) == my_last) tile_emask(p0, p1, qpos - 64 * (t) - 4 * h, -1000); \
        tile_softmax_pv<AB>(p0, p1, (buf) + AT_VB + voff, o, S, (t) == 0); } } while (0)
    KV_STREAM(ntiles, MLA_LOAD, MLA_COMP);
#undef MLA_LOAD
#undef MLA_COMP
    const float l = xhalf_sum(S.l);
    const float inv = 1.f / l;
    if (nostore && !(l == 123.456f)) return;
    float ss = 0.f;
    half_t* yrow = P.Y + trow * DM + hd * 64;
#pragma unroll
    for (int db = 0; db < 2; ++db)
#pragma unroll
        for (int cp = 0; cp < 2; ++cp) { unsigned w[4];
#pragma unroll
            for (int e = 0; e < 2; ++e) { const int c = 2 * cp + e; const float a0 = o[db][4 * c] * inv, a1 = o[db][4 * c + 1] * inv, a2 = o[db][4 * c + 2] * inv, a3 = o[db][4 * c + 3] * inv;
                ss += (a0 * a0 + a1 * a1) + (a2 * a2 + a3 * a3); w[2 * e] = pk_rne(a0, a1); w[2 * e + 1] = pk_rne(a2, a3); }
            store_pair16(yrow + db * 32 + 16 * cp + 8 * h, w[0], w[1], w[2], w[3]); }
    ss = xhalf_sum(ss);
    if (h == 0) P.SSM[trow * 8 + hd] = ss;
}

template <int NKS_unused = 4>
__device__ __forceinline__ void nsa_stream_begin(TileRegs& tr, const half_t* Kt, const half_t* Vt, LAS unsigned char* lds, int tid, int wid, int lane) {
    tile_load(tr, Kt, nullptr, Vt, tid, wid, lane);
    tile_store(tr, lds, false, tid, wid, lane);
    __syncthreads();
}
__device__ __forceinline__ void nsa_unit(const AttnPtrs& P, int bg, int qb, LAS unsigned char* lds) {
    int tid_ = threadIdx.x; asm volatile("" : "+v"(tid_));
    const int tid = tid_, lane = tid & 63, wid = __builtin_amdgcn_readfirstlane(tid >> 6), j = lane & 31, h = lane >> 5;
    const int b = bg >> 1, g = bg & 1, q0 = qb * 64, cur = qb, qi = j >> 2, hh = j & 3, qrel = wid * 8 + qi, qpos = q0 + qrel, head = g * 4 + hh;
    const size_t trow = (size_t)b * SEQ + qpos;
    half8 qf[4];
#pragma unroll
    for (int ks = 0; ks < 4; ++ks) qf[ks] = *(const half8*)(P.QN + trow * 512 + head * 64 + ks * 16 + h * 8);
    float g0 = P.GATE[trow * 24 + head], g1 = P.GATE[trow * 24 + 8 + head], g2 = P.GATE[trow * 24 + 16 + head];
#pragma unroll
    for (int ks = 0; ks < 4; ++ks) asm volatile("" : "+v"(qf[ks]));
    asm volatile("" : "+v"(g0), "+v"(g1), "+v"(g2));
    const int koff = h * 1024 + j * 16, voff = (4 * h + ((lane & 15) >> 2)) * 64 + ((lane >> 4) & 1) * 32 + (lane & 3) * 8;
    f32x16 acc[2]; acc[0] = (f32x16){0.f}; acc[1] = (f32x16){0.f};
    f32x16 o[2];
    LAS float* impw = (LAS float*)(lds + AT_IMP + wid * AT_IMPW);
    unsigned long long selmask = (2ull << cur) - 1ull;

    const int ncmp = ((q0 + 32) >> 4) / 64 + 1;
    const half_t* Kc = P.KC + (size_t)bg * 256 * 64; const half_t* Vc = P.VC + (size_t)bg * 256 * 64;
    const half_t* Ks = P.KS + (size_t)bg * SEQ * 64; const half_t* Vs = P.VS + (size_t)bg * SEQ * 64;
    const int t0 = (cur >= 8) ? cur - 8 : 0;
    const half_t* Kw = P.KW + ((size_t)bg * SEQ + (size_t)t0 * 64) * 64; const half_t* Vw = P.VW + ((size_t)bg * SEQ + (size_t)t0 * 64) * 64;
#define SLC_LOAD(t, sub) tile_dma(Ks + (size_t)(t) * 4096, nullptr, Vs + (size_t)(t) * 4096, sub, false, wid, lane)
#define WIN_LOAD(i, sub) tile_dma(Kw + (size_t)(i) * 4096, nullptr, Vw + (size_t)(i) * 4096, sub, false, wid, lane)
    const int par_c = ((ncmp + AT_SUB - 1) / AT_SUB) & 1, par_w = ((cur + 1 + AT_SUB - 1) / AT_SUB) & 1;
    float m = -1e30f, l = 0.f; const f32x16 zero16 = (f32x16){0.f};
#define CMP_LOAD(t, sub) tile_dma(Kc + (size_t)(t) * 4096, nullptr, Vc + (size_t)(t) * 4096, sub, false, wid, lane)
#define CMP_NEEDMASK(t) ((((q0 + wid * 8) - 31 - 1024 * (t)) >> 4) < 63)
#define CMP_QK(t, buf, CI) do { if (CMP_NEEDMASK(t)) { f32x16 c0_, c1_; tile_cmask(CI, ((qpos - 31 - 1024 * (t)) >> 4) - 4 * h, -1000, c0_, c1_); tile_qk2<4>((buf) + AT_KB + koff, qf, c0_, c1_, p0, p1); } \
        else tile_qk<4>((buf) + AT_KB + koff, qf, CI, p0, p1); } while (0)
#define CMP1_COMP(t, buf) do { f32x16 p0, p1; \
        CMP_QK(t, buf, zero16); \
        const float tm = tile_rowmax(p0, p1), mn = fmaxf(m, tm), alpha = __builtin_amdgcn_exp2f(m - mn); \
        float sum = 0.f; \
        _Pragma("unroll") for (int r = 0; r < 16; ++r) sum += __builtin_amdgcn_exp2f(p0[r] - mn) + __builtin_amdgcn_exp2f(p1[r] - mn); \
        l = l * alpha + sum; m = mn; } while (0)
    KV_STREAM_X(ncmp, CMP_LOAD, CMP1_COMP, 0, false, CMP_LOAD, ncmp);
    l = xhalf_sum(l);
    f32x16 cfin;
    { const float cf = (l > 0.f) ? -(m + __builtin_amdgcn_logf(l)) : -INFINITY;
#pragma unroll
      for (int r = 0; r < 16; ++r) cfin[r] = cf; }
    o[0] = (f32x16){0.f}; o[1] = (f32x16){0.f};
#define CMP2_COMP(t, buf) do { f32x16 p0, p1; \
        VFrags V; vfrag_load(V, (buf) + AT_VB + voff); \
        CMP_QK(t, buf, cfin); \
        _Pragma("unroll") for (int r = 0; r < 16; ++r) { p0[r] = __builtin_amdgcn_exp2f(p0[r]); p1[r] = __builtin_amdgcn_exp2f(p1[r]); } \
        if (cur >= 16) { \
            _Pragma("unroll") for (int kb = 0; kb < 2; ++kb) \
            _Pragma("unroll") for (int c = 0; c < 4; ++c) { \
                const f32x16& p = kb ? p1 : p0; \
                float C = (p[4 * c] + p[4 * c + 1]) + (p[4 * c + 2] + 0.5f * p[4 * c + 3]), D = 0.5f * p[4 * c + 3]; \
                C = quad_sum(C); D = quad_sum(D); \
                const int jb = 16 * (t) + 8 * kb + 2 * c + h; \
                if (hh == 0) { impw[qi * 136 + jb] = C; impw[qi * 136 + 68 + jb + 1] = D; } } } \
        tile_pv(p0, p1, V, o); } while (0)
    KV_STREAM_X(ncmp, CMP_LOAD, CMP2_COMP, par_c, true, SLC_LOAD, cur + 1);
#undef CMP_LOAD
#undef CMP1_COMP
#undef CMP2_COMP
#undef CMP_QK
#undef CMP_NEEDMASK
#pragma unroll
    for (int r = 0; r < 16; ++r) { acc[0][r] = g0 * o[0][r]; acc[1][r] = g0 * o[1][r]; }

    if (cur >= 16) {
        const int tq = lane >> 3, e = lane & 7;
        float v[8];
#pragma unroll
        for (int i = 0; i < 8; ++i) { const int jb = e + 8 * i; const float s = impw[tq * 136 + jb] + impw[tq * 136 + 68 + jb];
            v[i] = (jb >= 1 && jb <= cur - 2) ? s : -1.f; }
        int ix[8];
#pragma unroll
        for (int i = 0; i < 8; ++i) ix[i] = e + 8 * i;
#define TOPK_CX(p_, q_) do { const bool sw_ = (v[q_] > v[p_]) || (v[q_] == v[p_] && ix[q_] < ix[p_]); \
            const float va_ = sw_ ? v[q_] : v[p_], vb_ = sw_ ? v[p_] : v[q_]; const int ia_ = sw_ ? ix[q_] : ix[p_], ib_ = sw_ ? ix[p_] : ix[q_]; v[p_] = va_; v[q_] = vb_; ix[p_] = ia_; ix[q_] = ib_; } while (0)
        TOPK_CX(0, 1); TOPK_CX(2, 3); TOPK_CX(4, 5); TOPK_CX(6, 7);
        TOPK_CX(0, 2); TOPK_CX(1, 3); TOPK_CX(4, 6); TOPK_CX(5, 7);
        TOPK_CX(1, 2); TOPK_CX(5, 6); TOPK_CX(0, 4); TOPK_CX(3, 7);
        TOPK_CX(1, 5); TOPK_CX(2, 6);
        TOPK_CX(1, 4); TOPK_CX(3, 6);
        TOPK_CX(2, 4); TOPK_CX(3, 5);
        TOPK_CX(3, 4);
#undef TOPK_CX
        unsigned long long mk = 0ull;
        for (int it = 0; it < 13; ++it) {
            const float gm = oct_max(v[0]);
            const int gj = oct_min(v[0] == gm ? ix[0] : 99);
            const bool pop = ix[0] == gj;
#pragma unroll
            for (int k = 0; k < 7; ++k) { v[k] = pop ? v[k + 1] : v[k]; ix[k] = pop ? ix[k + 1] : ix[k]; }
            v[7] = pop ? -2.f : v[7];
            mk |= 1ull << gj;
        }
        mk |= 1ull | (1ull << cur) | (1ull << (cur - 1));
        LAS unsigned long long* selw = (LAS unsigned long long*)(lds + AT_SEL + wid * 64);
        if (e == 0) selw[tq] = mk;
        selmask = selw[qi];
    }

    {
        SmState S; sm_reset(S); bool seen = false; o[0] = (f32x16){0.f}; o[1] = (f32x16){0.f};
#define SLC_COMP(t, buf) do { const bool rowsel = (selmask >> (t)) & 1ull; \
            if (__any(rowsel)) { f32x16 p0, p1, ci; \
                _Pragma("unroll") for (int r = 0; r < 16; ++r) ci[r] = rowsel ? S.negm[r] : -INFINITY;     \
                tile_qk<4>((buf) + AT_KB + koff, qf, ci, p0, p1); \
                if ((t) == cur) tile_emask(p0, p1, qrel - 4 * h, -1000); \
                tile_softmax_pv(p0, p1, (buf) + AT_VB + voff, o, S, !seen); seen = seen || rowsel; } } while (0)
        KV_STREAM_X(cur + 1, SLC_LOAD, SLC_COMP, 0, true, WIN_LOAD, cur - t0 + 1);
#undef SLC_COMP
        const float sc = g1 / xhalf_sum(S.l);
#pragma unroll
        for (int r = 0; r < 16; ++r) { acc[0][r] += sc * o[0][r]; acc[1][r] += sc * o[1][r]; }
    }
    {
        SmState S; sm_reset(S); o[0] = (f32x16){0.f}; o[1] = (f32x16){0.f};
#define WIN_COMP(i, buf) do { const int t = t0 + (i); f32x16 p0, p1; \
            if (t == cur || t == cur - 8) { f32x16 c0, c1; tile_cmask(S.negm, t == cur ? qrel - 4 * h : 1000, t == cur ? -1000 : qrel + 1 - 4 * h, c0, c1); \
                tile_qk2<4>((buf) + AT_KB + koff, qf, c0, c1, p0, p1); } \
            else tile_qk<4>((buf) + AT_KB + koff, qf, S.negm, p0, p1); \
            tile_softmax_pv(p0, p1, (buf) + AT_VB + voff, o, S, (i) == 0); } while (0)
        KV_STREAM_X(cur - t0 + 1, WIN_LOAD, WIN_COMP, par_w, true, KV_NONE, 0);
#undef WIN_COMP
#undef WIN_LOAD
#undef SLC_LOAD
        const float sc = g2 / xhalf_sum(S.l);
#pragma unroll
        for (int r = 0; r < 16; ++r) { acc[0][r] += sc * o[0][r]; acc[1][r] += sc * o[1][r]; }
    }
    float ss = 0.f;
    half_t* yrow = P.Y + trow * DM + 512 + head * 64;
#pragma unroll
    for (int db = 0; db < 2; ++db)
#pragma unroll
        for (int cp = 0; cp < 2; ++cp) { unsigned w[4];
#pragma unroll
            for (int e = 0; e < 2; ++e) { const int c = 2 * cp + e; const float a0 = acc[db][4 * c], a1 = acc[db][4 * c + 1], a2 = acc[db][4 * c + 2], a3 = acc[db][4 * c + 3];
                ss += (a0 * a0 + a1 * a1) + (a2 * a2 + a3 * a3); w[2 * e] = pk_rne(a0, a1); w[2 * e + 1] = pk_rne(a2, a3); }
            store_pair16(yrow + db * 32 + 16 * cp + 8 * h, w[0], w[1], w[2], w[3]); }
    ss = xhalf_sum(ss);
    if (h == 0) P.SSN[trow * 8 + head] = ss;
}

struct Args { const float* in[24]; float* out; unsigned char* ws; int ph_lo, ph_hi, li, pad; };

struct ConvItem { int it, k0, n0, sc, c; float w[32]; float cmx[4]; f32x4 g0, g1; };
template <bool GAIN, int OUTM, class SrcFn>
__device__ __forceinline__ void conv_load(ConvItem& I, int it, const float* W, int Ksrc, int Nsrc, const float* gain, const float* gain2, int ksplit, int Ndst, SrcFn src, int lane, const float* cols) {
    const int nblk = Ndst / 32, kb = it / nblk, nb = it % nblk;
    I.it = it; I.k0 = 64 * kb; I.n0 = 32 * nb; I.sc = src(I.n0 + (lane & 31)); I.c = lane & 7;
    const int scc = I.sc >= 0 ? I.sc : 0;
#pragma unroll
    for (int i = 0; i < 32; ++i) { const int k = I.k0 + 2 * i + (lane >> 5), kc = k < Ksrc ? k : Ksrc - 1; I.w[i] = W[(size_t)kc * Nsrc + scc]; }
#pragma unroll
    for (int jj = 0; jj < 4; ++jj) I.cmx[jj] = 1.f;
    if constexpr (OUTM != 0) {
#pragma unroll
        for (int jj = 0; jj < 4; ++jj) I.cmx[jj] = cols[I.n0 + (lane >> 3) + 8 * jj]; }
    I.g0 = (f32x4){1.f, 1.f, 1.f, 1.f}; I.g1 = I.g0;
    if constexpr (GAIN) { int kq = I.k0 + 8 * I.c; kq = kq < Ksrc ? kq : Ksrc - 8; const float* gp = (I.k0 >= ksplit) ? gain2 + (kq - ksplit) : gain + kq; I.g0 = *(const f32x4*)gp; I.g1 = *(const f32x4*)(gp + 4); }
}
template <int OUTM>
__device__ __forceinline__ void conv_finish(const ConvItem& I, int Ksrc, half_t* WT, int Kdst, LAS float* scr, int lane, float* psq) {
    const int k0 = I.k0, n0 = I.n0, c = I.c;
#pragma unroll
    for (int i = 0; i < 32; ++i) { const int kk = 2 * i + (lane >> 5); scr[kk * 33 + (lane & 31)] = (I.sc >= 0 && k0 + kk < Ksrc) ? I.w[i] : 0.f; }
    asm volatile("s_waitcnt lgkmcnt(0)" ::: "memory");
    const float gs[8] = {I.g0[0], I.g0[1], I.g0[2], I.g0[3], I.g1[0], I.g1[1], I.g1[2], I.g1[3]};
    float ssq_ = 0.f;
#pragma unroll
    for (int jj = 0; jj < 4; ++jj) { const int n = (lane >> 3) + 8 * jj; const LAS float* s = scr + (8 * c) * 33 + n; float v[8];
#pragma unroll
        for (int e = 0; e < 8; ++e) { v[e] = s[e * 33] * gs[e]; ssq_ += v[e] * v[e]; }
        if constexpr (OUTM == 2) {
            const float qs = 127.f / I.cmx[jj];
            *(u32x2*)((unsigned char*)WT + (size_t)(n0 + n) * Kdst + k0 + 8 * c) = (u32x2){pk4_i8(clamp_i8(v[0] * qs), clamp_i8(v[1] * qs), clamp_i8(v[2] * qs), clamp_i8(v[3] * qs)), pk4_i8(clamp_i8(v[4] * qs), clamp_i8(v[5] * qs), clamp_i8(v[6] * qs), clamp_i8(v[7] * qs))}; }
        else if constexpr (OUTM == 1) {
#pragma unroll
            for (int e = 0; e < 8; ++e) v[e] = clamp_f8(v[e] * (WDN_TOP / I.cmx[jj]));
            *(u32x2*)((unsigned char*)WT + (size_t)(n0 + n) * Kdst + k0 + 8 * c) = (u32x2){pk4_f8(v[0], v[1], v[2], v[3]), pk4_f8(v[4], v[5], v[6], v[7])}; }
        else *(u32x4*)(WT + (size_t)(n0 + n) * Kdst + k0 + 8 * c) = pk8(v); }
    if (psq != nullptr) { ssq_ = wave_sum(ssq_); if (lane == 0) psq[I.it] = ssq_; }
    asm volatile("s_waitcnt lgkmcnt(0)" ::: "memory");
}
template <bool GAIN, int OUTM = 0, class SrcFn>
__device__ __forceinline__ void conv_wt(const float* W, int Ksrc, int Nsrc, const float* gain, const float* gain2, int ksplit, half_t* WT, int Ndst, int Kdst, SrcFn src, LAS float* scr, int gw, int ngw, int lane, const float* cols = nullptr, float* psq = nullptr) {
    const int nitems = (Ndst / 32) * (Kdst / 64);
    for (int it = gw; it < nitems; it += ngw) { ConvItem I; conv_load<GAIN, OUTM>(I, it, W, Ksrc, Nsrc, gain, gain2, ksplit, Ndst, src, lane, cols); conv_finish<OUTM>(I, Ksrc, WT, Kdst, scr, lane, psq); }
}
__device__ __forceinline__ void colmax_items(const float* W, const float* gain, float* pmax, float* psq, int gw, int ngw, int lane) {
    for (int it = gw; it < 2048; it += ngw) {
        const int kb = it >> 7, nb = it & 127, n = 32 * nb + (lane & 31), kh = 64 * kb + (lane >> 5);
        float w[32], g[32];
#pragma unroll
        for (int i = 0; i < 32; ++i) { w[i] = W[(size_t)(kh + 2 * i) * DFF + n]; g[i] = gain[kh + 2 * i]; }
        float m = 0.f;
#pragma unroll
        for (int i = 0; i < 32; ++i) m = fmaxf(m, fabsf(w[i] * g[i]));
        m = x32_max(m);
        if (lane < 32) pmax[kb * DFF + n] = m;
        float ss = 0.f;
#pragma unroll
        for (int i = 0; i < 32; ++i) ss += (w[i] * g[i]) * (w[i] * g[i]);
        ss = wave_sum(ss); if (lane == 0) psq[it] = ss;
    }
}
__device__ __forceinline__ void colmax_dn_items(const float* W, float* pmax, int gw, int ngw, int lane) {
    for (int it = gw; it < 2048; it += ngw) {
        const int kb = it >> 5, nb = it & 31, n = 32 * nb + (lane & 31), kh = 64 * kb + (lane >> 5);
        float w[32], m = 0.f;
#pragma unroll
        for (int i = 0; i < 32; ++i) w[i] = W[(size_t)(kh + 2 * i) * DM + n];
#pragma unroll
        for (int i = 0; i < 32; ++i) m = fmaxf(m, fabsf(w[i]));
        m = x32_max(m);
        if (lane < 32) pmax[kb * DM + n] = m;
    }
}
__device__ __forceinline__ int src_win(int n) {
    const int t = n >> 8, c = n & 255;
    if (t == 0) return c;
    if (t == 1) { if (c < 128) return 256 + c;
                  if (c < 160) { const int p = c - 128; return 384 + (p >> 1) + 16 * (p & 1); }
                  if (c < 184) return 1696 + (c - 160);
                  return -1; }
    if (t < 4) { const int hd = (t - 2) * 4 + (c >> 6), p = c & 63; const int d = (p < 16) ? (p >> 1) + 8 * (p & 1) : p; return 416 + hd * 64 + d; }
    const int br = (t - 4) * 2 + (c >> 7), g = (c >> 6) & 1, p = c & 63;
    const bool roped = (br == 2 || br == 4);
    const int d = (roped && p < 16) ? (p >> 1) + 8 * (p & 1) : p;
    return 928 + br * 128 + g * 64 + d;
}
__device__ __forceinline__ int src_wuq(int n) { const int hd = n / 96, p = n % 96; return (p < 64) ? hd * 96 + p : hd * 96 + 64 + ((p - 64) >> 1) + 16 * ((p - 64) & 1); }
__device__ __forceinline__ int src_wukv(int n) { return (n < 512) ? (n >> 6) * 128 + (n & 63) : ((n - 512) >> 6) * 128 + 64 + (n & 63); }

#define PH_IDS() int tid_ = threadIdx.x; asm volatile("" : "+v"(tid_)); const int tid = tid_, lane = tid & 63, wid = __builtin_amdgcn_readfirstlane(tid >> 6); \
    const int G = gridDim.x, gt = blockIdx.x * 512 + tid, ngt = G * 512, gw = blockIdx.x * 8 + wid, ngw = G * 8; (void)lane; (void)gt; (void)ngt; (void)gw; (void)ngw; (void)G
#define WSP(T, off) ((T*)(ws + (off)))


__global__ void __launch_bounds__(512, 2) hymba_fwd(Args args) {
    extern __shared__ __attribute__((aligned(16))) unsigned char lds_raw[];
    LAS unsigned char* lds = (LAS unsigned char*)lds_raw;
    unsigned char* ws = args.ws;
    volatile LAS unsigned* MISC = (volatile LAS unsigned*)(lds + LDS_MISC);
    if (threadIdx.x < 16) MISC[threadIdx.x] = 0u;
    __syncthreads();
    XcdBarrier bar = xcd_barrier_post(WSP(unsigned, WS_CTL) + CW_BAR + args.li * XCD_BAR_WORDS, MISC + 8);
#if defined(DBG_STAMP)
#define STAMP_FIRST() STAMP(0)
#define STAMP(k) do { if (blockIdx.x == 0 && threadIdx.x == 0) ((unsigned long long*)(WSP(unsigned, WS_CTL) + 160))[k] = __builtin_amdgcn_s_memrealtime(); } while (0)
#else
#define STAMP_FIRST() do { } while (0)
#define STAMP(k) do { } while (0)
#endif
    const int lo = args.ph_lo, hi = args.ph_hi;
    STAMP_FIRST();
#define IN(k) (lo <= (k) && (k) < hi)
#define REP_BEGIN(k) for (int rep_ = 0; rep_ < ((k) == REPEAT_PHASE ? 2 : 1); ++rep_) {
#define REP_END(k) if ((k) == REPEAT_PHASE && rep_ == 0) xcd_barrier(bar); }
#define SEAM(k) do { if (IN(k) && IN((k) + 1 + ((k) == 4))) xcd_barrier(bar); STAMP((k) + 1); } while (0)

    if (IN(0)) { REP_BEGIN(0)
        PH_IDS();
        LAS float* scr = (LAS float*)(lds + wid * 8448);
        const int BIG = 1 << 30;
        for (int step_ = 0; step_ < 2; ++step_) {
        if (((step_ ^ wid) & 1) == 0) {
        conv_wt<true>(args.in[2], 1024, IN_COLS, args.in[1], nullptr, BIG, WSP(half_t, WS_WIN), NIN, 1024, [](int n) { return src_win(n); }, scr, (gw + ngw - 0 % ngw) % ngw, ngw, lane);
        conv_wt<true>(args.in[4], 256, 768, args.in[3], nullptr, BIG, WSP(half_t, WS_WUQ), 768, 256, [](int n) { return src_wuq(n); }, scr, (gw + ngw - 896 % ngw) % ngw, ngw, lane);
        conv_wt<true>(args.in[6], 128, 1024, args.in[5], nullptr, BIG, WSP(half_t, WS_WUKV), 1024, 256, [](int n) { return src_wukv(n); }, scr, (gw + ngw - 992 % ngw) % ngw, ngw, lane);
        conv_wt<false>(args.in[8], 2048, 128, nullptr, nullptr, BIG, WSP(half_t, WS_WC1), 256, 2048, [](int n) { return n < 128 ? n : -1; }, scr, (gw + ngw - 1120 % ngw) % ngw, ngw, lane);
        conv_wt<false>(args.in[13], 2048, 128, nullptr, nullptr, BIG, WSP(half_t, WS_WC1) + 256 * 2048, 256, 2048, [](int n) { return n < 128 ? n : -1; }, scr, (gw + ngw - 1376 % ngw) % ngw, ngw, lane);
        conv_wt<true>(args.in[19], 1024, 1024, args.in[17], args.in[18], 512, WSP(half_t, WS_WO), 1024, 1024, [](int n) { return n; }, scr, (gw + ngw - 1632 % ngw) % ngw, ngw, lane, nullptr, WSP(float, WS_PSQO));
        colmax_items(args.in[21], args.in[20], WSP(float, WS_PMAX), WSP(float, WS_PSQU), (gw + ngw - 2144 % ngw) % ngw, ngw, lane);
        colmax_dn_items(args.in[22], WSP(float, WS_PMAXD), (gw + ngw - 4192 % ngw) % ngw, ngw, lane);
        { float2* ROPEM = WSP(float2, WS_ROPEM); float2* ROPEN = WSP(float2, WS_ROPEN);
          for (int it = gt; it < SEQ * 16; it += ngt) { const int pos = it >> 4, i = it & 15; const float inv = expf(-logf(500000.f) * (float)(2 * i) / 32.f), a = (float)pos * inv; ROPEM[it] = make_float2(cosf(a), sinf(a)); }
          for (int it = gt; it < SEQ * 8; it += ngt) { const int pos = it >> 3, i = it & 7; const float inv = expf(-logf(500000.f) * (float)(2 * i) / 16.f), a = (float)pos * inv; ROPEN[it] = make_float2(cosf(a), sinf(a)); } }
        for (int o = (gw & 7) == 0 ? (gw >> 3) : 256; o < 256; o += (ngw >> 3)) { const int kv = o >> 7, jj = o & 127; const float* pe = args.in[kv ? 12 : 7]; const float* w1 = args.in[kv ? 13 : 8]; const float* b1 = args.in[kv ? 14 : 9];
            float s = 0.f; for (int k = lane; k < 2048; k += 64) s += pe[k] * w1[(size_t)k * 128 + jj];
            s = wave_sum(s); if (lane == 0) WSP(float, WS_B1P)[o] = b1[jj] + s; }
        } else
        { const float* x = args.in[0]; half_t* XH = WSP(half_t, WS_XH); float* RS1 = WSP(float, WS_RS1); constexpr int XR = 8;
          for (int r0 = gw * XR; r0 < MROWS; r0 += ngw * XR) {
            f32x4 v[XR][4]; float s[XR];
#pragma unroll
            for (int rr = 0; rr < XR; ++rr) { const f32x4* xr = (const f32x4*)(x + (size_t)(r0 + rr) * DM) + lane;
#pragma unroll
                for (int jv = 0; jv < 4; ++jv) v[rr][jv] = __builtin_nontemporal_load(xr + 64 * jv); }
#pragma unroll
            for (int rr = 0; rr < XR; ++rr) { float t = 0.f;
#pragma unroll
                for (int jv = 0; jv < 4; ++jv) t += (v[rr][jv][0] * v[rr][jv][0] + v[rr][jv][1] * v[rr][jv][1]) + (v[rr][jv][2] * v[rr][jv][2] + v[rr][jv][3] * v[rr][jv][3]);
                s[rr] = t; }
#pragma unroll
            for (int rr = 0; rr < XR; ++rr) s[rr] = wave_sum(s[rr]);
#pragma unroll
            for (int rr = 0; rr < XR; ++rr) { u32x2* o8 = (u32x2*)(XH + (size_t)(r0 + rr) * DM) + lane;
#pragma unroll
                for (int jv = 0; jv < 4; ++jv)   __builtin_nontemporal_store((u32x2){pk_rne(v[rr][jv][0], v[rr][jv][1]), pk_rne(v[rr][jv][2], v[rr][jv][3])}, o8 + 64 * jv);
                if (lane == 0) RS1[r0 + rr] = __builtin_amdgcn_rsqf(s[rr] * (1.f / DM) + NORM_EPS); }
          } }
        }
    REP_END(0) }
    SEAM(0);
    if (IN(1)) { REP_BEGIN(1)
        pg8::Gemm g{WSP(half_t, WS_XH), WSP(half_t, WS_WIN), 1024, 1024, 1024}; pg8::StaticOrder S; S.init(MROWS, NIN, gridDim.x, (int)blockIdx.x, 1024, 1024);
        EpiIn E{WSP(float, WS_RS1), WSP(half_t, WS_CQ), WSP(half_t, WS_T1), WSP(half_t, WS_KPE), WSP(float, WS_GATE), WSP(float, WS_SSQ), WSP(float, WS_SSKV), WSP(half_t, WS_QN), WSP(half_t, WS_KVT), WSP(float2, WS_ROPEM), WSP(float2, WS_ROPEN)};
        pg8::gemm_phase(lds, g, S, E);
    REP_END(1) }
    SEAM(1);
    if (IN(2)) { REP_BEGIN(2)
        { PH_IDS();
          if (blockIdx.x < 4) { const float* pm = WSP(float, WS_PMAX);
#pragma unroll
              for (int h = 0; h < 2; ++h) { const int n = blockIdx.x * 1024 + h * 512 + tid; float v[16];
#pragma unroll
                  for (int q = 0; q < 16; ++q) v[q] = pm[q * DFF + n];
                  float m = v[0];
#pragma unroll
                  for (int q = 1; q < 16; ++q) m = fmaxf(m, v[q]);
                  WSP(float, WS_COLS)[n] = fmaxf(m, 1e-30f); } }
          else if (blockIdx.x < 6) { const float* pm = WSP(float, WS_PMAXD); const int n = (blockIdx.x - 4) * 512 + tid; float m = 0.f;
float v[64];
#pragma unroll
              for (int q = 0; q < 64; ++q) v[q] = pm[q * DM + n];
#pragma unroll
              for (int q = 0; q < 64; ++q) m = fmaxf(m, v[q]);
              WSP(float, WS_DCOLS)[n] = fmaxf(m, 1e-30f); }
          else if (blockIdx.x == 6 && wid < 2) {
              const float* ps = wid ? WSP(float, WS_PSQU) : WSP(float, WS_PSQO); const int cnt = wid ? 2048 : 512; float a = 0.f;
              for (int i = lane; i < cnt; i += 64) a += ps[i];
              a = wave_sum(a); if (lane == 0) WSP(float, WS_SCAL)[wid] = fmaxf(a * (wid ? 1.f / 4096.f : 1.f / 1024.f), 1e-30f); } }
        { pg8::Gemm g{WSP(half_t, WS_CQ), WSP(half_t, WS_WUQ), 256, 256, 256}; pg8::StaticOrder S; S.init(MROWS, 768, gridDim.x, (int)blockIdx.x, 256, 256); EpiUq E{WSP(float, WS_SSQ), WSP(half_t, WS_QM), WSP(float2, WS_ROPEM)}; pg8::gemm_phase(lds, g, S, E); }
        { pg8::Gemm g{WSP(half_t, WS_T1), WSP(half_t, WS_WUKV), 128, 256, 256};     pg8::StaticOrder S; S.init(MROWS, 1024, gridDim.x, (int)blockIdx.x, 256, 256); EpiUkv E{WSP(float, WS_SSKV), WSP(half_t, WS_KNM), WSP(half_t, WS_VM)}; pg8::gemm_phase(lds, g, S, E); }
        { pg8::Gemm g{WSP(half_t, WS_KVT), WSP(half_t, WS_WC1), 512, 1024, 2048}; pg8::Cmp1Order S{(int)gridDim.x, (int)blockIdx.x}; EpiC1 E{WSP(float, WS_HIDP)}; pg8::gemm_phase(lds, g, S, E); }
    REP_END(2) }
    SEAM(2);
    if (IN(3)) { REP_BEGIN(3)
        PH_IDS();
        const float* B1P = WSP(float, WS_B1P); const float* HIDP = WSP(float, WS_HIDP); const float2* ROPEN = WSP(float2, WS_ROPEN);
#define P3_LOAD_HV(it_) do { const int kv_ = (it_) >> 10, slab_ = ((it_) >> 5) & 31, n0_ = ((it_) & 31) * 8; \
            _Pragma("unroll") for (int rr = 0; rr < 8; ++rr) _Pragma("unroll") for (int c = 0; c < 2; ++c) _Pragma("unroll") for (int ch = 0; ch < 4; ++ch) \
                hv[rr][c][ch] = HIDP[((size_t)((kv_ * 32 + slab_) * 4 + ch) * 256 + n0_ + rr) * 128 + lane + 64 * c]; } while (0)
        float hv[8][2][4]; float t[32];
        { ConvItem Ia, Ib; LAS float* scr = (LAS float*)(lds + wid * 8448); const bool cv = gw < 2048;
          if (cv) { conv_load<true, 2>(Ia, gw, args.in[21], 1024, 4096, args.in[20], nullptr, 1 << 30, 4096, [](int n) { return n; }, lane, WSP(float, WS_COLS));
                    conv_load<false, 1>(Ib, gw, args.in[22], 4096, 1024, nullptr, nullptr, 1 << 30, 1024, [](int n) { return n; }, lane, WSP(float, WS_DCOLS)); }
#pragma unroll
          for (int j = 0; j < 32; ++j) { const int i = tid + 512 * j, kv = j >> 4, k = (i >> 6) & 127, p = i & 63; const int dsrc = (kv == 0 && p < 16) ? (p >> 1) + 8 * (p & 1) : p;
              t[j] = args.in[kv ? 15 : 10][k * 64 + dsrc]; }
          if (cv) { P3_LOAD_HV(gw);
                    conv_finish<2>(Ia, 1024, WSP(half_t, WS_WUPQ), 1024, scr, lane, nullptr);
                    conv_finish<1>(Ib, 4096, WSP(half_t, WS_WDN), 4096, scr, lane, nullptr); }
          for (int it = gw + ngw; it < 2048; it += ngw) {
              conv_load<true, 2>(Ia, it, args.in[21], 1024, 4096, args.in[20], nullptr, 1 << 30, 4096, [](int n) { return n; }, lane, WSP(float, WS_COLS)); conv_finish<2>(Ia, 1024, WSP(half_t, WS_WUPQ), 1024, scr, lane, nullptr);
              conv_load<false, 1>(Ib, it, args.in[22], 4096, 1024, nullptr, nullptr, 1 << 30, 1024, [](int n) { return n; }, lane, WSP(float, WS_DCOLS)); conv_finish<1>(Ib, 4096, WSP(half_t, WS_WDN), 4096, scr, lane, nullptr); } }
        __syncthreads();
        LAS float* w2s = (LAS float*)lds;
        LAS float* hl = (LAS float*)(lds + 65536 + wid * 4096);
#pragma unroll
        for (int j = 0; j < 32; ++j) w2s[tid + 512 * j] = t[j];
        __syncthreads();
        for (int it = gw; it < 2 * 32 * 32; it += ngw) {
            const int kv = it >> 10, slab = (it >> 5) & 31, n0 = (it & 31) * 8;
            const float* b2 = args.in[kv ? 16 : 11];
            if (it != gw) P3_LOAD_HV(it);
#pragma unroll
            for (int rr = 0; rr < 8; ++rr)
#pragma unroll
                for (int c = 0; c < 2; ++c) { const int col = lane + 64 * c; const float s = B1P[kv * 128 + col] + ((hv[rr][c][0] + hv[rr][c][1]) + (hv[rr][c][2] + hv[rr][c][3]));
                    const float z = 0.7978845608028654f * (s + 0.044715f * s * s * s), th = 1.f - 2.f / (1.f + __expf(2.f * z));
                    hl[rr * 128 + col] = 0.5f * s * (1.f + th); }
            asm volatile("s_waitcnt lgkmcnt(0)" ::: "memory");
            const int dsrc = (kv == 0 && lane < 16) ? (lane >> 1) + 8 * (lane & 1) : lane;
            float a[8];
#pragma unroll
            for (int rr = 0; rr < 8; ++rr) a[rr] = b2[dsrc];
            const LAS float* wk = w2s + kv * 8192 + lane;
#pragma unroll 4
            for (int k = 0; k < 128; k += 4) {
                const float w0 = wk[k * 64], w1 = wk[(k + 1) * 64], w2v = wk[(k + 2) * 64], w3 = wk[(k + 3) * 64];
#pragma unroll
                for (int rr = 0; rr < 8; ++rr) { const f32x4 hh = *(const LAS f32x4*)(hl + rr * 128 + k); a[rr] += (hh[0] * w0 + hh[1] * w1) + (hh[2] * w2v + hh[3] * w3); }
            }
            half_t* dst = (kv ? WSP(half_t, WS_VC) : WSP(half_t, WS_KC)) + (size_t)slab * 256 * 64;
#pragma unroll
            for (int rr = 0; rr < 8; ++rr) { const int n = n0 + rr; float v = a[rr];
                if (kv == 0) { const float pp = dpp_f<DPP_X1>(v);
                    if (lane < 16) { const int e1 = 16 * n + 31; const float2 cs = ROPEN[(size_t)(e1 > 4095 ? 4095 : e1) * 8 + (lane >> 1)];
                        v = (lane & 1) ? (v * cs.x + pp * cs.y) : (v * cs.x - pp * cs.y); } }
                if (n >= 255) v = 0.f;
                dst[kv ? v_off(n, lane) : k_off(n, lane)] = (half_t)v; }
            asm volatile("s_waitcnt lgkmcnt(0)" ::: "memory");
        }
    REP_END(3) }
    SEAM(3);
    if (IN(4)) {
        half_t* KVT = WSP(half_t, WS_KVT);
        const AttnPtrs P{WSP(half_t, WS_QM), WSP(half_t, WS_KNM), WSP(half_t, WS_KPE), WSP(half_t, WS_VM), WSP(half_t, WS_QN), WSP(half_t, WS_KC), WSP(half_t, WS_VC),
                         KVT + 2 * KVT_STRIDE, KVT + 3 * KVT_STRIDE, KVT + 4 * KVT_STRIDE, KVT + 5 * KVT_STRIDE, WSP(float, WS_GATE), WSP(half_t, WS_Y), WSP(float, WS_SSM), WSP(float, WS_SSN)};
        volatile LAS int* qw = (volatile LAS int*)(lds + AT_QIDX);
        if ((threadIdx.x >> 6) >= 4) __builtin_amdgcn_s_setprio(1);
        REP_BEGIN(4)
        unsigned* qhead = WSP(unsigned, WS_CTL) + CW_QHEAD + 64 * rep_;
        for (;;) {
            if (threadIdx.x == 0) *qw = (int)__hip_atomic_fetch_add(qhead, 1u, __ATOMIC_RELAXED, __HIP_MEMORY_SCOPE_AGENT);
            __syncthreads();
            const int qi = __builtin_amdgcn_readfirstlane(*qw);
            __syncthreads();
            if (qi >= 4096) break;
            const int L = qi >> 8, r = qi & 255;
#ifdef REP_FILTER
            if (rep_ == 1 && ((REP_FILTER == 1) != (r < 128))) continue;
#endif
            if (r >= 128) { const int r1 = r - 128; if (rep_ == 1) mla_unit<ABL>(P, r1, 15 - L, lds, true); else mla_unit<0>(P, r1, 15 - L, lds); }
            else { const int r2 = r; nsa_unit(P, r2 >> 2, 63 - 4 * L - (r2 & 3), lds); }
        }
        REP_END(4)
        __builtin_amdgcn_s_setprio(0);
    }
    SEAM(4);
    if (IN(6)) { REP_BEGIN(6) pg8::Gemm g{WSP(half_t, WS_Y), WSP(half_t, WS_WO), 1024, 1024, 1024}; pg8::StaticOrder S; S.init(MROWS, 1024, gridDim.x, (int)blockIdx.x, 1024, 1024);
        LAS float* rowc = (LAS float*)(lds + LDS_ROWC);
        { PH_IDS(); const float* SSM = WSP(float, WS_SSM); const float* SSN = WSP(float, WS_SSN);
          if (tid < 4) ((LAS int*)(rowc + 3072))[tid] = -1;
          __syncthreads();
          pg8::Unit u_; int last = -1;
          for (int i = 0; S.next(i, u_); ++i) if (u_.pm != last) { last = u_.pm; const int slot = (u_.pm >> 3) & 3;
              if (tid < 256) { const size_t row = (size_t)u_.pm * 256 + tid; const f32x4 m0 = *(const f32x4*)(SSM + row * 8), m1 = *(const f32x4*)(SSM + row * 8 + 4), n0 = *(const f32x4*)(SSN + row * 8), n1 = *(const f32x4*)(SSN + row * 8 + 4);
                  const float rn = __builtin_amdgcn_rsqf((sum4(n0) + sum4(n1)) * (1.f / 512.f) + NORM_EPS);
                  rowc[(slot * 256 + tid) * 3] = __builtin_amdgcn_rsqf((sum4(m0) + sum4(m1)) * (1.f / 512.f) + NORM_EPS) / rn; rowc[(slot * 256 + tid) * 3 + 1] = rn; rowc[(slot * 256 + tid) * 3 + 2] = h1q_scale(WSP(float, WS_RS1)[row], WSP(float, WS_SCAL)[0]); }
              if (tid == 0) ((LAS int*)(rowc + 3072))[slot] = u_.pm; }
          __syncthreads(); }
        EpiWo E{WSP(half_t, WS_XH), WSP(half_t, WS_H1), WSP(float, WS_SS2), WSP(float, WS_SSM), WSP(float, WS_SSN), (LAS float*)(lds + LDS_RED), WSP(unsigned char, WS_H1Q), WSP(float, WS_RS1), WSP(float, WS_SCAL), rowc}; pg8::gemm_phase<EpiWo, pg8::StaticOrder, true, false, true>(lds, g, S, E); REP_END(6) }
    SEAM(6);
    if (IN(7)) { REP_BEGIN(7)
        pg8::Gemm g{WSP(half_t, WS_H1Q), WSP(half_t, WS_WUPQ), 512, 512, 512}; pg8::StaticOrder S; S.init(MROWS, DFF, gridDim.x, (int)blockIdx.x, 512, 512);
        LAS float* rowc = (LAS float*)(lds + LDS_ROWC);
        { PH_IDS(); const float* SS2 = WSP(float, WS_SS2);
          if (tid < 4) ((LAS int*)(rowc + 3072))[tid] = -1;
          __syncthreads();
          pg8::Unit u_; int last = -1;
          for (int i = 0; S.next(i, u_); ++i) if (u_.pm != last) { last = u_.pm; const int slot = (u_.pm >> 3) & 3;
              if (tid < 256) { const int row = u_.pm * 256 + tid; const f32x4 s4 = *(const f32x4*)(SS2 + (size_t)row * 4); rowc[slot * 256 + tid] = up_row_factor(sum4(s4), WSP(float, WS_RS1)[row], WSP(float, WS_SCAL)); }
              if (tid == 0) ((LAS int*)(rowc + 3072))[slot] = u_.pm; }
          __syncthreads(); }
        EpiUp E{WSP(float, WS_SS2), WSP(unsigned char, WS_A2), rowc, WSP(float, WS_COLS), WSP(float, WS_RS1), WSP(float, WS_SCAL)}; pg8::gemm_phase<EpiUp, pg8::StaticOrder, false, false, true, true>(lds, g, S, E); REP_END(7) }
    SEAM(7);
    if (IN(8)) { REP_BEGIN(8) pg8::Gemm g{WSP(half_t, WS_A2), WSP(half_t, WS_WDN), 2048, 2048, 2048}; pg8::StaticOrder S; S.init(MROWS, 1024, gridDim.x, (int)blockIdx.x, 2048, 2048);
        EpiDn E{WSP(half_t, WS_H1), args.out, args.in[23], WSP(unsigned, WS_EX), (LAS float*)(lds + LDS_RED), WSP(float, WS_SCAL), WSP(float, WS_DCOLS)}; pg8::gemm_phase<EpiDn, pg8::StaticOrder, false, true, true>(lds, g, S, E); REP_END(8) }
    STAMP(10);
#undef IN
#undef SEAM
}

#if DBG_CHECK
constexpr int CW_DBG = 96;
__device__ __forceinline__ void dbg_flag(unsigned* ctl, int id, float got, float ref) {
    const float d = fabsf(got - ref);
    if (!(d <= 0.03f + 0.03f * fabsf(ref))) atomicOr(ctl + CW_DBG, 1u << id);
}
__device__ __forceinline__ float h2f(const half_t* p) { return (float)(*p); }
__device__ float dbg_rope_cs(int pos, int i, int dim, bool want_sin) { const float inv = expf(-logf(500000.f) * (float)(2 * i) / (float)dim), a = (float)pos * inv; return want_sin ? sinf(a) : cosf(a); }
__device__ float dbg_u(const Args& args, int row, int co, int lane) {
    const float* x = args.in[0] + (size_t)row * DM; const float* g = args.in[1]; const float* w = args.in[2];
    float ss = 0.f, acc = 0.f;
    for (int k = lane; k < DM; k += 64) { const float xv = x[k]; ss += xv * xv; acc += xv * g[k] * w[(size_t)k * IN_COLS + co]; }
    ss = wave_sum(ss); acc = wave_sum(acc);
    return acc * (1.f / sqrtf(ss / DM + NORM_EPS));
}
__device__ const int dbgt_0_dbg_rows[4] = {0, 4096 + 6, 30000, 65535};
__device__ const int dbgt_1_cs[3] = {0, 77, 255};
__device__ const int dbgt_2_cs[2] = {5, 127};
__device__ const int dbgt_3_ps[4] = {0, 1, 14, 31};
__device__ const int dbgt_4_is[3] = {0, 13, 23};
__device__ const int dbgt_5_hs[4] = {0, 3, 5, 7};
__device__ const int dbgt_6_ps[4] = {0, 1, 14, 40};
__device__ const int dbgt_7_brs[7] = {0, 1, 2, 2, 3, 4, 5};
__device__ const int dbgt_8_gs[7] = {0, 1, 0, 1, 0, 1, 1};
__device__ const int dbgt_9_ps[7] = {3, 20, 1, 50, 9, 14, 63};
__device__ const int dbgt_10_hs[4] = {0, 2, 5, 7};
__device__ const int dbgt_11_ps[4] = {3, 64, 77, 95};
__device__ const int dbgt_12_slabs[3] = {0, 17, 31};
__device__ const int dbgt_13_ns[3] = {0, 100, 254};
__device__ const int dbgt_14_ps[4] = {0, 1, 15, 40};
__device__ const int dbgt_15_bs[5] = {0, 0, 5, 15, 9};
__device__ const int dbgt_16_hs[5] = {0, 3, 7, 2, 5};
__device__ const int dbgt_17_qs[5] = {0, 100, 2047, 4095, 1234};
__device__ const int dbgt_18_bs[6] = {0, 3, 7, 15, 11, 2};
__device__ const int dbgt_19_gs[6] = {0, 1, 0, 1, 1, 0};
__device__ const int dbgt_20_hhs[6] = {0, 2, 3, 1, 0, 2};
__device__ const int dbgt_21_qs[6] = {5, 700, 1030, 4095, 2500, 3071};
__device__ const int dbgt_22_dd[3] = {0, 33, 63};
__device__ const int dbgt_23_c4[4] = {0, 1300, 2777, 4095};
__device__ const int dbgt_24_cols[4] = {0, 300, 777, 1023};
__device__ const int dbgt_25_cc[6] = {768, 896, 800, 776, 775, 1023};
__global__ void __launch_bounds__(512) dbg_checks_a(Args args) {
    extern __shared__ __attribute__((aligned(16))) unsigned char lds_raw[]; LAS unsigned char* lds = (LAS unsigned char*)lds_raw;
    unsigned char* ws = args.ws; unsigned* ctl = WSP(unsigned, WS_CTL);
    const int lane = threadIdx.x & 63, wid = threadIdx.x >> 6;
    const int* rows = dbgt_0_dbg_rows;
    const half_t* XH = WSP(half_t, WS_XH);
    if (blockIdx.x == 0) {
        if (wid == 0) for (int s = 0; s < 4; ++s) { const int r = rows[s]; const float* x = args.in[0] + (size_t)r * DM; float ss = 0.f; for (int k = lane; k < DM; k += 64) ss += x[k] * x[k]; ss = wave_sum(ss);
            if (lane == 0) { dbg_flag(ctl, 1, WSP(float, WS_RS1)[r], 1.f / sqrtf(ss / DM + NORM_EPS)); dbg_flag(ctl, 1, h2f(XH + (size_t)r * DM + 517), x[517]); } }
        if (wid == 1) for (int s = 0; s < 4; ++s) { const int r = rows[s], pos = r & 4095, b = r >> 12;
            { const int* cs = dbgt_1_cs; for (int i = 0; i < 3; ++i) { const float u = dbg_u(args, r, cs[i], lane); if (lane == 0) dbg_flag(ctl, 2, h2f(WSP(half_t, WS_CQ) + (size_t)r * 256 + cs[i]), u); } }
            { const int* cs = dbgt_2_cs; for (int i = 0; i < 2; ++i) { const float u = dbg_u(args, r, 256 + cs[i], lane); if (lane == 0) dbg_flag(ctl, 3, h2f(WSP(half_t, WS_T1) + (size_t)r * 256 + cs[i]), u); } }
            { const int* ps = dbgt_3_ps; for (int i = 0; i < 4; ++i) { const int p = ps[i], pr = p >> 1; const float x1 = dbg_u(args, r, 384 + pr, lane), x2 = dbg_u(args, r, 384 + pr + 16, lane);
                const float c = dbg_rope_cs(pos, pr, 32, false), sn = dbg_rope_cs(pos, pr, 32, true); const float ref = (p & 1) ? (x2 * c + x1 * sn) : (x1 * c - x2 * sn);
                if (lane == 0) dbg_flag(ctl, 4, h2f(WSP(half_t, WS_KPE) + (size_t)b * SEQ * 32 + kpe_off(pos, p)), ref); } }
            { const int* is = dbgt_4_is; for (int i = 0; i < 3; ++i) { const float u = dbg_u(args, r, 1696 + is[i], lane); if (lane == 0) dbg_flag(ctl, 5, WSP(float, WS_GATE)[(size_t)r * 24 + is[i]], 1.f / (1.f + expf(-u))); } }
            { const int* hs = dbgt_5_hs; const int* ps = dbgt_6_ps; for (int i = 0; i < 4; ++i) { const int hd = hs[i], p = ps[i]; float ref;
                if (p < 16) { const int pr = p >> 1; const float x1 = dbg_u(args, r, 416 + hd * 64 + pr, lane), x2 = dbg_u(args, r, 416 + hd * 64 + pr + 8, lane);
                    const float c = dbg_rope_cs(pos, pr, 16, false), sn = dbg_rope_cs(pos, pr, 16, true); ref = (p & 1) ? (x2 * c + x1 * sn) : (x1 * c - x2 * sn); }
                else ref = dbg_u(args, r, 416 + hd * 64 + p, lane);
                if (lane == 0) dbg_flag(ctl, 6, h2f(WSP(half_t, WS_QN) + (size_t)r * 512 + hd * 64 + p), ref * QS_N); } }
            { const int* brs = dbgt_7_brs; const int* gs = dbgt_8_gs; const int* ps = dbgt_9_ps;
              for (int i = 0; i < 7; ++i) { const int br = brs[i], g = gs[i], p = ps[i]; const int base = 928 + br * 128 + g * 64; float ref;
                if ((br == 2 || br == 4) && p < 16) { const int pr = p >> 1; const float x1 = dbg_u(args, r, base + pr, lane), x2 = dbg_u(args, r, base + pr + 8, lane);
                    const float c = dbg_rope_cs(pos, pr, 16, false), sn = dbg_rope_cs(pos, pr, 16, true); ref = (p & 1) ? (x2 * c + x1 * sn) : (x1 * c - x2 * sn); }
                else ref = dbg_u(args, r, base + p, lane);
                if (lane == 0) dbg_flag(ctl, 7, h2f(WSP(half_t, WS_KVT) + (size_t)br * KVT_STRIDE + (size_t)(b * 2 + g) * SEQ * 64 + (br < 2 ? (size_t)pos * 64 + p : ((br & 1) ? v_off(pos, p) : k_off(pos, p)))), ref); } }
        }
        if (wid == 2) for (int s = 0; s < 4; ++s) { const int r = rows[s], pos = r & 4095, b = r >> 12;
            const half_t* cq = WSP(half_t, WS_CQ) + (size_t)r * 256; const half_t* t1 = WSP(half_t, WS_T1) + (size_t)r * 256;
            float sq = 0.f, skv = 0.f; for (int k = lane; k < 256; k += 64) { const float a = h2f(cq + k); sq += a * a; } for (int k = lane; k < 128; k += 64) { const float a = h2f(t1 + k); skv += a * a; }
            sq = wave_sum(sq); skv = wave_sum(skv); const float rq = 1.f / sqrtf(sq / 256.f + NORM_EPS), rkv = 1.f / sqrtf(skv / 128.f + NORM_EPS);
            const int* hs = dbgt_10_hs; const int* ps = dbgt_11_ps;
            for (int i = 0; i < 4; ++i) { const int hd = hs[i], p = ps[i]; float ref;
                auto qcol = [&](int col) { float a = 0.f; for (int k = lane; k < 256; k += 64) a += h2f(cq + k) * args.in[3][k] * args.in[4][(size_t)k * 768 + col]; return wave_sum(a) * rq; };
                if (p < 64) ref = qcol(hd * 96 + p);
                else { const int pp = p - 64, pr = pp >> 1; const float x1 = qcol(hd * 96 + 64 + pr), x2 = qcol(hd * 96 + 64 + pr + 16);
                    const float c = dbg_rope_cs(pos, pr, 32, false), sn = dbg_rope_cs(pos, pr, 32, true); ref = (pp & 1) ? (x2 * c + x1 * sn) : (x1 * c - x2 * sn); }
                if (lane == 0) dbg_flag(ctl, 8, h2f(WSP(half_t, WS_QM) + (size_t)r * 768 + hd * 96 + p), ref * QS_M); }
            for (int i = 0; i < 4; ++i) { const int hd = hs[i], d = ps[i] & 63;
                auto kvcol = [&](int col) { float a = 0.f; for (int k = lane; k < 128; k += 64) a += h2f(t1 + k) * args.in[5][k] * args.in[6][(size_t)k * 1024 + col]; return wave_sum(a) * rkv; };
                const float kr = kvcol(hd * 128 + d), vr = kvcol(hd * 128 + 64 + d);
                if (lane == 0) { dbg_flag(ctl, 9, h2f(WSP(half_t, WS_KNM) + (size_t)(b * 8 + hd) * SEQ * 64 + k_off(pos, d)), kr); dbg_flag(ctl, 10, h2f(WSP(half_t, WS_VM) + (size_t)(b * 8 + hd) * SEQ * 64 + v_off(pos, d)), vr); } }
        }
        if (wid == 3 || wid == 4) { const int kv = wid - 3; const int* slabs = dbgt_12_slabs; const int* ns = dbgt_13_ns;
            LAS float* hid = (LAS float*)(lds + 65536 + kv * 1024);
            const float* pe = args.in[kv ? 12 : 7]; const float* w1 = args.in[kv ? 13 : 8]; const float* b1 = args.in[kv ? 14 : 9]; const float* w2 = args.in[kv ? 15 : 10]; const float* b2 = args.in[kv ? 16 : 11];
            for (int s = 0; s < 3; ++s) { const int slab = slabs[s], n = ns[s]; const half_t* tok = WSP(half_t, WS_KVT) + (size_t)kv * KVT_STRIDE + ((size_t)slab * SEQ + 16 * n) * 64;
                for (int jj = 0; jj < 2; ++jj) { const int j = lane + 64 * jj; float a = b1[j]; for (int k = 0; k < 2048; ++k) a += (h2f(tok + k) + pe[k]) * w1[(size_t)k * 128 + j];
                    const float z = 0.7978845608028654f * (a + 0.044715f * a * a * a); hid[j] = 0.5f * a * (1.f + tanhf(z)); }
                asm volatile("s_waitcnt lgkmcnt(0)" ::: "memory");
                float o = b2[lane]; for (int j = 0; j < 128; ++j) o += hid[j] * w2[j * 64 + lane];
                const int* ps = dbgt_14_ps;
                for (int i = 0; i < 4; ++i) { const int p = ps[i]; float ref;
                    if (kv == 0 && p < 16) { const int pr = p >> 1; const float x1 = __shfl(o, pr), x2 = __shfl(o, pr + 8); const int pos = 16 * n + 31;
                        const float c = dbg_rope_cs(pos, pr, 16, false), sn = dbg_rope_cs(pos, pr, 16, true); ref = (p & 1) ? (x2 * c + x1 * sn) : (x1 * c - x2 * sn); }
                    else ref = __shfl(o, p);
                    if (lane == 0) dbg_flag(ctl, 11 + kv, h2f((kv ? WSP(half_t, WS_VC) : WSP(half_t, WS_KC)) + (size_t)slab * 256 * 64 + (kv ? v_off(n, p) : k_off(n, p))), ref); }
                asm volatile("s_waitcnt lgkmcnt(0)" ::: "memory"); }
        }
        if (wid == 5) { const int* bs = dbgt_15_bs; const int* hs = dbgt_16_hs; const int* qs = dbgt_17_qs;
            for (int s = 0; s < 5; ++s) { const int b = bs[s], hd = hs[s], q = qs[s]; const size_t r = (size_t)b * SEQ + q;
                const half_t* qv = WSP(half_t, WS_QM) + r * 768 + hd * 96; const half_t* Kn = WSP(half_t, WS_KNM) + (size_t)(b * 8 + hd) * SEQ * 64; const half_t* Kp = WSP(half_t, WS_KPE) + (size_t)b * SEQ * 32; const half_t* V = WSP(half_t, WS_VM) + (size_t)(b * 8 + hd) * SEQ * 64;
                float mx = -1e30f;
                for (int k = lane; k <= q; k += 64) { float sc = 0.f; for (int d = 0; d < 64; ++d) sc += h2f(qv + d) * h2f(Kn + k_off(k, d)); for (int d = 0; d < 32; ++d) sc += h2f(qv + 64 + d) * h2f(Kp + kpe_off(k, d)); mx = fmaxf(mx, sc); }
                for (int o = 1; o < 64; o <<= 1) mx = fmaxf(mx, __shfl_xor(mx, o));
                float l = 0.f, o0 = 0.f, o1 = 0.f, o2 = 0.f;
                for (int k = lane; k <= q; k += 64) { float sc = 0.f; for (int d = 0; d < 64; ++d) sc += h2f(qv + d) * h2f(Kn + k_off(k, d)); for (int d = 0; d < 32; ++d) sc += h2f(qv + 64 + d) * h2f(Kp + kpe_off(k, d));
                    const float p = exp2f(sc - mx); l += p; o0 += p * h2f(V + v_off(k, 0)); o1 += p * h2f(V + v_off(k, 33)); o2 += p * h2f(V + v_off(k, 63)); }
                l = wave_sum(l); o0 = wave_sum(o0); o1 = wave_sum(o1); o2 = wave_sum(o2);
                if (lane == 0) { const half_t* y = WSP(half_t, WS_Y) + r * DM + hd * 64; dbg_flag(ctl, 13, h2f(y + 0), o0 / l); dbg_flag(ctl, 13, h2f(y + 33), o1 / l); dbg_flag(ctl, 13, h2f(y + 63), o2 / l); } }
        }
        if (wid == 6 || wid == 7) { const int* bs = dbgt_18_bs; const int* gs = dbgt_19_gs; const int* hhs = dbgt_20_hhs; const int* qs = dbgt_21_qs;
            LAS float* pc = (LAS float*)(lds + 70000 + (wid - 6) * 8192);
            for (int s = wid - 6; s < 6; s += 2) { const int b = bs[s], g = gs[s], hh = hhs[s], q = qs[s], cur = q >> 6; const size_t r = (size_t)b * SEQ + q; const int bg = b * 2 + g;
                const half_t* Kc = WSP(half_t, WS_KC) + (size_t)bg * 256 * 64; const half_t* Vc = WSP(half_t, WS_VC) + (size_t)bg * 256 * 64;
                for (int h4 = 0; h4 < 4; ++h4) { const half_t* qv = WSP(half_t, WS_QN) + r * 512 + (g * 4 + h4) * 64;
                    float sc[4]; float mx = -1e30f;
                    for (int i = 0; i < 4; ++i) { const int n = lane + 64 * i; float a = -INFINITY; if (n < 255 && 16 * n + 31 <= q) { a = 0.f; for (int d = 0; d < 64; ++d) a += h2f(qv + d) * h2f(Kc + k_off(n, d)); } sc[i] = a; mx = fmaxf(mx, a); }
                    for (int o = 1; o < 64; o <<= 1) mx = fmaxf(mx, __shfl_xor(mx, o));
                    float l = 0.f; for (int i = 0; i < 4; ++i) { sc[i] = exp2f(sc[i] - mx); l += sc[i]; } l = wave_sum(l);
                    for (int i = 0; i < 4; ++i) pc[h4 * 256 + lane + 64 * i] = (l > 0.f) ? sc[i] / l : 0.f; }
                asm volatile("s_waitcnt lgkmcnt(0)" ::: "memory");
                { float imp = 0.f; const int jb = lane;
                  for (int n = 0; n < 255; ++n) { const int cs = 16 * n, ss0 = 64 * jb; const int lo2 = cs > ss0 ? cs : ss0, hi2 = (cs + 32 < ss0 + 64) ? cs + 32 : ss0 + 64; const int ov = hi2 - lo2; if (ov > 0) { const float w = (float)ov / 32.f; for (int h4 = 0; h4 < 4; ++h4) imp += pc[h4 * 256 + n] * w; } }
                  const bool forced = (jb == 0) || (jb == cur) || (jb == cur - 1), causal = jb * 64 <= q;
                  pc[1024 + jb] = forced ? 1e9f : (causal ? imp : -1e9f); }
                asm volatile("s_waitcnt lgkmcnt(0)" ::: "memory");
                if (lane == 0) { for (int jb = 0; jb < 64; ++jb) pc[1088 + jb] = 0.f; for (int it = 0; it < 16; ++it) { int best = -1; float bv = -INFINITY; for (int jb = 0; jb < 64; ++jb) if (pc[1088 + jb] == 0.f && pc[1024 + jb] > bv) { bv = pc[1024 + jb]; best = jb; } pc[1088 + best] = 1.f; } }
                asm volatile("s_waitcnt lgkmcnt(0)" ::: "memory");
                const half_t* qv = WSP(half_t, WS_QN) + r * 512 + (g * 4 + hh) * 64; const int* dd = dbgt_22_dd;
                float oc[3] = {0.f, 0.f, 0.f};
                for (int i = 0; i < 4; ++i) { const int n = lane + 64 * i; if (n < 255) { const float p = pc[hh * 256 + n]; for (int e = 0; e < 3; ++e) oc[e] += p * h2f(Vc + v_off(n, dd[e])); } }
                for (int e = 0; e < 3; ++e) oc[e] = wave_sum(oc[e]);
                float osw[2][3];
                for (int br = 0; br < 2; ++br) { const half_t* Kx = WSP(half_t, WS_KVT) + (size_t)(2 + 2 * br) * KVT_STRIDE + (size_t)bg * SEQ * 64; const half_t* Vx = WSP(half_t, WS_KVT) + (size_t)(3 + 2 * br) * KVT_STRIDE + (size_t)bg * SEQ * 64;
                    float mx = -1e30f;
                    for (int k = lane; k <= q; k += 64) { const bool ok = br ? (q - k < 512) : (pc[1088 + (k >> 6)] != 0.f); if (!ok) continue; float a = 0.f; for (int d = 0; d < 64; ++d) a += h2f(qv + d) * h2f(Kx + k_off(k, d)); mx = fmaxf(mx, a); }
                    for (int o = 1; o < 64; o <<= 1) mx = fmaxf(mx, __shfl_xor(mx, o));
                    float l = 0.f, a3[3] = {0.f, 0.f, 0.f};
                    for (int k = lane; k <= q; k += 64) { const bool ok = br ? (q - k < 512) : (pc[1088 + (k >> 6)] != 0.f); if (!ok) continue; float a = 0.f; for (int d = 0; d < 64; ++d) a += h2f(qv + d) * h2f(Kx + k_off(k, d));
                        const float p = exp2f(a - mx); l += p; for (int e = 0; e < 3; ++e) a3[e] += p * h2f(Vx + v_off(k, dd[e])); }
                    l = wave_sum(l); for (int e = 0; e < 3; ++e) osw[br][e] = wave_sum(a3[e]) / l; }
                if (lane == 0) { const float* gt = WSP(float, WS_GATE) + r * 24; const int head = g * 4 + hh; const float g0 = gt[head], g1 = gt[8 + head], g2 = gt[16 + head];
                    for (int e = 0; e < 3; ++e) dbg_flag(ctl, q < 1024 ? 14 : 15, h2f(WSP(half_t, WS_Y) + r * DM + 512 + head * 64 + dd[e]), g0 * oc[e] + g1 * osw[0][e] + g2 * osw[1][e]); }
                asm volatile("s_waitcnt lgkmcnt(0)" ::: "memory"); }
        }
    }
}
__global__ void __launch_bounds__(512) dbg_checks_b(Args args, int which) {
    unsigned char* ws = args.ws; unsigned* ctl = WSP(unsigned, WS_CTL);
    const int lane = threadIdx.x & 63, wid = threadIdx.x >> 6;
    const int* rows = dbgt_0_dbg_rows; const int* cols = dbgt_24_cols;
    if (blockIdx.x != 0 || wid >= 4) return;
    const int r = rows[wid];
    if (which == 6 && wid == 3) { const half_t* y = WSP(half_t, WS_Y) + (size_t)r * DM; const int* cc = dbgt_25_cc;
        for (int i = 0; i < 6; ++i) { const int c = cc[i]; float a = 0.f; for (int k = lane; k < DM; k += 64) a += h2f(y + k) * (k < 512 ? args.in[17][k] : args.in[18][k - 512]) * args.in[19][(size_t)k * DM + c];
            const float dot = wave_sum(a), xr = args.in[0][(size_t)r * DM + c], got = h2f(WSP(half_t, WS_H1) + (size_t)r * DM + c);
            if (lane == 0 && !(fabsf(got - (dot + xr)) <= 0.03f + 0.03f * fabsf(dot + xr))) atomicAdd(ctl + CW_DBG + 2, 1u << i); } }
    if (which == 6) { const half_t* y = WSP(half_t, WS_Y) + (size_t)r * DM;
        { float s0 = 0.f, s1 = 0.f; for (int k = lane; k < 512; k += 64) { const float a = h2f(y + k), b = h2f(y + 512 + k); s0 += a * a; s1 += b * b; } s0 = wave_sum(s0); s1 = wave_sum(s1);
          if (lane == 0) { dbg_flag(ctl, 20, s0 / 512.f, 1.f); dbg_flag(ctl, 21, s1 / 512.f, 1.f); } }
        { const int c = cols[wid], k = rows[wid] & 1023; if (lane == 0) dbg_flag(ctl, 22, 100.f * h2f(WSP(half_t, WS_WO) + (size_t)c * DM + k), 100.f * args.in[19][(size_t)k * DM + c] * (k < 512 ? args.in[17][k] : args.in[18][k - 512])); }
        for (int i = 0; i < 4; ++i) { const int c = cols[i]; float a = 0.f; for (int k = lane; k < DM; k += 64) a += h2f(y + k) * (k < 512 ? args.in[17][k] : args.in[18][k - 512]) * args.in[19][(size_t)k * DM + c];
            const float dot = wave_sum(a), xr = args.in[0][(size_t)r * DM + c], got = h2f(WSP(half_t, WS_H1) + (size_t)r * DM + c); a = dot + xr;
            if (lane == 0) { dbg_flag(ctl, 16, got, a);
                if ((wid == 0 && i == 0) || (wid == 3 && i == 3)) { int hcode = 9; auto near = [](float p, float q) { return fabsf(p - q) <= 0.03f + 0.03f * fabsf(q); };
                    if (near(got, dot + xr)) hcode = 1; else if (near(got, dot)) hcode = 2; else if (near(got, xr)) hcode = 3; else if (near(got, 2.f * xr + dot)) hcode = 4; else if (!(got == got)) hcode = 5; else if (near(got, 0.f)) hcode = 6;
                    atomicAdd(ctl + CW_DBG + 1, (unsigned)(wid == 0 ? 10 * hcode : hcode)); } } } }
    if (which == 7) { const half_t* h1 = WSP(half_t, WS_H1) + (size_t)r * DM; float ss = 0.f; for (int k = lane; k < DM; k += 64) { const float a = h2f(h1 + k); ss += a * a; } ss = wave_sum(ss); const float rs = 1.f / sqrtf(ss / DM + NORM_EPS);
        const int* c4 = dbgt_23_c4;
        for (int i = 0; i < 4; ++i) { const int c = c4[i]; float a = 0.f; for (int k = lane; k < DM; k += 64) a += h2f(h1 + k) * args.in[20][k] * args.in[21][(size_t)k * DFF + c];
            a = fmaxf(wave_sum(a) * rs, 0.f); if (lane == 0) dbg_flag(ctl, 17, h2f(WSP(half_t, WS_A2) + (size_t)r * DFF + c), a * a); } }
    if (which == 8) { const half_t* a2 = WSP(half_t, WS_A2) + (size_t)r * DFF;
        for (int i = 0; i < 4; ++i) { const int c = cols[i]; float a = 0.f; for (int k = lane; k < DFF; k += 64) a += h2f(a2 + k) * args.in[22][(size_t)k * DM + c];
            a = wave_sum(a) + h2f(WSP(half_t, WS_H1) + (size_t)r * DM + c); if (lane == 0) dbg_flag(ctl, 18, h2f(WSP(half_t, WS_H2) + (size_t)r * DM + c), a); } }
    if (which == 9) { const half_t* h2 = WSP(half_t, WS_H2) + (size_t)r * DM; float ss = 0.f; for (int k = lane; k < DM; k += 64) { const float a = h2f(h2 + k); ss += a * a; } ss = wave_sum(ss); const float rs = 1.f / sqrtf(ss / DM + NORM_EPS);
        for (int i = 0; i < 4; ++i) { const int c = cols[i]; if (lane == 0) dbg_flag(ctl, 19, args.out[(size_t)r * DM + c], h2f(h2 + c) * rs * args.in[23][c]); } }
}
__global__ void __launch_bounds__(512) dbg_fill(Args args) {
    unsigned char* ws = args.ws; unsigned* ctl = WSP(unsigned, WS_CTL);
#ifndef DBG_SKIP
#define DBG_SKIP 0
#endif
    const unsigned m = __hip_atomic_load(ctl + CW_DBG, __ATOMIC_RELAXED, __HIP_MEMORY_SCOPE_AGENT) & ~((1u << DBG_SKIP) - 1u);
#ifdef DBG_STAMP
    const unsigned long long* ts = (const unsigned long long*)(ctl + 160); (void)m;
    const int code = (int)((ts[DBG_T1B] - ts[DBG_T1A]) / 4000ull);
    const float vbig = (float)((ts[DBG_T2B] - ts[DBG_T2A]) / 100ull);
    if (blockIdx.x == 0 && threadIdx.x == 0) { args.out[(size_t)MROWS * DM - 1] = vbig; }
#elif defined(DBG_VALUE)
    const int code = (int)__hip_atomic_load(ctl + CW_DBG + 2, __ATOMIC_RELAXED, __HIP_MEMORY_SCOPE_AGENT); (void)m;
#else
    const int code = m ? __builtin_ctz(m) : 0;
#endif
    const float a = sqrtf((float)code);
#ifdef DBG_STAMP
    const size_t nfill = (size_t)MROWS * DM / 4 - 1;
    if (blockIdx.x == 0 && threadIdx.x == 1) { args.out[(size_t)MROWS * DM - 4] = a; args.out[(size_t)MROWS * DM - 3] = a; args.out[(size_t)MROWS * DM - 2] = a; }
#else
    const size_t nfill = (size_t)MROWS * DM / 4;
#endif
    for (size_t i = (size_t)blockIdx.x * 512 + threadIdx.x; i < nfill; i += (size_t)gridDim.x * 512) ((f32x4*)args.out)[i] = (f32x4){a, a, a, a};
}
#endif

extern "C" void kernel_launch(void* const* d_in, const int* in_sizes, int n_in, void* d_out, int out_size, void* d_ws, size_t ws_size, hipStream_t stream) {
    static int grid = 0;
    if (grid == 0) {
        if (n_in != 24 || out_size != MROWS * DM || ws_size < WS_END) { fprintf(stderr, "kernel_launch: unexpected problem (n_in %d, out %d, ws %zu)\n", n_in, out_size, ws_size); grid = -1; return; }
        int dev = 0, cus = 0, per_cu = 0;
        if (hipGetDevice(&dev) != hipSuccess || hipDeviceGetAttribute(&cus, hipDeviceAttributeMultiprocessorCount, dev) != hipSuccess) { grid = -1; return; }
        if (hipFuncSetAttribute((const void*)hymba_fwd, hipFuncAttributeMaxDynamicSharedMemorySize, LDS_BYTES) != hipSuccess) { fprintf(stderr, "kernel_launch: hipFuncSetAttribute failed\n"); grid = -1; return; }
        if (hipOccupancyMaxActiveBlocksPerMultiprocessor(&per_cu, (const void*)hymba_fwd, 512, LDS_BYTES) != hipSuccess || per_cu < 1) fprintf(stderr, "kernel_launch: occupancy query says %d\n", per_cu);
        (void)hipGetLastError();
        grid = cus;
#if DBG_CHECK
        (void)hipFuncSetAttribute((const void*)dbg_checks_a, hipFuncAttributeMaxDynamicSharedMemorySize, 98304);
#endif
    }
    if (grid < 0) return;
    (void)hipMemsetAsync((char*)d_ws + WS_CTL, 0, CTL_ZERO_BYTES, stream);
    (void)hipMemsetAsync((char*)d_ws + WS_EX, 0, EX_BYTES, stream);
    Args a{};
    for (int i = 0; i < 24; ++i) a.in[i] = (const float*)d_in[i];
    a.out = (float*)d_out; a.ws = (unsigned char*)d_ws;
#if DBG_CHECK == 1
    a.ph_lo = 0; a.ph_hi = 5; a.li = 0; hipLaunchKernelGGL(hymba_fwd, dim3(grid), dim3(512), LDS_BYTES, stream, a);
    hipLaunchKernelGGL(dbg_checks_a, dim3(1), dim3(512), 98304, stream, a);
    hipLaunchKernelGGL(dbg_fill, dim3(1024), dim3(512), 0, stream, a);
#elif DBG_CHECK == 2
    a.ph_lo = 0; a.ph_hi = 7; a.li = 0; hipLaunchKernelGGL(hymba_fwd, dim3(grid), dim3(512), LDS_BYTES, stream, a);
    hipLaunchKernelGGL(dbg_checks_b, dim3(1), dim3(512), 0, stream, a, 6);
    a.ph_lo = 7; a.ph_hi = 8; a.li = 1; hipLaunchKernelGGL(hymba_fwd, dim3(grid), dim3(512), LDS_BYTES, stream, a);
    hipLaunchKernelGGL(dbg_checks_b, dim3(1), dim3(512), 0, stream, a, 7);
    a.ph_lo = 8; a.ph_hi = 9; a.li = 2; hipLaunchKernelGGL(hymba_fwd, dim3(grid), dim3(512), LDS_BYTES, stream, a);
    hipLaunchKernelGGL(dbg_checks_b, dim3(1), dim3(512), 0, stream, a, 8);
    a.ph_lo = 9; a.ph_hi = 10; a.li = 3; hipLaunchKernelGGL(hymba_fwd, dim3(grid), dim3(512), LDS_BYTES, stream, a);
    hipLaunchKernelGGL(dbg_checks_b, dim3(1), dim3(512), 0, stream, a, 9);
    hipLaunchKernelGGL(dbg_fill, dim3(1024), dim3(512), 0, stream, a);
#elif DBG_CHECK == 3
    a.ph_lo = 0; a.ph_hi = 10; a.li = 0; hipLaunchKernelGGL(hymba_fwd, dim3(grid), dim3(512), LDS_BYTES, stream, a);
    hipLaunchKernelGGL(dbg_fill, dim3(1024), dim3(512), 0, stream, a);
#elif MK_N_LAUNCHES == 1
    a.ph_lo = 0; a.ph_hi = 10; a.li = 0;
    hipLaunchKernelGGL(hymba_fwd, dim3(grid), dim3(512), LDS_BYTES, stream, a);
#else
    for (int p = 0; p < 10; ++p) { a.ph_lo = p; a.ph_hi = p + 1; a.li = p; hipLaunchKernelGGL(hymba_fwd, dim3(grid), dim3(512), LDS_BYTES, stream, a); }
#endif
}
```
